# Optimizing an MI355X kernel written in HIP

```python
import jax, jax.numpy as jnp
from jax import lax
import numpy as np

D_MODEL = 1024
BATCH = 4
SEQ = 8192
DEPTH = 4

CHUNK = 128
FOURIER_W = D_MODEL // 4
N_FGROUPS = 4
ML_W = 3 * D_MODEL // 8
RET_W = D_MODEL - FOURIER_W - ML_W
D_MIX = FOURIER_W + ML_W + RET_W
ML_HEADS = 4
ML_DV = ML_W // ML_HEADS
ML_DK = ML_DV // 2
RET_HEADS = 4
RET_DV = RET_W // RET_HEADS
RET_DK = RET_DV // 2
CONV_W = 3
ROPE_BASE = 10000.0
RET_GAMMA_EXP0 = 5.0
RET_BWD_EXP_OFFSET = 0.5
N_EXPERTS = 32
TOP_K = 4
D_FF = D_MODEL
SWIGLU_ALPHA = 1.702
SWIGLU_LIMIT = 7.0
MOE_BLOCK = 128
DEEPNORM_ALPHA = (2.0 * DEPTH) ** 0.25
DEEPNORM_BETA = (8.0 * DEPTH) ** -0.25
LN_EPS = 1e-5

COL_F = 0
COL_MQK = COL_F + FOURIER_W
COL_MV = COL_MQK + 2 * ML_HEADS * ML_DK
COL_MO = COL_MV + ML_W
COL_MG = COL_MO + ML_W
COL_RQ = COL_MG + 4 * ML_HEADS
COL_RK = COL_RQ + RET_HEADS * RET_DK
COL_RV = COL_RK + RET_HEADS * RET_DK
COL_RG = COL_RV + RET_W
PROJ_W = COL_RG + RET_W

kernel_name = "hybrid_fnet_mlstm_retention_moe_deepnorm"


def _layernorm(x, g, b):
    xf = x.astype(jnp.float32)
    mu = xf.mean(-1, keepdims=True)
    var = jnp.square(xf - mu).mean(-1, keepdims=True)
    return ((xf - mu) * lax.rsqrt(var + LN_EPS) * g + b).astype(x.dtype)


def _head_norm(h, w):
    mu = h.mean(-1, keepdims=True)
    var = jnp.square(h - mu).mean(-1, keepdims=True)
    y = (h - mu) * lax.rsqrt(var + LN_EPS)
    return y.reshape(h.shape[0], h.shape[1], -1) * w


def _to_chunks(t):
    Bb, S, H, d = t.shape
    return t.reshape(Bb, S // CHUNK, CHUNK, H, d).transpose(0, 3, 1, 2, 4)


def _gate_chunks(t):
    Bb, S, H = t.shape
    return t.reshape(Bb, S // CHUNK, CHUNK, H).transpose(0, 3, 1, 2)


def _from_chunks(t):
    Bb, H, N, L, d = t.shape
    return t.transpose(0, 2, 3, 1, 4).reshape(Bb, N * L, H, d)


def _centred_dwconv(u, w):
    pad = CONV_W // 2
    S = u.shape[1]
    up = jnp.pad(u, ((0, 0), (pad, pad), (0, 0)))
    return sum(up[:, j:j + S] * w[j] for j in range(CONV_W))


def _rotary(t):
    S, d = t.shape[1], t.shape[3]
    inv = 1.0 / (ROPE_BASE ** (jnp.arange(0, d, 2, dtype=jnp.float32) / d))
    ang = jnp.arange(S, dtype=jnp.float32)[:, None] * inv[None, :]
    cos = jnp.cos(ang)[None, :, None, :]
    sin = jnp.sin(ang)[None, :, None, :]
    t1, t2 = t[..., 0::2], t[..., 1::2]
    return jnp.stack([t1 * cos - t2 * sin, t1 * sin + t2 * cos], axis=-1).reshape(t.shape)


def _fourier_mixer(u):
    Bb, S, _ = u.shape
    ug = u.astype(jnp.float32).reshape(Bb, S, N_FGROUPS, FOURIER_W // N_FGROUPS)
    y = jnp.fft.fft2(ug, axes=(1, 3), norm="ortho").real
    return y.reshape(Bb, S, FOURIER_W)


def _mlstm_chunkwise(q, k, v, i_pre, f_pre):
    qc, kc, vc = _to_chunks(q), _to_chunks(k), _to_chunks(v)
    ic = _gate_chunks(i_pre)
    a = jnp.cumsum(jax.nn.log_sigmoid(_gate_chunks(f_pre)), axis=-1)
    a_end = a[..., -1]
    w_key = a_end[..., None] - a + ic
    m_chunk = w_key.max(-1)
    p = jnp.exp(w_key - m_chunk[..., None])
    c_chunk = jnp.einsum('bhnsv,bhnsk->bhnvk', vc * p[..., None], kc)
    n_chunk = jnp.einsum('bhnsk,bhns->bhnk', kc, p)

    def step(carry, xs):
        c, n, m = carry
        ae, mc, cc, nc = xs
        m_new = jnp.maximum(ae + m, mc)
        s_prev = jnp.exp(ae + m - m_new)
        s_cur = jnp.exp(mc - m_new)
        c_new = s_prev[..., None, None] * c + s_cur[..., None, None] * cc
        n_new = s_prev[..., None] * n + s_cur[..., None] * nc
        return (c_new, n_new, m_new), (c, n, m)

    Bb, H = qc.shape[:2]
    dk, dv = qc.shape[-1], vc.shape[-1]
    init = (jnp.zeros((Bb, H, dv, dk), jnp.float32), jnp.zeros((Bb, H, dk), jnp.float32),
            jnp.zeros((Bb, H), jnp.float32))
    xs = tuple(jnp.moveaxis(t, 2, 0) for t in (a_end, m_chunk, c_chunk, n_chunk))
    _, (c_prev, n_prev, m_prev) = lax.scan(step, init, xs)
    c_prev = jnp.moveaxis(c_prev, 0, 2)
    n_prev = jnp.moveaxis(n_prev, 0, 2)
    m_prev = jnp.moveaxis(m_prev, 0, 2)

    inter_log = a + m_prev[..., None]
    causal = jnp.tril(jnp.ones((CHUNK, CHUNK), dtype=bool))
    d_log = jnp.where(causal, a[..., :, None] - a[..., None, :] + ic[..., None, :], -jnp.inf)
    m_t = jnp.maximum(inter_log, d_log.max(-1))
    scale_inter = jnp.exp(inter_log - m_t)
    scores = jnp.einsum('bhntk,bhnsk->bhnts', qc, kc) * jnp.exp(d_log - m_t[..., None])
    num = (jnp.einsum('bhnts,bhnsv->bhntv', scores, vc)
           + scale_inter[..., None] * jnp.einsum('bhnvk,bhntk->bhntv', c_prev, qc))
    den = scores.sum(-1) + scale_inter * jnp.einsum('bhnk,bhntk->bhnt', n_prev, qc)
    h = num / jnp.maximum(jnp.abs(den), jnp.exp(-m_t))[..., None]
    return _from_chunks(h)


def _mlstm_mixer(qk, v, o, gates, norm_w):
    Bb, S, _ = v.shape
    q, k = jnp.split(qk, 2, axis=-1)
    q = q.reshape(Bb, S, ML_HEADS, ML_DK)
    k = k.reshape(Bb, S, ML_HEADS, ML_DK) * ML_DK ** -0.5
    v = v.reshape(Bb, S, ML_HEADS, ML_DV)
    i_f, f_f, i_b, f_b = jnp.split(gates, 4, axis=-1)
    fl = lambda t: jnp.flip(t, axis=1)
    h_fwd = _mlstm_chunkwise(q, k, v, i_f, f_f)
    h_bwd = fl(_mlstm_chunkwise(fl(q), fl(k), fl(v), fl(i_b), fl(f_b)))
    h = jax.nn.sigmoid(o).reshape(Bb, S, ML_HEADS, ML_DV) * (h_fwd + h_bwd)
    return _head_norm(h, norm_w)


def _ret_log_gamma(offset):
    return jnp.log1p(-jnp.exp2(-(RET_GAMMA_EXP0 + offset) - jnp.arange(RET_HEADS, dtype=jnp.float32)))


def _retention_chunkwise(q, k, v, log_gamma, inclusive):
    qc, kc, vc = _to_chunks(q), _to_chunks(k), _to_chunks(v)
    idx = jnp.arange(CHUNK, dtype=jnp.float32)
    lg = log_gamma[:, None]
    diff = idx[:, None] - idx[None, :]
    mask = (diff >= 0) if inclusive else (diff > 0)
    decay = jnp.where(mask[None], jnp.exp(log_gamma[:, None, None] * jnp.maximum(diff, 0.0)[None]), 0.0)
    w_key = jnp.exp(lg * (CHUNK - 1 - idx))
    w_inter = jnp.exp(lg * (idx + 1.0))
    g_chunk = jnp.exp(log_gamma * CHUNK)
    s_chunk = jnp.einsum('bhnsv,bhnsk,hs->bhnvk', vc, kc, w_key)

    def step(state, s_c):
        return g_chunk[None, :, None, None] * state + s_c, state

    Bb, H = qc.shape[:2]
    init = jnp.zeros((Bb, H, vc.shape[-1], kc.shape[-1]), jnp.float32)
    _, s_prev = lax.scan(step, init, jnp.moveaxis(s_chunk, 2, 0))
    s_prev = jnp.moveaxis(s_prev, 0, 2)
    scores = jnp.einsum('bhntk,bhnsk->bhnts', qc, kc) * decay[None, :, None]
    y = (jnp.einsum('bhnts,bhnsv->bhntv', scores, vc)
         + w_inter[None, :, None, :, None] * jnp.einsum('bhnvk,bhntk->bhntv', s_prev, qc))
    return _from_chunks(y)


def _retention_mixer(q, k, v, g, norm_w):
    Bb, S, _ = q.shape
    q = _rotary(q.reshape(Bb, S, RET_HEADS, RET_DK))
    k = _rotary(k.reshape(Bb, S, RET_HEADS, RET_DK)) * RET_DK ** -0.5
    v = v.reshape(Bb, S, RET_HEADS, RET_DV)
    fl = lambda t: jnp.flip(t, axis=1)
    y_fwd = _retention_chunkwise(q, k, v, _ret_log_gamma(0.0), True)
    y_bwd = fl(_retention_chunkwise(fl(q), fl(k), fl(v), _ret_log_gamma(RET_BWD_EXP_OFFSET), False))
    return jax.nn.silu(g) * _head_norm(y_fwd + y_bwd, norm_w)


def _moe(h, w_router, b_router, w1, b1, w2, b2):
    Bb, S, D = h.shape
    T = Bb * S
    xt = h.reshape(T, D)
    logits = (xt @ w_router + b_router).astype(jnp.float32)
    top_v, top_i = lax.top_k(logits, TOP_K)
    gates = jax.nn.softmax(top_v, axis=-1)
    N = T * TOP_K
    e_flat = top_i.reshape(N)
    tok_flat = jnp.arange(N, dtype=jnp.int32) // TOP_K
    order = jnp.argsort(e_flat)
    e_sorted, tok_sorted = e_flat[order], tok_flat[order]
    g_sorted = gates.reshape(N)[order]
    sizes = jnp.bincount(e_flat, length=N_EXPERTS)
    starts = jnp.cumsum(sizes) - sizes
    psizes = (sizes + MOE_BLOCK - 1) // MOE_BLOCK * MOE_BLOCK
    pends = jnp.cumsum(psizes)
    pstarts = pends - psizes
    pos = pstarts[e_sorted] + jnp.arange(N, dtype=jnp.int32) - starts[e_sorted]
    P = N + N_EXPERTS * MOE_BLOCK
    NB = P // MOE_BLOCK
    src_tok = jnp.zeros((P,), jnp.int32).at[pos].set(tok_sorted)
    gate_pad = jnp.zeros((P,), jnp.float32).at[pos].set(g_sorted)
    block_e = jnp.minimum(jnp.searchsorted(pends, jnp.arange(NB, dtype=jnp.int32) * MOE_BLOCK, side='right'),
                          N_EXPERTS - 1)
    x_pad = xt[src_tok].reshape(NB, MOE_BLOCK, D)

    def expert_block(args):
        xb, e = args
        hc = xb @ w1[e] + b1[e]
        gate, up = hc[:, :D_FF], hc[:, D_FF:]
        gate = jnp.minimum(gate, SWIGLU_LIMIT)
        up = jnp.clip(up, -SWIGLU_LIMIT, SWIGLU_LIMIT)
        glu = gate * jax.nn.sigmoid(SWIGLU_ALPHA * gate)
        return ((up + 1.0) * glu) @ w2[e] + b2[e]

    y_pad = lax.map(expert_block, (x_pad, block_e)).reshape(P, D)
    y = jnp.zeros((T, D), h.dtype).at[src_tok].add(y_pad * gate_pad[:, None].astype(h.dtype))
    return y.reshape(Bb, S, D)


def setup_inputs(seed: int = 0) -> dict:
    key = jax.random.key(seed)
    ks = jax.random.split(key, 20)
    f32 = jnp.float32

    def nrm(k, shape, scale):
        return jax.random.normal(k, shape, f32) * scale

    x = nrm(ks[0], (BATCH, SEQ, D_MODEL), 1.0)
    emb_ln_g = 1.0 + nrm(ks[1], (D_MODEL,), 0.01)
    emb_ln_b = nrm(ks[2], (D_MODEL,), 0.01)
    w_in = nrm(ks[3], (DEPTH, D_MODEL, PROJ_W), D_MODEL ** -0.5)
    b_in = nrm(ks[4], (DEPTH, PROJ_W), 0.01)
    f_bias = jnp.linspace(3.0, 6.0, ML_HEADS, dtype=f32)
    b_in = b_in.at[:, COL_MG + ML_HEADS:COL_MG + 2 * ML_HEADS].add(f_bias)
    b_in = b_in.at[:, COL_MG + 3 * ML_HEADS:COL_MG + 4 * ML_HEADS].add(f_bias)
    conv_w = nrm(ks[5], (DEPTH, CONV_W, 2 * ML_HEADS * ML_DK), CONV_W ** -0.5)
    ml_norm_w = 1.0 + nrm(ks[6], (DEPTH, ML_W), 0.01)
    ret_norm_w = 1.0 + nrm(ks[7], (DEPTH, RET_W), 0.01)
    w_out = nrm(ks[8], (DEPTH, D_MIX, D_MODEL), DEEPNORM_BETA * D_MIX ** -0.5)
    ln1_g = 1.0 + nrm(ks[9], (DEPTH, D_MODEL), 0.01)
    ln1_b = nrm(ks[10], (DEPTH, D_MODEL), 0.01)
    w_router = nrm(ks[11], (DEPTH, D_MODEL, N_EXPERTS), D_MODEL ** -0.5)
    b_router = nrm(ks[12], (DEPTH, N_EXPERTS), 0.01)
    w1 = nrm(ks[13], (DEPTH, N_EXPERTS, D_MODEL, 2 * D_FF), D_MODEL ** -0.5)
    b1 = nrm(ks[14], (DEPTH, N_EXPERTS, 2 * D_FF), 0.01)
    w2 = nrm(ks[15], (DEPTH, N_EXPERTS, D_FF, D_MODEL), DEEPNORM_BETA * D_FF ** -0.5)
    b2 = nrm(ks[16], (DEPTH, N_EXPERTS, D_MODEL), 0.01)
    ln2_g = 1.0 + nrm(ks[17], (DEPTH, D_MODEL), 0.01)
    ln2_b = nrm(ks[18], (DEPTH, D_MODEL), 0.01)
    return {"x": x, "emb_ln_g": emb_ln_g, "emb_ln_b": emb_ln_b, "w_in": w_in, "b_in": b_in,
            "conv_w": conv_w, "ml_norm_w": ml_norm_w, "ret_norm_w": ret_norm_w, "w_out": w_out,
            "ln1_g": ln1_g, "ln1_b": ln1_b, "w_router": w_router, "b_router": b_router,
            "w1": w1, "b1": b1, "w2": w2, "b2": b2, "ln2_g": ln2_g, "ln2_b": ln2_b}


def reference(x, emb_ln_g, emb_ln_b, w_in, b_in, conv_w, ml_norm_w, ret_norm_w, w_out,
              ln1_g, ln1_b, w_router, b_router, w1, b1, w2, b2, ln2_g, ln2_b):
    x = _layernorm(x, emb_ln_g, emb_ln_b)
    for l in range(DEPTH):
        proj = (x @ w_in[l] + b_in[l]).astype(jnp.float32)
        y_f = _fourier_mixer(proj[..., COL_F:COL_MQK])
        qk_m = jax.nn.silu(_centred_dwconv(proj[..., COL_MQK:COL_MV], conv_w[l]))
        y_m = _mlstm_mixer(qk_m, proj[..., COL_MV:COL_MO], proj[..., COL_MO:COL_MG],
                           proj[..., COL_MG:COL_RQ], ml_norm_w[l])
        y_r = _retention_mixer(proj[..., COL_RQ:COL_RK], proj[..., COL_RK:COL_RV],
                               proj[..., COL_RV:COL_RG], proj[..., COL_RG:PROJ_W], ret_norm_w[l])
        mix = jnp.concatenate([y_f, y_m, y_r], axis=-1).astype(x.dtype) @ w_out[l]
        x = _layernorm(DEEPNORM_ALPHA * x + mix, ln1_g[l], ln1_b[l])
        moe = _moe(x, w_router[l], b_router[l], w1[l], b1[l], w2[l], b2[l])
        x = _layernorm(DEEPNORM_ALPHA * x + moe, ln2_g[l], ln2_b[l])
    return x
```

```cpp
#include <hip/hip_runtime.h>
#include <cstdio>
#include <cstdint>

#ifndef MK_MULTI
#define MK_MULTI 1
#endif

#define LAS __attribute__((address_space(3)))
#define GAS __attribute__((address_space(1)))
typedef unsigned short bf16_t;
typedef short bf16x8 __attribute__((ext_vector_type(8)));
typedef float f32x4 __attribute__((ext_vector_type(4)));
typedef float f32x2 __attribute__((ext_vector_type(2)));
typedef unsigned u32x4 __attribute__((ext_vector_type(4)));
typedef unsigned u32x2 __attribute__((ext_vector_type(2)));

constexpr int D = 1024, NB = 4, S = 8192, T = NB * S, NL = 4;
constexpr int CH = 128, NCH = S / CH;
constexpr int PW = 2576, PWP = 2816;
constexpr int COL_F = 0, COL_MQK = 256, COL_MV = 640, COL_MO = 1024, COL_MG = 1408, COL_RQ = 1424, COL_RK = 1616, COL_RV = 1808, COL_RG = 2192;
constexpr int NH = 4, DK = 48, DV = 96;
constexpr int NE = 32, TOPK = 4, FF = 1024;
constexpr int ROWS_PAD = T * TOPK + NE * 256;
constexpr int MT_MAX = ROWS_PAD / 256;
constexpr float LN_EPS = 1e-5f;
constexpr float DN_ALPHA = 1.6817928305074290f;
constexpr float SW_ALPHA = 1.702f, SW_LIMIT = 7.0f;

constexpr size_t MiB = 1u << 20;
constexpr size_t WS_CTL = 0, CTL_BYTES = 1 * MiB;
constexpr size_t WS_WIN = 1 * MiB;
constexpr size_t WS_WOUT = WS_WIN + 22 * MiB;
constexpr size_t WS_W1 = WS_WOUT + 8 * MiB;
constexpr size_t WS_W2 = WS_W1 + 512 * MiB;
constexpr size_t WS_BIN = WS_W2 + 256 * MiB;
constexpr size_t WS_ROT = WS_BIN + 1 * MiB;
constexpr size_t WS_XF = WS_ROT + 2 * MiB;
constexpr size_t WS_XB = WS_XF + 128 * MiB;
constexpr size_t WS_P = WS_XB + 64 * MiB;
constexpr size_t WS_MIX = WS_P + 176 * MiB;
constexpr size_t WS_PRE = WS_MIX + 64 * MiB;
constexpr size_t WS_X1F = WS_PRE + 128 * MiB;
constexpr size_t WS_X1B = WS_X1F + 128 * MiB;
constexpr size_t WS_XS = WS_X1B + 64 * MiB;
constexpr size_t WS_H = WS_XS + 272 * MiB;
constexpr size_t WS_Y = WS_H + 272 * MiB;
constexpr size_t WS_TKE = WS_Y + 272 * MiB;
constexpr size_t WS_TKG = WS_TKE + 1 * MiB;
constexpr size_t WS_TKS = WS_TKG + 1 * MiB;
constexpr size_t WS_LIST = WS_TKS + 1 * MiB;
constexpr size_t WS_MC = WS_LIST + 4 * MiB;
constexpr size_t WS_RS = WS_MC + 36 * MiB;
constexpr size_t WS_MN = WS_RS + 36 * MiB;
constexpr size_t WS_MSC = WS_MN + 1 * MiB;
constexpr size_t WS_UCS = WS_MSC + 1 * MiB;
constexpr size_t WS_END = WS_UCS + 64 * MiB;

constexpr int CW_TMO = 0;
constexpr int CW_BAR = 4096;
constexpr int CW_CNT = 16384;

constexpr int RING_BYTES = 131072;
constexpr int MISC_OFF = RING_BYTES;
constexpr int LDS_BYTES = 147456;

__device__ __forceinline__ unsigned f2bf(float f) { unsigned u = __builtin_bit_cast(unsigned, f); return (u + 0x7fffu + ((u >> 16) & 1u)) >> 16; }
__device__ __forceinline__ unsigned pk2(float lo, float hi) { return f2bf(lo) | (f2bf(hi) << 16); }
__device__ __forceinline__ float bf2f(bf16_t b) { return __builtin_bit_cast(float, (unsigned)b << 16); }
__device__ __forceinline__ float wave_sum(float v) {
#pragma unroll
    for (int o = 1; o < 64; o <<= 1) v += __shfl_xor(v, o);
    return v;
}
__device__ __forceinline__ float wave_max(float v) {
#pragma unroll
    for (int o = 1; o < 64; o <<= 1) v = fmaxf(v, __shfl_xor(v, o));
    return v;
}
__device__ __forceinline__ float sigmoidf_(float x) { return 1.0f / (1.0f + __expf(-x)); }
__device__ __forceinline__ float siluf_(float x) { return x / (1.0f + __expf(-x)); }
__device__ __forceinline__ float logsigmoidf_(float x) { return x >= 0.f ? -log1pf(__expf(-x)) : x - log1pf(__expf(x)); }

namespace pg8 {
constexpr int BM = 256, BK = 64, HALF = 128, HTB = HALF * BK * 2, STAGE_BYTES = 8 * HTB;
__host__ __device__ __forceinline__ int lds_byte(int r, int c) { const int st = (r >> 4) * 2 + (c >> 5), rr = r & 15, cc = c & 31, ob = rr * 64 + cc * 2; return st * 1024 + (ob ^ (((ob >> 9) & 1) << 5)); }
__host__ __device__ __forceinline__ void stage_rc(int b, int& R, int& C) { const int st = b / 1024, sb = b % 1024, swz = sb ^ (((sb >> 9) & 1) << 5); R = (st >> 1) * 16 + swz / 64; C = (st & 1) * 32 + (swz % 64) / 2; }
__host__ __device__ __forceinline__ int perm32(int rho) { const int n = rho >> 4, i = rho & 15; return 8 * (i >> 2) + 4 * n + (i & 3); }
struct Unit { int pm, pn, e; };
__device__ __forceinline__ unsigned cvt_pk_bf16(float lo, float hi) { unsigned r; asm volatile("v_cvt_pk_bf16_f32 %0, %1, %2" : "=v"(r) : "v"(lo), "v"(hi)); return r; }

template <class Epi, class Sched, bool ALIGN_EPI = false, bool SP2 = false>
__device__ __forceinline__ void gemm_phase(LAS unsigned char* lds, const int K, const Sched& S, const Epi& E) {
    const int tid = threadIdx.x, wid = __builtin_amdgcn_readfirstlane(tid >> 6), lane = tid & 63, wr = wid >> 2, wc = wid & 3, fr = lane & 15, fq = lane >> 4;
    const int nt = K / BK;
    unsigned voffA[2], voffB[2];
#pragma unroll
    for (int i = 0; i < 2; ++i) { int R, C; stage_rc(tid * 16 + i * 8192, R, C); const int Rb = Epi::PERM ? ((R & ~31) + perm32(R & 31)) : R;
        voffA[i] = (unsigned)(R * K + C) * 2u; voffB[i] = (unsigned)(Rb * K + C) * 2u; }
    const size_t kstep = (size_t)(BK * 2);
    const size_t hstep = (size_t)HALF * K * 2;
    const unsigned ldsw = (unsigned)wid * 1024u;
    const int aoff = lds_byte(wr * 64 + fr, fq * 8), boff = lds_byte(wc * 32 + fr, fq * 8);
#define PG8_SA(b, h) (((b) * 2 + (h)) * HTB)
#define PG8_SB(b, h) ((4 + (b) * 2 + (h)) * HTB)
#define PG8_STAGE(bufoff, gbase, voff) do { _Pragma("unroll") for (int _i = 0; _i < 2; ++_i) \
        __builtin_amdgcn_global_load_lds((const unsigned*)((const char*)(gbase) + (voff)[_i]), (LAS unsigned*)(lds + (bufoff) + ldsw + _i * 8192), 16, 0, 0); } while (0)
#define PG8_LDA(dst, b, h) do { _Pragma("unroll") for (int m = 0; m < 4; ++m) _Pragma("unroll") for (int k = 0; k < 2; ++k) dst[m][k] = *(const LAS bf16x8*)(lds + PG8_SA(b, h) + aoff + m * 2048 + k * 1024); } while (0)
#define PG8_LDB(dst, b, h) do { _Pragma("unroll") for (int n = 0; n < 2; ++n) _Pragma("unroll") for (int k = 0; k < 2; ++k) dst[n][k] = *(const LAS bf16x8*)(lds + PG8_SB(b, h) + boff + n * 2048 + k * 1024); } while (0)
#define PG8_MMA(ai, bj, At, Bt) do { __builtin_amdgcn_s_setprio(1); _Pragma("unroll") for (int m = 0; m < 4; ++m) _Pragma("unroll") for (int n = 0; n < 2; ++n) _Pragma("unroll") for (int k = 0; k < 2; ++k) \
        acc[ai][bj][m][n] = __builtin_amdgcn_mfma_f32_16x16x32_bf16(Bt[n][k], At[m][k], acc[ai][bj][m][n], 0, 0, 0); __builtin_amdgcn_s_setprio(0); } while (0)
#define PG8_WAIT_V(n) asm volatile("s_waitcnt vmcnt(" #n ")" ::: "memory")
#define PG8_WAIT_L(n) asm volatile("s_waitcnt lgkmcnt(" #n ")" ::: "memory")
#define PG8_BAR __builtin_amdgcn_s_barrier()
#define PG8_SCHED __builtin_amdgcn_sched_barrier(0)
    Unit cur, nxt; int ui = 0;
    if (!S.next(0, cur)) return;
    f32x4 acc[2][2][4][2];
#pragma unroll
    for (int a = 0; a < 2; ++a)
#pragma unroll
        for (int b = 0; b < 2; ++b)
#pragma unroll
            for (int m = 0; m < 4; ++m)
#pragma unroll
                for (int n = 0; n < 2; ++n) acc[a][b][m][n] = (f32x4){0.f, 0.f, 0.f, 0.f};
    bf16x8 At[4][2], B0[2][2], B1[2][2];
    const char* cA = S.a_base(cur); const char* cB = S.b_base(cur);
    if constexpr (SP2) {
        PG8_STAGE(PG8_SB(0, 0), cB, voffB); PG8_STAGE(PG8_SB(0, 1), cB + hstep, voffB); PG8_STAGE(PG8_SA(0, 0), cA, voffA); PG8_STAGE(PG8_SA(0, 1), cA + hstep, voffA);
        if (wr == 1) PG8_BAR;
        PG8_WAIT_V(2); PG8_BAR;
        PG8_STAGE(PG8_SB(1, 0), cB + kstep, voffB); PG8_STAGE(PG8_SA(1, 0), cA + kstep, voffA); PG8_STAGE(PG8_SB(1, 1), cB + hstep + kstep, voffB);
        PG8_WAIT_V(6); PG8_BAR;
    } else {
        PG8_STAGE(PG8_SB(0, 0), cB, voffB); PG8_STAGE(PG8_SA(0, 0), cA, voffA); PG8_STAGE(PG8_SB(0, 1), cB + hstep, voffB); PG8_STAGE(PG8_SA(0, 1), cA + hstep, voffA);
        if (wr == 1) PG8_BAR;
        PG8_WAIT_V(4); PG8_BAR;
        PG8_STAGE(PG8_SB(1, 0), cB + kstep, voffB); PG8_STAGE(PG8_SA(1, 0), cA + kstep, voffA); PG8_STAGE(PG8_SB(1, 1), cB + hstep + kstep, voffB);
        PG8_WAIT_V(6); PG8_BAR;
    }
    for (;;) {
        const bool has_next = S.next(ui + 1, nxt);
        const char* nA = has_next ? S.a_base(nxt) : cA; const char* nB = has_next ? S.b_base(nxt) : cB;
        for (int t = 0; t < nt; t += 2) {
            const bool last = (t == nt - 2);
            const char* a1 = cA + (size_t)(t + 1) * kstep;
            const char* a2 = last ? nA : cA + (size_t)(t + 2) * kstep; const char* b2 = last ? nB : cB + (size_t)(t + 2) * kstep;
            const char* a3 = a2 + kstep; const char* b3 = b2 + kstep;
            if constexpr (SP2) {
            PG8_LDB(B0, 0, 0); PG8_LDB(B1, 0, 1); PG8_SCHED; PG8_LDA(At, 0, 0); PG8_STAGE(PG8_SA(1, 1), a1 + hstep, voffA);
            PG8_WAIT_V(8); PG8_WAIT_L(0); PG8_BAR; PG8_MMA(0, 0, At, B0); PG8_MMA(0, 1, At, B1); PG8_BAR; PG8_SCHED;
            PG8_LDA(At, 0, 1); PG8_STAGE(PG8_SB(0, 0), b2, voffB); PG8_STAGE(PG8_SB(0, 1), b2 + hstep, voffB); PG8_STAGE(PG8_SA(0, 0), a2, voffA);
            PG8_WAIT_V(8); PG8_WAIT_L(0); PG8_BAR; PG8_MMA(1, 0, At, B0); PG8_MMA(1, 1, At, B1); PG8_BAR; PG8_SCHED;
            PG8_LDB(B0, 1, 0); PG8_LDB(B1, 1, 1); PG8_SCHED; PG8_LDA(At, 1, 0); PG8_STAGE(PG8_SA(0, 1), a2 + hstep, voffA);
            PG8_WAIT_V(8); PG8_WAIT_L(0); PG8_BAR; PG8_MMA(0, 0, At, B0); PG8_MMA(0, 1, At, B1); PG8_BAR; PG8_SCHED;
            PG8_LDA(At, 1, 1); PG8_STAGE(PG8_SB(1, 0), b3, voffB); PG8_STAGE(PG8_SB(1, 1), b3 + hstep, voffB); PG8_STAGE(PG8_SA(1, 0), a3, voffA);
            PG8_WAIT_V(8); PG8_WAIT_L(0); PG8_BAR; PG8_MMA(1, 0, At, B0); PG8_MMA(1, 1, At, B1); PG8_BAR; PG8_SCHED;
            } else {
            PG8_LDB(B0, 0, 0); PG8_SCHED; PG8_LDA(At, 0, 0); PG8_STAGE(PG8_SA(1, 1), a1 + hstep, voffA);
            PG8_WAIT_L(8); PG8_BAR; PG8_WAIT_L(0); PG8_MMA(0, 0, At, B0); PG8_BAR; PG8_SCHED;
            PG8_LDB(B1, 0, 1); PG8_STAGE(PG8_SB(0, 0), b2, voffB);
            PG8_BAR; PG8_WAIT_L(0); PG8_MMA(0, 1, At, B1); PG8_BAR;
            PG8_LDA(At, 0, 1); PG8_STAGE(PG8_SA(0, 0), a2, voffA);
            PG8_BAR; PG8_WAIT_L(0); PG8_MMA(1, 0, At, B0); PG8_BAR; PG8_SCHED;
            PG8_STAGE(PG8_SB(0, 1), b2 + hstep, voffB);
            PG8_WAIT_V(6); PG8_BAR; PG8_MMA(1, 1, At, B1); PG8_BAR;
            PG8_LDB(B0, 1, 0); PG8_SCHED; PG8_LDA(At, 1, 0); PG8_STAGE(PG8_SA(0, 1), a2 + hstep, voffA);
            PG8_WAIT_L(8); PG8_BAR; PG8_WAIT_L(0); PG8_MMA(0, 0, At, B0); PG8_BAR; PG8_SCHED;
            PG8_LDB(B1, 1, 1); PG8_STAGE(PG8_SB(1, 0), b3, voffB);
            PG8_BAR; PG8_WAIT_L(0); PG8_MMA(0, 1, At, B1); PG8_BAR;
            PG8_LDA(At, 1, 1); PG8_STAGE(PG8_SA(1, 0), a3, voffA);
            PG8_BAR; PG8_WAIT_L(0); PG8_MMA(1, 0, At, B0); PG8_BAR; PG8_SCHED;
            PG8_STAGE(PG8_SB(1, 1), b3 + hstep, voffB);
            PG8_WAIT_V(6); PG8_BAR; PG8_MMA(1, 1, At, B1); PG8_BAR;
            }
        }
        if constexpr (ALIGN_EPI) { if (wr == 0) PG8_BAR; }
        E(acc, cur, wr, wc, fr, fq);
        if (!has_next) break;
#pragma unroll
        for (int a = 0; a < 2; ++a)
#pragma unroll
            for (int b = 0; b < 2; ++b)
#pragma unroll
                for (int m = 0; m < 4; ++m)
#pragma unroll
                    for (int n = 0; n < 2; ++n) acc[a][b][m][n] = (f32x4){0.f, 0.f, 0.f, 0.f};
        cur = nxt; cA = nA; cB = nB; ++ui;
        if constexpr (ALIGN_EPI) { if (wr == 1) PG8_BAR; }
    }
    PG8_WAIT_V(0);
    if constexpr (!ALIGN_EPI) { if (wr == 0) PG8_BAR; }
    PG8_BAR;
#undef PG8_SA
#undef PG8_SB
#undef PG8_STAGE
#undef PG8_LDA
#undef PG8_LDB
#undef PG8_MMA
#undef PG8_WAIT_V
#undef PG8_WAIT_L
#undef PG8_BAR
#undef PG8_SCHED
}

struct PlainOrder {
    const char* A; const char* Bt; int K; int nM, nN, nwg, G, c;
    __device__ __forceinline__ void init(const void* A_, const void* Bt_, int M, int N, int K_, int G_, int c_) { A = (const char*)A_; Bt = (const char*)Bt_; K = K_; nM = M / BM; nN = N / BM; nwg = nM * nN; G = G_; c = c_; }
    __device__ __forceinline__ bool next(int i, Unit& u) const {
        const long Lq = (long)i * G + c; if (Lq >= nwg) return false;
        int wgid = (int)Lq; { const int q = nwg / 8, r = nwg % 8, xcd = wgid % 8, off = wgid / 8; wgid = (xcd < r ? xcd * (q + 1) : r * (q + 1) + (xcd - r) * q) + off; }
        const int nig = 8 * nN, gid = wgid / nig, fm = gid * 8, gsz = (nM - fm) < 8 ? (nM - fm) : 8;
        u.pm = fm + ((wgid % nig) % gsz); u.pn = (wgid % nig) / gsz; u.e = 0; return true;
    }
    __device__ __forceinline__ const char* a_base(const Unit& u) const { return A + (size_t)u.pm * 256 * K * 2; }
    __device__ __forceinline__ const char* b_base(const Unit& u) const { return Bt + (size_t)u.pn * 256 * K * 2; }
};
struct GroupOrder {
    const char* A; const char* Bt; int K; int nN, ntot, G, c; size_t bstride; const LAS unsigned char* tile_e;
    __device__ __forceinline__ bool next(int i, Unit& u) const {
        const long Lq = (long)i * G + c; if (Lq >= (long)ntot * nN) return false;
        u.pm = (int)(Lq / nN); u.pn = (int)(Lq % nN); u.e = __builtin_amdgcn_readfirstlane((int)tile_e[u.pm]); return true;
    }
    __device__ __forceinline__ const char* a_base(const Unit& u) const { return A + (size_t)u.pm * 256 * K * 2; }
    __device__ __forceinline__ const char* b_base(const Unit& u) const { return Bt + (size_t)u.e * bstride + (size_t)u.pn * 256 * K * 2; }
};

struct EpiBf16Bias {
    static constexpr bool PERM = true;
    bf16_t* O; int ldc; const float* bias;
    __device__ __forceinline__ void operator()(const f32x4 (&acc)[2][2][4][2], const Unit& u, int wr, int wc, int fr, int fq) const {
        const int row0 = u.pm * BM + wr * 64 + fr, col0 = u.pn * BM + wc * 32 + 8 * fq;
        f32x4 bv[2][2];
#pragma unroll
        for (int bj = 0; bj < 2; ++bj)
#pragma unroll
            for (int n = 0; n < 2; ++n) bv[bj][n] = *(const f32x4*)(bias + col0 + bj * HALF + 4 * n);
#pragma unroll
        for (int ai = 0; ai < 2; ++ai)
#pragma unroll
            for (int m = 0; m < 4; ++m) { bf16_t* rowp = O + (size_t)(row0 + ai * HALF + m * 16) * ldc + col0;
#pragma unroll
                for (int bj = 0; bj < 2; ++bj) { const f32x4 v0 = acc[ai][bj][m][0] + bv[bj][0], v1 = acc[ai][bj][m][1] + bv[bj][1];
                    u32x4 w; w.x = cvt_pk_bf16(v0[0], v0[1]); w.y = cvt_pk_bf16(v0[2], v0[3]); w.z = cvt_pk_bf16(v1[0], v1[1]); w.w = cvt_pk_bf16(v1[2], v1[3]);
                    *(u32x4*)(rowp + bj * HALF) = w; } }
    }
};
struct EpiResF32 {
    static constexpr bool PERM = false;
    float* C; const float* R; int ldc; float alpha;
    __device__ __forceinline__ void operator()(const f32x4 (&acc)[2][2][4][2], const Unit& u, int wr, int wc, int fr, int fq) const {
        const int row0 = u.pm * BM + wr * 64 + fr, col0 = u.pn * BM + wc * 32 + 4 * fq;
#pragma unroll
        for (int ai = 0; ai < 2; ++ai)
#pragma unroll
            for (int m = 0; m < 4; ++m) { const size_t off = (size_t)(row0 + ai * HALF + m * 16) * ldc + col0;
#pragma unroll
                for (int bj = 0; bj < 2; ++bj)
#pragma unroll
                    for (int n = 0; n < 2; ++n) { const f32x4 r = *(const f32x4*)(R + off + bj * HALF + n * 16); *(f32x4*)(C + off + bj * HALF + n * 16) = acc[ai][bj][m][n] + r * alpha; } }
    }
};
struct EpiSwiglu {
    static constexpr bool PERM = true;
    bf16_t* H; const float* b1;
    __device__ __forceinline__ void operator()(const f32x4 (&acc)[2][2][4][2], const Unit& u, int wr, int wc, int fr, int fq) const {
        const int row0 = u.pm * BM + wr * 64 + fr, col0 = u.pn * HALF + wc * 32 + 8 * fq;
        const float* bg = b1 + (size_t)u.e * 2048 + col0; const float* bu = bg + 1024;
        f32x4 g0 = *(const f32x4*)(bg), g1 = *(const f32x4*)(bg + 4), u0 = *(const f32x4*)(bu), u1 = *(const f32x4*)(bu + 4);
#pragma unroll
        for (int ai = 0; ai < 2; ++ai)
#pragma unroll
            for (int m = 0; m < 4; ++m) { bf16_t* rowp = H + (size_t)(row0 + ai * HALF + m * 16) * FF + col0;
                float o[8];
#pragma unroll
                for (int n = 0; n < 2; ++n)
#pragma unroll
                    for (int j = 0; j < 4; ++j) { float g = acc[ai][0][m][n][j] + (n ? g1[j] : g0[j]); float up = acc[ai][1][m][n][j] + (n ? u1[j] : u0[j]);
                        g = fminf(g, SW_LIMIT); up = fminf(fmaxf(up, -SW_LIMIT), SW_LIMIT);
                        const float glu = g / (1.0f + __expf(-SW_ALPHA * g)); o[n * 4 + j] = (up + 1.0f) * glu; }
                u32x4 w; w.x = cvt_pk_bf16(o[0], o[1]); w.y = cvt_pk_bf16(o[2], o[3]); w.z = cvt_pk_bf16(o[4], o[5]); w.w = cvt_pk_bf16(o[6], o[7]);
                *(u32x4*)rowp = w; }
    }
};
struct EpiExpertOut {
    static constexpr bool PERM = true;
    bf16_t* Y; const float* b2;
    __device__ __forceinline__ void operator()(const f32x4 (&acc)[2][2][4][2], const Unit& u, int wr, int wc, int fr, int fq) const {
        const int row0 = u.pm * BM + wr * 64 + fr, col0 = u.pn * BM + wc * 32 + 8 * fq;
        const float* bb = b2 + (size_t)u.e * D + col0;
        f32x4 bv[2][2];
#pragma unroll
        for (int bj = 0; bj < 2; ++bj)
#pragma unroll
            for (int n = 0; n < 2; ++n) bv[bj][n] = *(const f32x4*)(bb + bj * HALF + 4 * n);
#pragma unroll
        for (int ai = 0; ai < 2; ++ai)
#pragma unroll
            for (int m = 0; m < 4; ++m) { bf16_t* rowp = Y + (size_t)(row0 + ai * HALF + m * 16) * D + col0;
#pragma unroll
                for (int bj = 0; bj < 2; ++bj) { const f32x4 v0 = acc[ai][bj][m][0] + bv[bj][0], v1 = acc[ai][bj][m][1] + bv[bj][1];
                    u32x4 w; w.x = cvt_pk_bf16(v0[0], v0[1]); w.y = cvt_pk_bf16(v0[2], v0[3]); w.z = cvt_pk_bf16(v1[0], v1[1]); w.w = cvt_pk_bf16(v1[2], v1[3]);
                    *(u32x4*)(rowp + bj * HALF) = w; } }
    }
};
}

#define XB_TMO      128
#define XB_XCNT(j)  (256  + 64 * (j))
#define XB_XSUB(j)  (1280 + 64 * (j))
#define XB_XGEN(j)  (2304 + 64 * (j))
#define XB_TOP      3328
#define XB_TOPGEN   3392
#define XCD_BAR_WORDS 3456
#define XB_SPIN_CAP (1u << 22)
__device__ __forceinline__ unsigned xb_ld(unsigned* p)              { return __hip_atomic_load(p, __ATOMIC_RELAXED, __HIP_MEMORY_SCOPE_AGENT); }
__device__ __forceinline__ unsigned xb_add(unsigned* p, unsigned v) { return __hip_atomic_fetch_add(p, v, __ATOMIC_RELAXED, __HIP_MEMORY_SCOPE_AGENT); }
__device__ __forceinline__ unsigned xb_xcc_id() { return (unsigned)__builtin_amdgcn_s_getreg((3 << 11) | 20) & 0xFu; }
#define XB_SPIN(cond, bar) do { unsigned _sp = 0; while (cond) { __builtin_amdgcn_s_sleep(1); \
    if ((++_sp & 255u) == 0u) { if (xb_ld(&(bar)[XB_TMO])) break; if (_sp > XB_SPIN_CAP) { atomicAdd(&(bar)[XB_TMO], 1u); break; } } } } while (0)
struct XcdBarrier { unsigned* bar; unsigned x; volatile LAS unsigned* st; };
__device__ __forceinline__ XcdBarrier xcd_barrier_post(unsigned* bar, volatile LAS unsigned* st) {
    XcdBarrier b; b.bar = bar; b.x = xb_xcc_id(); b.st = st;
    if (threadIdx.x == 0) (void)xb_add(&bar[XB_XCNT(b.x)], 1u);
    return b;
}
__device__ __forceinline__ void xcd_barrier_complete(unsigned* bar, unsigned x, unsigned& nloc, unsigned& nx) {
    const unsigned G = gridDim.x * gridDim.y * gridDim.z;
    unsigned sum, cnt, mine, sp = 0u;
    for (;;) {
        sum = 0u; cnt = 0u; mine = 0u;
#pragma unroll
        for (unsigned j = 0; j < 16; ++j) { const unsigned c = xb_ld(&bar[XB_XCNT(j)]); sum += c; cnt += (c > 0u) ? 1u : 0u; mine = (j == x) ? c : mine; }
        if (sum == G) break;
        __builtin_amdgcn_s_sleep(1);
        if ((++sp & 255u) == 0u) { if (xb_ld(&bar[XB_TMO])) break; if (sp > XB_SPIN_CAP) { atomicAdd(&bar[XB_TMO], 1u); break; } }
    }
    nloc = mine > 0u ? mine : 1u; nx = cnt > 0u ? cnt : 1u;
}
__device__ __forceinline__ void xcd_barrier(const XcdBarrier& b) {
    asm volatile("s_waitcnt vmcnt(0)" ::: "memory");
    __syncthreads();
    if (threadIdx.x == 0) {
        unsigned* bar = b.bar;
        __builtin_amdgcn_s_waitcnt(0);
        unsigned nloc = b.st[0], nx = b.st[1];
        if (nloc == 0u) { xcd_barrier_complete(bar, b.x, nloc, nx); b.st[0] = nloc; b.st[1] = nx; }
        const unsigned old = xb_add(&bar[XB_XSUB(b.x)], 1u);
        const unsigned gen = old / nloc;
        if (old + 1u == (gen + 1u) * nloc) {
            __builtin_amdgcn_fence(__ATOMIC_RELEASE, "agent");
            asm volatile("s_waitcnt vmcnt(0)" ::: "memory");
            const unsigned og = xb_add(&bar[XB_TOP], 1u);
            const unsigned tg = og / nx;
            if (og + 1u == (tg + 1u) * nx) xb_add(&bar[XB_TOPGEN], 1u);
            else XB_SPIN(xb_ld(&bar[XB_TOPGEN]) == tg, bar);
            __builtin_amdgcn_fence(__ATOMIC_ACQUIRE, "agent");
            xb_add(&bar[XB_XGEN(b.x)], 1u);
            asm volatile("s_waitcnt vmcnt(0)" ::: "memory");
        } else {
            XB_SPIN(xb_ld(&bar[XB_XGEN(b.x)]) == gen, bar);
            __builtin_amdgcn_fence(__ATOMIC_ACQUIRE, "agent");
            asm volatile("s_waitcnt vmcnt(0)" ::: "memory");
        }
    }
    __syncthreads();
}

struct Args {
    const float* x; const float* emb_g; const float* emb_b; const float* w_in; const float* b_in; const float* conv_w; const float* ml_nw; const float* ret_nw;
    const float* w_out; const float* ln1_g; const float* ln1_b; const float* w_router; const float* b_router; const float* w1; const float* b1; const float* w2; const float* b2;
    const float* ln2_g; const float* ln2_b;
    float* out; unsigned char* ws; int ph_lo, ph_hi;
};
constexpr int NWAVES = 8, NTHR = 512;
constexpr int NPH_LAYER = 10;
constexpr int NPH = 1 + NL * NPH_LAYER;

struct Frame {
    LAS unsigned char* lds;
    unsigned* ctl;
    int tid, lane, wave, G, bid;
};

__device__ __forceinline__ int sidx(int b, int h, int dir, int c) { return ((b * NH + h) * 2 + dir) * NCH + c; }

template <class RowMap>
__device__ __forceinline__ void transpose_item(const float* W, int K, int Nsrc, bf16_t* WT, LAS float* scr, int kb, int nb, int lane, const RowMap& rm) {
    const int k0 = 64 * kb, n0 = 32 * nb;
    const int nn = n0 + (lane & 31);
#pragma unroll 8
    for (int i = 0; i < 32; ++i) { const int kk = 2 * i + (lane >> 5); scr[kk * 33 + (lane & 31)] = nn < Nsrc ? W[(size_t)(k0 + kk) * Nsrc + nn] : 0.f; }
    asm volatile("s_waitcnt lgkmcnt(0)" ::: "memory");
    const int c = lane & 7;
#pragma unroll
    for (int j = 0; j < 4; ++j) { const int n = (lane >> 3) + 8 * j; const LAS float* s = scr + (8 * c) * 33 + n;
        u32x4 o; o.x = pk2(s[0 * 33], s[1 * 33]); o.y = pk2(s[2 * 33], s[3 * 33]); o.z = pk2(s[4 * 33], s[5 * 33]); o.w = pk2(s[6 * 33], s[7 * 33]);
        *(u32x4*)(WT + (size_t)rm(n0 + n) * K + k0 + 8 * c) = o; }
    asm volatile("s_waitcnt lgkmcnt(0)" ::: "memory");
}
struct RowId { __device__ __forceinline__ int operator()(int n) const { return n; } };
struct RowW1 { __device__ __forceinline__ int operator()(int n) const { const int up = n >> 10, j = n & 1023; return (j >> 7) * 256 + up * 128 + (j & 127); } };

__device__ __forceinline__ void ln_row(const f32x4 (&vin)[4], const float* g, const float* b, float* of, bf16_t* ob, float* of2, int lane) {
    f32x4 v[4]; float s = 0.f;
#pragma unroll
    for (int j = 0; j < 4; ++j) { v[j] = vin[j]; s += (v[j].x + v[j].y) + (v[j].z + v[j].w); }
    const float mean = wave_sum(s) * (1.f / D); float s2 = 0.f;
#pragma unroll
    for (int j = 0; j < 4; ++j) { v[j] = v[j] - mean; s2 += (v[j].x * v[j].x + v[j].y * v[j].y) + (v[j].z * v[j].z + v[j].w * v[j].w); }
    const float rstd = 1.f / sqrtf(wave_sum(s2) * (1.f / D) + LN_EPS);
#pragma unroll
    for (int j = 0; j < 4; ++j) { const f32x4 gg = *(const f32x4*)(g + 4 * lane + 256 * j), bb = *(const f32x4*)(b + 4 * lane + 256 * j);
        const f32x4 o = v[j] * rstd * gg + bb;
        if (of) *(f32x4*)(of + 4 * lane + 256 * j) = o;
        if (of2) *(f32x4*)(of2 + 4 * lane + 256 * j) = o;
        if (ob) { u32x2 w; w.x = pk2(o.x, o.y); w.y = pk2(o.z, o.w); *(u32x2*)(ob + 4 * lane + 256 * j) = w; } }
}

__device__ __forceinline__ void p0_prologue(const Frame& F, const Args& a) {
    unsigned char* ws = a.ws;
    LAS float* scr = (LAS float*)(F.lds + F.wave * 16384);
    const int gw = F.bid * NWAVES + F.wave, NGW = F.G * NWAVES;
    constexpr int I_IN = NL * 16 * 88, I_OUT = NL * 16 * 32, I_W1 = NL * NE * 16 * 64, I_W2 = NL * NE * 16 * 32;
    for (int it = gw; it < I_IN + I_OUT + I_W1 + I_W2; it += NGW) {
        int r = it;
        if (r < I_IN) { const int l = r / (16 * 88), q = r % (16 * 88); transpose_item(a.w_in + (size_t)l * D * PW, D, PW, (bf16_t*)(ws + WS_WIN) + (size_t)l * PWP * D, scr, q / 88, q % 88, F.lane, RowId()); continue; } r -= I_IN;
        if (r < I_OUT) { const int l = r / (16 * 32), q = r % (16 * 32); transpose_item(a.w_out + (size_t)l * D * D, D, D, (bf16_t*)(ws + WS_WOUT) + (size_t)l * D * D, scr, q / 32, q % 32, F.lane, RowId()); continue; } r -= I_OUT;
        if (r < I_W1) { const int le = r / (16 * 64), q = r % (16 * 64); transpose_item(a.w1 + (size_t)le * D * 2048, D, 2048, (bf16_t*)(ws + WS_W1) + (size_t)le * 2048 * D, scr, q / 64, q % 64, F.lane, RowW1()); continue; } r -= I_W1;
        { const int le = r / (16 * 32), q = r % (16 * 32); transpose_item(a.w2 + (size_t)le * FF * D, FF, D, (bf16_t*)(ws + WS_W2) + (size_t)le * D * FF, scr, q / 32, q % 32, F.lane, RowId()); }
    }
    const int gt = F.bid * NTHR + F.tid, NGT = F.G * NTHR;
    float* binp = (float*)(ws + WS_BIN);
    for (int i = gt; i < NL * PWP; i += NGT) { const int l = i / PWP, c = i % PWP; binp[i] = c < PW ? a.b_in[l * PW + c] : 0.f; }
    float* rot = (float*)(ws + WS_ROT);
    for (int i = gt; i < S * 24; i += NGT) { const int pos = i / 24, j = i % 24; const float inv = 1.0f / powf(10000.0f, (float)(2 * j) / 48.0f); const float ang = (float)pos * inv;
        float sn, cs; sincosf(ang, &sn, &cs); rot[2 * i] = cs; rot[2 * i + 1] = sn; }
    float* xf = (float*)(ws + WS_XF); bf16_t* xb = (bf16_t*)(ws + WS_XB);
    for (int m = gw; m < T; m += NGW) { f32x4 v[4];
#pragma unroll
        for (int j = 0; j < 4; ++j) v[j] = *(const f32x4*)(a.x + (size_t)m * D + 4 * F.lane + 256 * j);
        ln_row(v, a.emb_g, a.emb_b, xf + (size_t)m * D, xb + (size_t)m * D, nullptr, F.lane); }
}

template <bool REV, bool MAXOP> __device__ __forceinline__ void wave_scan128(LAS float* arr, int lane) {
    const int i0 = REV ? 127 - 2 * lane : 2 * lane, i1 = REV ? 126 - 2 * lane : 2 * lane + 1;
    const float a = arr[i0], b = arr[i1];
    float s = MAXOP ? fmaxf(a, b) : a + b;
#pragma unroll
    for (int o = 1; o < 64; o <<= 1) { const float t = __shfl_up(s, o); if (lane >= o) s = MAXOP ? fmaxf(s, t) : s + t; }
    float ex = __shfl_up(s, 1); if (lane == 0) ex = MAXOP ? -INFINITY : 0.f;
    arr[i0] = MAXOP ? fmaxf(ex, a) : ex + a; arr[i1] = MAXOP ? fmaxf(fmaxf(ex, a), b) : ex + a + b;
}
__device__ __forceinline__ float ret_lg(int h, float off) { return log1pf(-exp2f(-(5.0f + off) - (float)h)); }

__device__ __forceinline__ float mlstm_qk(const bf16_t* P, const float* convw, int b, int s, int ch) {
    float acc = 0.f;
#pragma unroll
    for (int d = 0; d < 3; ++d) { const int sp = s + d - 1; if (sp >= 0 && sp < S) acc += bf2f(P[(size_t)(b * S + sp) * PWP + COL_MQK + ch]) * convw[d * 384 + ch]; }
    return siluf_(acc);
}
__device__ __forceinline__ float ret_rot(const bf16_t* P, const float* rot, int b, int s, int colbase, int h, int kk) {
    const bf16_t* p = P + (size_t)(b * S + s) * PWP + colbase + h * DK + (kk & ~1);
    const float t1 = bf2f(p[0]), t2 = bf2f(p[1]);
    const float cs = rot[(s * 24 + (kk >> 1)) * 2], sn = rot[(s * 24 + (kk >> 1)) * 2 + 1];
    return (kk & 1) ? t1 * sn + t2 * cs : t1 * cs - t2 * sn;
}

__device__ __forceinline__ void phaseB_unit(const Frame& F, const Args& a, int l, int u) {
    unsigned char* ws = a.ws;
    const bf16_t* P = (const bf16_t*)(ws + WS_P);
    const int type = u >> 10, r = u & 1023, b = r >> 8, c = (r >> 2) & 63, h = r & 3;
    LAS float* kS = (LAS float*)F.lds;
    LAS float* vS = kS + 128 * 49;
    LAS float* ga = vS + 128 * 97;
    LAS float* lff = ga, *lfb = ga + 128, *iff = ga + 256, *ibb = ga + 384, *pf = ga + 512, *pb = ga + 640, *scal = ga + 768;
    const int t0 = b * S + c * CH;
    const float kscale = 0.14433756729740643f;
    if (type == 0) {
        const float* convw = a.conv_w + (size_t)l * 3 * 384;
        for (int idx = F.tid; idx < 128 * DK; idx += NTHR) { const int j = idx / DK, kk = idx % DK; kS[j * 49 + kk] = mlstm_qk(P, convw, b, c * CH + j, 192 + h * DK + kk) * kscale; }
        for (int idx = F.tid; idx < 128 * DV; idx += NTHR) { const int j = idx / DV, vv = idx % DV; vS[j * 97 + vv] = bf2f(P[(size_t)(t0 + j) * PWP + COL_MV + h * DV + vv]); }
        if (F.tid < 128) { const bf16_t* g = P + (size_t)(t0 + F.tid) * PWP + COL_MG;
            iff[F.tid] = bf2f(g[h]); lff[F.tid] = logsigmoidf_(bf2f(g[4 + h])); ibb[F.tid] = bf2f(g[8 + h]); lfb[F.tid] = logsigmoidf_(bf2f(g[12 + h])); }
        __syncthreads();
        if (F.wave == 0) wave_scan128<false, false>(lff, F.lane);
        if (F.wave == 1) wave_scan128<true, false>(lfb, F.lane);
        __syncthreads();
        if (F.tid < 128) pf[F.tid] = lff[127] - lff[F.tid] + iff[F.tid];
        else if (F.tid < 256) { const int j = F.tid - 128; pb[j] = lfb[0] - lfb[j] + ibb[j]; }
        __syncthreads();
        if (F.wave == 0) { const float m = wave_max(fmaxf(pf[2 * F.lane], pf[2 * F.lane + 1])); if (F.lane == 0) scal[0] = m; }
        if (F.wave == 1) { const float m = wave_max(fmaxf(pb[2 * F.lane], pb[2 * F.lane + 1])); if (F.lane == 0) scal[1] = m; }
        __syncthreads();
        if (F.tid < 128) pf[F.tid] = __expf(pf[F.tid] - scal[0]);
        else if (F.tid < 256) { const int j = F.tid - 128; pb[j] = __expf(pb[j] - scal[1]); }
        __syncthreads();
        float* mC = (float*)(ws + WS_MC); float* mN = (float*)(ws + WS_MN); float* msc = (float*)(ws + WS_MSC);
        for (int idx = F.tid; idx < 2 * DV * DK; idx += NTHR) { const int dir = idx / (DV * DK), e = idx % (DV * DK), vv = e / DK, kk = e % DK; const LAS float* p = dir ? pb : pf;
            float s = 0.f;
            for (int j = 0; j < 128; ++j) s += p[j] * vS[j * 97 + vv] * kS[j * 49 + kk];
            mC[(size_t)sidx(b, h, dir, c) * (DV * DK) + e] = s; }
        if (F.tid < 2 * DK) { const int dir = F.tid / DK, kk = F.tid % DK; const LAS float* p = dir ? pb : pf; float s = 0.f;
            for (int j = 0; j < 128; ++j) s += p[j] * kS[j * 49 + kk];
            mN[(size_t)sidx(b, h, dir, c) * DK + kk] = s; }
        if (F.tid == 0) { msc[sidx(b, h, 0, c)] = scal[0]; msc[sidx(b, h, 1, c)] = scal[1]; msc[2048 + sidx(b, h, 0, c)] = lff[127]; msc[2048 + sidx(b, h, 1, c)] = lfb[0]; }
    } else {
        const float* rot = (const float*)(ws + WS_ROT);
        for (int idx = F.tid; idx < 128 * DK; idx += NTHR) { const int j = idx / DK, kk = idx % DK; kS[j * 49 + kk] = ret_rot(P, rot, b, c * CH + j, COL_RK, h, kk) * kscale; }
        for (int idx = F.tid; idx < 128 * DV; idx += NTHR) { const int j = idx / DV, vv = idx % DV; vS[j * 97 + vv] = bf2f(P[(size_t)(t0 + j) * PWP + COL_RV + h * DV + vv]); }
        const float lgf = ret_lg(h, 0.f), lgb = ret_lg(h, 0.5f);
        if (F.tid < 128) pf[F.tid] = __expf(lgf * (float)(127 - F.tid));
        else if (F.tid < 256) { const int j = F.tid - 128; pb[j] = __expf(lgb * (float)j); }
        __syncthreads();
        float* rS = (float*)(ws + WS_RS);
        for (int idx = F.tid; idx < 2 * DV * DK; idx += NTHR) { const int dir = idx / (DV * DK), e = idx % (DV * DK), vv = e / DK, kk = e % DK; const LAS float* p = dir ? pb : pf;
            float s = 0.f;
            for (int j = 0; j < 128; ++j) s += p[j] * vS[j * 97 + vv] * kS[j * 49 + kk];
            rS[(size_t)sidx(b, h, dir, c) * (DV * DK) + e] = s; }
    }
    __syncthreads();
}

__device__ __forceinline__ void fourier_chan_naive(const Frame& F, const Args& a) {
    unsigned char* ws = a.ws; const bf16_t* P = (const bf16_t*)(ws + WS_P); float* U = (float*)(ws + WS_UCS);
    LAS float* tab = (LAS float*)(F.lds);
    LAS float* xs = tab + 128;
    if (F.tid < 64) { float sn, cs; sincosf(6.283185307179586f * (float)F.tid / 64.0f, &sn, &cs); tab[F.tid] = cs; tab[64 + F.tid] = sn; }
    __syncthreads();
    for (int t8 = F.bid; t8 < T / 8; t8 += F.G) {
        for (int i = F.tid; i < 8 * 256; i += NTHR) xs[i] = bf2f(P[(size_t)(t8 * 8 + (i >> 8)) * PWP + COL_F + (i & 255)]);
        __syncthreads();
        for (int i = F.tid; i < 8 * 512; i += NTHR) { const int tk = i >> 9, o = i & 511, csel = o >> 8, chn = o & 255, g = chn >> 6, cp = chn & 63; float s = 0.f;
            for (int cc = 0; cc < 64; ++cc) s += xs[tk * 256 + g * 64 + cc] * tab[csel * 64 + ((cc * cp) & 63)];
            U[(size_t)(t8 * 8 + tk) * 512 + o] = s; }
        __syncthreads();
    }
}

__device__ __forceinline__ void phaseC_unit(const Frame& F, const Args& a, int u) {
    unsigned char* ws = a.ws;
    const int type = u >> 7, seq = (u & 127) >> 2, part = u & 3, dir = seq & 1;
    LAS float* sp = (LAS float*)F.lds; LAS float* sc = sp + 64;
    float* msc = (float*)(ws + WS_MSC);
    if (type == 0) {
        if (F.tid == 0) { float m = 0.f;
            for (int n = 0; n < NCH; ++n) { const int c = dir ? NCH - 1 - n : n; const int si = seq * NCH + c; const float mc = msc[si], ae = msc[2048 + si];
                if (part == 0) msc[4096 + si] = m;
                const float mn = fmaxf(ae + m, mc); sp[n] = __expf(ae + m - mn); sc[n] = __expf(mc - mn); m = mn; } }
    } else {
        if (F.tid < 64) { const int h = (seq >> 1) & 3; const float lg = ret_lg(h, dir ? 0.5f : 0.f); sp[F.tid] = __expf(lg * 128.0f); sc[F.tid] = 1.0f; }
    }
    __syncthreads();
    float* X = (float*)(ws + (type ? WS_RS : WS_MC));
    for (int e = F.tid; e < 1152; e += NTHR) { float st = 0.f; float* p = X + (size_t)seq * NCH * (DV * DK) + part * 1152 + e;
#pragma unroll 8
        for (int n = 0; n < NCH; ++n) { const int c = dir ? NCH - 1 - n : n; float* q = p + (size_t)c * (DV * DK); const float v = *q; *q = st; st = sp[n] * st + sc[n] * v; } }
    if (type == 0 && part == 0 && F.tid < DK) { float st = 0.f; float* p = (float*)(ws + WS_MN) + (size_t)seq * NCH * DK + F.tid;
        for (int n = 0; n < NCH; ++n) { const int c = dir ? NCH - 1 - n : n; float* q = p + (size_t)c * DK; const float v = *q; *q = st; st = sp[n] * st + sc[n] * v; } }
    __syncthreads();
}

__device__ __forceinline__ void phaseD_unit(const Frame& F, const Args& a, int l, int u) {
    unsigned char* ws = a.ws;
    const bf16_t* P = (const bf16_t*)(ws + WS_P); bf16_t* mix = (bf16_t*)(ws + WS_MIX);
    const int type = u >> 10, r = u & 1023, b = r >> 8, c = (r >> 2) & 63, h = r & 3;
    LAS bf16_t* qS = (LAS bf16_t*)F.lds;
    LAS bf16_t* kS = qS + 128 * 50;
    LAS bf16_t* vS = kS + 128 * 50;
    LAS float* SS = (LAS float*)(vS + 128 * 98);
    LAS float* ar = SS + 128 * 129;
    LAS float* af = ar, *ab = ar + 128, *iff = ar + 256, *ibb = ar + 384, *gxf = ar + 512, *gxb = ar + 640, *mtf = ar + 768, *mtb = ar + 896, *rdf = ar + 1024, *rdb = ar + 1152, *sif = ar + 1280, *sib = ar + 1408;
    LAS float* ps = ar + 1536;
    const int t0 = b * S + c * CH;
    const float kscale = 0.14433756729740643f;
    const float* rot = (const float*)(ws + WS_ROT);
    if (type == 0) {
        const float* convw = a.conv_w + (size_t)l * 3 * 384;
        for (int idx = F.tid; idx < 128 * DK; idx += NTHR) { const int j = idx / DK, kk = idx % DK;
            qS[j * 50 + kk] = (bf16_t)f2bf(mlstm_qk(P, convw, b, c * CH + j, h * DK + kk));
            kS[j * 50 + kk] = (bf16_t)f2bf(mlstm_qk(P, convw, b, c * CH + j, 192 + h * DK + kk) * kscale); }
        for (int idx = F.tid; idx < 128 * DV; idx += NTHR) { const int j = idx / DV, vv = idx % DV; vS[j * 98 + vv] = P[(size_t)(t0 + j) * PWP + COL_MV + h * DV + vv]; }
        if (F.tid < 128) { const bf16_t* g = P + (size_t)(t0 + F.tid) * PWP + COL_MG;
            iff[F.tid] = bf2f(g[h]); af[F.tid] = logsigmoidf_(bf2f(g[4 + h])); ibb[F.tid] = bf2f(g[8 + h]); ab[F.tid] = logsigmoidf_(bf2f(g[12 + h])); }
    } else {
        for (int idx = F.tid; idx < 128 * DK; idx += NTHR) { const int j = idx / DK, kk = idx % DK;
            qS[j * 50 + kk] = (bf16_t)f2bf(ret_rot(P, rot, b, c * CH + j, COL_RQ, h, kk));
            kS[j * 50 + kk] = (bf16_t)f2bf(ret_rot(P, rot, b, c * CH + j, COL_RK, h, kk) * kscale); }
        for (int idx = F.tid; idx < 128 * DV; idx += NTHR) { const int j = idx / DV, vv = idx % DV; vS[j * 98 + vv] = P[(size_t)(t0 + j) * PWP + COL_RV + h * DV + vv]; }
    }
    __syncthreads();
    { const int j = F.tid >> 2, s0 = (F.tid & 3) * 32;
#pragma unroll 1
      for (int s = s0; s < s0 + 32; ++s) { float d = 0.f;
#pragma unroll 8
          for (int kk = 0; kk < DK; ++kk) d += bf2f(qS[j * 50 + kk]) * bf2f(kS[s * 50 + kk]);
          SS[j * 129 + s] = d; } }
    const int j = F.tid & 127, vq = F.tid >> 7;
    float acc[24];
#pragma unroll
    for (int x = 0; x < 24; ++x) acc[x] = 0.f;
    if (type == 0) {
        const float* msc = (const float*)(ws + WS_MSC);
        const float mpf = msc[4096 + sidx(b, h, 0, c)], mpb = msc[4096 + sidx(b, h, 1, c)];
        if (F.wave == 0) wave_scan128<false, false>(af, F.lane);
        if (F.wave == 1) wave_scan128<true, false>(ab, F.lane);
        __syncthreads();
        if (F.tid < 128) gxf[F.tid] = iff[F.tid] - af[F.tid]; else if (F.tid < 256) gxb[F.tid - 128] = ibb[F.tid - 128] - ab[F.tid - 128];
        __syncthreads();
        if (F.wave == 0) wave_scan128<false, true>(gxf, F.lane);
        if (F.wave == 1) wave_scan128<true, true>(gxb, F.lane);
        __syncthreads();
        if (F.tid < 128) mtf[F.tid] = fmaxf(af[F.tid] + mpf, af[F.tid] + gxf[F.tid]); else if (F.tid < 256) { const int q = F.tid - 128; mtb[q] = fmaxf(ab[q] + mpb, ab[q] + gxb[q]); }
        __syncthreads();
        if (F.tid < 256) { const int dir = F.tid >> 7, jj = F.tid & 127; const LAS float* A_ = dir ? ab : af; const LAS float* I_ = dir ? ibb : iff; const float mt = dir ? mtb[jj] : mtf[jj];
            float den = 0.f; const int lo = dir ? jj : 0, hi = dir ? 127 : jj;
            for (int s = lo; s <= hi; ++s) den += SS[jj * 129 + s] * __expf(A_[jj] - A_[s] + I_[s] - mt);
            const float si = __expf(A_[jj] + (dir ? mpb : mpf) - mt);
            const float* np = (const float*)(ws + WS_MN) + (size_t)sidx(b, h, dir, c) * DK; float nq = 0.f;
            for (int kk = 0; kk < DK; ++kk) nq += np[kk] * bf2f(qS[jj * 50 + kk]);
            den += si * nq;
            const float dn = fmaxf(fabsf(den), __expf(-mt));
            if (dir) { rdb[jj] = 1.0f / dn; sib[jj] = si; } else { rdf[jj] = 1.0f / dn; sif[jj] = si; } }
        __syncthreads();
#pragma unroll 1
        for (int dir = 0; dir < 2; ++dir) {
            const LAS float* A_ = dir ? ab : af; const LAS float* I_ = dir ? ibb : iff; const float mt = dir ? mtb[j] : mtf[j]; const float rd = dir ? rdb[j] : rdf[j]; const float si = dir ? sib[j] : sif[j];
            const int lo = dir ? j : 0, hi = dir ? 127 : j;
            for (int s = lo; s <= hi; ++s) { const float w = SS[j * 129 + s] * __expf(A_[j] - A_[s] + I_[s] - mt) * rd;
#pragma unroll
                for (int x = 0; x < 24; ++x) acc[x] += w * bf2f(vS[s * 98 + vq * 24 + x]); }
            const float* cp = (const float*)(ws + WS_MC) + (size_t)sidx(b, h, dir, c) * (DV * DK) + (size_t)(vq * 24) * DK;
            for (int kk = 0; kk < DK; ++kk) { const float qv = bf2f(qS[j * 50 + kk]) * si * rd;
#pragma unroll
                for (int x = 0; x < 24; ++x) acc[x] += qv * cp[x * DK + kk]; }
        }
        const bf16_t* og = P + (size_t)(t0 + j) * PWP + COL_MO + h * DV + vq * 24;
#pragma unroll
        for (int x = 0; x < 24; ++x) acc[x] *= sigmoidf_(bf2f(og[x]));
    } else {
        const float lgf = ret_lg(h, 0.f), lgb = ret_lg(h, 0.5f);
        __syncthreads();
        for (int s = 0; s < 128; ++s) { const float w = SS[j * 129 + s] * (s <= j ? __expf(lgf * (float)(j - s)) : __expf(lgb * (float)(s - j)));
#pragma unroll
            for (int x = 0; x < 24; ++x) acc[x] += w * bf2f(vS[s * 98 + vq * 24 + x]); }
#pragma unroll 1
        for (int dir = 0; dir < 2; ++dir) {
            const float wi = dir ? __expf(lgb * (float)(128 - j)) : __expf(lgf * (float)(j + 1));
            const float* cp = (const float*)(ws + WS_RS) + (size_t)sidx(b, h, dir, c) * (DV * DK) + (size_t)(vq * 24) * DK;
            for (int kk = 0; kk < DK; ++kk) { const float qv = bf2f(qS[j * 50 + kk]) * wi;
#pragma unroll
                for (int x = 0; x < 24; ++x) acc[x] += qv * cp[x * DK + kk]; }
        }
    }
    float s1 = 0.f;
#pragma unroll
    for (int x = 0; x < 24; ++x) s1 += acc[x];
    ps[vq * 128 + j] = s1;
    __syncthreads();
    const float mean = (ps[j] + ps[128 + j] + ps[256 + j] + ps[384 + j]) * (1.0f / 96.0f);
    __syncthreads();
    float s2 = 0.f;
#pragma unroll
    for (int x = 0; x < 24; ++x) { acc[x] -= mean; s2 += acc[x] * acc[x]; }
    ps[vq * 128 + j] = s2;
    __syncthreads();
    const float rstd = 1.0f / sqrtf((ps[j] + ps[128 + j] + ps[256 + j] + ps[384 + j]) * (1.0f / 96.0f) + LN_EPS);
    bf16_t* o = mix + (size_t)(t0 + j) * D + (type ? 640 : 256) + h * DV + vq * 24;
    if (type == 0) {
        const float* nw = a.ml_nw + (size_t)l * 384 + h * DV + vq * 24;
#pragma unroll
        for (int x = 0; x < 24; x += 2) *(unsigned*)(o + x) = pk2(acc[x] * rstd * nw[x], acc[x + 1] * rstd * nw[x + 1]);
    } else {
        const float* nw = a.ret_nw + (size_t)l * 384 + h * DV + vq * 24;
        const bf16_t* gg = P + (size_t)(t0 + j) * PWP + COL_RG + h * DV + vq * 24;
#pragma unroll
        for (int x = 0; x < 24; x += 2) *(unsigned*)(o + x) = pk2(acc[x] * rstd * nw[x] * siluf_(bf2f(gg[x])), acc[x + 1] * rstd * nw[x + 1] * siluf_(bf2f(gg[x + 1])));
    }
    __syncthreads();
}

__device__ __forceinline__ void fourier_seq_naive(const Frame& F, const Args& a) {
    unsigned char* ws = a.ws; const float* U = (const float*)(ws + WS_UCS); bf16_t* mix = (bf16_t*)(ws + WS_MIX);
    LAS float* ct = (LAS float*)F.lds; LAS float* st = ct + S;
    for (int i = F.tid; i < S; i += NTHR) { float sn, cs; sincosf(6.283185307179586f * (float)i / (float)S, &sn, &cs); ct[i] = cs; st[i] = sn; }
    __syncthreads();
    const int chn = F.tid & 255, kh = F.tid >> 8;
    const float nrm = 0.0013810679320049757f;
    for (int it = F.bid; it < NB * (S / 8); it += F.G) {
        const int b = it / (S / 8), k0 = (it % (S / 8)) * 8 + kh * 4;
        float acc0 = 0.f, acc1 = 0.f, acc2 = 0.f, acc3 = 0.f;
        const float* up = U + (size_t)b * S * 512 + chn;
        for (int s = 0; s < S; ++s) { const float uc = up[(size_t)s * 512], us = up[(size_t)s * 512 + 256];
            const int i0 = (k0 * s) & (S - 1), i1 = (i0 + s) & (S - 1), i2 = (i1 + s) & (S - 1), i3 = (i2 + s) & (S - 1);
            acc0 += uc * ct[i0] - us * st[i0]; acc1 += uc * ct[i1] - us * st[i1]; acc2 += uc * ct[i2] - us * st[i2]; acc3 += uc * ct[i3] - us * st[i3]; }
        bf16_t* o = mix + (size_t)(b * S + k0) * D + chn;
        o[0] = (bf16_t)f2bf(acc0 * nrm); o[D] = (bf16_t)f2bf(acc1 * nrm); o[2 * D] = (bf16_t)f2bf(acc2 * nrm); o[3 * D] = (bf16_t)f2bf(acc3 * nrm);
    }
    __syncthreads();
}

__device__ __forceinline__ int build_tiles(const Frame& F, unsigned* cnt, LAS int* tst, LAS unsigned char* tile_e) {
    if (F.tid == 0) { int acc = 0; for (int e = 0; e < NE; ++e) { tst[e] = acc; acc += ((int)__hip_atomic_load(cnt + e, __ATOMIC_RELAXED, __HIP_MEMORY_SCOPE_AGENT) + 255) >> 8; } tst[NE] = acc; }
    __syncthreads();
    const int ntot = tst[NE];
    for (int mt = F.tid; mt < ntot; mt += NTHR) { int e = 0; for (int q = 1; q < NE; ++q) if (mt >= tst[q]) e = q; tile_e[mt] = (unsigned char)e; }
    __syncthreads();
    return ntot;
}

__device__ __forceinline__ void phaseF(const Frame& F, const Args& a, int l) {
    unsigned char* ws = a.ws;
    const float* pre = (const float*)(ws + WS_PRE); float* x1f = (float*)(ws + WS_X1F); bf16_t* x1b = (bf16_t*)(ws + WS_X1B);
    int* tke = (int*)(ws + WS_TKE); float* tkg = (float*)(ws + WS_TKG); int* tks = (int*)(ws + WS_TKS); int* list = (int*)(ws + WS_LIST);
    unsigned* cnt = F.ctl + CW_CNT + l * 64;
    LAS float* wrT = (LAS float*)F.lds;
    LAS int* lcnt = (LAS int*)(F.lds + MISC_OFF + 2048);
    LAS int* lbase = lcnt + 32;
    LAS int* le = lbase + 32;
    LAS int* ls = le + 512;
    const float* wr = a.w_router + (size_t)l * D * NE;
    for (int i = F.tid; i < D * NE; i += NTHR) { const int c = i >> 5, e = i & 31; wrT[e * D + c] = wr[i]; }
    if (F.tid < 32) lcnt[F.tid] = 0;
    __syncthreads();
    const float* g1 = a.ln1_g + (size_t)l * D; const float* b1 = a.ln1_b + (size_t)l * D; const float* br = a.b_router + (size_t)l * NE;
    for (int chunk = F.bid; chunk < T / 128; chunk += F.G) {
        for (int q = 0; q < 16; ++q) {
            const int tl = F.wave * 16 + q, t = chunk * 128 + tl;
            f32x4 v[4];
#pragma unroll
            for (int j = 0; j < 4; ++j) v[j] = *(const f32x4*)(pre + (size_t)t * D + 4 * F.lane + 256 * j);
            float s = 0.f;
#pragma unroll
            for (int j = 0; j < 4; ++j) s += (v[j].x + v[j].y) + (v[j].z + v[j].w);
            const float mean = wave_sum(s) * (1.f / D); float s2 = 0.f;
#pragma unroll
            for (int j = 0; j < 4; ++j) { v[j] = v[j] - mean; s2 += (v[j].x * v[j].x + v[j].y * v[j].y) + (v[j].z * v[j].z + v[j].w * v[j].w); }
            const float rstd = 1.f / sqrtf(wave_sum(s2) * (1.f / D) + LN_EPS);
#pragma unroll
            for (int j = 0; j < 4; ++j) { const f32x4 gg = *(const f32x4*)(g1 + 4 * F.lane + 256 * j), bb = *(const f32x4*)(b1 + 4 * F.lane + 256 * j);
                v[j] = v[j] * rstd * gg + bb;
                *(f32x4*)(x1f + (size_t)t * D + 4 * F.lane + 256 * j) = v[j];
                u32x2 w; w.x = pk2(v[j].x, v[j].y); w.y = pk2(v[j].z, v[j].w); *(u32x2*)(x1b + (size_t)t * D + 4 * F.lane + 256 * j) = w; }
            float mylogit = -INFINITY;
            for (int e = 0; e < NE; ++e) { float p = 0.f;
#pragma unroll
                for (int j = 0; j < 4; ++j) { const f32x4 w = *(const LAS f32x4*)(wrT + e * D + 4 * F.lane + 256 * j); p += (v[j].x * w.x + v[j].y * w.y) + (v[j].z * w.z + v[j].w * w.w); }
                p = wave_sum(p);
                if (F.lane == e) mylogit = p + br[e]; }
            float tv[4]; int ti[4];
#pragma unroll
            for (int k = 0; k < 4; ++k) { float bv = mylogit; int bi = F.lane;
#pragma unroll
                for (int o = 1; o < 64; o <<= 1) { const float ov = __shfl_xor(bv, o); const int oi = __shfl_xor(bi, o); if (ov > bv || (ov == bv && oi < bi)) { bv = ov; bi = oi; } }
                tv[k] = bv; ti[k] = bi; if (F.lane == bi) mylogit = -INFINITY; }
            const float w1 = __expf(tv[1] - tv[0]), w2 = __expf(tv[2] - tv[0]), w3 = __expf(tv[3] - tv[0]); const float inv = 1.0f / (1.0f + w1 + w2 + w3);
            if (F.lane < 4) { const int k = F.lane; const int e = k == 0 ? ti[0] : k == 1 ? ti[1] : k == 2 ? ti[2] : ti[3]; const float g = (k == 0 ? 1.0f : k == 1 ? w1 : k == 2 ? w2 : w3) * inv;
                tke[t * 4 + k] = e; tkg[t * 4 + k] = g;
                const int sl = __hip_atomic_fetch_add(lcnt + e, 1, __ATOMIC_RELAXED, __HIP_MEMORY_SCOPE_WORKGROUP);
                le[tl * 4 + k] = e; ls[tl * 4 + k] = sl; }
        }
        __syncthreads();
        if (F.tid < 32) lbase[F.tid] = (int)__hip_atomic_fetch_add(cnt + F.tid, (unsigned)lcnt[F.tid], __ATOMIC_RELAXED, __HIP_MEMORY_SCOPE_AGENT);
        __syncthreads();
        { const int tl = F.tid >> 2, k = F.tid & 3, t = chunk * 128 + tl, e = le[F.tid], slot = lbase[e] + ls[F.tid];
          list[(size_t)e * T + slot] = t; tks[t * 4 + k] = slot; }
        __syncthreads();
        if (F.tid < 32) lcnt[F.tid] = 0;
        __syncthreads();
    }
}

__device__ __forceinline__ void phaseG0(const Frame& F, const Args& a, int l) {
    unsigned char* ws = a.ws;
    unsigned* cnt = F.ctl + CW_CNT + l * 64;
    LAS int* tst = (LAS int*)(F.lds + MISC_OFF + 256); LAS unsigned char* tile_e = (LAS unsigned char*)(F.lds + MISC_OFF + 512);
    const int ntot = build_tiles(F, cnt, tst, tile_e);
    const bf16_t* x1b = (const bf16_t*)(ws + WS_X1B); bf16_t* xs = (bf16_t*)(ws + WS_XS); const int* list = (const int*)(ws + WS_LIST);
    const int gw = F.bid * NWAVES + F.wave, NGW = F.G * NWAVES;
    for (int r = gw; r < ntot * 256; r += NGW) { const int mt = r >> 8, e = tile_e[mt], within = r - tst[e] * 256;
        const int c = (int)__hip_atomic_load(cnt + e, __ATOMIC_RELAXED, __HIP_MEMORY_SCOPE_AGENT);
        const int tok = within < c ? list[(size_t)e * T + within] : 0;
        const u32x4* src = (const u32x4*)(x1b + (size_t)tok * D); u32x4* dst = (u32x4*)(xs + (size_t)r * D);
        dst[F.lane] = src[F.lane]; dst[64 + F.lane] = src[64 + F.lane]; }
    __syncthreads();
}

__device__ __forceinline__ void phaseI(const Frame& F, const Args& a, int l) {
    unsigned char* ws = a.ws;
    unsigned* cnt = F.ctl + CW_CNT + l * 64;
    LAS int* tst = (LAS int*)(F.lds + MISC_OFF + 256); LAS unsigned char* tile_e = (LAS unsigned char*)(F.lds + MISC_OFF + 512);
    (void)build_tiles(F, cnt, tst, tile_e);
    const float* x1f = (const float*)(ws + WS_X1F); const bf16_t* Y = (const bf16_t*)(ws + WS_Y);
    const int* tke = (const int*)(ws + WS_TKE); const float* tkg = (const float*)(ws + WS_TKG); const int* tks = (const int*)(ws + WS_TKS);
    float* xf = (float*)(ws + WS_XF); bf16_t* xb = (bf16_t*)(ws + WS_XB);
    const float* g2 = a.ln2_g + (size_t)l * D; const float* b2 = a.ln2_b + (size_t)l * D;
    const int gw = F.bid * NWAVES + F.wave, NGW = F.G * NWAVES;
    for (int t = gw; t < T; t += NGW) {
        f32x4 v[4];
#pragma unroll
        for (int j = 0; j < 4; ++j) v[j] = *(const f32x4*)(x1f + (size_t)t * D + 4 * F.lane + 256 * j) * DN_ALPHA;
#pragma unroll
        for (int k = 0; k < 4; ++k) { const int e = tke[t * 4 + k]; const float g = tkg[t * 4 + k]; const size_t row = (size_t)tst[e] * 256 + tks[t * 4 + k];
#pragma unroll
            for (int j = 0; j < 4; ++j) { const u32x2 w = *(const u32x2*)(Y + row * D + 4 * F.lane + 256 * j);
                v[j].x += g * __builtin_bit_cast(float, w.x << 16); v[j].y += g * __builtin_bit_cast(float, w.x & 0xffff0000u);
                v[j].z += g * __builtin_bit_cast(float, w.y << 16); v[j].w += g * __builtin_bit_cast(float, w.y & 0xffff0000u); } }
        ln_row(v, g2, b2, xf + (size_t)t * D, xb + (size_t)t * D, l == NL - 1 ? a.out + (size_t)t * D : nullptr, F.lane);
    }
    __syncthreads();
}

template <int PHMASK_T> __global__ void __launch_bounds__(NTHR, 2) hybrid_fwd(Args a) {
    extern __shared__ __attribute__((aligned(16))) unsigned char lds_raw[];
    Frame F;
    F.lds = (LAS unsigned char*)lds_raw;
    F.tid = threadIdx.x; F.lane = F.tid & 63; F.wave = __builtin_amdgcn_readfirstlane(F.tid >> 6);
    F.G = gridDim.x; F.bid = blockIdx.x;
    F.ctl = (unsigned*)(a.ws + WS_CTL);
    unsigned char* ws = a.ws;
    volatile LAS unsigned* MISC = (volatile LAS unsigned*)(F.lds + MISC_OFF);
    if (F.tid < 64) MISC[F.tid] = 0u;
    __syncthreads();
#if MK_MULTI
#define GRID_BAR() do { } while (0)
#else
    XcdBarrier bar = xcd_barrier_post(F.ctl + CW_BAR, MISC);
#define GRID_BAR() xcd_barrier(bar)
#endif
    const int lo = a.ph_lo, hi = a.ph_hi;
#define PH_ON(j) (((PHMASK_T) >> (j)) & 1)
#define IN(k) (lo <= (k) && (k) < hi)
#define SEAM(k) do { if (IN(k) && IN((k) + 1)) GRID_BAR(); } while (0)
    if (PH_ON(10) && IN(0)) { p0_prologue(F, a); }
    SEAM(0);
    for (int l = 0; l < NL; ++l) {
        const int pb = 1 + l * NPH_LAYER;
        if (PH_ON(0) && IN(pb + 0)) {
            pg8::PlainOrder So; So.init(ws + WS_XB, (bf16_t*)(ws + WS_WIN) + (size_t)l * PWP * D, T, PWP, D, F.G, F.bid);
            pg8::EpiBf16Bias E{(bf16_t*)(ws + WS_P), PWP, (const float*)(ws + WS_BIN) + (size_t)l * PWP};
            pg8::gemm_phase<pg8::EpiBf16Bias, pg8::PlainOrder, true, true>(F.lds, D, So, E);
        }
        SEAM(pb + 0);
        if (PH_ON(1) && IN(pb + 1)) {
            for (int u = F.bid; u < 2048; u += F.G) phaseB_unit(F, a, l, u);
            fourier_chan_naive(F, a);
        }
        SEAM(pb + 1);
        if (PH_ON(2) && IN(pb + 2)) { for (int u = F.bid; u < 256; u += F.G) phaseC_unit(F, a, u); }
        SEAM(pb + 2);
        if (PH_ON(3) && IN(pb + 3)) {
            for (int u = F.bid; u < 2048; u += F.G) phaseD_unit(F, a, l, u);
            fourier_seq_naive(F, a);
        }
        SEAM(pb + 3);
        if (PH_ON(4) && IN(pb + 4)) {
            pg8::PlainOrder So; So.init(ws + WS_MIX, (bf16_t*)(ws + WS_WOUT) + (size_t)l * D * D, T, D, D, F.G, F.bid);
            pg8::EpiResF32 E{(float*)(ws + WS_PRE), (const float*)(ws + WS_XF), D, DN_ALPHA};
            pg8::gemm_phase<pg8::EpiResF32, pg8::PlainOrder, true, true>(F.lds, D, So, E);
        }
        SEAM(pb + 4);
        if (PH_ON(5) && IN(pb + 5)) phaseF(F, a, l);
        SEAM(pb + 5);
        if (PH_ON(6) && IN(pb + 6)) phaseG0(F, a, l);
        SEAM(pb + 6);
        if (PH_ON(7) && IN(pb + 7)) {
            LAS int* tst = (LAS int*)(F.lds + MISC_OFF + 256); LAS unsigned char* tile_e = (LAS unsigned char*)(F.lds + MISC_OFF + 512);
            const int ntot = build_tiles(F, F.ctl + CW_CNT + l * 64, tst, tile_e);
            pg8::GroupOrder So{(const char*)(ws + WS_XS), (const char*)(ws + WS_W1) + (size_t)l * NE * 2048 * D * 2, D, 8, ntot, F.G, F.bid, (size_t)2048 * D * 2, tile_e};
            pg8::EpiSwiglu E{(bf16_t*)(ws + WS_H), a.b1 + (size_t)l * NE * 2048};
            pg8::gemm_phase<pg8::EpiSwiglu, pg8::GroupOrder, true, true>(F.lds, D, So, E);
        }
        SEAM(pb + 7);
        if (PH_ON(8) && IN(pb + 8)) {
            LAS int* tst = (LAS int*)(F.lds + MISC_OFF + 256); LAS unsigned char* tile_e = (LAS unsigned char*)(F.lds + MISC_OFF + 512);
            const int ntot = build_tiles(F, F.ctl + CW_CNT + l * 64, tst, tile_e);
            pg8::GroupOrder So{(const char*)(ws + WS_H), (const char*)(ws + WS_W2) + (size_t)l * NE * D * FF * 2, FF, 4, ntot, F.G, F.bid, (size_t)D * FF * 2, tile_e};
            pg8::EpiExpertOut E{(bf16_t*)(ws + WS_Y), a.b2 + (size_t)l * NE * D};
            pg8::gemm_phase<pg8::EpiExpertOut, pg8::GroupOrder, true, true>(F.lds, FF, So, E);
        }
        SEAM(pb + 8);
        if (PH_ON(9) && IN(pb + 9)) phaseI(F, a, l);
        SEAM(pb + 9);
    }
#undef IN
#undef SEAM
}

template <int MASK> static void launch_one(int grid, hipStream_t stream, const Args& a) {
    static bool attr = false;
    if (!attr) { (void)hipFuncSetAttribute((const void*)hybrid_fwd<MASK>, hipFuncAttributeMaxDynamicSharedMemorySize, LDS_BYTES); attr = true; }
    hipLaunchKernelGGL(hybrid_fwd<MASK>, dim3(grid), dim3(NTHR), LDS_BYTES, stream, a);
}
extern "C" void kernel_launch(void* const* d_in, const int* in_sizes, int n_in, void* d_out, int out_size, void* d_ws, size_t ws_size, hipStream_t stream) {
    static int grid = 0;
    if (grid == 0) {
        if (n_in != 19 || out_size != T * D || ws_size < WS_END) { fprintf(stderr, "kernel_launch: unexpected shapes (n_in %d out %d ws %zu need %zu)\n", n_in, out_size, ws_size, (size_t)WS_END); grid = -1; return; }
        int dev = 0, cus = 0;
        if (hipGetDevice(&dev) != hipSuccess || hipDeviceGetAttribute(&cus, hipDeviceAttributeMultiprocessorCount, dev) != hipSuccess) { grid = -1; return; }
        grid = cus;
    }
    if (grid < 0) return;
    (void)hipMemsetAsync((char*)d_ws + WS_CTL, 0, CTL_BYTES, stream);
    Args a{};
    a.x = (const float*)d_in[0]; a.emb_g = (const float*)d_in[1]; a.emb_b = (const float*)d_in[2]; a.w_in = (const float*)d_in[3]; a.b_in = (const float*)d_in[4];
    a.conv_w = (const float*)d_in[5]; a.ml_nw = (const float*)d_in[6]; a.ret_nw = (const float*)d_in[7]; a.w_out = (const float*)d_in[8];
    a.ln1_g = (const float*)d_in[9]; a.ln1_b = (const float*)d_in[10]; a.w_router = (const float*)d_in[11]; a.b_router = (const float*)d_in[12];
    a.w1 = (const float*)d_in[13]; a.b1 = (const float*)d_in[14]; a.w2 = (const float*)d_in[15]; a.b2 = (const float*)d_in[16]; a.ln2_g = (const float*)d_in[17]; a.ln2_b = (const float*)d_in[18];
    a.out = (float*)d_out; a.ws = (unsigned char*)d_ws;
#if MK_MULTI
    a.ph_lo = 0; a.ph_hi = 1; launch_one<0x400>(grid, stream, a);
    for (int l = 0; l < NL; ++l) {
        const int pb = 1 + l * NPH_LAYER;
#define LP(j) a.ph_lo = pb + (j); a.ph_hi = pb + (j) + 1; launch_one<(1 << (j))>(grid, stream, a);
        LP(0) LP(1) LP(2) LP(3) LP(4) LP(5) LP(6) LP(7) LP(8) LP(9)
#undef LP
    }
#else
    a.ph_lo = 0; a.ph_hi = NPH; launch_one<0x7ff>(grid, stream, a);
#endif
}
```

```cpp
#include <hip/hip_runtime.h>
#include <cstdio>
#include <cstdint>

#ifndef MK_MULTI
#define MK_MULTI 0
#endif

#define LAS __attribute__((address_space(3)))
#define GAS __attribute__((address_space(1)))
typedef unsigned short bf16_t;
typedef short bf16x8 __attribute__((ext_vector_type(8)));
typedef float f32x4 __attribute__((ext_vector_type(4)));
typedef float f32x2 __attribute__((ext_vector_type(2)));
typedef unsigned u32x4 __attribute__((ext_vector_type(4)));
typedef unsigned u32x2 __attribute__((ext_vector_type(2)));

constexpr int D = 1024, NB = 4, S = 8192, T = NB * S, NL = 4;
constexpr int CH = 128, NCH = S / CH;
constexpr int PW = 2576, PWP = 2816;
constexpr int COL_F = 0, COL_MQK = 256, COL_MV = 640, COL_MO = 1024, COL_MG = 1408, COL_RQ = 1424, COL_RK = 1616, COL_RV = 1808, COL_RG = 2192;
constexpr int NH = 4, DK = 48, DV = 96;
constexpr int NE = 32, TOPK = 4, FF = 1024;
constexpr int ROWS_PAD = T * TOPK + NE * 256;
constexpr int MT_MAX = ROWS_PAD / 256;
constexpr float LN_EPS = 1e-5f;
constexpr float DN_ALPHA = 1.6817928305074290f;
constexpr float SW_ALPHA = 1.702f, SW_LIMIT = 7.0f;

constexpr size_t MiB = 1u << 20;
constexpr size_t WS_CTL = 0, CTL_BYTES = 1 * MiB;
constexpr size_t WS_WIN = 1 * MiB;
constexpr size_t WS_WOUT = WS_WIN + 22 * MiB;
constexpr size_t WS_W1 = WS_WOUT + 8 * MiB;
constexpr size_t WS_W2 = WS_W1 + 512 * MiB;
constexpr size_t WS_BIN = WS_W2 + 256 * MiB;
constexpr size_t WS_ROT = WS_BIN + 1 * MiB;
constexpr size_t WS_XF = WS_ROT + 2 * MiB;
constexpr size_t WS_XB = WS_XF + 128 * MiB;
constexpr size_t WS_P = WS_XB + 64 * MiB;
constexpr size_t WS_MIX = WS_P + 176 * MiB;
constexpr size_t WS_PRE = WS_MIX + 64 * MiB;
constexpr size_t WS_X1F = WS_PRE + 128 * MiB;
constexpr size_t WS_X1B = WS_X1F + 128 * MiB;
constexpr size_t WS_XS = WS_X1B + 64 * MiB;
constexpr size_t WS_H = WS_XS + 272 * MiB;
constexpr size_t WS_Y = WS_H + 272 * MiB;
constexpr size_t WS_TKE = WS_Y + 272 * MiB;
constexpr size_t WS_TKG = WS_TKE + 1 * MiB;
constexpr size_t WS_TKS = WS_TKG + 1 * MiB;
constexpr size_t WS_LIST = WS_TKS + 1 * MiB;
constexpr size_t WS_MC = WS_LIST + 4 * MiB;
constexpr size_t WS_RS = WS_MC + 36 * MiB;
constexpr size_t WS_MN = WS_RS + 36 * MiB;
constexpr size_t WS_MSC = WS_MN + 1 * MiB;
constexpr size_t WS_UCS = WS_MSC + 1 * MiB;
constexpr size_t WS_END = WS_UCS + 64 * MiB;

constexpr int CW_TMO = 0;
constexpr int CW_BAR = 4096;
constexpr int CW_CNT = 16384;

constexpr int RING_BYTES = 131072;
constexpr int MISC_OFF = RING_BYTES;
constexpr int LDS_BYTES = 147456;

__device__ __forceinline__ unsigned f2bf(float f) { unsigned u = __builtin_bit_cast(unsigned, f); return (u + 0x7fffu + ((u >> 16) & 1u)) >> 16; }
__device__ __forceinline__ unsigned pk2(float lo, float hi) { return f2bf(lo) | (f2bf(hi) << 16); }
__device__ __forceinline__ float bf2f(bf16_t b) { return __builtin_bit_cast(float, (unsigned)b << 16); }
__device__ __forceinline__ float wave_sum(float v) {
#pragma unroll
    for (int o = 1; o < 64; o <<= 1) v += __shfl_xor(v, o);
    return v;
}
__device__ __forceinline__ float wave_max(float v) {
#pragma unroll
    for (int o = 1; o < 64; o <<= 1) v = fmaxf(v, __shfl_xor(v, o));
    return v;
}
__device__ __forceinline__ float sigmoidf_(float x) { return 1.0f / (1.0f + __expf(-x)); }
__device__ __forceinline__ float siluf_(float x) { return x / (1.0f + __expf(-x)); }
__device__ __forceinline__ float logsigmoidf_(float x) { return x >= 0.f ? -log1pf(__expf(-x)) : x - log1pf(__expf(x)); }

namespace pg8 {
constexpr int BM = 256, BK = 64, HALF = 128, HTB = HALF * BK * 2, STAGE_BYTES = 8 * HTB;
__host__ __device__ __forceinline__ int lds_byte(int r, int c) { const int st = (r >> 4) * 2 + (c >> 5), rr = r & 15, cc = c & 31, ob = rr * 64 + cc * 2; return st * 1024 + (ob ^ (((ob >> 9) & 1) << 5)); }
__host__ __device__ __forceinline__ void stage_rc(int b, int& R, int& C) { const int st = b / 1024, sb = b % 1024, swz = sb ^ (((sb >> 9) & 1) << 5); R = (st >> 1) * 16 + swz / 64; C = (st & 1) * 32 + (swz % 64) / 2; }
__host__ __device__ __forceinline__ int perm32(int rho) { const int n = rho >> 4, i = rho & 15; return 8 * (i >> 2) + 4 * n + (i & 3); }
struct Unit { int pm, pn, e; };
__device__ __forceinline__ unsigned cvt_pk_bf16(float lo, float hi) { unsigned r; asm volatile("v_cvt_pk_bf16_f32 %0, %1, %2" : "=v"(r) : "v"(lo), "v"(hi)); return r; }

template <class Epi, class Sched, bool ALIGN_EPI = false, bool SP2 = false>
__device__ __forceinline__ void gemm_phase(LAS unsigned char* lds, const int K, const Sched& S, const Epi& E) {
    const int tid = threadIdx.x, wid = __builtin_amdgcn_readfirstlane(tid >> 6), lane = tid & 63, wr = wid >> 2, wc = wid & 3, fr = lane & 15, fq = lane >> 4;
    const int nt = K / BK;
    unsigned voffA[2], voffB[2];
#pragma unroll
    for (int i = 0; i < 2; ++i) { int R, C; stage_rc(tid * 16 + i * 8192, R, C); const int Rb = Epi::PERM ? ((R & ~31) + perm32(R & 31)) : R;
        voffA[i] = (unsigned)(R * K + C) * 2u; voffB[i] = (unsigned)(Rb * K + C) * 2u; }
    const size_t kstep = (size_t)(BK * 2);
    const size_t hstep = (size_t)HALF * K * 2;
    const unsigned ldsw = (unsigned)wid * 1024u;
    const int aoff = lds_byte(wr * 64 + fr, fq * 8), boff = lds_byte(wc * 32 + fr, fq * 8);
#define PG8_SA(b, h) (((b) * 2 + (h)) * HTB)
#define PG8_SB(b, h) ((4 + (b) * 2 + (h)) * HTB)
#define PG8_STAGE(bufoff, gbase, voff) do { _Pragma("unroll") for (int _i = 0; _i < 2; ++_i) \
        __builtin_amdgcn_global_load_lds((const unsigned*)((const char*)(gbase) + (voff)[_i]), (LAS unsigned*)(lds + (bufoff) + ldsw + _i * 8192), 16, 0, 0); } while (0)
#define PG8_LDA(dst, b, h) do { _Pragma("unroll") for (int m = 0; m < 4; ++m) _Pragma("unroll") for (int k = 0; k < 2; ++k) dst[m][k] = *(const LAS bf16x8*)(lds + PG8_SA(b, h) + aoff + m * 2048 + k * 1024); } while (0)
#define PG8_LDB(dst, b, h) do { _Pragma("unroll") for (int n = 0; n < 2; ++n) _Pragma("unroll") for (int k = 0; k < 2; ++k) dst[n][k] = *(const LAS bf16x8*)(lds + PG8_SB(b, h) + boff + n * 2048 + k * 1024); } while (0)
#define PG8_MMA(ai, bj, At, Bt) do { __builtin_amdgcn_s_setprio(1); _Pragma("unroll") for (int m = 0; m < 4; ++m) _Pragma("unroll") for (int n = 0; n < 2; ++n) _Pragma("unroll") for (int k = 0; k < 2; ++k) \
        acc[ai][bj][m][n] = __builtin_amdgcn_mfma_f32_16x16x32_bf16(Bt[n][k], At[m][k], acc[ai][bj][m][n], 0, 0, 0); __builtin_amdgcn_s_setprio(0); } while (0)
#define PG8_WAIT_V(n) asm volatile("s_waitcnt vmcnt(" #n ")" ::: "memory")
#define PG8_WAIT_L(n) asm volatile("s_waitcnt lgkmcnt(" #n ")" ::: "memory")
#define PG8_BAR __builtin_amdgcn_s_barrier()
#define PG8_SCHED __builtin_amdgcn_sched_barrier(0)
    Unit cur, nxt; int ui = 0;
    if (!S.next(0, cur)) return;
    f32x4 acc[2][2][4][2];
#pragma unroll
    for (int a = 0; a < 2; ++a)
#pragma unroll
        for (int b = 0; b < 2; ++b)
#pragma unroll
            for (int m = 0; m < 4; ++m)
#pragma unroll
                for (int n = 0; n < 2; ++n) acc[a][b][m][n] = (f32x4){0.f, 0.f, 0.f, 0.f};
    bf16x8 At[4][2], B0[2][2], B1[2][2];
    const char* cA = S.a_base(cur); const char* cB = S.b_base(cur);
    if constexpr (SP2) {
        PG8_STAGE(PG8_SB(0, 0), cB, voffB); PG8_STAGE(PG8_SB(0, 1), cB + hstep, voffB); PG8_STAGE(PG8_SA(0, 0), cA, voffA); PG8_STAGE(PG8_SA(0, 1), cA + hstep, voffA);
        if (wr == 1) PG8_BAR;
        PG8_WAIT_V(2); PG8_BAR;
        PG8_STAGE(PG8_SB(1, 0), cB + kstep, voffB); PG8_STAGE(PG8_SA(1, 0), cA + kstep, voffA); PG8_STAGE(PG8_SB(1, 1), cB + hstep + kstep, voffB);
        PG8_WAIT_V(6); PG8_BAR;
    } else {
        PG8_STAGE(PG8_SB(0, 0), cB, voffB); PG8_STAGE(PG8_SA(0, 0), cA, voffA); PG8_STAGE(PG8_SB(0, 1), cB + hstep, voffB); PG8_STAGE(PG8_SA(0, 1), cA + hstep, voffA);
        if (wr == 1) PG8_BAR;
        PG8_WAIT_V(4); PG8_BAR;
        PG8_STAGE(PG8_SB(1, 0), cB + kstep, voffB); PG8_STAGE(PG8_SA(1, 0), cA + kstep, voffA); PG8_STAGE(PG8_SB(1, 1), cB + hstep + kstep, voffB);
        PG8_WAIT_V(6); PG8_BAR;
    }
    for (;;) {
        const bool has_next = S.next(ui + 1, nxt);
        const char* nA = has_next ? S.a_base(nxt) : cA; const char* nB = has_next ? S.b_base(nxt) : cB;
        for (int t = 0; t < nt; t += 2) {
            const bool last = (t == nt - 2);
            const char* a1 = cA + (size_t)(t + 1) * kstep;
            const char* a2 = last ? nA : cA + (size_t)(t + 2) * kstep; const char* b2 = last ? nB : cB + (size_t)(t + 2) * kstep;
            const char* a3 = a2 + kstep; const char* b3 = b2 + kstep;
            if constexpr (SP2) {
            PG8_LDB(B0, 0, 0); PG8_LDB(B1, 0, 1); PG8_SCHED; PG8_LDA(At, 0, 0); PG8_STAGE(PG8_SA(1, 1), a1 + hstep, voffA);
            PG8_WAIT_V(8); PG8_WAIT_L(0); PG8_BAR; PG8_MMA(0, 0, At, B0); PG8_MMA(0, 1, At, B1); PG8_BAR; PG8_SCHED;
            PG8_LDA(At, 0, 1); PG8_STAGE(PG8_SB(0, 0), b2, voffB); PG8_STAGE(PG8_SB(0, 1), b2 + hstep, voffB); PG8_STAGE(PG8_SA(0, 0), a2, voffA);
            PG8_WAIT_V(8); PG8_WAIT_L(0); PG8_BAR; PG8_MMA(1, 0, At, B0); PG8_MMA(1, 1, At, B1); PG8_BAR; PG8_SCHED;
            PG8_LDB(B0, 1, 0); PG8_LDB(B1, 1, 1); PG8_SCHED; PG8_LDA(At, 1, 0); PG8_STAGE(PG8_SA(0, 1), a2 + hstep, voffA);
            PG8_WAIT_V(8); PG8_WAIT_L(0); PG8_BAR; PG8_MMA(0, 0, At, B0); PG8_MMA(0, 1, At, B1); PG8_BAR; PG8_SCHED;
            PG8_LDA(At, 1, 1); PG8_STAGE(PG8_SB(1, 0), b3, voffB); PG8_STAGE(PG8_SB(1, 1), b3 + hstep, voffB); PG8_STAGE(PG8_SA(1, 0), a3, voffA);
            PG8_WAIT_V(8); PG8_WAIT_L(0); PG8_BAR; PG8_MMA(1, 0, At, B0); PG8_MMA(1, 1, At, B1); PG8_BAR; PG8_SCHED;
            } else {
            PG8_LDB(B0, 0, 0); PG8_SCHED; PG8_LDA(At, 0, 0); PG8_STAGE(PG8_SA(1, 1), a1 + hstep, voffA);
            PG8_WAIT_L(8); PG8_BAR; PG8_WAIT_L(0); PG8_MMA(0, 0, At, B0); PG8_BAR; PG8_SCHED;
            PG8_LDB(B1, 0, 1); PG8_STAGE(PG8_SB(0, 0), b2, voffB);
            PG8_BAR; PG8_WAIT_L(0); PG8_MMA(0, 1, At, B1); PG8_BAR;
            PG8_LDA(At, 0, 1); PG8_STAGE(PG8_SA(0, 0), a2, voffA);
            PG8_BAR; PG8_WAIT_L(0); PG8_MMA(1, 0, At, B0); PG8_BAR; PG8_SCHED;
            PG8_STAGE(PG8_SB(0, 1), b2 + hstep, voffB);
            PG8_WAIT_V(6); PG8_BAR; PG8_MMA(1, 1, At, B1); PG8_BAR;
            PG8_LDB(B0, 1, 0); PG8_SCHED; PG8_LDA(At, 1, 0); PG8_STAGE(PG8_SA(0, 1), a2 + hstep, voffA);
            PG8_WAIT_L(8); PG8_BAR; PG8_WAIT_L(0); PG8_MMA(0, 0, At, B0); PG8_BAR; PG8_SCHED;
            PG8_LDB(B1, 1, 1); PG8_STAGE(PG8_SB(1, 0), b3, voffB);
            PG8_BAR; PG8_WAIT_L(0); PG8_MMA(0, 1, At, B1); PG8_BAR;
            PG8_LDA(At, 1, 1); PG8_STAGE(PG8_SA(1, 0), a3, voffA);
            PG8_BAR; PG8_WAIT_L(0); PG8_MMA(1, 0, At, B0); PG8_BAR; PG8_SCHED;
            PG8_STAGE(PG8_SB(1, 1), b3 + hstep, voffB);
            PG8_WAIT_V(6); PG8_BAR; PG8_MMA(1, 1, At, B1); PG8_BAR;
            }
        }
        if constexpr (ALIGN_EPI) { if (wr == 0) PG8_BAR; }
        E(acc, cur, wr, wc, fr, fq);
        if (!has_next) break;
#pragma unroll
        for (int a = 0; a < 2; ++a)
#pragma unroll
            for (int b = 0; b < 2; ++b)
#pragma unroll
                for (int m = 0; m < 4; ++m)
#pragma unroll
                    for (int n = 0; n < 2; ++n) acc[a][b][m][n] = (f32x4){0.f, 0.f, 0.f, 0.f};
        cur = nxt; cA = nA; cB = nB; ++ui;
        if constexpr (ALIGN_EPI) { if (wr == 1) PG8_BAR; }
    }
    PG8_WAIT_V(0);
    if constexpr (!ALIGN_EPI) { if (wr == 0) PG8_BAR; }
    PG8_BAR;
#undef PG8_SA
#undef PG8_SB
#undef PG8_STAGE
#undef PG8_LDA
#undef PG8_LDB
#undef PG8_MMA
#undef PG8_WAIT_V
#undef PG8_WAIT_L
#undef PG8_BAR
#undef PG8_SCHED
}

struct PlainOrder {
    const char* A; const char* Bt; int K; int nM, nN, nwg, G, c;
    __device__ __forceinline__ void init(const void* A_, const void* Bt_, int M, int N, int K_, int G_, int c_) { A = (const char*)A_; Bt = (const char*)Bt_; K = K_; nM = M / BM; nN = N / BM; nwg = nM * nN; G = G_; c = c_; }
    __device__ __forceinline__ bool next(int i, Unit& u) const {
        const long Lq = (long)i * G + c; if (Lq >= nwg) return false;
        int wgid = (int)Lq; { const int q = nwg / 8, r = nwg % 8, xcd = wgid % 8, off = wgid / 8; wgid = (xcd < r ? xcd * (q + 1) : r * (q + 1) + (xcd - r) * q) + off; }
        const int nig = 8 * nN, gid = wgid / nig, fm = gid * 8, gsz = (nM - fm) < 8 ? (nM - fm) : 8;
        u.pm = fm + ((wgid % nig) % gsz); u.pn = (wgid % nig) / gsz; u.e = 0; return true;
    }
    __device__ __forceinline__ const char* a_base(const Unit& u) const { return A + (size_t)u.pm * 256 * K * 2; }
    __device__ __forceinline__ const char* b_base(const Unit& u) const { return Bt + (size_t)u.pn * 256 * K * 2; }
};
struct GroupOrder {
    const char* A; const char* Bt; int K; int nN, ntot, G, c; size_t bstride; const LAS unsigned char* tile_e;
    __device__ __forceinline__ bool next(int i, Unit& u) const {
        const long Lq = (long)i * G + c; if (Lq >= (long)ntot * nN) return false;
        u.pm = (int)(Lq / nN); u.pn = (int)(Lq % nN); u.e = __builtin_amdgcn_readfirstlane((int)tile_e[u.pm]); return true;
    }
    __device__ __forceinline__ const char* a_base(const Unit& u) const { return A + (size_t)u.pm * 256 * K * 2; }
    __device__ __forceinline__ const char* b_base(const Unit& u) const { return Bt + (size_t)u.e * bstride + (size_t)u.pn * 256 * K * 2; }
};

struct EpiBf16Bias {
    static constexpr bool PERM = true;
    bf16_t* O; int ldc; const float* bias;
    __device__ __forceinline__ void operator()(const f32x4 (&acc)[2][2][4][2], const Unit& u, int wr, int wc, int fr, int fq) const {
        const int row0 = u.pm * BM + wr * 64 + fr, col0 = u.pn * BM + wc * 32 + 8 * fq;
        f32x4 bv[2][2];
#pragma unroll
        for (int bj = 0; bj < 2; ++bj)
#pragma unroll
            for (int n = 0; n < 2; ++n) bv[bj][n] = *(const f32x4*)(bias + col0 + bj * HALF + 4 * n);
#pragma unroll
        for (int ai = 0; ai < 2; ++ai)
#pragma unroll
            for (int m = 0; m < 4; ++m) { bf16_t* rowp = O + (size_t)(row0 + ai * HALF + m * 16) * ldc + col0;
#pragma unroll
                for (int bj = 0; bj < 2; ++bj) { const f32x4 v0 = acc[ai][bj][m][0] + bv[bj][0], v1 = acc[ai][bj][m][1] + bv[bj][1];
                    u32x4 w; w.x = cvt_pk_bf16(v0[0], v0[1]); w.y = cvt_pk_bf16(v0[2], v0[3]); w.z = cvt_pk_bf16(v1[0], v1[1]); w.w = cvt_pk_bf16(v1[2], v1[3]);
                    *(u32x4*)(rowp + bj * HALF) = w; } }
    }
};
struct EpiResF32 {
    static constexpr bool PERM = false;
    float* C; const float* R; int ldc; float alpha;
    __device__ __forceinline__ void operator()(const f32x4 (&acc)[2][2][4][2], const Unit& u, int wr, int wc, int fr, int fq) const {
        const int row0 = u.pm * BM + wr * 64 + fr, col0 = u.pn * BM + wc * 32 + 4 * fq;
#pragma unroll
        for (int ai = 0; ai < 2; ++ai)
#pragma unroll
            for (int m = 0; m < 4; ++m) { const size_t off = (size_t)(row0 + ai * HALF + m * 16) * ldc + col0;
#pragma unroll
                for (int bj = 0; bj < 2; ++bj)
#pragma unroll
                    for (int n = 0; n < 2; ++n) { const f32x4 r = *(const f32x4*)(R + off + bj * HALF + n * 16); *(f32x4*)(C + off + bj * HALF + n * 16) = acc[ai][bj][m][n] + r * alpha; } }
    }
};
struct EpiSwiglu {
    static constexpr bool PERM = true;
    bf16_t* H; const float* b1;
    __device__ __forceinline__ void operator()(const f32x4 (&acc)[2][2][4][2], const Unit& u, int wr, int wc, int fr, int fq) const {
        const int row0 = u.pm * BM + wr * 64 + fr, col0 = u.pn * HALF + wc * 32 + 8 * fq;
        const float* bg = b1 + (size_t)u.e * 2048 + col0; const float* bu = bg + 1024;
        f32x4 g0 = *(const f32x4*)(bg), g1 = *(const f32x4*)(bg + 4), u0 = *(const f32x4*)(bu), u1 = *(const f32x4*)(bu + 4);
#pragma unroll
        for (int ai = 0; ai < 2; ++ai)
#pragma unroll
            for (int m = 0; m < 4; ++m) { bf16_t* rowp = H + (size_t)(row0 + ai * HALF + m * 16) * FF + col0;
                float o[8];
#pragma unroll
                for (int n = 0; n < 2; ++n)
#pragma unroll
                    for (int j = 0; j < 4; ++j) { float g = acc[ai][0][m][n][j] + (n ? g1[j] : g0[j]); float up = acc[ai][1][m][n][j] + (n ? u1[j] : u0[j]);
                        g = fminf(g, SW_LIMIT); up = fminf(fmaxf(up, -SW_LIMIT), SW_LIMIT);
                        const float glu = g / (1.0f + __expf(-SW_ALPHA * g)); o[n * 4 + j] = (up + 1.0f) * glu; }
                u32x4 w; w.x = cvt_pk_bf16(o[0], o[1]); w.y = cvt_pk_bf16(o[2], o[3]); w.z = cvt_pk_bf16(o[4], o[5]); w.w = cvt_pk_bf16(o[6], o[7]);
                *(u32x4*)rowp = w; }
    }
};
struct EpiExpertOut {
    static constexpr bool PERM = true;
    bf16_t* Y; const float* b2;
    __device__ __forceinline__ void operator()(const f32x4 (&acc)[2][2][4][2], const Unit& u, int wr, int wc, int fr, int fq) const {
        const int row0 = u.pm * BM + wr * 64 + fr, col0 = u.pn * BM + wc * 32 + 8 * fq;
        const float* bb = b2 + (size_t)u.e * D + col0;
        f32x4 bv[2][2];
#pragma unroll
        for (int bj = 0; bj < 2; ++bj)
#pragma unroll
            for (int n = 0; n < 2; ++n) bv[bj][n] = *(const f32x4*)(bb + bj * HALF + 4 * n);
#pragma unroll
        for (int ai = 0; ai < 2; ++ai)
#pragma unroll
            for (int m = 0; m < 4; ++m) { bf16_t* rowp = Y + (size_t)(row0 + ai * HALF + m * 16) * D + col0;
#pragma unroll
                for (int bj = 0; bj < 2; ++bj) { const f32x4 v0 = acc[ai][bj][m][0] + bv[bj][0], v1 = acc[ai][bj][m][1] + bv[bj][1];
                    u32x4 w; w.x = cvt_pk_bf16(v0[0], v0[1]); w.y = cvt_pk_bf16(v0[2], v0[3]); w.z = cvt_pk_bf16(v1[0], v1[1]); w.w = cvt_pk_bf16(v1[2], v1[3]);
                    *(u32x4*)(rowp + bj * HALF) = w; } }
    }
};
}

#define XB_TMO      128
#define XB_XCNT(j)  (256  + 64 * (j))
#define XB_XSUB(j)  (1280 + 64 * (j))
#define XB_XGEN(j)  (2304 + 64 * (j))
#define XB_TOP      3328
#define XB_TOPGEN   3392
#define XCD_BAR_WORDS 3456
#define XB_SPIN_CAP (1u << 22)
__device__ __forceinline__ unsigned xb_ld(unsigned* p)              { return __hip_atomic_load(p, __ATOMIC_RELAXED, __HIP_MEMORY_SCOPE_AGENT); }
__device__ __forceinline__ unsigned xb_add(unsigned* p, unsigned v) { return __hip_atomic_fetch_add(p, v, __ATOMIC_RELAXED, __HIP_MEMORY_SCOPE_AGENT); }
__device__ __forceinline__ unsigned xb_xcc_id() { return (unsigned)__builtin_amdgcn_s_getreg((3 << 11) | 20) & 0xFu; }
#define XB_SPIN(cond, bar) do { unsigned _sp = 0; while (cond) { __builtin_amdgcn_s_sleep(1); \
    if ((++_sp & 255u) == 0u) { if (xb_ld(&(bar)[XB_TMO])) break; if (_sp > XB_SPIN_CAP) { atomicAdd(&(bar)[XB_TMO], 1u); break; } } } } while (0)
struct XcdBarrier { unsigned* bar; unsigned x; volatile LAS unsigned* st; };
__device__ __forceinline__ XcdBarrier xcd_barrier_post(unsigned* bar, volatile LAS unsigned* st) {
    XcdBarrier b; b.bar = bar; b.x = xb_xcc_id(); b.st = st;
    if (threadIdx.x == 0) (void)xb_add(&bar[XB_XCNT(b.x)], 1u);
    return b;
}
__device__ __forceinline__ void xcd_barrier_complete(unsigned* bar, unsigned x, unsigned& nloc, unsigned& nx) {
    const unsigned G = gridDim.x * gridDim.y * gridDim.z;
    unsigned sum, cnt, mine, sp = 0u;
    for (;;) {
        sum = 0u; cnt = 0u; mine = 0u;
#pragma unroll
        for (unsigned j = 0; j < 16; ++j) { const unsigned c = xb_ld(&bar[XB_XCNT(j)]); sum += c; cnt += (c > 0u) ? 1u : 0u; mine = (j == x) ? c : mine; }
        if (sum == G) break;
        __builtin_amdgcn_s_sleep(1);
        if ((++sp & 255u) == 0u) { if (xb_ld(&bar[XB_TMO])) break; if (sp > XB_SPIN_CAP) { atomicAdd(&bar[XB_TMO], 1u); break; } }
    }
    nloc = mine > 0u ? mine : 1u; nx = cnt > 0u ? cnt : 1u;
}
__device__ __forceinline__ void xcd_barrier(const XcdBarrier& b) {
    asm volatile("s_waitcnt vmcnt(0)" ::: "memory");
    __syncthreads();
    if (threadIdx.x == 0) {
        unsigned* bar = b.bar;
        __builtin_amdgcn_s_waitcnt(0);
        unsigned nloc = b.st[0], nx = b.st[1];
        if (nloc == 0u) { xcd_barrier_complete(bar, b.x, nloc, nx); b.st[0] = nloc; b.st[1] = nx; }
        const unsigned old = xb_add(&bar[XB_XSUB(b.x)], 1u);
        const unsigned gen = old / nloc;
        if (old + 1u == (gen + 1u) * nloc) {
            __builtin_amdgcn_fence(__ATOMIC_RELEASE, "agent");
            asm volatile("s_waitcnt vmcnt(0)" ::: "memory");
            const unsigned og = xb_add(&bar[XB_TOP], 1u);
            const unsigned tg = og / nx;
            if (og + 1u == (tg + 1u) * nx) xb_add(&bar[XB_TOPGEN], 1u);
            else XB_SPIN(xb_ld(&bar[XB_TOPGEN]) == tg, bar);
            __builtin_amdgcn_fence(__ATOMIC_ACQUIRE, "agent");
            xb_add(&bar[XB_XGEN(b.x)], 1u);
            asm volatile("s_waitcnt vmcnt(0)" ::: "memory");
        } else {
            XB_SPIN(xb_ld(&bar[XB_XGEN(b.x)]) == gen, bar);
            __builtin_amdgcn_fence(__ATOMIC_ACQUIRE, "agent");
            asm volatile("s_waitcnt vmcnt(0)" ::: "memory");
        }
    }
    __syncthreads();
}

struct Args {
    const float* x; const float* emb_g; const float* emb_b; const float* w_in; const float* b_in; const float* conv_w; const float* ml_nw; const float* ret_nw;
    const float* w_out; const float* ln1_g; const float* ln1_b; const float* w_router; const float* b_router; const float* w1; const float* b1; const float* w2; const float* b2;
    const float* ln2_g; const float* ln2_b;
    float* out; unsigned char* ws; int ph_lo, ph_hi;
};
#define KA(f) (((const volatile __attribute__((address_space(4))) Args*)__builtin_amdgcn_kernarg_segment_ptr())->f)
constexpr int NWAVES = 8, NTHR = 512;
constexpr int NPH_LAYER = 10;
constexpr int NPH = 1 + NL * NPH_LAYER;

struct Frame {
    LAS unsigned char* lds;
    unsigned* ctl;
    int tid, lane, wave, G, bid;
};

__device__ __forceinline__ int sidx(int b, int h, int dir, int c) { return ((b * NH + h) * 2 + dir) * NCH + c; }

template <class RowMap>
__device__ __forceinline__ void transpose_item(const float* W, int K, int Nsrc, bf16_t* WT, LAS float* scr, int kb, int nb, int lane, const RowMap& rm) {
    const int k0 = 64 * kb, n0 = 32 * nb;
    const int nn = n0 + (lane & 31);
#pragma unroll 8
    for (int i = 0; i < 32; ++i) { const int kk = 2 * i + (lane >> 5); scr[kk * 33 + (lane & 31)] = nn < Nsrc ? W[(size_t)(k0 + kk) * Nsrc + nn] : 0.f; }
    asm volatile("s_waitcnt lgkmcnt(0)" ::: "memory");
    const int c = lane & 7;
#pragma unroll
    for (int j = 0; j < 4; ++j) { const int n = (lane >> 3) + 8 * j; const LAS float* s = scr + (8 * c) * 33 + n;
        u32x4 o; o.x = pk2(s[0 * 33], s[1 * 33]); o.y = pk2(s[2 * 33], s[3 * 33]); o.z = pk2(s[4 * 33], s[5 * 33]); o.w = pk2(s[6 * 33], s[7 * 33]);
        *(u32x4*)(WT + (size_t)rm(n0 + n) * K + k0 + 8 * c) = o; }
    asm volatile("s_waitcnt lgkmcnt(0)" ::: "memory");
}
struct RowId { __device__ __forceinline__ int operator()(int n) const { return n; } };
struct RowW1 { __device__ __forceinline__ int operator()(int n) const { const int up = n >> 10, j = n & 1023; return (j >> 7) * 256 + up * 128 + (j & 127); } };

__device__ __forceinline__ void ln_row(const f32x4 (&vin)[4], const float* g, const float* b, float* of, bf16_t* ob, float* of2, int lane) {
    f32x4 v[4]; float s = 0.f;
#pragma unroll
    for (int j = 0; j < 4; ++j) { v[j] = vin[j]; s += (v[j].x + v[j].y) + (v[j].z + v[j].w); }
    const float mean = wave_sum(s) * (1.f / D); float s2 = 0.f;
#pragma unroll
    for (int j = 0; j < 4; ++j) { v[j] = v[j] - mean; s2 += (v[j].x * v[j].x + v[j].y * v[j].y) + (v[j].z * v[j].z + v[j].w * v[j].w); }
    const float rstd = 1.f / sqrtf(wave_sum(s2) * (1.f / D) + LN_EPS);
#pragma unroll
    for (int j = 0; j < 4; ++j) { const f32x4 gg = *(const f32x4*)(g + 4 * lane + 256 * j), bb = *(const f32x4*)(b + 4 * lane + 256 * j);
        const f32x4 o = v[j] * rstd * gg + bb;
        if (of) *(f32x4*)(of + 4 * lane + 256 * j) = o;
        if (of2) *(f32x4*)(of2 + 4 * lane + 256 * j) = o;
        if (ob) { u32x2 w; w.x = pk2(o.x, o.y); w.y = pk2(o.z, o.w); *(u32x2*)(ob + 4 * lane + 256 * j) = w; } }
}

__device__ __forceinline__ void p0_prologue(const Frame& F, const Args& a) {
    unsigned char* ws = KA(ws);
    LAS float* scr = (LAS float*)(F.lds + F.wave * 16384);
    const int gw = F.bid * NWAVES + F.wave, NGW = F.G * NWAVES;
    const float* w_in_ = KA(w_in); const float* w_out_ = KA(w_out); const float* w1_ = KA(w1); const float* w2_ = KA(w2);
    constexpr int I_IN = NL * 16 * 88, I_OUT = NL * 16 * 32, I_W1 = NL * NE * 16 * 64, I_W2 = NL * NE * 16 * 32;
    for (int it = gw; it < I_IN + I_OUT + I_W1 + I_W2; it += NGW) {
        int r = it;
        if (r < I_IN) { const int l = r / (16 * 88), q = r % (16 * 88); transpose_item(w_in_ + (size_t)l * D * PW, D, PW, (bf16_t*)(ws + WS_WIN) + (size_t)l * PWP * D, scr, q / 88, q % 88, F.lane, RowId()); continue; } r -= I_IN;
        if (r < I_OUT) { const int l = r / (16 * 32), q = r % (16 * 32); transpose_item(w_out_ + (size_t)l * D * D, D, D, (bf16_t*)(ws + WS_WOUT) + (size_t)l * D * D, scr, q / 32, q % 32, F.lane, RowId()); continue; } r -= I_OUT;
        if (r < I_W1) { const int le = r / (16 * 64), q = r % (16 * 64); transpose_item(w1_ + (size_t)le * D * 2048, D, 2048, (bf16_t*)(ws + WS_W1) + (size_t)le * 2048 * D, scr, q / 64, q % 64, F.lane, RowW1()); continue; } r -= I_W1;
        { const int le = r / (16 * 32), q = r % (16 * 32); transpose_item(w2_ + (size_t)le * FF * D, FF, D, (bf16_t*)(ws + WS_W2) + (size_t)le * D * FF, scr, q / 32, q % 32, F.lane, RowId()); }
    }
    const int gt = F.bid * NTHR + F.tid, NGT = F.G * NTHR;
    float* binp = (float*)(ws + WS_BIN); const float* bin_ = KA(b_in);
    for (int i = gt; i < NL * PWP; i += NGT) { const int l = i / PWP, c = i % PWP; binp[i] = c < PW ? bin_[l * PW + c] : 0.f; }
    float* rot = (float*)(ws + WS_ROT);
    for (int i = gt; i < S * 24; i += NGT) { const int pos = i / 24, j = i % 24; const float inv = 1.0f / powf(10000.0f, (float)(2 * j) / 48.0f); const float ang = (float)pos * inv;
        float sn, cs; sincosf(ang, &sn, &cs); rot[2 * i] = cs; rot[2 * i + 1] = sn; }
    float* xf = (float*)(ws + WS_XF); bf16_t* xb = (bf16_t*)(ws + WS_XB); const float* xin = KA(x); const float* eg = KA(emb_g); const float* eb = KA(emb_b);
    for (int m = gw; m < T; m += NGW) { f32x4 v[4];
#pragma unroll
        for (int j = 0; j < 4; ++j) v[j] = *(const f32x4*)(xin + (size_t)m * D + 4 * F.lane + 256 * j);
        ln_row(v, eg, eb, xf + (size_t)m * D, xb + (size_t)m * D, nullptr, F.lane); }
}

template <bool REV, bool MAXOP> __device__ __forceinline__ void wave_scan128(LAS float* arr, int lane) {
    const int i0 = REV ? 127 - 2 * lane : 2 * lane, i1 = REV ? 126 - 2 * lane : 2 * lane + 1;
    const float a = arr[i0], b = arr[i1];
    float s = MAXOP ? fmaxf(a, b) : a + b;
#pragma unroll
    for (int o = 1; o < 64; o <<= 1) { const float t = __shfl_up(s, o); if (lane >= o) s = MAXOP ? fmaxf(s, t) : s + t; }
    float ex = __shfl_up(s, 1); if (lane == 0) ex = MAXOP ? -INFINITY : 0.f;
    arr[i0] = MAXOP ? fmaxf(ex, a) : ex + a; arr[i1] = MAXOP ? fmaxf(fmaxf(ex, a), b) : ex + a + b;
}
__device__ __forceinline__ float ret_lg(int h, float off) { return log1pf(-exp2f(-(5.0f + off) - (float)h)); }

__device__ __forceinline__ float mlstm_qk(const bf16_t* P, const float* convw, int b, int s, int ch) {
    float acc = 0.f;
#pragma unroll
    for (int d = 0; d < 3; ++d) { const int sp = s + d - 1; if (sp >= 0 && sp < S) acc += bf2f(P[(size_t)(b * S + sp) * PWP + COL_MQK + ch]) * convw[d * 384 + ch]; }
    return siluf_(acc);
}
__device__ __forceinline__ float ret_rot(const bf16_t* P, const float* rot, int b, int s, int colbase, int h, int kk) {
    const bf16_t* p = P + (size_t)(b * S + s) * PWP + colbase + h * DK + (kk & ~1);
    const float t1 = bf2f(p[0]), t2 = bf2f(p[1]);
    const float cs = rot[(s * 24 + (kk >> 1)) * 2], sn = rot[(s * 24 + (kk >> 1)) * 2 + 1];
    return (kk & 1) ? t1 * sn + t2 * cs : t1 * cs - t2 * sn;
}

__device__ __forceinline__ void phaseB_unit(const Frame& F, const Args& a, int l, int u) {
    unsigned char* ws = KA(ws);
    const bf16_t* P = (const bf16_t*)(ws + WS_P);
    const int type = u >> 10, r = u & 1023, b = r >> 8, c = (r >> 2) & 63, h = r & 3;
    LAS float* kS = (LAS float*)F.lds;
    LAS float* vS = kS + 128 * 49;
    LAS float* ga = vS + 128 * 97;
    LAS float* lff = ga, *lfb = ga + 128, *iff = ga + 256, *ibb = ga + 384, *pf = ga + 512, *pb = ga + 640, *scal = ga + 768;
    const int t0 = b * S + c * CH;
    const float kscale = 0.14433756729740643f;
    if (type == 0) {
        const float* convw = KA(conv_w) + (size_t)l * 3 * 384;
        for (int idx = F.tid; idx < 128 * DK; idx += NTHR) { const int j = idx / DK, kk = idx % DK; kS[j * 49 + kk] = mlstm_qk(P, convw, b, c * CH + j, 192 + h * DK + kk) * kscale; }
        for (int idx = F.tid; idx < 128 * DV; idx += NTHR) { const int j = idx / DV, vv = idx % DV; vS[j * 97 + vv] = bf2f(P[(size_t)(t0 + j) * PWP + COL_MV + h * DV + vv]); }
        if (F.tid < 128) { const bf16_t* g = P + (size_t)(t0 + F.tid) * PWP + COL_MG;
            iff[F.tid] = bf2f(g[h]); lff[F.tid] = logsigmoidf_(bf2f(g[4 + h])); ibb[F.tid] = bf2f(g[8 + h]); lfb[F.tid] = logsigmoidf_(bf2f(g[12 + h])); }
        __syncthreads();
        if (F.wave == 0) wave_scan128<false, false>(lff, F.lane);
        if (F.wave == 1) wave_scan128<true, false>(lfb, F.lane);
        __syncthreads();
        if (F.tid < 128) pf[F.tid] = lff[127] - lff[F.tid] + iff[F.tid];
        else if (F.tid < 256) { const int j = F.tid - 128; pb[j] = lfb[0] - lfb[j] + ibb[j]; }
        __syncthreads();
        if (F.wave == 0) { const float m = wave_max(fmaxf(pf[2 * F.lane], pf[2 * F.lane + 1])); if (F.lane == 0) scal[0] = m; }
        if (F.wave == 1) { const float m = wave_max(fmaxf(pb[2 * F.lane], pb[2 * F.lane + 1])); if (F.lane == 0) scal[1] = m; }
        __syncthreads();
        if (F.tid < 128) pf[F.tid] = __expf(pf[F.tid] - scal[0]);
        else if (F.tid < 256) { const int j = F.tid - 128; pb[j] = __expf(pb[j] - scal[1]); }
        __syncthreads();
        float* mC = (float*)(ws + WS_MC); float* mN = (float*)(ws + WS_MN); float* msc = (float*)(ws + WS_MSC);
        for (int idx = F.tid; idx < 2 * DV * DK; idx += NTHR) { const int dir = idx / (DV * DK), e = idx % (DV * DK), vv = e / DK, kk = e % DK; const LAS float* p = dir ? pb : pf;
            float s = 0.f;
            for (int j = 0; j < 128; ++j) s += p[j] * vS[j * 97 + vv] * kS[j * 49 + kk];
            mC[(size_t)sidx(b, h, dir, c) * (DV * DK) + e] = s; }
        if (F.tid < 2 * DK) { const int dir = F.tid / DK, kk = F.tid % DK; const LAS float* p = dir ? pb : pf; float s = 0.f;
            for (int j = 0; j < 128; ++j) s += p[j] * kS[j * 49 + kk];
            mN[(size_t)sidx(b, h, dir, c) * DK + kk] = s; }
        if (F.tid == 0) { msc[sidx(b, h, 0, c)] = scal[0]; msc[sidx(b, h, 1, c)] = scal[1]; msc[2048 + sidx(b, h, 0, c)] = lff[127]; msc[2048 + sidx(b, h, 1, c)] = lfb[0]; }
    } else {
        const float* rot = (const float*)(ws + WS_ROT);
        for (int idx = F.tid; idx < 128 * DK; idx += NTHR) { const int j = idx / DK, kk = idx % DK; kS[j * 49 + kk] = ret_rot(P, rot, b, c * CH + j, COL_RK, h, kk) * kscale; }
        for (int idx = F.tid; idx < 128 * DV; idx += NTHR) { const int j = idx / DV, vv = idx % DV; vS[j * 97 + vv] = bf2f(P[(size_t)(t0 + j) * PWP + COL_RV + h * DV + vv]); }
        const float lgf = ret_lg(h, 0.f), lgb = ret_lg(h, 0.5f);
        if (F.tid < 128) pf[F.tid] = __expf(lgf * (float)(127 - F.tid));
        else if (F.tid < 256) { const int j = F.tid - 128; pb[j] = __expf(lgb * (float)j); }
        __syncthreads();
        float* rS = (float*)(ws + WS_RS);
        for (int idx = F.tid; idx < 2 * DV * DK; idx += NTHR) { const int dir = idx / (DV * DK), e = idx % (DV * DK), vv = e / DK, kk = e % DK; const LAS float* p = dir ? pb : pf;
            float s = 0.f;
            for (int j = 0; j < 128; ++j) s += p[j] * vS[j * 97 + vv] * kS[j * 49 + kk];
            rS[(size_t)sidx(b, h, dir, c) * (DV * DK) + e] = s; }
    }
    __syncthreads();
}

__device__ __forceinline__ void fourier_chan_naive(const Frame& F, const Args& a) {
    unsigned char* ws = KA(ws); const bf16_t* P = (const bf16_t*)(ws + WS_P); float* U = (float*)(ws + WS_UCS);
    LAS float* tab = (LAS float*)(F.lds);
    LAS float* xs = tab + 128;
    if (F.tid < 64) { float sn, cs; sincosf(6.283185307179586f * (float)F.tid / 64.0f, &sn, &cs); tab[F.tid] = cs; tab[64 + F.tid] = sn; }
    __syncthreads();
    for (int t8 = F.bid; t8 < T / 8; t8 += F.G) {
        for (int i = F.tid; i < 8 * 256; i += NTHR) xs[i] = bf2f(P[(size_t)(t8 * 8 + (i >> 8)) * PWP + COL_F + (i & 255)]);
        __syncthreads();
        for (int i = F.tid; i < 8 * 512; i += NTHR) { const int tk = i >> 9, o = i & 511, csel = o >> 8, chn = o & 255, g = chn >> 6, cp = chn & 63; float s = 0.f;
            for (int cc = 0; cc < 64; ++cc) s += xs[tk * 256 + g * 64 + cc] * tab[csel * 64 + ((cc * cp) & 63)];
            U[(size_t)(t8 * 8 + tk) * 512 + o] = s; }
        __syncthreads();
    }
}

__device__ __forceinline__ void phaseC_unit(const Frame& F, const Args& a, int u) {
    unsigned char* ws = KA(ws);
    const int type = u >> 7, seq = (u & 127) >> 2, part = u & 3, dir = seq & 1;
    LAS float* sp = (LAS float*)F.lds; LAS float* sc = sp + 64;
    float* msc = (float*)(ws + WS_MSC);
    if (type == 0) {
        if (F.tid == 0) { float m = 0.f;
            for (int n = 0; n < NCH; ++n) { const int c = dir ? NCH - 1 - n : n; const int si = seq * NCH + c; const float mc = msc[si], ae = msc[2048 + si];
                if (part == 0) msc[4096 + si] = m;
                const float mn = fmaxf(ae + m, mc); sp[n] = __expf(ae + m - mn); sc[n] = __expf(mc - mn); m = mn; } }
    } else {
        if (F.tid < 64) { const int h = (seq >> 1) & 3; const float lg = ret_lg(h, dir ? 0.5f : 0.f); sp[F.tid] = __expf(lg * 128.0f); sc[F.tid] = 1.0f; }
    }
    __syncthreads();
    float* X = (float*)(ws + (type ? WS_RS : WS_MC));
    for (int e = F.tid; e < 1152; e += NTHR) { float st = 0.f; float* p = X + (size_t)seq * NCH * (DV * DK) + part * 1152 + e;
#pragma unroll 8
        for (int n = 0; n < NCH; ++n) { const int c = dir ? NCH - 1 - n : n; float* q = p + (size_t)c * (DV * DK); const float v = *q; *q = st; st = sp[n] * st + sc[n] * v; } }
    if (type == 0 && part == 0 && F.tid < DK) { float st = 0.f; float* p = (float*)(ws + WS_MN) + (size_t)seq * NCH * DK + F.tid;
        for (int n = 0; n < NCH; ++n) { const int c = dir ? NCH - 1 - n : n; float* q = p + (size_t)c * DK; const float v = *q; *q = st; st = sp[n] * st + sc[n] * v; } }
    __syncthreads();
}

__device__ __forceinline__ void phaseD_unit(const Frame& F, const Args& a, int l, int u) {
    unsigned char* ws = KA(ws);
    const bf16_t* P = (const bf16_t*)(ws + WS_P); bf16_t* mix = (bf16_t*)(ws + WS_MIX);
    const int type = u >> 10, r = u & 1023, b = r >> 8, c = (r >> 2) & 63, h = r & 3;
    LAS bf16_t* qS = (LAS bf16_t*)F.lds;
    LAS bf16_t* kS = qS + 128 * 50;
    LAS bf16_t* vS = kS + 128 * 50;
    LAS float* SS = (LAS float*)(vS + 128 * 98);
    LAS float* ar = SS + 128 * 129;
    LAS float* af = ar, *ab = ar + 128, *iff = ar + 256, *ibb = ar + 384, *gxf = ar + 512, *gxb = ar + 640, *mtf = ar + 768, *mtb = ar + 896, *rdf = ar + 1024, *rdb = ar + 1152, *sif = ar + 1280, *sib = ar + 1408;
    LAS float* ps = ar + 1536;
    const int t0 = b * S + c * CH;
    const float kscale = 0.14433756729740643f;
    const float* rot = (const float*)(ws + WS_ROT);
    if (type == 0) {
        const float* convw = KA(conv_w) + (size_t)l * 3 * 384;
        for (int idx = F.tid; idx < 128 * DK; idx += NTHR) { const int j = idx / DK, kk = idx % DK;
            qS[j * 50 + kk] = (bf16_t)f2bf(mlstm_qk(P, convw, b, c * CH + j, h * DK + kk));
            kS[j * 50 + kk] = (bf16_t)f2bf(mlstm_qk(P, convw, b, c * CH + j, 192 + h * DK + kk) * kscale); }
        for (int idx = F.tid; idx < 128 * DV; idx += NTHR) { const int j = idx / DV, vv = idx % DV; vS[j * 98 + vv] = P[(size_t)(t0 + j) * PWP + COL_MV + h * DV + vv]; }
        if (F.tid < 128) { const bf16_t* g = P + (size_t)(t0 + F.tid) * PWP + COL_MG;
            iff[F.tid] = bf2f(g[h]); af[F.tid] = logsigmoidf_(bf2f(g[4 + h])); ibb[F.tid] = bf2f(g[8 + h]); ab[F.tid] = logsigmoidf_(bf2f(g[12 + h])); }
    } else {
        for (int idx = F.tid; idx < 128 * DK; idx += NTHR) { const int j = idx / DK, kk = idx % DK;
            qS[j * 50 + kk] = (bf16_t)f2bf(ret_rot(P, rot, b, c * CH + j, COL_RQ, h, kk));
            kS[j * 50 + kk] = (bf16_t)f2bf(ret_rot(P, rot, b, c * CH + j, COL_RK, h, kk) * kscale); }
        for (int idx = F.tid; idx < 128 * DV; idx += NTHR) { const int j = idx / DV, vv = idx % DV; vS[j * 98 + vv] = P[(size_t)(t0 + j) * PWP + COL_RV + h * DV + vv]; }
    }
    __syncthreads();
    { const int j = F.tid >> 2, s0 = (F.tid & 3) * 32;
#pragma unroll 1
      for (int s = s0; s < s0 + 32; ++s) { float d = 0.f;
#pragma unroll 8
          for (int kk = 0; kk < DK; ++kk) d += bf2f(qS[j * 50 + kk]) * bf2f(kS[s * 50 + kk]);
          SS[j * 129 + s] = d; } }
    const int j = F.tid & 127, vq = F.tid >> 7;
    float acc[24];
#pragma unroll
    for (int x = 0; x < 24; ++x) acc[x] = 0.f;
    if (type == 0) {
        const float* msc = (const float*)(ws + WS_MSC);
        const float mpf = msc[4096 + sidx(b, h, 0, c)], mpb = msc[4096 + sidx(b, h, 1, c)];
        if (F.wave == 0) wave_scan128<false, false>(af, F.lane);
        if (F.wave == 1) wave_scan128<true, false>(ab, F.lane);
        __syncthreads();
        if (F.tid < 128) gxf[F.tid] = iff[F.tid] - af[F.tid]; else if (F.tid < 256) gxb[F.tid - 128] = ibb[F.tid - 128] - ab[F.tid - 128];
        __syncthreads();
        if (F.wave == 0) wave_scan128<false, true>(gxf, F.lane);
        if (F.wave == 1) wave_scan128<true, true>(gxb, F.lane);
        __syncthreads();
        if (F.tid < 128) mtf[F.tid] = fmaxf(af[F.tid] + mpf, af[F.tid] + gxf[F.tid]); else if (F.tid < 256) { const int q = F.tid - 128; mtb[q] = fmaxf(ab[q] + mpb, ab[q] + gxb[q]); }
        __syncthreads();
        if (F.tid < 256) { const int dir = F.tid >> 7, jj = F.tid & 127; const LAS float* A_ = dir ? ab : af; const LAS float* I_ = dir ? ibb : iff; const float mt = dir ? mtb[jj] : mtf[jj];
            float den = 0.f; const int lo = dir ? jj : 0, hi = dir ? 127 : jj;
            for (int s = lo; s <= hi; ++s) den += SS[jj * 129 + s] * __expf(A_[jj] - A_[s] + I_[s] - mt);
            const float si = __expf(A_[jj] + (dir ? mpb : mpf) - mt);
            const float* np = (const float*)(ws + WS_MN) + (size_t)sidx(b, h, dir, c) * DK; float nq = 0.f;
            for (int kk = 0; kk < DK; ++kk) nq += np[kk] * bf2f(qS[jj * 50 + kk]);
            den += si * nq;
            const float dn = fmaxf(fabsf(den), __expf(-mt));
            if (dir) { rdb[jj] = 1.0f / dn; sib[jj] = si; } else { rdf[jj] = 1.0f / dn; sif[jj] = si; } }
        __syncthreads();
#pragma unroll 1
        for (int dir = 0; dir < 2; ++dir) {
            const LAS float* A_ = dir ? ab : af; const LAS float* I_ = dir ? ibb : iff; const float mt = dir ? mtb[j] : mtf[j]; const float rd = dir ? rdb[j] : rdf[j]; const float si = dir ? sib[j] : sif[j];
            const int lo = dir ? j : 0, hi = dir ? 127 : j;
            for (int s = lo; s <= hi; ++s) { const float w = SS[j * 129 + s] * __expf(A_[j] - A_[s] + I_[s] - mt) * rd;
#pragma unroll
                for (int x = 0; x < 24; ++x) acc[x] += w * bf2f(vS[s * 98 + vq * 24 + x]); }
            const float* cp = (const float*)(ws + WS_MC) + (size_t)sidx(b, h, dir, c) * (DV * DK) + (size_t)(vq * 24) * DK;
            for (int kk = 0; kk < DK; ++kk) { const float qv = bf2f(qS[j * 50 + kk]) * si * rd;
#pragma unroll
                for (int x = 0; x < 24; ++x) acc[x] += qv * cp[x * DK + kk]; }
        }
        const bf16_t* og = P + (size_t)(t0 + j) * PWP + COL_MO + h * DV + vq * 24;
#pragma unroll
        for (int x = 0; x < 24; ++x) acc[x] *= sigmoidf_(bf2f(og[x]));
    } else {
        const float lgf = ret_lg(h, 0.f), lgb = ret_lg(h, 0.5f);
        __syncthreads();
        for (int s = 0; s < 128; ++s) { const float w = SS[j * 129 + s] * (s <= j ? __expf(lgf * (float)(j - s)) : __expf(lgb * (float)(s - j)));
#pragma unroll
            for (int x = 0; x < 24; ++x) acc[x] += w * bf2f(vS[s * 98 + vq * 24 + x]); }
#pragma unroll 1
        for (int dir = 0; dir < 2; ++dir) {
            const float wi = dir ? __expf(lgb * (float)(128 - j)) : __expf(lgf * (float)(j + 1));
            const float* cp = (const float*)(ws + WS_RS) + (size_t)sidx(b, h, dir, c) * (DV * DK) + (size_t)(vq * 24) * DK;
            for (int kk = 0; kk < DK; ++kk) { const float qv = bf2f(qS[j * 50 + kk]) * wi;
#pragma unroll
                for (int x = 0; x < 24; ++x) acc[x] += qv * cp[x * DK + kk]; }
        }
    }
    float s1 = 0.f;
#pragma unroll
    for (int x = 0; x < 24; ++x) s1 += acc[x];
    ps[vq * 128 + j] = s1;
    __syncthreads();
    const float mean = (ps[j] + ps[128 + j] + ps[256 + j] + ps[384 + j]) * (1.0f / 96.0f);
    __syncthreads();
    float s2 = 0.f;
#pragma unroll
    for (int x = 0; x < 24; ++x) { acc[x] -= mean; s2 += acc[x] * acc[x]; }
    ps[vq * 128 + j] = s2;
    __syncthreads();
    const float rstd = 1.0f / sqrtf((ps[j] + ps[128 + j] + ps[256 + j] + ps[384 + j]) * (1.0f / 96.0f) + LN_EPS);
    bf16_t* o = mix + (size_t)(t0 + j) * D + (type ? 640 : 256) + h * DV + vq * 24;
    if (type == 0) {
        const float* nw = KA(ml_nw) + (size_t)l * 384 + h * DV + vq * 24;
#pragma unroll
        for (int x = 0; x < 24; x += 2) *(unsigned*)(o + x) = pk2(acc[x] * rstd * nw[x], acc[x + 1] * rstd * nw[x + 1]);
    } else {
        const float* nw = KA(ret_nw) + (size_t)l * 384 + h * DV + vq * 24;
        const bf16_t* gg = P + (size_t)(t0 + j) * PWP + COL_RG + h * DV + vq * 24;
#pragma unroll
        for (int x = 0; x < 24; x += 2) *(unsigned*)(o + x) = pk2(acc[x] * rstd * nw[x] * siluf_(bf2f(gg[x])), acc[x + 1] * rstd * nw[x + 1] * siluf_(bf2f(gg[x + 1])));
    }
    __syncthreads();
}

__device__ __forceinline__ void fourier_seq_naive(const Frame& F, const Args& a) {
    unsigned char* ws = KA(ws); const float* U = (const float*)(ws + WS_UCS); bf16_t* mix = (bf16_t*)(ws + WS_MIX);
    LAS float* ct = (LAS float*)F.lds; LAS float* st = ct + S;
    for (int i = F.tid; i < S; i += NTHR) { float sn, cs; sincosf(6.283185307179586f * (float)i / (float)S, &sn, &cs); ct[i] = cs; st[i] = sn; }
    __syncthreads();
    const int chn = F.tid & 255, kh = F.tid >> 8;
    const float nrm = 0.0013810679320049757f;
    for (int it = F.bid; it < NB * (S / 8); it += F.G) {
        const int b = it / (S / 8), k0 = (it % (S / 8)) * 8 + kh * 4;
        float acc0 = 0.f, acc1 = 0.f, acc2 = 0.f, acc3 = 0.f;
        const float* up = U + (size_t)b * S * 512 + chn;
        for (int s = 0; s < S; ++s) { const float uc = up[(size_t)s * 512], us = up[(size_t)s * 512 + 256];
            const int i0 = (k0 * s) & (S - 1), i1 = (i0 + s) & (S - 1), i2 = (i1 + s) & (S - 1), i3 = (i2 + s) & (S - 1);
            acc0 += uc * ct[i0] - us * st[i0]; acc1 += uc * ct[i1] - us * st[i1]; acc2 += uc * ct[i2] - us * st[i2]; acc3 += uc * ct[i3] - us * st[i3]; }
        bf16_t* o = mix + (size_t)(b * S + k0) * D + chn;
        o[0] = (bf16_t)f2bf(acc0 * nrm); o[D] = (bf16_t)f2bf(acc1 * nrm); o[2 * D] = (bf16_t)f2bf(acc2 * nrm); o[3 * D] = (bf16_t)f2bf(acc3 * nrm);
    }
    __syncthreads();
}

__device__ __forceinline__ int build_tiles(const Frame& F, unsigned* cnt, LAS int* tst, LAS unsigned char* tile_e) {
    if (F.tid == 0) { int acc = 0; for (int e = 0; e < NE; ++e) { tst[e] = acc; acc += ((int)__hip_atomic_load(cnt + e, __ATOMIC_RELAXED, __HIP_MEMORY_SCOPE_AGENT) + 255) >> 8; } tst[NE] = acc; }
    __syncthreads();
    const int ntot = tst[NE];
    for (int mt = F.tid; mt < ntot; mt += NTHR) { int e = 0; for (int q = 1; q < NE; ++q) if (mt >= tst[q]) e = q; tile_e[mt] = (unsigned char)e; }
    __syncthreads();
    return ntot;
}

__device__ __forceinline__ void phaseF(const Frame& F, const Args& a, int l) {
    unsigned char* ws = KA(ws);
    const float* pre = (const float*)(ws + WS_PRE); float* x1f = (float*)(ws + WS_X1F); bf16_t* x1b = (bf16_t*)(ws + WS_X1B);
    int* tke = (int*)(ws + WS_TKE); float* tkg = (float*)(ws + WS_TKG); int* tks = (int*)(ws + WS_TKS); int* list = (int*)(ws + WS_LIST);
    unsigned* cnt = F.ctl + CW_CNT + l * 64;
    LAS float* wrT = (LAS float*)F.lds;
    LAS int* lcnt = (LAS int*)(F.lds + MISC_OFF + 2048);
    LAS int* lbase = lcnt + 32;
    LAS int* le = lbase + 32;
    LAS int* ls = le + 512;
    const float* wr = KA(w_router) + (size_t)l * D * NE;
    for (int i = F.tid; i < D * NE; i += NTHR) { const int c = i >> 5, e = i & 31; wrT[e * D + c] = wr[i]; }
    if (F.tid < 32) lcnt[F.tid] = 0;
    __syncthreads();
    const float* g1 = KA(ln1_g) + (size_t)l * D; const float* b1 = KA(ln1_b) + (size_t)l * D; const float* br = KA(b_router) + (size_t)l * NE;
    for (int chunk = F.bid; chunk < T / 128; chunk += F.G) {
        for (int q = 0; q < 16; ++q) {
            const int tl = F.wave * 16 + q, t = chunk * 128 + tl;
            f32x4 v[4];
#pragma unroll
            for (int j = 0; j < 4; ++j) v[j] = *(const f32x4*)(pre + (size_t)t * D + 4 * F.lane + 256 * j);
            float s = 0.f;
#pragma unroll
            for (int j = 0; j < 4; ++j) s += (v[j].x + v[j].y) + (v[j].z + v[j].w);
            const float mean = wave_sum(s) * (1.f / D); float s2 = 0.f;
#pragma unroll
            for (int j = 0; j < 4; ++j) { v[j] = v[j] - mean; s2 += (v[j].x * v[j].x + v[j].y * v[j].y) + (v[j].z * v[j].z + v[j].w * v[j].w); }
            const float rstd = 1.f / sqrtf(wave_sum(s2) * (1.f / D) + LN_EPS);
#pragma unroll
            for (int j = 0; j < 4; ++j) { const f32x4 gg = *(const f32x4*)(g1 + 4 * F.lane + 256 * j), bb = *(const f32x4*)(b1 + 4 * F.lane + 256 * j);
                v[j] = v[j] * rstd * gg + bb;
                *(f32x4*)(x1f + (size_t)t * D + 4 * F.lane + 256 * j) = v[j];
                u32x2 w; w.x = pk2(v[j].x, v[j].y); w.y = pk2(v[j].z, v[j].w); *(u32x2*)(x1b + (size_t)t * D + 4 * F.lane + 256 * j) = w; }
            float mylogit = -INFINITY;
            for (int e = 0; e < NE; ++e) { float p = 0.f;
#pragma unroll
                for (int j = 0; j < 4; ++j) { const f32x4 w = *(const LAS f32x4*)(wrT + e * D + 4 * F.lane + 256 * j); p += (v[j].x * w.x + v[j].y * w.y) + (v[j].z * w.z + v[j].w * w.w); }
                p = wave_sum(p);
                if (F.lane == e) mylogit = p + br[e]; }
            float tv[4]; int ti[4];
#pragma unroll
            for (int k = 0; k < 4; ++k) { float bv = mylogit; int bi = F.lane;
#pragma unroll
                for (int o = 1; o < 64; o <<= 1) { const float ov = __shfl_xor(bv, o); const int oi = __shfl_xor(bi, o); if (ov > bv || (ov == bv && oi < bi)) { bv = ov; bi = oi; } }
                tv[k] = bv; ti[k] = bi; if (F.lane == bi) mylogit = -INFINITY; }
            const float w1 = __expf(tv[1] - tv[0]), w2 = __expf(tv[2] - tv[0]), w3 = __expf(tv[3] - tv[0]); const float inv = 1.0f / (1.0f + w1 + w2 + w3);
            if (F.lane < 4) { const int k = F.lane; const int e = k == 0 ? ti[0] : k == 1 ? ti[1] : k == 2 ? ti[2] : ti[3]; const float g = (k == 0 ? 1.0f : k == 1 ? w1 : k == 2 ? w2 : w3) * inv;
                tke[t * 4 + k] = e; tkg[t * 4 + k] = g;
                const int sl = __hip_atomic_fetch_add(lcnt + e, 1, __ATOMIC_RELAXED, __HIP_MEMORY_SCOPE_WORKGROUP);
                le[tl * 4 + k] = e; ls[tl * 4 + k] = sl; }
        }
        __syncthreads();
        if (F.tid < 32) lbase[F.tid] = (int)__hip_atomic_fetch_add(cnt + F.tid, (unsigned)lcnt[F.tid], __ATOMIC_RELAXED, __HIP_MEMORY_SCOPE_AGENT);
        __syncthreads();
        { const int tl = F.tid >> 2, k = F.tid & 3, t = chunk * 128 + tl, e = le[F.tid], slot = lbase[e] + ls[F.tid];
          list[(size_t)e * T + slot] = t; tks[t * 4 + k] = slot; }
        __syncthreads();
        if (F.tid < 32) lcnt[F.tid] = 0;
        __syncthreads();
    }
}

__device__ __forceinline__ void phaseG0(const Frame& F, const Args& a, int l) {
    unsigned char* ws = KA(ws);
    unsigned* cnt = F.ctl + CW_CNT + l * 64;
    LAS int* tst = (LAS int*)(F.lds + MISC_OFF + 256); LAS unsigned char* tile_e = (LAS unsigned char*)(F.lds + MISC_OFF + 512);
    const int ntot = build_tiles(F, cnt, tst, tile_e);
    const bf16_t* x1b = (const bf16_t*)(ws + WS_X1B); bf16_t* xs = (bf16_t*)(ws + WS_XS); const int* list = (const int*)(ws + WS_LIST);
    const int gw = F.bid * NWAVES + F.wave, NGW = F.G * NWAVES;
    for (int r = gw; r < ntot * 256; r += NGW) { const int mt = r >> 8, e = tile_e[mt], within = r - tst[e] * 256;
        const int c = (int)__hip_atomic_load(cnt + e, __ATOMIC_RELAXED, __HIP_MEMORY_SCOPE_AGENT);
        const int tok = within < c ? list[(size_t)e * T + within] : 0;
        const u32x4* src = (const u32x4*)(x1b + (size_t)tok * D); u32x4* dst = (u32x4*)(xs + (size_t)r * D);
        dst[F.lane] = src[F.lane]; dst[64 + F.lane] = src[64 + F.lane]; }
    __syncthreads();
}

__device__ __forceinline__ void phaseI(const Frame& F, const Args& a, int l) {
    unsigned char* ws = KA(ws);
    unsigned* cnt = F.ctl + CW_CNT + l * 64;
    LAS int* tst = (LAS int*)(F.lds + MISC_OFF + 256); LAS unsigned char* tile_e = (LAS unsigned char*)(F.lds + MISC_OFF + 512);
    (void)build_tiles(F, cnt, tst, tile_e);
    const float* x1f = (const float*)(ws + WS_X1F); const bf16_t* Y = (const bf16_t*)(ws + WS_Y);
    const int* tke = (const int*)(ws + WS_TKE); const float* tkg = (const float*)(ws + WS_TKG); const int* tks = (const int*)(ws + WS_TKS);
    float* xf = (float*)(ws + WS_XF); bf16_t* xb = (bf16_t*)(ws + WS_XB);
    const float* g2 = KA(ln2_g) + (size_t)l * D; const float* b2 = KA(ln2_b) + (size_t)l * D;
    const int gw = F.bid * NWAVES + F.wave, NGW = F.G * NWAVES; float* outp = KA(out);
    for (int t = gw; t < T; t += NGW) {
        f32x4 v[4];
#pragma unroll
        for (int j = 0; j < 4; ++j) v[j] = *(const f32x4*)(x1f + (size_t)t * D + 4 * F.lane + 256 * j) * DN_ALPHA;
#pragma unroll
        for (int k = 0; k < 4; ++k) { const int e = tke[t * 4 + k]; const float g = tkg[t * 4 + k]; const size_t row = (size_t)tst[e] * 256 + tks[t * 4 + k];
#pragma unroll
            for (int j = 0; j < 4; ++j) { const u32x2 w = *(const u32x2*)(Y + row * D + 4 * F.lane + 256 * j);
                v[j].x += g * __builtin_bit_cast(float, w.x << 16); v[j].y += g * __builtin_bit_cast(float, w.x & 0xffff0000u);
                v[j].z += g * __builtin_bit_cast(float, w.y << 16); v[j].w += g * __builtin_bit_cast(float, w.y & 0xffff0000u); } }
        ln_row(v, g2, b2, xf + (size_t)t * D, xb + (size_t)t * D, l == NL - 1 ? outp + (size_t)t * D : nullptr, F.lane);
    }
    __syncthreads();
}

template <int PHMASK_T> __global__ void __launch_bounds__(NTHR, 2) hybrid_fwd(Args a) {
    extern __shared__ __attribute__((aligned(16))) unsigned char lds_raw[];
    Frame F;
    F.lds = (LAS unsigned char*)lds_raw;
    F.tid = threadIdx.x; F.lane = F.tid & 63; F.wave = __builtin_amdgcn_readfirstlane(F.tid >> 6);
    F.G = gridDim.x; F.bid = blockIdx.x;
    F.ctl = (unsigned*)(KA(ws) + WS_CTL);
    unsigned char* ws = KA(ws);
    volatile LAS unsigned* MISC = (volatile LAS unsigned*)(F.lds + MISC_OFF);
    if (F.tid < 64) MISC[F.tid] = 0u;
    __syncthreads();
#if MK_MULTI
#define GRID_BAR() do { } while (0)
#else
    XcdBarrier bar = xcd_barrier_post(F.ctl + CW_BAR, MISC);
#define GRID_BAR() do { unsigned long long _bp = (unsigned long long)(uintptr_t)bar.bar; unsigned _bx = bar.x; unsigned _bs = (unsigned)(uintptr_t)bar.st; asm volatile("" : "+s"(_bp), "+s"(_bx), "+s"(_bs)); \
        XcdBarrier _b; _b.bar = (unsigned*)(uintptr_t)_bp; _b.x = _bx; _b.st = (volatile LAS unsigned*)(uintptr_t)_bs; xcd_barrier(_b); } while (0)
#endif
    const int lo = KA(ph_lo), hi = KA(ph_hi);
#define PH_ON(j) (((PHMASK_T) >> (j)) & 1)
#define IN(k) (lo <= (k) && (k) < hi)
#define SEAM(k) do { if (IN(k) && IN((k) + 1)) GRID_BAR(); } while (0)
    if (PH_ON(10) && IN(0)) { p0_prologue(F, a); }
    SEAM(0);
#define LAUNDER() do { unsigned _lp = (unsigned)(uintptr_t)F.lds; unsigned long long _cp = (unsigned long long)(uintptr_t)F.ctl; unsigned long long _wp = (unsigned long long)(uintptr_t)ws; \
        asm volatile("" : "+v"(F.tid), "+v"(F.lane)); asm volatile("" : "+s"(F.wave), "+s"(F.bid), "+s"(F.G), "+s"(_lp), "+s"(_cp), "+s"(_wp)); \
        F.lds = (LAS unsigned char*)(uintptr_t)_lp; F.ctl = (unsigned*)(uintptr_t)_cp; ws = (unsigned char*)(uintptr_t)_wp; } while (0)
    for (int l = 0; l < NL; ++l) {
        const int pb = 1 + l * NPH_LAYER;
        LAUNDER();
        if (PH_ON(0) && IN(pb + 0)) {
            pg8::PlainOrder So; So.init(ws + WS_XB, (bf16_t*)(ws + WS_WIN) + (size_t)l * PWP * D, T, PWP, D, F.G, F.bid);
            pg8::EpiBf16Bias E{(bf16_t*)(ws + WS_P), PWP, (const float*)(ws + WS_BIN) + (size_t)l * PWP};
            pg8::gemm_phase<pg8::EpiBf16Bias, pg8::PlainOrder, true, true>(F.lds, D, So, E);
        }
        SEAM(pb + 0);
        LAUNDER();
        if (PH_ON(1) && IN(pb + 1)) {
            for (int u = F.bid; u < 2048; u += F.G) phaseB_unit(F, a, l, u);
            fourier_chan_naive(F, a);
        }
        SEAM(pb + 1);
        LAUNDER();
        if (PH_ON(2) && IN(pb + 2)) { for (int u = F.bid; u < 256; u += F.G) phaseC_unit(F, a, u); }
        SEAM(pb + 2);
        LAUNDER();
        if (PH_ON(3) && IN(pb + 3)) {
            for (int u = F.bid; u < 2048; u += F.G) phaseD_unit(F, a, l, u);
            fourier_seq_naive(F, a);
        }
        SEAM(pb + 3);
        LAUNDER();
        if (PH_ON(4) && IN(pb + 4)) {
            pg8::PlainOrder So; So.init(ws + WS_MIX, (bf16_t*)(ws + WS_WOUT) + (size_t)l * D * D, T, D, D, F.G, F.bid);
            pg8::EpiResF32 E{(float*)(ws + WS_PRE), (const float*)(ws + WS_XF), D, DN_ALPHA};
            pg8::gemm_phase<pg8::EpiResF32, pg8::PlainOrder, true, true>(F.lds, D, So, E);
        }
        SEAM(pb + 4);
        LAUNDER();
        if (PH_ON(5) && IN(pb + 5)) phaseF(F, a, l);
        SEAM(pb + 5);
        LAUNDER();
        if (PH_ON(6) && IN(pb + 6)) phaseG0(F, a, l);
        SEAM(pb + 6);
        LAUNDER();
        if (PH_ON(7) && IN(pb + 7)) {
            LAS int* tst = (LAS int*)(F.lds + MISC_OFF + 256); LAS unsigned char* tile_e = (LAS unsigned char*)(F.lds + MISC_OFF + 512);
            const int ntot = build_tiles(F, F.ctl + CW_CNT + l * 64, tst, tile_e);
            pg8::GroupOrder So{(const char*)(ws + WS_XS), (const char*)(ws + WS_W1) + (size_t)l * NE * 2048 * D * 2, D, 8, ntot, F.G, F.bid, (size_t)2048 * D * 2, tile_e};
            pg8::EpiSwiglu E{(bf16_t*)(ws + WS_H), KA(b1) + (size_t)l * NE * 2048};
            pg8::gemm_phase<pg8::EpiSwiglu, pg8::GroupOrder, true, true>(F.lds, D, So, E);
        }
        SEAM(pb + 7);
        LAUNDER();
        if (PH_ON(8) && IN(pb + 8)) {
            LAS int* tst = (LAS int*)(F.lds + MISC_OFF + 256); LAS unsigned char* tile_e = (LAS unsigned char*)(F.lds + MISC_OFF + 512);
            const int ntot = build_tiles(F, F.ctl + CW_CNT + l * 64, tst, tile_e);
            pg8::GroupOrder So{(const char*)(ws + WS_H), (const char*)(ws + WS_W2) + (size_t)l * NE * D * FF * 2, FF, 4, ntot, F.G, F.bid, (size_t)D * FF * 2, tile_e};
            pg8::EpiExpertOut E{(bf16_t*)(ws + WS_Y), KA(b2) + (size_t)l * NE * D};
            pg8::gemm_phase<pg8::EpiExpertOut, pg8::GroupOrder, true, true>(F.lds, FF, So, E);
        }
        SEAM(pb + 8);
        LAUNDER();
        if (PH_ON(9) && IN(pb + 9)) phaseI(F, a, l);
        SEAM(pb + 9);
    }
#undef IN
#undef SEAM
}

template <int MASK> static void launch_one(int grid, hipStream_t stream, const Args& a) {
    static bool attr = false;
    if (!attr) { (void)hipFuncSetAttribute((const void*)hybrid_fwd<MASK>, hipFuncAttributeMaxDynamicSharedMemorySize, LDS_BYTES); attr = true; }
    hipLaunchKernelGGL(hybrid_fwd<MASK>, dim3(grid), dim3(NTHR), LDS_BYTES, stream, a);
}
extern "C" void kernel_launch(void* const* d_in, const int* in_sizes, int n_in, void* d_out, int out_size, void* d_ws, size_t ws_size, hipStream_t stream) {
    static int grid = 0;
    if (grid == 0) {
        if (n_in != 19 || out_size != T * D || ws_size < WS_END) { fprintf(stderr, "kernel_launch: unexpected shapes (n_in %d out %d ws %zu need %zu)\n", n_in, out_size, ws_size, (size_t)WS_END); grid = -1; return; }
        int dev = 0, cus = 0;
        if (hipGetDevice(&dev) != hipSuccess || hipDeviceGetAttribute(&cus, hipDeviceAttributeMultiprocessorCount, dev) != hipSuccess) { grid = -1; return; }
        grid = cus;
    }
    if (grid < 0) return;
    (void)hipMemsetAsync((char*)d_ws + WS_CTL, 0, CTL_BYTES, stream);
    Args a{};
    a.x = (const float*)d_in[0]; a.emb_g = (const float*)d_in[1]; a.emb_b = (const float*)d_in[2]; a.w_in = (const float*)d_in[3]; a.b_in = (const float*)d_in[4];
    a.conv_w = (const float*)d_in[5]; a.ml_nw = (const float*)d_in[6]; a.ret_nw = (const float*)d_in[7]; a.w_out = (const float*)d_in[8];
    a.ln1_g = (const float*)d_in[9]; a.ln1_b = (const float*)d_in[10]; a.w_router = (const float*)d_in[11]; a.b_router = (const float*)d_in[12];
    a.w1 = (const float*)d_in[13]; a.b1 = (const float*)d_in[14]; a.w2 = (const float*)d_in[15]; a.b2 = (const float*)d_in[16]; a.ln2_g = (const float*)d_in[17]; a.ln2_b = (const float*)d_in[18];
    a.out = (float*)d_out; a.ws = (unsigned char*)d_ws;
#if MK_MULTI
    a.ph_lo = 0; a.ph_hi = 1; launch_one<0x400>(grid, stream, a);
#define LAUNDER() do { unsigned _lp = (unsigned)(uintptr_t)F.lds; unsigned long long _cp = (unsigned long long)(uintptr_t)F.ctl; unsigned long long _wp = (unsigned long long)(uintptr_t)ws; \
        asm volatile("" : "+v"(F.tid), "+v"(F.lane)); asm volatile("" : "+s"(F.wave), "+s"(F.bid), "+s"(F.G), "+s"(_lp), "+s"(_cp), "+s"(_wp)); \
        F.lds = (LAS unsigned char*)(uintptr_t)_lp; F.ctl = (unsigned*)(uintptr_t)_cp; ws = (unsigned char*)(uintptr_t)_wp; } while (0)
    for (int l = 0; l < NL; ++l) {
        const int pb = 1 + l * NPH_LAYER;
#define LP(j) a.ph_lo = pb + (j); a.ph_hi = pb + (j) + 1; launch_one<(1 << (j))>(grid, stream, a);
        LP(0) LP(1) LP(2) LP(3) LP(4) LP(5) LP(6) LP(7) LP(8) LP(9)
#undef LP
    }
#else
    a.ph_lo = 0; a.ph_hi = NPH; launch_one<0x7ff>(grid, stream, a);
#endif
}
```

```cpp
#include <hip/hip_runtime.h>
#include <cstdio>
#include <cstdint>

#ifndef MK_MULTI
#define MK_MULTI 0
#endif

#define LAS __attribute__((address_space(3)))
#define GAS __attribute__((address_space(1)))
typedef unsigned short bf16_t;
typedef short bf16x8 __attribute__((ext_vector_type(8)));
typedef float f32x4 __attribute__((ext_vector_type(4)));
typedef float f32x2 __attribute__((ext_vector_type(2)));
typedef unsigned u32x4 __attribute__((ext_vector_type(4)));
typedef unsigned u32x2 __attribute__((ext_vector_type(2)));

constexpr int D = 1024, NB = 4, S = 8192, T = NB * S, NL = 4;
constexpr int CH = 128, NCH = S / CH;
constexpr int PW = 2576, PWF = 256, PW2 = PW - PWF, PWP = 2560;
constexpr int COL_MQK = 0, COL_MV = 384, COL_MO = 768, COL_MG = 1152, COL_RQ = 1168, COL_RK = 1360, COL_RV = 1552, COL_RG = 1936;
constexpr int NH = 4, DK = 48, DV = 96;
constexpr int NE = 32, TOPK = 4, FF = 1024;
constexpr int ROWS_PAD = T * TOPK + NE * 256;
constexpr int MT_MAX = ROWS_PAD / 256;
constexpr float LN_EPS = 1e-5f;
constexpr float DN_ALPHA = 1.6817928305074290f;
constexpr float SW_ALPHA = 1.702f, SW_LIMIT = 7.0f;

constexpr size_t MiB = 1u << 20;
constexpr size_t WS_CTL = 0, CTL_BYTES = 1 * MiB;
constexpr size_t WS_WIN = 1 * MiB;
constexpr size_t WS_WOUT = WS_WIN + 22 * MiB;
constexpr size_t WS_W1 = WS_WOUT + 8 * MiB;
constexpr size_t WS_W2 = WS_W1 + 512 * MiB;
constexpr size_t WS_BIN = WS_W2 + 256 * MiB;
constexpr size_t WS_ROT = WS_BIN + 1 * MiB;
constexpr size_t WS_XF = WS_ROT + 2 * MiB;
constexpr size_t WS_XB = WS_XF + 128 * MiB;
constexpr size_t WS_P = WS_XB + 64 * MiB;
constexpr size_t WS_MIX = WS_P + 176 * MiB;
constexpr size_t WS_PRE = WS_MIX + 64 * MiB;
constexpr size_t WS_X1F = WS_PRE + 128 * MiB;
constexpr size_t WS_X1B = WS_X1F + 128 * MiB;
constexpr size_t WS_XS = WS_X1B + 64 * MiB;
constexpr size_t WS_H = WS_XS + 272 * MiB;
constexpr size_t WS_Y = WS_H + 272 * MiB;
constexpr size_t WS_TKE = WS_Y + 272 * MiB;
constexpr size_t WS_TKG = WS_TKE + 1 * MiB;
constexpr size_t WS_TKS = WS_TKG + 1 * MiB;
constexpr size_t WS_LIST = WS_TKS + 1 * MiB;
constexpr size_t WS_MC = WS_LIST + 4 * MiB;
constexpr size_t WS_RS = WS_MC + 36 * MiB;
constexpr size_t WS_MN = WS_RS + 36 * MiB;
constexpr size_t WS_MSC = WS_MN + 1 * MiB;
constexpr size_t WS_UT = WS_MSC + 1 * MiB;
constexpr size_t WS_AT = WS_UT + 32 * MiB;
constexpr size_t WS_WF = WS_AT + 32 * MiB;
constexpr size_t WS_FG = WS_WF + 4 * MiB;
constexpr size_t WS_END = WS_FG + 1 * MiB;
constexpr size_t FG_H_OFF = 32768, FG_BF_OFF = 131072, WRT_OFF = 262144;

constexpr int CW_TMO = 0;
constexpr int CW_BAR = 4096;
constexpr int CW_CNT = 16384;

constexpr int RING_BYTES = 131072;
constexpr int MISC_OFF = RING_BYTES;
constexpr int LDS_BYTES = 147456;

__device__ __forceinline__ unsigned f2bf(float f) { unsigned u = __builtin_bit_cast(unsigned, f); return (u + 0x7fffu + ((u >> 16) & 1u)) >> 16; }
__device__ __forceinline__ unsigned pk2(float lo, float hi) { return f2bf(lo) | (f2bf(hi) << 16); }
__device__ __forceinline__ float bf2f(bf16_t b) { return __builtin_bit_cast(float, (unsigned)b << 16); }
__device__ __forceinline__ float wave_sum(float v) {
#pragma unroll
    for (int o = 1; o < 64; o <<= 1) v += __shfl_xor(v, o);
    return v;
}
__device__ __forceinline__ float wave_max(float v) {
#pragma unroll
    for (int o = 1; o < 64; o <<= 1) v = fmaxf(v, __shfl_xor(v, o));
    return v;
}
__device__ __forceinline__ float sigmoidf_(float x) { return 1.0f / (1.0f + __expf(-x)); }
__device__ __forceinline__ float siluf_(float x) { return x / (1.0f + __expf(-x)); }
__device__ __forceinline__ float logsigmoidf_(float x) { return x >= 0.f ? -log1pf(__expf(-x)) : x - log1pf(__expf(x)); }

namespace pg8 {
constexpr int BM = 256, BK = 64, HALF = 128, HTB = HALF * BK * 2, STAGE_BYTES = 8 * HTB;
__host__ __device__ __forceinline__ int lds_byte(int r, int c) { const int st = (r >> 4) * 2 + (c >> 5), rr = r & 15, cc = c & 31, ob = rr * 64 + cc * 2; return st * 1024 + (ob ^ (((ob >> 9) & 1) << 5)); }
__host__ __device__ __forceinline__ void stage_rc(int b, int& R, int& C) { const int st = b / 1024, sb = b % 1024, swz = sb ^ (((sb >> 9) & 1) << 5); R = (st >> 1) * 16 + swz / 64; C = (st & 1) * 32 + (swz % 64) / 2; }
__host__ __device__ __forceinline__ int perm32(int rho) { const int n = rho >> 4, i = rho & 15; return 8 * (i >> 2) + 4 * n + (i & 3); }
struct Unit { int pm, pn, e; };
__device__ __forceinline__ unsigned cvt_pk_bf16(float lo, float hi) { unsigned r; asm volatile("v_cvt_pk_bf16_f32 %0, %1, %2" : "=v"(r) : "v"(lo), "v"(hi)); return r; }

template <class Epi, class Sched, bool ALIGN_EPI = false, bool SP2 = false>
__device__ __forceinline__ void gemm_phase(LAS unsigned char* lds, const int K, const Sched& S, const Epi& E, const int tid) {
    const int wid = __builtin_amdgcn_readfirstlane(tid >> 6), lane = tid & 63, wr = wid >> 2, wc = wid & 3, fr = lane & 15, fq = lane >> 4;
    const int nt = K / BK;
    unsigned voffA[2], voffB[2];
#pragma unroll
    for (int i = 0; i < 2; ++i) { int R, C; stage_rc(tid * 16 + i * 8192, R, C); const int Rb = Epi::PERM ? ((R & ~31) + perm32(R & 31)) : R;
        voffA[i] = S.a_off(R, C); voffB[i] = S.b_off(Rb, C); }
    const size_t kstep = (size_t)(BK * 2);
    const size_t hstepA = S.hstep_a(), hstepB = S.hstep_b();
    const unsigned ldsw = (unsigned)wid * 1024u;
    const int aoff = lds_byte(wr * 64 + fr, fq * 8), boff = lds_byte(wc * 32 + fr, fq * 8);
#define PG8_SA(b, h) (((b) * 2 + (h)) * HTB)
#define PG8_SB(b, h) ((4 + (b) * 2 + (h)) * HTB)
#define PG8_STAGE(bufoff, gbase, voff) do { _Pragma("unroll") for (int _i = 0; _i < 2; ++_i) \
        __builtin_amdgcn_global_load_lds((const unsigned*)((const char*)(gbase) + (voff)[_i]), (LAS unsigned*)(lds + (bufoff) + ldsw + _i * 8192), 16, 0, 0); } while (0)
#define PG8_LDA(dst, b, h) do { _Pragma("unroll") for (int m = 0; m < 4; ++m) _Pragma("unroll") for (int k = 0; k < 2; ++k) dst[m][k] = *(const LAS bf16x8*)(lds + PG8_SA(b, h) + aoff + m * 2048 + k * 1024); } while (0)
#define PG8_LDB(dst, b, h) do { _Pragma("unroll") for (int n = 0; n < 2; ++n) _Pragma("unroll") for (int k = 0; k < 2; ++k) dst[n][k] = *(const LAS bf16x8*)(lds + PG8_SB(b, h) + boff + n * 2048 + k * 1024); } while (0)
#define PG8_MMA(ai, bj, At, Bt) do { __builtin_amdgcn_s_setprio(1); _Pragma("unroll") for (int m = 0; m < 4; ++m) _Pragma("unroll") for (int n = 0; n < 2; ++n) _Pragma("unroll") for (int k = 0; k < 2; ++k) \
        acc[ai][bj][m][n] = __builtin_amdgcn_mfma_f32_16x16x32_bf16(Bt[n][k], At[m][k], acc[ai][bj][m][n], 0, 0, 0); __builtin_amdgcn_s_setprio(0); } while (0)
#define PG8_WAIT_V(n) asm volatile("s_waitcnt vmcnt(" #n ")" ::: "memory")
#define PG8_WAIT_L(n) asm volatile("s_waitcnt lgkmcnt(" #n ")" ::: "memory")
#define PG8_BAR __builtin_amdgcn_s_barrier()
#define PG8_SCHED __builtin_amdgcn_sched_barrier(0)
    Unit cur, nxt; int ui = 0;
    if (!S.next(0, cur)) return;
    f32x4 acc[2][2][4][2];
#pragma unroll
    for (int a = 0; a < 2; ++a)
#pragma unroll
        for (int b = 0; b < 2; ++b)
#pragma unroll
            for (int m = 0; m < 4; ++m)
#pragma unroll
                for (int n = 0; n < 2; ++n) acc[a][b][m][n] = (f32x4){0.f, 0.f, 0.f, 0.f};
    bf16x8 At[4][2], B0[2][2], B1[2][2];
    const char* cA = S.a_base(cur); const char* cB = S.b_base(cur);
    if constexpr (SP2) {
        PG8_STAGE(PG8_SB(0, 0), cB, voffB); PG8_STAGE(PG8_SB(0, 1), cB + hstepB, voffB); PG8_STAGE(PG8_SA(0, 0), cA, voffA); PG8_STAGE(PG8_SA(0, 1), cA + hstepA, voffA);
        if (wr == 1) PG8_BAR;
        PG8_WAIT_V(2); PG8_BAR;
        PG8_STAGE(PG8_SB(1, 0), cB + kstep, voffB); PG8_STAGE(PG8_SA(1, 0), cA + kstep, voffA); PG8_STAGE(PG8_SB(1, 1), cB + hstepB + kstep, voffB);
        PG8_WAIT_V(6); PG8_BAR;
    } else {
        PG8_STAGE(PG8_SB(0, 0), cB, voffB); PG8_STAGE(PG8_SA(0, 0), cA, voffA); PG8_STAGE(PG8_SB(0, 1), cB + hstepB, voffB); PG8_STAGE(PG8_SA(0, 1), cA + hstepA, voffA);
        if (wr == 1) PG8_BAR;
        PG8_WAIT_V(4); PG8_BAR;
        PG8_STAGE(PG8_SB(1, 0), cB + kstep, voffB); PG8_STAGE(PG8_SA(1, 0), cA + kstep, voffA); PG8_STAGE(PG8_SB(1, 1), cB + hstepB + kstep, voffB);
        PG8_WAIT_V(6); PG8_BAR;
    }
    for (;;) {
        const bool has_next = S.next(ui + 1, nxt);
        const char* nA = has_next ? S.a_base(nxt) : cA; const char* nB = has_next ? S.b_base(nxt) : cB;
        for (int t = 0; t < nt; t += 2) {
            const bool last = (t == nt - 2);
            const char* a1 = cA + (size_t)(t + 1) * kstep;
            const char* a2 = last ? nA : cA + (size_t)(t + 2) * kstep; const char* b2 = last ? nB : cB + (size_t)(t + 2) * kstep;
            const char* a3 = a2 + kstep; const char* b3 = b2 + kstep;
            if constexpr (SP2) {
            PG8_LDB(B0, 0, 0); PG8_LDB(B1, 0, 1); PG8_SCHED; PG8_LDA(At, 0, 0); PG8_STAGE(PG8_SA(1, 1), a1 + hstepA, voffA);
            PG8_WAIT_V(8); PG8_WAIT_L(0); PG8_BAR; PG8_MMA(0, 0, At, B0); PG8_MMA(0, 1, At, B1); PG8_BAR; PG8_SCHED;
            PG8_LDA(At, 0, 1); PG8_STAGE(PG8_SB(0, 0), b2, voffB); PG8_STAGE(PG8_SB(0, 1), b2 + hstepB, voffB); PG8_STAGE(PG8_SA(0, 0), a2, voffA);
            PG8_WAIT_V(8); PG8_WAIT_L(0); PG8_BAR; PG8_MMA(1, 0, At, B0); PG8_MMA(1, 1, At, B1); PG8_BAR; PG8_SCHED;
            PG8_LDB(B0, 1, 0); PG8_LDB(B1, 1, 1); PG8_SCHED; PG8_LDA(At, 1, 0); PG8_STAGE(PG8_SA(0, 1), a2 + hstepA, voffA);
            PG8_WAIT_V(8); PG8_WAIT_L(0); PG8_BAR; PG8_MMA(0, 0, At, B0); PG8_MMA(0, 1, At, B1); PG8_BAR; PG8_SCHED;
            PG8_LDA(At, 1, 1); PG8_STAGE(PG8_SB(1, 0), b3, voffB); PG8_STAGE(PG8_SB(1, 1), b3 + hstepB, voffB); PG8_STAGE(PG8_SA(1, 0), a3, voffA);
            PG8_WAIT_V(8); PG8_WAIT_L(0); PG8_BAR; PG8_MMA(1, 0, At, B0); PG8_MMA(1, 1, At, B1); PG8_BAR; PG8_SCHED;
            } else {
            PG8_LDB(B0, 0, 0); PG8_SCHED; PG8_LDA(At, 0, 0); PG8_STAGE(PG8_SA(1, 1), a1 + hstepA, voffA);
            PG8_WAIT_L(8); PG8_BAR; PG8_WAIT_L(0); PG8_MMA(0, 0, At, B0); PG8_BAR; PG8_SCHED;
            PG8_LDB(B1, 0, 1); PG8_STAGE(PG8_SB(0, 0), b2, voffB);
            PG8_BAR; PG8_WAIT_L(0); PG8_MMA(0, 1, At, B1); PG8_BAR;
            PG8_LDA(At, 0, 1); PG8_STAGE(PG8_SA(0, 0), a2, voffA);
            PG8_BAR; PG8_WAIT_L(0); PG8_MMA(1, 0, At, B0); PG8_BAR; PG8_SCHED;
            PG8_STAGE(PG8_SB(0, 1), b2 + hstepB, voffB);
            PG8_WAIT_V(6); PG8_BAR; PG8_MMA(1, 1, At, B1); PG8_BAR;
            PG8_LDB(B0, 1, 0); PG8_SCHED; PG8_LDA(At, 1, 0); PG8_STAGE(PG8_SA(0, 1), a2 + hstepA, voffA);
            PG8_WAIT_L(8); PG8_BAR; PG8_WAIT_L(0); PG8_MMA(0, 0, At, B0); PG8_BAR; PG8_SCHED;
            PG8_LDB(B1, 1, 1); PG8_STAGE(PG8_SB(1, 0), b3, voffB);
            PG8_BAR; PG8_WAIT_L(0); PG8_MMA(0, 1, At, B1); PG8_BAR;
            PG8_LDA(At, 1, 1); PG8_STAGE(PG8_SA(1, 0), a3, voffA);
            PG8_BAR; PG8_WAIT_L(0); PG8_MMA(1, 0, At, B0); PG8_BAR; PG8_SCHED;
            PG8_STAGE(PG8_SB(1, 1), b3 + hstepB, voffB);
            PG8_WAIT_V(6); PG8_BAR; PG8_MMA(1, 1, At, B1); PG8_BAR;
            }
        }
        if constexpr (ALIGN_EPI) { if (wr == 0) PG8_BAR; }
        E(acc, cur, wr, wc, fr, fq);
        if (!has_next) break;
#pragma unroll
        for (int a = 0; a < 2; ++a)
#pragma unroll
            for (int b = 0; b < 2; ++b)
#pragma unroll
                for (int m = 0; m < 4; ++m)
#pragma unroll
                    for (int n = 0; n < 2; ++n) acc[a][b][m][n] = (f32x4){0.f, 0.f, 0.f, 0.f};
        cur = nxt; cA = nA; cB = nB; ++ui;
        if constexpr (ALIGN_EPI) { if (wr == 1) PG8_BAR; }
    }
    PG8_WAIT_V(0);
    if constexpr (!ALIGN_EPI) { if (wr == 0) PG8_BAR; }
    PG8_BAR;
#undef PG8_SA
#undef PG8_SB
#undef PG8_STAGE
#undef PG8_LDA
#undef PG8_LDB
#undef PG8_MMA
#undef PG8_WAIT_V
#undef PG8_WAIT_L
#undef PG8_BAR
#undef PG8_SCHED
}

struct PlainOrder {
    const char* A; const char* Bt; int K; int nM, nN, nwg, G, c;
    __device__ __forceinline__ void init(const void* A_, const void* Bt_, int M, int N, int K_, int G_, int c_) { A = (const char*)A_; Bt = (const char*)Bt_; K = K_; nM = M / BM; nN = N / BM; nwg = nM * nN; G = G_; c = c_; }
    __device__ __forceinline__ bool next(int i, Unit& u) const {
        const long Lq = (long)i * G + c; if (Lq >= nwg) return false;
        int wgid = (int)Lq; { const int q = nwg / 8, r = nwg % 8, xcd = wgid % 8, off = wgid / 8; wgid = (xcd < r ? xcd * (q + 1) : r * (q + 1) + (xcd - r) * q) + off; }
        const int nig = 8 * nN, gid = wgid / nig, fm = gid * 8, gsz = (nM - fm) < 8 ? (nM - fm) : 8;
        u.pm = fm + ((wgid % nig) % gsz); u.pn = (wgid % nig) / gsz; u.e = 0; return true;
    }
    __device__ __forceinline__ const char* a_base(const Unit& u) const { return A + (size_t)u.pm * 256 * K * 2; }
    __device__ __forceinline__ const char* b_base(const Unit& u) const { return Bt + (size_t)u.pn * 256 * K * 2; }
    __device__ __forceinline__ unsigned a_off(int R, int C) const { return (unsigned)(R * K + C) * 2u; }
    __device__ __forceinline__ unsigned b_off(int R, int C) const { return (unsigned)(R * K + C) * 2u; }
    __device__ __forceinline__ size_t hstep_a() const { return (size_t)HALF * K * 2; }
    __device__ __forceinline__ size_t hstep_b() const { return (size_t)HALF * K * 2; }
};
struct FourierOrder {
    const char* A; const char* X; int K, G, c;
    __device__ __forceinline__ bool next(int i, Unit& u) const { const int Lq = i * G + c; if (Lq >= 256) return false; u.pm = Lq & 1; u.pn = Lq >> 1; u.e = 0; return true; }
    __device__ __forceinline__ const char* a_base(const Unit& u) const { return A + (size_t)u.pm * 256 * K * 2; }
    __device__ __forceinline__ const char* b_base(const Unit& u) const { return X + (size_t)((u.pn >> 5) * 8192 + (u.pn & 31) * 4) * K * 2; }
    __device__ __forceinline__ unsigned a_off(int R, int C) const { return (unsigned)(R * K + C) * 2u; }
    __device__ __forceinline__ unsigned b_off(int R, int C) const { return (unsigned)((((R & 63) * 128 + (R >> 6)) * K + C) * 2); }
    __device__ __forceinline__ size_t hstep_a() const { return (size_t)HALF * K * 2; }
    __device__ __forceinline__ size_t hstep_b() const { return (size_t)2 * K * 2; }
};
struct GroupOrder {
    const char* A; const char* Bt; int K; int nN, ntot, G, c; size_t bstride; const LAS unsigned char* tile_e;
    __device__ __forceinline__ bool next(int i, Unit& u) const {
        const long Lq = (long)i * G + c; if (Lq >= (long)ntot * nN) return false;
        u.pm = (int)(Lq / nN); u.pn = (int)(Lq % nN); u.e = __builtin_amdgcn_readfirstlane((int)tile_e[u.pm]); return true;
    }
    __device__ __forceinline__ const char* a_base(const Unit& u) const { return A + (size_t)u.pm * 256 * K * 2; }
    __device__ __forceinline__ const char* b_base(const Unit& u) const { return Bt + (size_t)u.e * bstride + (size_t)u.pn * 256 * K * 2; }
    __device__ __forceinline__ unsigned a_off(int R, int C) const { return (unsigned)(R * K + C) * 2u; }
    __device__ __forceinline__ unsigned b_off(int R, int C) const { return (unsigned)(R * K + C) * 2u; }
    __device__ __forceinline__ size_t hstep_a() const { return (size_t)HALF * K * 2; }
    __device__ __forceinline__ size_t hstep_b() const { return (size_t)HALF * K * 2; }
};

struct EpiBf16Bias {
    static constexpr bool PERM = true;
    bf16_t* O; int ldc; const float* bias;
    __device__ __forceinline__ void operator()(const f32x4 (&acc)[2][2][4][2], const Unit& u, int wr, int wc, int fr, int fq) const {
        const int row0 = u.pm * BM + wr * 64 + fr, col0 = u.pn * BM + wc * 32 + 8 * fq;
        f32x4 bv[2][2];
#pragma unroll
        for (int bj = 0; bj < 2; ++bj)
#pragma unroll
            for (int n = 0; n < 2; ++n) bv[bj][n] = *(const f32x4*)(bias + col0 + bj * HALF + 4 * n);
#pragma unroll
        for (int ai = 0; ai < 2; ++ai)
#pragma unroll
            for (int m = 0; m < 4; ++m) { bf16_t* rowp = O + (size_t)(row0 + ai * HALF + m * 16) * ldc + col0;
#pragma unroll
                for (int bj = 0; bj < 2; ++bj) { const f32x4 v0 = acc[ai][bj][m][0] + bv[bj][0], v1 = acc[ai][bj][m][1] + bv[bj][1];
                    u32x4 w; w.x = cvt_pk_bf16(v0[0], v0[1]); w.y = cvt_pk_bf16(v0[2], v0[3]); w.z = cvt_pk_bf16(v1[0], v1[1]); w.w = cvt_pk_bf16(v1[2], v1[3]);
                    *(u32x4*)(rowp + bj * HALF) = w; } }
    }
};
struct EpiFourierT {
    static constexpr bool PERM = true;
    bf16_t* UT; const float* bF;
    __device__ __forceinline__ void operator()(const f32x4 (&acc)[2][2][4][2], const Unit& u, int wr, int wc, int fr, int fq) const {
        const int b = u.pn >> 5, q = u.pn & 31, cs = u.pm;
#pragma unroll
        for (int ai = 0; ai < 2; ++ai)
#pragma unroll
            for (int m = 0; m < 4; ++m) { const int ch = ai * HALF + wr * 64 + m * 16 + fr; const float bv = bF[cs * 256 + ch];
#pragma unroll
                for (int bj = 0; bj < 2; ++bj) { const int s2 = 4 * q + 2 * bj + (wc >> 1), s1 = 32 * (wc & 1) + 8 * fq;
                    const f32x4 v0 = acc[ai][bj][m][0] + bv, v1 = acc[ai][bj][m][1] + bv;
                    u32x4 w; w.x = cvt_pk_bf16(v0[0], v0[1]); w.y = cvt_pk_bf16(v0[2], v0[3]); w.z = cvt_pk_bf16(v1[0], v1[1]); w.w = cvt_pk_bf16(v1[2], v1[3]);
                    *(u32x4*)(UT + ((size_t)((b * 256 + ch) * 128 + s2) * 2 + cs) * 64 + s1) = w; } }
    }
};
struct EpiResF32 {
    static constexpr bool PERM = false;
    float* C; const float* R; int ldc; float alpha;
    __device__ __forceinline__ void operator()(const f32x4 (&acc)[2][2][4][2], const Unit& u, int wr, int wc, int fr, int fq) const {
        const int row0 = u.pm * BM + wr * 64 + fr, col0 = u.pn * BM + wc * 32 + 4 * fq;
#pragma unroll
        for (int ai = 0; ai < 2; ++ai)
#pragma unroll
            for (int m = 0; m < 4; ++m) { const size_t off = (size_t)(row0 + ai * HALF + m * 16) * ldc + col0;
#pragma unroll
                for (int bj = 0; bj < 2; ++bj)
#pragma unroll
                    for (int n = 0; n < 2; ++n) { const f32x4 r = *(const f32x4*)(R + off + bj * HALF + n * 16); *(f32x4*)(C + off + bj * HALF + n * 16) = acc[ai][bj][m][n] + r * alpha; } }
    }
};
struct EpiSwiglu {
    static constexpr bool PERM = true;
    bf16_t* H; const float* b1;
    __device__ __forceinline__ void operator()(const f32x4 (&acc)[2][2][4][2], const Unit& u, int wr, int wc, int fr, int fq) const {
        const int row0 = u.pm * BM + wr * 64 + fr, col0 = u.pn * HALF + wc * 32 + 8 * fq;
        const float* bg = b1 + (size_t)u.e * 2048 + col0; const float* bu = bg + 1024;
        f32x4 g0 = *(const f32x4*)(bg), g1 = *(const f32x4*)(bg + 4), u0 = *(const f32x4*)(bu), u1 = *(const f32x4*)(bu + 4);
#pragma unroll
        for (int ai = 0; ai < 2; ++ai)
#pragma unroll
            for (int m = 0; m < 4; ++m) { bf16_t* rowp = H + (size_t)(row0 + ai * HALF + m * 16) * FF + col0;
                float o[8];
#pragma unroll
                for (int n = 0; n < 2; ++n)
#pragma unroll
                    for (int j = 0; j < 4; ++j) { float g = acc[ai][0][m][n][j] + (n ? g1[j] : g0[j]); float up = acc[ai][1][m][n][j] + (n ? u1[j] : u0[j]);
                        g = fminf(g, SW_LIMIT); up = fminf(fmaxf(up, -SW_LIMIT), SW_LIMIT);
                        const float glu = g / (1.0f + __expf(-SW_ALPHA * g)); o[n * 4 + j] = (up + 1.0f) * glu; }
                u32x4 w; w.x = cvt_pk_bf16(o[0], o[1]); w.y = cvt_pk_bf16(o[2], o[3]); w.z = cvt_pk_bf16(o[4], o[5]); w.w = cvt_pk_bf16(o[6], o[7]);
                *(u32x4*)rowp = w; }
    }
};
struct EpiExpertOut {
    static constexpr bool PERM = true;
    bf16_t* Y; const float* b2;
    __device__ __forceinline__ void operator()(const f32x4 (&acc)[2][2][4][2], const Unit& u, int wr, int wc, int fr, int fq) const {
        const int row0 = u.pm * BM + wr * 64 + fr, col0 = u.pn * BM + wc * 32 + 8 * fq;
        const float* bb = b2 + (size_t)u.e * D + col0;
        f32x4 bv[2][2];
#pragma unroll
        for (int bj = 0; bj < 2; ++bj)
#pragma unroll
            for (int n = 0; n < 2; ++n) bv[bj][n] = *(const f32x4*)(bb + bj * HALF + 4 * n);
#pragma unroll
        for (int ai = 0; ai < 2; ++ai)
#pragma unroll
            for (int m = 0; m < 4; ++m) { bf16_t* rowp = Y + (size_t)(row0 + ai * HALF + m * 16) * D + col0;
#pragma unroll
                for (int bj = 0; bj < 2; ++bj) { const f32x4 v0 = acc[ai][bj][m][0] + bv[bj][0], v1 = acc[ai][bj][m][1] + bv[bj][1];
                    u32x4 w; w.x = cvt_pk_bf16(v0[0], v0[1]); w.y = cvt_pk_bf16(v0[2], v0[3]); w.z = cvt_pk_bf16(v1[0], v1[1]); w.w = cvt_pk_bf16(v1[2], v1[3]);
                    *(u32x4*)(rowp + bj * HALF) = w; } }
    }
};
}

#define XB_TMO      128
#define XB_XCNT(j)  (256  + 64 * (j))
#define XB_XSUB(j)  (1280 + 64 * (j))
#define XB_XGEN(j)  (2304 + 64 * (j))
#define XB_TOP      3328
#define XB_TOPGEN   3392
#define XCD_BAR_WORDS 3456
#define XB_SPIN_CAP (1u << 22)
__device__ __forceinline__ unsigned xb_ld(unsigned* p)              { return __hip_atomic_load(p, __ATOMIC_RELAXED, __HIP_MEMORY_SCOPE_AGENT); }
__device__ __forceinline__ unsigned xb_add(unsigned* p, unsigned v) { return __hip_atomic_fetch_add(p, v, __ATOMIC_RELAXED, __HIP_MEMORY_SCOPE_AGENT); }
__device__ __forceinline__ unsigned xb_xcc_id() { return (unsigned)__builtin_amdgcn_s_getreg((3 << 11) | 20) & 0xFu; }
#define XB_SPIN(cond, bar) do { unsigned _sp = 0; while (cond) { __builtin_amdgcn_s_sleep(1); \
    if ((++_sp & 255u) == 0u) { if (xb_ld(&(bar)[XB_TMO])) break; if (_sp > XB_SPIN_CAP) { atomicAdd(&(bar)[XB_TMO], 1u); break; } } } } while (0)
struct XcdBarrier { unsigned* bar; unsigned x; volatile LAS unsigned* st; };
__device__ __forceinline__ XcdBarrier xcd_barrier_post(unsigned* bar, volatile LAS unsigned* st) {
    XcdBarrier b; b.bar = bar; b.x = xb_xcc_id(); b.st = st;
    if (threadIdx.x == 0) (void)xb_add(&bar[XB_XCNT(b.x)], 1u);
    return b;
}
__device__ __forceinline__ void xcd_barrier_complete(unsigned* bar, unsigned x, unsigned& nloc, unsigned& nx) {
    const unsigned G = gridDim.x * gridDim.y * gridDim.z;
    unsigned sum, cnt, mine, sp = 0u;
    for (;;) {
        sum = 0u; cnt = 0u; mine = 0u;
#pragma unroll
        for (unsigned j = 0; j < 16; ++j) { const unsigned c = xb_ld(&bar[XB_XCNT(j)]); sum += c; cnt += (c > 0u) ? 1u : 0u; mine = (j == x) ? c : mine; }
        if (sum == G) break;
        __builtin_amdgcn_s_sleep(1);
        if ((++sp & 255u) == 0u) { if (xb_ld(&bar[XB_TMO])) break; if (sp > XB_SPIN_CAP) { atomicAdd(&bar[XB_TMO], 1u); break; } }
    }
    nloc = mine > 0u ? mine : 1u; nx = cnt > 0u ? cnt : 1u;
}
__device__ __forceinline__ void xcd_barrier(const XcdBarrier& b) {
    asm volatile("s_waitcnt vmcnt(0)" ::: "memory");
    __syncthreads();
    if (threadIdx.x == 0) {
        unsigned* bar = b.bar;
        __builtin_amdgcn_s_waitcnt(0);
        unsigned nloc = b.st[0], nx = b.st[1];
        if (nloc == 0u) { xcd_barrier_complete(bar, b.x, nloc, nx); b.st[0] = nloc; b.st[1] = nx; }
        const unsigned old = xb_add(&bar[XB_XSUB(b.x)], 1u);
        const unsigned gen = old / nloc;
        if (old + 1u == (gen + 1u) * nloc) {
            __builtin_amdgcn_fence(__ATOMIC_RELEASE, "agent");
            asm volatile("s_waitcnt vmcnt(0)" ::: "memory");
            const unsigned og = xb_add(&bar[XB_TOP], 1u);
            const unsigned tg = og / nx;
            if (og + 1u == (tg + 1u) * nx) xb_add(&bar[XB_TOPGEN], 1u);
            else XB_SPIN(xb_ld(&bar[XB_TOPGEN]) == tg, bar);
            __builtin_amdgcn_fence(__ATOMIC_ACQUIRE, "agent");
            xb_add(&bar[XB_XGEN(b.x)], 1u);
            asm volatile("s_waitcnt vmcnt(0)" ::: "memory");
        } else {
            XB_SPIN(xb_ld(&bar[XB_XGEN(b.x)]) == gen, bar);
            __builtin_amdgcn_fence(__ATOMIC_ACQUIRE, "agent");
            asm volatile("s_waitcnt vmcnt(0)" ::: "memory");
        }
    }
    __syncthreads();
}

struct Args {
    const float* x; const float* emb_g; const float* emb_b; const float* w_in; const float* b_in; const float* conv_w; const float* ml_nw; const float* ret_nw;
    const float* w_out; const float* ln1_g; const float* ln1_b; const float* w_router; const float* b_router; const float* w1; const float* b1; const float* w2; const float* b2;
    const float* ln2_g; const float* ln2_b;
    float* out; unsigned char* ws; int ph_lo, ph_hi;
};
#define KA(f) (((const volatile __attribute__((address_space(4))) Args*)__builtin_amdgcn_kernarg_segment_ptr())->f)
constexpr int NWAVES = 8, NTHR = 512;
constexpr int NPH_LAYER = 10;
constexpr int NPH = 1 + NL * NPH_LAYER;

struct Frame {
    LAS unsigned char* lds;
    unsigned* ctl;
    int tid, lane, wave, G, bid;
};

__device__ __forceinline__ int sidx(int b, int h, int dir, int c) { return ((b * NH + h) * 2 + dir) * NCH + c; }

template <class RowMap>
__device__ __forceinline__ void transpose_item(const float* W, int K, int Nsrc, bf16_t* WT, LAS float* scr, int kb, int nb, int lane, const RowMap& rm, int coff = 0) {
    const int k0 = 64 * kb, n0 = 32 * nb;
    const int nn = n0 + (lane & 31) + coff;
#pragma unroll 8
    for (int i = 0; i < 32; ++i) { const int kk = 2 * i + (lane >> 5); scr[kk * 33 + (lane & 31)] = nn < Nsrc ? W[(size_t)(k0 + kk) * Nsrc + nn] : 0.f; }
    asm volatile("s_waitcnt lgkmcnt(0)" ::: "memory");
    const int c = lane & 7;
#pragma unroll
    for (int j = 0; j < 4; ++j) { const int n = (lane >> 3) + 8 * j; const LAS float* s = scr + (8 * c) * 33 + n;
        u32x4 o; o.x = pk2(s[0 * 33], s[1 * 33]); o.y = pk2(s[2 * 33], s[3 * 33]); o.z = pk2(s[4 * 33], s[5 * 33]); o.w = pk2(s[6 * 33], s[7 * 33]);
        *(u32x4*)(WT + (size_t)rm(n0 + n) * K + k0 + 8 * c) = o; }
    asm volatile("s_waitcnt lgkmcnt(0)" ::: "memory");
}
struct RowId { __device__ __forceinline__ int operator()(int n) const { return n; } };
struct RowW1 { __device__ __forceinline__ int operator()(int n) const { const int up = n >> 10, j = n & 1023; return (j >> 7) * 256 + up * 128 + (j & 127); } };

__device__ __forceinline__ void ln_row(const f32x4 (&vin)[4], const float* g, const float* b, float* of, bf16_t* ob, float* of2, int lane) {
    f32x4 v[4]; float s = 0.f;
#pragma unroll
    for (int j = 0; j < 4; ++j) { v[j] = vin[j]; s += (v[j].x + v[j].y) + (v[j].z + v[j].w); }
    const float mean = wave_sum(s) * (1.f / D); float s2 = 0.f;
#pragma unroll
    for (int j = 0; j < 4; ++j) { v[j] = v[j] - mean; s2 += (v[j].x * v[j].x + v[j].y * v[j].y) + (v[j].z * v[j].z + v[j].w * v[j].w); }
    const float rstd = 1.f / sqrtf(wave_sum(s2) * (1.f / D) + LN_EPS);
#pragma unroll
    for (int j = 0; j < 4; ++j) { const f32x4 gg = *(const f32x4*)(g + 4 * lane + 256 * j), bb = *(const f32x4*)(b + 4 * lane + 256 * j);
        const f32x4 o = v[j] * rstd * gg + bb;
        if (of) *(f32x4*)(of + 4 * lane + 256 * j) = o;
        if (of2) *(f32x4*)(of2 + 4 * lane + 256 * j) = o;
        if (ob) { u32x2 w; w.x = pk2(o.x, o.y); w.y = pk2(o.z, o.w); *(u32x2*)(ob + 4 * lane + 256 * j) = w; } }
}

__device__ __forceinline__ void p0_prologue(const Frame& F, const Args& a) {
    unsigned char* ws = KA(ws);
    LAS float* scr = (LAS float*)(F.lds + F.wave * 16384);
    const int gw = F.bid * NWAVES + F.wave, NGW = F.G * NWAVES;
    const float* w_in_ = KA(w_in); const float* w_out_ = KA(w_out); const float* w1_ = KA(w1); const float* w2_ = KA(w2);
    constexpr int I_IN = NL * 16 * 80, I_OUT = NL * 16 * 32, I_W1 = NL * NE * 16 * 64, I_W2 = NL * NE * 16 * 32;
    for (int it = gw; it < I_IN + I_OUT + I_W1 + I_W2; it += NGW) {
        int r = it;
        if (r < I_IN) { const int l = r / (16 * 80), q = r % (16 * 80); transpose_item(w_in_ + (size_t)l * D * PW, D, PW, (bf16_t*)(ws + WS_WIN) + (size_t)l * PWP * D, scr, q / 80, q % 80, F.lane, RowId(), PWF); continue; } r -= I_IN;
        if (r < I_OUT) { const int l = r / (16 * 32), q = r % (16 * 32); transpose_item(w_out_ + (size_t)l * D * D, D, D, (bf16_t*)(ws + WS_WOUT) + (size_t)l * D * D, scr, q / 32, q % 32, F.lane, RowId()); continue; } r -= I_OUT;
        if (r < I_W1) { const int le = r / (16 * 64), q = r % (16 * 64); transpose_item(w1_ + (size_t)le * D * 2048, D, 2048, (bf16_t*)(ws + WS_W1) + (size_t)le * 2048 * D, scr, q / 64, q % 64, F.lane, RowW1()); continue; } r -= I_W1;
        { const int le = r / (16 * 32), q = r % (16 * 32); transpose_item(w2_ + (size_t)le * FF * D, FF, D, (bf16_t*)(ws + WS_W2) + (size_t)le * D * FF, scr, q / 32, q % 32, F.lane, RowId()); }
    }
    const int gt = F.bid * NTHR + F.tid, NGT = F.G * NTHR;
    float* binp = (float*)(ws + WS_BIN); const float* bin_ = KA(b_in);
    for (int i = gt; i < NL * PWP; i += NGT) { const int l = i / PWP, c = i % PWP; binp[i] = c < PW2 ? bin_[l * PW + PWF + c] : 0.f; }
    { bf16_t* WF = (bf16_t*)(ws + WS_WF); float* bF = (float*)(ws + WS_FG + FG_BF_OFF);
      for (int i = gt; i < NL * 512 * D; i += NGT) { const int l = i / (512 * D), r = (i / D) % 512, k = i % D, cs = r >> 8, g = (r >> 6) & 3, cp = r & 63;
          const float* wrow = w_in_ + ((size_t)l * D + k) * PW + g * 64; float acc = 0.f;
          for (int c = 0; c < 64; ++c) { const float rev = (float)((c * cp) & 63) * (1.0f / 64.0f); acc += wrow[c] * (cs ? __builtin_amdgcn_sinf(rev) : __builtin_amdgcn_cosf(rev)); }
          WF[i] = (bf16_t)f2bf(acc); }
      for (int i = gt; i < NL * 512; i += NGT) { const int l = i / 512, r = i % 512, cs = r >> 8, g = (r >> 6) & 3, cp = r & 63; float acc = 0.f;
          for (int c = 0; c < 64; ++c) { const float rev = (float)((c * cp) & 63) * (1.0f / 64.0f); acc += bin_[l * PW + g * 64 + c] * (cs ? __builtin_amdgcn_sinf(rev) : __builtin_amdgcn_cosf(rev)); }
          bF[i] = acc; }
      bf16_t* Gm = (bf16_t*)(ws + WS_FG);
      for (int i = gt; i < 128 * 128; i += NGT) { const int ro = i >> 13, k1 = (i >> 7) & 63, ri = (i >> 6) & 1, s1 = i & 63; const float rev = (float)((k1 * s1) & 63) * (1.0f / 64.0f);
          const float c = __builtin_amdgcn_cosf(rev), sn = __builtin_amdgcn_sinf(rev); Gm[i] = (bf16_t)f2bf(ro == 0 ? (ri == 0 ? c : -sn) : (ri == 0 ? -sn : -c)); }
      bf16_t* Hm = (bf16_t*)(ws + WS_FG + FG_H_OFF);
      for (int i = gt; i < 128 * 256; i += NGT) { const int k2 = i >> 8, ri = (i >> 7) & 1, s2 = i & 127; const float rev = (float)((k2 * s2) & 127) * (1.0f / 128.0f);
          Hm[i] = (bf16_t)f2bf(0.0013810679320049757f * (ri ? __builtin_amdgcn_sinf(rev) : __builtin_amdgcn_cosf(rev))); } }
    float* rot = (float*)(ws + WS_ROT);
    for (int i = gt; i < S * 24; i += NGT) { const int pos = i / 24, j = i % 24; const float inv = 1.0f / powf(10000.0f, (float)(2 * j) / 48.0f); const float ang = (float)pos * inv;
        float sn, cs; sincosf(ang, &sn, &cs); rot[2 * i] = cs; rot[2 * i + 1] = sn; }
    float* xf = (float*)(ws + WS_XF); bf16_t* xb = (bf16_t*)(ws + WS_XB); const float* xin = KA(x); const float* eg = KA(emb_g); const float* eb = KA(emb_b);
    for (int m = gw; m < T; m += NGW) { f32x4 v[4];
#pragma unroll
        for (int j = 0; j < 4; ++j) v[j] = *(const f32x4*)(xin + (size_t)m * D + 4 * F.lane + 256 * j);
        ln_row(v, eg, eb, xf + (size_t)m * D, xb + (size_t)m * D, nullptr, F.lane); }
}

template <bool REV, bool MAXOP> __device__ __forceinline__ void wave_scan128(LAS float* arr, int lane) {
    const int i0 = REV ? 127 - 2 * lane : 2 * lane, i1 = REV ? 126 - 2 * lane : 2 * lane + 1;
    const float a = arr[i0], b = arr[i1];
    float s = MAXOP ? fmaxf(a, b) : a + b;
#pragma unroll
    for (int o = 1; o < 64; o <<= 1) { const float t = __shfl_up(s, o); if (lane >= o) s = MAXOP ? fmaxf(s, t) : s + t; }
    float ex = __shfl_up(s, 1); if (lane == 0) ex = MAXOP ? -INFINITY : 0.f;
    arr[i0] = MAXOP ? fmaxf(ex, a) : ex + a; arr[i1] = MAXOP ? fmaxf(fmaxf(ex, a), b) : ex + a + b;
}
__device__ __forceinline__ float ret_lg(int h, float off) { return log1pf(-exp2f(-(5.0f + off) - (float)h)); }

__device__ __forceinline__ float mlstm_qk(const bf16_t* P, const float* convw, int b, int s, int ch) {
    float acc = 0.f;
#pragma unroll
    for (int d = 0; d < 3; ++d) { const int sp = s + d - 1; if (sp >= 0 && sp < S) acc += bf2f(P[(size_t)(b * S + sp) * PWP + COL_MQK + ch]) * convw[d * 384 + ch]; }
    return siluf_(acc);
}
__device__ __forceinline__ float ret_rot(const bf16_t* P, const float* rot, int b, int s, int colbase, int h, int kk) {
    const bf16_t* p = P + (size_t)(b * S + s) * PWP + colbase + h * DK + (kk & ~1);
    const float t1 = bf2f(p[0]), t2 = bf2f(p[1]);
    const float cs = rot[(s * 24 + (kk >> 1)) * 2], sn = rot[(s * 24 + (kk >> 1)) * 2 + 1];
    return (kk & 1) ? t1 * sn + t2 * cs : t1 * cs - t2 * sn;
}

__device__ __forceinline__ void phaseB_unit(const Frame& F, const Args& a, int l, int u) {
    unsigned char* ws = KA(ws);
    const bf16_t* P = (const bf16_t*)(ws + WS_P);
    const int type = u >> 10, r = u & 1023, b = r >> 8, c = (r >> 2) & 63, h = r & 3;
    LAS float* kS = (LAS float*)F.lds;
    LAS float* vS = kS + 128 * 49;
    LAS float* ga = vS + 128 * 97;
    LAS float* lff = ga, *lfb = ga + 128, *iff = ga + 256, *ibb = ga + 384, *pf = ga + 512, *pb = ga + 640, *scal = ga + 768;
    const int t0 = b * S + c * CH;
    const float kscale = 0.14433756729740643f;
    if (type == 0) {
        const float* convw = KA(conv_w) + (size_t)l * 3 * 384;
        for (int idx = F.tid; idx < 128 * DK; idx += NTHR) { const int j = idx / DK, kk = idx % DK; kS[j * 49 + kk] = mlstm_qk(P, convw, b, c * CH + j, 192 + h * DK + kk) * kscale; }
        for (int idx = F.tid; idx < 128 * DV; idx += NTHR) { const int j = idx / DV, vv = idx % DV; vS[j * 97 + vv] = bf2f(P[(size_t)(t0 + j) * PWP + COL_MV + h * DV + vv]); }
        if (F.tid < 128) { const bf16_t* g = P + (size_t)(t0 + F.tid) * PWP + COL_MG;
            iff[F.tid] = bf2f(g[h]); lff[F.tid] = logsigmoidf_(bf2f(g[4 + h])); ibb[F.tid] = bf2f(g[8 + h]); lfb[F.tid] = logsigmoidf_(bf2f(g[12 + h])); }
        __syncthreads();
        if (F.wave == 0) wave_scan128<false, false>(lff, F.lane);
        if (F.wave == 1) wave_scan128<true, false>(lfb, F.lane);
        __syncthreads();
        if (F.tid < 128) pf[F.tid] = lff[127] - lff[F.tid] + iff[F.tid];
        else if (F.tid < 256) { const int j = F.tid - 128; pb[j] = lfb[0] - lfb[j] + ibb[j]; }
        __syncthreads();
        if (F.wave == 0) { const float m = wave_max(fmaxf(pf[2 * F.lane], pf[2 * F.lane + 1])); if (F.lane == 0) scal[0] = m; }
        if (F.wave == 1) { const float m = wave_max(fmaxf(pb[2 * F.lane], pb[2 * F.lane + 1])); if (F.lane == 0) scal[1] = m; }
        __syncthreads();
        if (F.tid < 128) pf[F.tid] = __expf(pf[F.tid] - scal[0]);
        else if (F.tid < 256) { const int j = F.tid - 128; pb[j] = __expf(pb[j] - scal[1]); }
        __syncthreads();
        float* mC = (float*)(ws + WS_MC); float* mN = (float*)(ws + WS_MN); float* msc = (float*)(ws + WS_MSC);
        for (int idx = F.tid; idx < 2 * DV * DK; idx += NTHR) { const int dir = idx / (DV * DK), e = idx % (DV * DK), vv = e / DK, kk = e % DK; const LAS float* p = dir ? pb : pf;
            float s = 0.f;
            for (int j = 0; j < 128; ++j) s += p[j] * vS[j * 97 + vv] * kS[j * 49 + kk];
            mC[(size_t)sidx(b, h, dir, c) * (DV * DK) + e] = s; }
        if (F.tid < 2 * DK) { const int dir = F.tid / DK, kk = F.tid % DK; const LAS float* p = dir ? pb : pf; float s = 0.f;
            for (int j = 0; j < 128; ++j) s += p[j] * kS[j * 49 + kk];
            mN[(size_t)sidx(b, h, dir, c) * DK + kk] = s; }
        if (F.tid == 0) { msc[sidx(b, h, 0, c)] = scal[0]; msc[sidx(b, h, 1, c)] = scal[1]; msc[2048 + sidx(b, h, 0, c)] = lff[127]; msc[2048 + sidx(b, h, 1, c)] = lfb[0]; }
    } else {
        const float* rot = (const float*)(ws + WS_ROT);
        for (int idx = F.tid; idx < 128 * DK; idx += NTHR) { const int j = idx / DK, kk = idx % DK; kS[j * 49 + kk] = ret_rot(P, rot, b, c * CH + j, COL_RK, h, kk) * kscale; }
        for (int idx = F.tid; idx < 128 * DV; idx += NTHR) { const int j = idx / DV, vv = idx % DV; vS[j * 97 + vv] = bf2f(P[(size_t)(t0 + j) * PWP + COL_RV + h * DV + vv]); }
        const float lgf = ret_lg(h, 0.f), lgb = ret_lg(h, 0.5f);
        if (F.tid < 128) pf[F.tid] = __expf(lgf * (float)(127 - F.tid));
        else if (F.tid < 256) { const int j = F.tid - 128; pb[j] = __expf(lgb * (float)j); }
        __syncthreads();
        float* rS = (float*)(ws + WS_RS);
        for (int idx = F.tid; idx < 2 * DV * DK; idx += NTHR) { const int dir = idx / (DV * DK), e = idx % (DV * DK), vv = e / DK, kk = e % DK; const LAS float* p = dir ? pb : pf;
            float s = 0.f;
            for (int j = 0; j < 128; ++j) s += p[j] * vS[j * 97 + vv] * kS[j * 49 + kk];
            rS[(size_t)sidx(b, h, dir, c) * (DV * DK) + e] = s; }
    }
    __syncthreads();
}

__device__ __forceinline__ void phaseC_unit(const Frame& F, const Args& a, int u) {
    unsigned char* ws = KA(ws);
    const int type = u >> 7, seq = (u & 127) >> 2, part = u & 3, dir = seq & 1;
    LAS float* sp = (LAS float*)F.lds; LAS float* sc = sp + 64;
    float* msc = (float*)(ws + WS_MSC);
    if (type == 0) {
        if (F.tid == 0) { float m = 0.f;
            for (int n = 0; n < NCH; ++n) { const int c = dir ? NCH - 1 - n : n; const int si = seq * NCH + c; const float mc = msc[si], ae = msc[2048 + si];
                if (part == 0) msc[4096 + si] = m;
                const float mn = fmaxf(ae + m, mc); sp[n] = __expf(ae + m - mn); sc[n] = __expf(mc - mn); m = mn; } }
    } else {
        if (F.tid < 64) { const int h = (seq >> 1) & 3; const float lg = ret_lg(h, dir ? 0.5f : 0.f); sp[F.tid] = __expf(lg * 128.0f); sc[F.tid] = 1.0f; }
    }
    __syncthreads();
    float* X = (float*)(ws + (type ? WS_RS : WS_MC));
    for (int e = F.tid; e < 1152; e += NTHR) { float st = 0.f; float* p = X + (size_t)seq * NCH * (DV * DK) + part * 1152 + e;
#pragma unroll 8
        for (int n = 0; n < NCH; ++n) { const int c = dir ? NCH - 1 - n : n; float* q = p + (size_t)c * (DV * DK); const float v = *q; *q = st; st = sp[n] * st + sc[n] * v; } }
    if (type == 0 && part == 0 && F.tid < DK) { float st = 0.f; float* p = (float*)(ws + WS_MN) + (size_t)seq * NCH * DK + F.tid;
        for (int n = 0; n < NCH; ++n) { const int c = dir ? NCH - 1 - n : n; float* q = p + (size_t)c * DK; const float v = *q; *q = st; st = sp[n] * st + sc[n] * v; } }
    __syncthreads();
}

__device__ __forceinline__ void phaseD_unit(const Frame& F, const Args& a, int l, int u) {
    unsigned char* ws = KA(ws);
    const bf16_t* P = (const bf16_t*)(ws + WS_P); bf16_t* mix = (bf16_t*)(ws + WS_MIX);
    const int type = u >> 10, r = u & 1023, b = r >> 8, c = (r >> 2) & 63, h = r & 3;
    LAS bf16_t* qS = (LAS bf16_t*)F.lds;
    LAS bf16_t* kS = qS + 128 * 50;
    LAS bf16_t* vS = kS + 128 * 50;
    LAS float* SS = (LAS float*)(vS + 128 * 98);
    LAS float* ar = SS + 128 * 129;
    LAS float* af = ar, *ab = ar + 128, *iff = ar + 256, *ibb = ar + 384, *gxf = ar + 512, *gxb = ar + 640, *mtf = ar + 768, *mtb = ar + 896, *rdf = ar + 1024, *rdb = ar + 1152, *sif = ar + 1280, *sib = ar + 1408;
    LAS float* ps = ar + 1536;
    const int t0 = b * S + c * CH;
    const float kscale = 0.14433756729740643f;
    const float* rot = (const float*)(ws + WS_ROT);
    if (type == 0) {
        const float* convw = KA(conv_w) + (size_t)l * 3 * 384;
        for (int idx = F.tid; idx < 128 * DK; idx += NTHR) { const int j = idx / DK, kk = idx % DK;
            qS[j * 50 + kk] = (bf16_t)f2bf(mlstm_qk(P, convw, b, c * CH + j, h * DK + kk));
            kS[j * 50 + kk] = (bf16_t)f2bf(mlstm_qk(P, convw, b, c * CH + j, 192 + h * DK + kk) * kscale); }
        for (int idx = F.tid; idx < 128 * DV; idx += NTHR) { const int j = idx / DV, vv = idx % DV; vS[j * 98 + vv] = P[(size_t)(t0 + j) * PWP + COL_MV + h * DV + vv]; }
        if (F.tid < 128) { const bf16_t* g = P + (size_t)(t0 + F.tid) * PWP + COL_MG;
            iff[F.tid] = bf2f(g[h]); af[F.tid] = logsigmoidf_(bf2f(g[4 + h])); ibb[F.tid] = bf2f(g[8 + h]); ab[F.tid] = logsigmoidf_(bf2f(g[12 + h])); }
    } else {
        for (int idx = F.tid; idx < 128 * DK; idx += NTHR) { const int j = idx / DK, kk = idx % DK;
            qS[j * 50 + kk] = (bf16_t)f2bf(ret_rot(P, rot, b, c * CH + j, COL_RQ, h, kk));
            kS[j * 50 + kk] = (bf16_t)f2bf(ret_rot(P, rot, b, c * CH + j, COL_RK, h, kk) * kscale); }
        for (int idx = F.tid; idx < 128 * DV; idx += NTHR) { const int j = idx / DV, vv = idx % DV; vS[j * 98 + vv] = P[(size_t)(t0 + j) * PWP + COL_RV + h * DV + vv]; }
    }
    __syncthreads();
    { const int j = F.tid >> 2, s0 = (F.tid & 3) * 32;
#pragma unroll 1
      for (int s = s0; s < s0 + 32; ++s) { float d = 0.f;
#pragma unroll 8
          for (int kk = 0; kk < DK; ++kk) d += bf2f(qS[j * 50 + kk]) * bf2f(kS[s * 50 + kk]);
          SS[j * 129 + s] = d; } }
    const int j = F.tid & 127, vq = F.tid >> 7;
    float acc[24];
#pragma unroll
    for (int x = 0; x < 24; ++x) acc[x] = 0.f;
    if (type == 0) {
        const float* msc = (const float*)(ws + WS_MSC);
        const float mpf = msc[4096 + sidx(b, h, 0, c)], mpb = msc[4096 + sidx(b, h, 1, c)];
        if (F.wave == 0) wave_scan128<false, false>(af, F.lane);
        if (F.wave == 1) wave_scan128<true, false>(ab, F.lane);
        __syncthreads();
        if (F.tid < 128) gxf[F.tid] = iff[F.tid] - af[F.tid]; else if (F.tid < 256) gxb[F.tid - 128] = ibb[F.tid - 128] - ab[F.tid - 128];
        __syncthreads();
        if (F.wave == 0) wave_scan128<false, true>(gxf, F.lane);
        if (F.wave == 1) wave_scan128<true, true>(gxb, F.lane);
        __syncthreads();
        if (F.tid < 128) mtf[F.tid] = fmaxf(af[F.tid] + mpf, af[F.tid] + gxf[F.tid]); else if (F.tid < 256) { const int q = F.tid - 128; mtb[q] = fmaxf(ab[q] + mpb, ab[q] + gxb[q]); }
        __syncthreads();
        if (F.tid < 256) { const int dir = F.tid >> 7, jj = F.tid & 127; const LAS float* A_ = dir ? ab : af; const LAS float* I_ = dir ? ibb : iff; const float mt = dir ? mtb[jj] : mtf[jj];
            float den = 0.f; const int lo = dir ? jj : 0, hi = dir ? 127 : jj;
            for (int s = lo; s <= hi; ++s) den += SS[jj * 129 + s] * __expf(A_[jj] - A_[s] + I_[s] - mt);
            const float si = __expf(A_[jj] + (dir ? mpb : mpf) - mt);
            const float* np = (const float*)(ws + WS_MN) + (size_t)sidx(b, h, dir, c) * DK; float nq = 0.f;
            for (int kk = 0; kk < DK; ++kk) nq += np[kk] * bf2f(qS[jj * 50 + kk]);
            den += si * nq;
            const float dn = fmaxf(fabsf(den), __expf(-mt));
            if (dir) { rdb[jj] = 1.0f / dn; sib[jj] = si; } else { rdf[jj] = 1.0f / dn; sif[jj] = si; } }
        __syncthreads();
#pragma unroll 1
        for (int dir = 0; dir < 2; ++dir) {
            const LAS float* A_ = dir ? ab : af; const LAS float* I_ = dir ? ibb : iff; const float mt = dir ? mtb[j] : mtf[j]; const float rd = dir ? rdb[j] : rdf[j]; const float si = dir ? sib[j] : sif[j];
            const int lo = dir ? j : 0, hi = dir ? 127 : j;
            for (int s = lo; s <= hi; ++s) { const float w = SS[j * 129 + s] * __expf(A_[j] - A_[s] + I_[s] - mt) * rd;
#pragma unroll
                for (int x = 0; x < 24; ++x) acc[x] += w * bf2f(vS[s * 98 + vq * 24 + x]); }
            const float* cp = (const float*)(ws + WS_MC) + (size_t)sidx(b, h, dir, c) * (DV * DK) + (size_t)(vq * 24) * DK;
            for (int kk = 0; kk < DK; ++kk) { const float qv = bf2f(qS[j * 50 + kk]) * si * rd;
#pragma unroll
                for (int x = 0; x < 24; ++x) acc[x] += qv * cp[x * DK + kk]; }
        }
        const bf16_t* og = P + (size_t)(t0 + j) * PWP + COL_MO + h * DV + vq * 24;
#pragma unroll
        for (int x = 0; x < 24; ++x) acc[x] *= sigmoidf_(bf2f(og[x]));
    } else {
        const float lgf = ret_lg(h, 0.f), lgb = ret_lg(h, 0.5f);
        __syncthreads();
        for (int s = 0; s < 128; ++s) { const float w = SS[j * 129 + s] * (s <= j ? __expf(lgf * (float)(j - s)) : __expf(lgb * (float)(s - j)));
#pragma unroll
            for (int x = 0; x < 24; ++x) acc[x] += w * bf2f(vS[s * 98 + vq * 24 + x]); }
#pragma unroll 1
        for (int dir = 0; dir < 2; ++dir) {
            const float wi = dir ? __expf(lgb * (float)(128 - j)) : __expf(lgf * (float)(j + 1));
            const float* cp = (const float*)(ws + WS_RS) + (size_t)sidx(b, h, dir, c) * (DV * DK) + (size_t)(vq * 24) * DK;
            for (int kk = 0; kk < DK; ++kk) { const float qv = bf2f(qS[j * 50 + kk]) * wi;
#pragma unroll
                for (int x = 0; x < 24; ++x) acc[x] += qv * cp[x * DK + kk]; }
        }
    }
    float s1 = 0.f;
#pragma unroll
    for (int x = 0; x < 24; ++x) s1 += acc[x];
    ps[vq * 128 + j] = s1;
    __syncthreads();
    const float mean = (ps[j] + ps[128 + j] + ps[256 + j] + ps[384 + j]) * (1.0f / 96.0f);
    __syncthreads();
    float s2 = 0.f;
#pragma unroll
    for (int x = 0; x < 24; ++x) { acc[x] -= mean; s2 += acc[x] * acc[x]; }
    ps[vq * 128 + j] = s2;
    __syncthreads();
    const float rstd = 1.0f / sqrtf((ps[j] + ps[128 + j] + ps[256 + j] + ps[384 + j]) * (1.0f / 96.0f) + LN_EPS);
    bf16_t* o = mix + (size_t)(t0 + j) * D + (type ? 640 : 256) + h * DV + vq * 24;
    if (type == 0) {
        const float* nw = KA(ml_nw) + (size_t)l * 384 + h * DV + vq * 24;
#pragma unroll
        for (int x = 0; x < 24; x += 2) *(unsigned*)(o + x) = pk2(acc[x] * rstd * nw[x], acc[x + 1] * rstd * nw[x + 1]);
    } else {
        const float* nw = KA(ret_nw) + (size_t)l * 384 + h * DV + vq * 24;
        const bf16_t* gg = P + (size_t)(t0 + j) * PWP + COL_RG + h * DV + vq * 24;
#pragma unroll
        for (int x = 0; x < 24; x += 2) *(unsigned*)(o + x) = pk2(acc[x] * rstd * nw[x] * siluf_(bf2f(gg[x])), acc[x + 1] * rstd * nw[x + 1] * siluf_(bf2f(gg[x + 1])));
    }
    __syncthreads();
}

__device__ __forceinline__ void fourier_stage1(const Frame& F, unsigned char* ws) {
    const bf16_t* UT = (const bf16_t*)(ws + WS_UT); bf16_t* AT = (bf16_t*)(ws + WS_AT);
    LAS bf16_t* Gs = (LAS bf16_t*)F.lds;
    { const bf16_t* Gg = (const bf16_t*)(ws + WS_FG);
      for (int i = F.tid; i < 128 * 16; i += NTHR) { const int r = i >> 4, c8 = i & 15; *(LAS u32x4*)(Gs + r * 136 + c8 * 8) = *(const u32x4*)(Gg + r * 128 + c8 * 8); } }
    __syncthreads();
    const int l15 = F.lane & 15, lq = F.lane >> 4;
    for (int u = F.bid; u < 1024; u += F.G) {
        const int b = u >> 8, ch = u & 255;
        const bf16_t* xr = UT + ((size_t)u * 128 + 16 * F.wave + l15) * 128 + 8 * lq;
        bf16x8 af[4];
#pragma unroll
        for (int ks = 0; ks < 4; ++ks) af[ks] = *(const bf16x8*)(xr + 32 * ks);
        f32x4 acc[8];
#pragma unroll
        for (int n = 0; n < 8; ++n) { acc[n] = (f32x4){0.f, 0.f, 0.f, 0.f};
#pragma unroll
            for (int ks = 0; ks < 4; ++ks) { const bf16x8 bfr = *(const LAS bf16x8*)(Gs + (16 * n + l15) * 136 + 32 * ks + 8 * lq);
                acc[n] = __builtin_amdgcn_mfma_f32_16x16x32_bf16(af[ks], bfr, acc[n], 0, 0, 0); } }
#pragma unroll
        for (int n = 0; n < 4; ++n) { const int k1 = 16 * n + l15; u32x2 wre, wim; float ore[4], oim[4];
#pragma unroll
            for (int r = 0; r < 4; ++r) { const int s2 = 16 * F.wave + 4 * lq + r; const float rev = (float)(k1 * s2) * (1.0f / 8192.0f);
                const float cs = __builtin_amdgcn_cosf(rev), sn = __builtin_amdgcn_sinf(rev); const float re = acc[n][r], im = acc[n + 4][r];
                ore[r] = re * cs + im * sn; oim[r] = im * cs - re * sn; }
            wre.x = pk2(ore[0], ore[1]); wre.y = pk2(ore[2], ore[3]); wim.x = pk2(oim[0], oim[1]); wim.y = pk2(oim[2], oim[3]);
            bf16_t* o = AT + ((size_t)((b * 64 + k1) * 256 + ch)) * 256 + 16 * F.wave + 4 * lq;
            *(u32x2*)o = wre; *(u32x2*)(o + 128) = wim; }
    }
    __syncthreads();
}
__device__ __forceinline__ void fourier_stage2(const Frame& F, unsigned char* ws) {
    const bf16_t* AT = (const bf16_t*)(ws + WS_AT); bf16_t* mix = (bf16_t*)(ws + WS_MIX);
    LAS bf16_t* Hs = (LAS bf16_t*)F.lds;
    { const bf16_t* Hg = (const bf16_t*)(ws + WS_FG + FG_H_OFF);
      for (int i = F.tid; i < 128 * 32; i += NTHR) { const int r = i >> 5, c8 = i & 31; *(LAS u32x4*)(Hs + r * 264 + c8 * 8) = *(const u32x4*)(Hg + r * 256 + c8 * 8); } }
    __syncthreads();
    const int l15 = F.lane & 15, lq = F.lane >> 4;
    for (int u = F.bid; u < 256; u += F.G) {
        const int b = u >> 6, k1 = u & 63;
        f32x4 acc[2][8];
#pragma unroll
        for (int m = 0; m < 2; ++m)
#pragma unroll
            for (int n = 0; n < 8; ++n) acc[m][n] = (f32x4){0.f, 0.f, 0.f, 0.f};
        const bf16_t* ar = AT + ((size_t)u * 256 + 32 * F.wave + l15) * 256 + 8 * lq;
#pragma unroll
        for (int ks = 0; ks < 8; ++ks) { const bf16x8 a0 = *(const bf16x8*)(ar + 32 * ks), a1 = *(const bf16x8*)(ar + 16 * 256 + 32 * ks);
#pragma unroll
            for (int n = 0; n < 8; ++n) { const bf16x8 bfr = *(const LAS bf16x8*)(Hs + (16 * n + l15) * 264 + 32 * ks + 8 * lq);
                acc[0][n] = __builtin_amdgcn_mfma_f32_16x16x32_bf16(a0, bfr, acc[0][n], 0, 0, 0); acc[1][n] = __builtin_amdgcn_mfma_f32_16x16x32_bf16(a1, bfr, acc[1][n], 0, 0, 0); } }
#pragma unroll
        for (int m = 0; m < 2; ++m)
#pragma unroll
            for (int n = 0; n < 8; ++n) { const int k2 = 16 * n + l15, chn = 32 * F.wave + 16 * m + 4 * lq;
                u32x2 w; w.x = pk2(acc[m][n][0], acc[m][n][1]); w.y = pk2(acc[m][n][2], acc[m][n][3]);
                *(u32x2*)(mix + (size_t)(b * S + k1 + 64 * k2) * D + chn) = w; }
    }
    __syncthreads();
}

__device__ __forceinline__ int build_tiles(const Frame& F, unsigned* cnt, LAS int* tst, LAS unsigned char* tile_e) {
    if (F.tid == 0) { int acc = 0; for (int e = 0; e < NE; ++e) { tst[e] = acc; acc += ((int)__hip_atomic_load(cnt + e, __ATOMIC_RELAXED, __HIP_MEMORY_SCOPE_AGENT) + 255) >> 8; } tst[NE] = acc; }
    __syncthreads();
    const int ntot = tst[NE];
    for (int mt = F.tid; mt < ntot; mt += NTHR) { int e = 0; for (int q = 1; q < NE; ++q) if (mt >= tst[q]) e = q; tile_e[mt] = (unsigned char)e; }
    __syncthreads();
    return ntot;
}

__device__ __forceinline__ void phaseF(const Frame& F, const Args& a, int l) {
    unsigned char* ws = KA(ws);
    const float* pre = (const float*)(ws + WS_PRE); float* x1f = (float*)(ws + WS_X1F); bf16_t* x1b = (bf16_t*)(ws + WS_X1B);
    int* tke = (int*)(ws + WS_TKE); float* tkg = (float*)(ws + WS_TKG); int* tks = (int*)(ws + WS_TKS); int* list = (int*)(ws + WS_LIST);
    unsigned* cnt = F.ctl + CW_CNT + l * 64;
    LAS float* wrT = (LAS float*)F.lds;
    LAS int* lcnt = (LAS int*)(F.lds + MISC_OFF + 2048);
    LAS int* lbase = lcnt + 32;
    LAS int* le = lbase + 32;
    LAS int* ls = le + 512;
    const float* wr = KA(w_router) + (size_t)l * D * NE;
    for (int i = F.tid; i < D * NE; i += NTHR) { const int c = i >> 5, e = i & 31; wrT[e * D + c] = wr[i]; }
    if (F.tid < 32) lcnt[F.tid] = 0;
    __syncthreads();
    const float* g1 = KA(ln1_g) + (size_t)l * D; const float* b1 = KA(ln1_b) + (size_t)l * D; const float* br = KA(b_router) + (size_t)l * NE;
    for (int chunk = F.bid; chunk < T / 128; chunk += F.G) {
        for (int q = 0; q < 16; ++q) {
            const int tl = F.wave * 16 + q, t = chunk * 128 + tl;
            f32x4 v[4];
#pragma unroll
            for (int j = 0; j < 4; ++j) v[j] = *(const f32x4*)(pre + (size_t)t * D + 4 * F.lane + 256 * j);
            float s = 0.f;
#pragma unroll
            for (int j = 0; j < 4; ++j) s += (v[j].x + v[j].y) + (v[j].z + v[j].w);
            const float mean = wave_sum(s) * (1.f / D); float s2 = 0.f;
#pragma unroll
            for (int j = 0; j < 4; ++j) { v[j] = v[j] - mean; s2 += (v[j].x * v[j].x + v[j].y * v[j].y) + (v[j].z * v[j].z + v[j].w * v[j].w); }
            const float rstd = 1.f / sqrtf(wave_sum(s2) * (1.f / D) + LN_EPS);
#pragma unroll
            for (int j = 0; j < 4; ++j) { const f32x4 gg = *(const f32x4*)(g1 + 4 * F.lane + 256 * j), bb = *(const f32x4*)(b1 + 4 * F.lane + 256 * j);
                v[j] = v[j] * rstd * gg + bb;
                *(f32x4*)(x1f + (size_t)t * D + 4 * F.lane + 256 * j) = v[j];
                u32x2 w; w.x = pk2(v[j].x, v[j].y); w.y = pk2(v[j].z, v[j].w); *(u32x2*)(x1b + (size_t)t * D + 4 * F.lane + 256 * j) = w; }
            float mylogit = -INFINITY;
            for (int e = 0; e < NE; ++e) { float p = 0.f;
#pragma unroll
                for (int j = 0; j < 4; ++j) { const f32x4 w = *(const LAS f32x4*)(wrT + e * D + 4 * F.lane + 256 * j); p += (v[j].x * w.x + v[j].y * w.y) + (v[j].z * w.z + v[j].w * w.w); }
                p = wave_sum(p);
                if (F.lane == e) mylogit = p + br[e]; }
            float tv[4]; int ti[4];
#pragma unroll
            for (int k = 0; k < 4; ++k) { float bv = mylogit; int bi = F.lane;
#pragma unroll
                for (int o = 1; o < 64; o <<= 1) { const float ov = __shfl_xor(bv, o); const int oi = __shfl_xor(bi, o); if (ov > bv || (ov == bv && oi < bi)) { bv = ov; bi = oi; } }
                tv[k] = bv; ti[k] = bi; if (F.lane == bi) mylogit = -INFINITY; }
            const float w1 = __expf(tv[1] - tv[0]), w2 = __expf(tv[2] - tv[0]), w3 = __expf(tv[3] - tv[0]); const float inv = 1.0f / (1.0f + w1 + w2 + w3);
            if (F.lane < 4) { const int k = F.lane; const int e = k == 0 ? ti[0] : k == 1 ? ti[1] : k == 2 ? ti[2] : ti[3]; const float g = (k == 0 ? 1.0f : k == 1 ? w1 : k == 2 ? w2 : w3) * inv;
                tke[t * 4 + k] = e; tkg[t * 4 + k] = g;
                const int sl = __hip_atomic_fetch_add(lcnt + e, 1, __ATOMIC_RELAXED, __HIP_MEMORY_SCOPE_WORKGROUP);
                le[tl * 4 + k] = e; ls[tl * 4 + k] = sl; }
        }
        __syncthreads();
        if (F.tid < 32) lbase[F.tid] = (int)__hip_atomic_fetch_add(cnt + F.tid, (unsigned)lcnt[F.tid], __ATOMIC_RELAXED, __HIP_MEMORY_SCOPE_AGENT);
        __syncthreads();
        { const int tl = F.tid >> 2, k = F.tid & 3, t = chunk * 128 + tl, e = le[F.tid], slot = lbase[e] + ls[F.tid];
          list[(size_t)e * T + slot] = t; tks[t * 4 + k] = slot; }
        __syncthreads();
        if (F.tid < 32) lcnt[F.tid] = 0;
        __syncthreads();
    }
}

__device__ __forceinline__ void phaseG0(const Frame& F, const Args& a, int l) {
    unsigned char* ws = KA(ws);
    unsigned* cnt = F.ctl + CW_CNT + l * 64;
    LAS int* tst = (LAS int*)(F.lds + MISC_OFF + 256); LAS unsigned char* tile_e = (LAS unsigned char*)(F.lds + MISC_OFF + 512);
    const int ntot = build_tiles(F, cnt, tst, tile_e);
    const bf16_t* x1b = (const bf16_t*)(ws + WS_X1B); bf16_t* xs = (bf16_t*)(ws + WS_XS); const int* list = (const int*)(ws + WS_LIST);
    const int gw = F.bid * NWAVES + F.wave, NGW = F.G * NWAVES;
    for (int r = gw; r < ntot * 256; r += NGW) { const int mt = r >> 8, e = tile_e[mt], within = r - tst[e] * 256;
        const int c = (int)__hip_atomic_load(cnt + e, __ATOMIC_RELAXED, __HIP_MEMORY_SCOPE_AGENT);
        const int tok = within < c ? list[(size_t)e * T + within] : 0;
        const u32x4* src = (const u32x4*)(x1b + (size_t)tok * D); u32x4* dst = (u32x4*)(xs + (size_t)r * D);
        dst[F.lane] = src[F.lane]; dst[64 + F.lane] = src[64 + F.lane]; }
    __syncthreads();
}

__device__ __forceinline__ void phaseI(const Frame& F, const Args& a, int l) {
    unsigned char* ws = KA(ws);
    unsigned* cnt = F.ctl + CW_CNT + l * 64;
    LAS int* tst = (LAS int*)(F.lds + MISC_OFF + 256); LAS unsigned char* tile_e = (LAS unsigned char*)(F.lds + MISC_OFF + 512);
    (void)build_tiles(F, cnt, tst, tile_e);
    const float* x1f = (const float*)(ws + WS_X1F); const bf16_t* Y = (const bf16_t*)(ws + WS_Y);
    const int* tke = (const int*)(ws + WS_TKE); const float* tkg = (const float*)(ws + WS_TKG); const int* tks = (const int*)(ws + WS_TKS);
    float* xf = (float*)(ws + WS_XF); bf16_t* xb = (bf16_t*)(ws + WS_XB);
    const float* g2 = KA(ln2_g) + (size_t)l * D; const float* b2 = KA(ln2_b) + (size_t)l * D;
    const int gw = F.bid * NWAVES + F.wave, NGW = F.G * NWAVES; float* outp = KA(out);
    for (int t = gw; t < T; t += NGW) {
        f32x4 v[4];
#pragma unroll
        for (int j = 0; j < 4; ++j) v[j] = *(const f32x4*)(x1f + (size_t)t * D + 4 * F.lane + 256 * j) * DN_ALPHA;
#pragma unroll
        for (int k = 0; k < 4; ++k) { const int e = tke[t * 4 + k]; const float g = tkg[t * 4 + k]; const size_t row = (size_t)tst[e] * 256 + tks[t * 4 + k];
#pragma unroll
            for (int j = 0; j < 4; ++j) { const u32x2 w = *(const u32x2*)(Y + row * D + 4 * F.lane + 256 * j);
                v[j].x += g * __builtin_bit_cast(float, w.x << 16); v[j].y += g * __builtin_bit_cast(float, w.x & 0xffff0000u);
                v[j].z += g * __builtin_bit_cast(float, w.y << 16); v[j].w += g * __builtin_bit_cast(float, w.y & 0xffff0000u); } }
        ln_row(v, g2, b2, xf + (size_t)t * D, xb + (size_t)t * D, l == NL - 1 ? outp + (size_t)t * D : nullptr, F.lane);
    }
    __syncthreads();
}

template <int PHMASK_T> __global__ void __launch_bounds__(NTHR, 2) hybrid_fwd(Args a) {
    extern __shared__ __attribute__((aligned(16))) unsigned char lds_raw[];
    Frame F;
    F.lds = (LAS unsigned char*)lds_raw;
    F.tid = threadIdx.x; F.lane = F.tid & 63; F.wave = __builtin_amdgcn_readfirstlane(F.tid >> 6);
    F.G = gridDim.x; F.bid = blockIdx.x;
    F.ctl = (unsigned*)(KA(ws) + WS_CTL);
    unsigned char* ws = KA(ws);
    volatile LAS unsigned* MISC = (volatile LAS unsigned*)(F.lds + MISC_OFF);
    if (F.tid < 64) MISC[F.tid] = 0u;
    __syncthreads();
#if MK_MULTI
#define GRID_BAR() do { } while (0)
#else
    XcdBarrier bar = xcd_barrier_post(F.ctl + CW_BAR, MISC);
#define GRID_BAR() do { unsigned long long _bp = (unsigned long long)(uintptr_t)bar.bar; unsigned _bx = bar.x; unsigned _bs = (unsigned)(uintptr_t)bar.st; asm volatile("" : "+s"(_bp), "+s"(_bx), "+s"(_bs)); \
        XcdBarrier _b; _b.bar = (unsigned*)(uintptr_t)_bp; _b.x = _bx; _b.st = (volatile LAS unsigned*)(uintptr_t)_bs; xcd_barrier(_b); } while (0)
#endif
    const int lo = KA(ph_lo), hi = KA(ph_hi);
#define PH_ON(j) (((PHMASK_T) >> (j)) & 1)
#define IN(k) (lo <= (k) && (k) < hi)
#define SEAM(k) do { if (IN(k) && IN((k) + 1)) GRID_BAR(); } while (0)
    if (PH_ON(10) && IN(0)) { p0_prologue(F, a); }
    SEAM(0);
#define LAUNDER() do { unsigned _lp = (unsigned)(uintptr_t)F.lds; unsigned long long _cp = (unsigned long long)(uintptr_t)F.ctl; unsigned long long _wp = (unsigned long long)(uintptr_t)ws; \
        F.tid = threadIdx.x; asm volatile("" : "+v"(F.tid)); F.lane = F.tid & 63; F.wave = __builtin_amdgcn_readfirstlane(F.tid >> 6); F.bid = blockIdx.x; F.G = gridDim.x; \
        asm volatile("" : "+s"(F.bid), "+s"(F.G), "+s"(_lp), "+s"(_cp), "+s"(_wp)); \
        F.lds = (LAS unsigned char*)(uintptr_t)_lp; F.ctl = (unsigned*)(uintptr_t)_cp; ws = (unsigned char*)(uintptr_t)_wp; } while (0)
    for (int l = 0; l < NL; ++l) {
        const int pb = 1 + l * NPH_LAYER;
        LAUNDER();
        if (PH_ON(0) && IN(pb + 0)) {
            pg8::PlainOrder So; So.init(ws + WS_XB, (bf16_t*)(ws + WS_WIN) + (size_t)l * PWP * D, T, PWP, D, F.G, F.bid);
            pg8::EpiBf16Bias E{(bf16_t*)(ws + WS_P), PWP, (const float*)(ws + WS_BIN) + (size_t)l * PWP};
            pg8::gemm_phase<pg8::EpiBf16Bias, pg8::PlainOrder, true, true>(F.lds, D, So, E, F.tid);
            pg8::FourierOrder Sf{(const char*)(ws + WS_WF) + (size_t)l * 512 * D * 2, (const char*)(ws + WS_XB), D, F.G, F.bid};
            pg8::EpiFourierT Ef{(bf16_t*)(ws + WS_UT), (const float*)(ws + WS_FG + FG_BF_OFF) + l * 512};
            pg8::gemm_phase<pg8::EpiFourierT, pg8::FourierOrder, true, true>(F.lds, D, Sf, Ef, F.tid);
        }
        SEAM(pb + 0);
        LAUNDER();
        if (PH_ON(1) && IN(pb + 1)) {
            for (int u = F.bid; u < 2048; u += F.G) phaseB_unit(F, a, l, u);
            fourier_stage1(F, ws);
        }
        SEAM(pb + 1);
        LAUNDER();
        if (PH_ON(2) && IN(pb + 2)) { for (int u = F.bid; u < 256; u += F.G) phaseC_unit(F, a, u); fourier_stage2(F, ws); }
        SEAM(pb + 2);
        LAUNDER();
        if (PH_ON(3) && IN(pb + 3)) {
            for (int u = F.bid; u < 2048; u += F.G) phaseD_unit(F, a, l, u);
        }
        SEAM(pb + 3);
        LAUNDER();
        if (PH_ON(4) && IN(pb + 4)) {
            pg8::PlainOrder So; So.init(ws + WS_MIX, (bf16_t*)(ws + WS_WOUT) + (size_t)l * D * D, T, D, D, F.G, F.bid);
            pg8::EpiResF32 E{(float*)(ws + WS_PRE), (const float*)(ws + WS_XF), D, DN_ALPHA};
            pg8::gemm_phase<pg8::EpiResF32, pg8::PlainOrder, true, true>(F.lds, D, So, E, F.tid);
        }
        SEAM(pb + 4);
        LAUNDER();
        if (PH_ON(5) && IN(pb + 5)) phaseF(F, a, l);
        SEAM(pb + 5);
        LAUNDER();
        if (PH_ON(6) && IN(pb + 6)) phaseG0(F, a, l);
        SEAM(pb + 6);
        LAUNDER();
        if (PH_ON(7) && IN(pb + 7)) {
            LAS int* tst = (LAS int*)(F.lds + MISC_OFF + 256); LAS unsigned char* tile_e = (LAS unsigned char*)(F.lds + MISC_OFF + 512);
            const int ntot = build_tiles(F, F.ctl + CW_CNT + l * 64, tst, tile_e);
            pg8::GroupOrder So{(const char*)(ws + WS_XS), (const char*)(ws + WS_W1) + (size_t)l * NE * 2048 * D * 2, D, 8, ntot, F.G, F.bid, (size_t)2048 * D * 2, tile_e};
            pg8::EpiSwiglu E{(bf16_t*)(ws + WS_H), KA(b1) + (size_t)l * NE * 2048};
            pg8::gemm_phase<pg8::EpiSwiglu, pg8::GroupOrder, true, true>(F.lds, D, So, E, F.tid);
        }
        SEAM(pb + 7);
        LAUNDER();
        if (PH_ON(8) && IN(pb + 8)) {
            LAS int* tst = (LAS int*)(F.lds + MISC_OFF + 256); LAS unsigned char* tile_e = (LAS unsigned char*)(F.lds + MISC_OFF + 512);
            const int ntot = build_tiles(F, F.ctl + CW_CNT + l * 64, tst, tile_e);
            pg8::GroupOrder So{(const char*)(ws + WS_H), (const char*)(ws + WS_W2) + (size_t)l * NE * D * FF * 2, FF, 4, ntot, F.G, F.bid, (size_t)D * FF * 2, tile_e};
            pg8::EpiExpertOut E{(bf16_t*)(ws + WS_Y), KA(b2) + (size_t)l * NE * D};
            pg8::gemm_phase<pg8::EpiExpertOut, pg8::GroupOrder, true, true>(F.lds, FF, So, E, F.tid);
        }
        SEAM(pb + 8);
        LAUNDER();
        if (PH_ON(9) && IN(pb + 9)) phaseI(F, a, l);
        SEAM(pb + 9);
    }
#undef IN
#undef SEAM
}

template <int MASK> static void launch_one(int grid, hipStream_t stream, const Args& a) {
    static bool attr = false;
    if (!attr) { (void)hipFuncSetAttribute((const void*)hybrid_fwd<MASK>, hipFuncAttributeMaxDynamicSharedMemorySize, LDS_BYTES); attr = true; }
    hipLaunchKernelGGL(hybrid_fwd<MASK>, dim3(grid), dim3(NTHR), LDS_BYTES, stream, a);
}
extern "C" void kernel_launch(void* const* d_in, const int* in_sizes, int n_in, void* d_out, int out_size, void* d_ws, size_t ws_size, hipStream_t stream) {
    static int grid = 0;
    if (grid == 0) {
        if (n_in != 19 || out_size != T * D || ws_size < WS_END) { fprintf(stderr, "kernel_launch: unexpected shapes (n_in %d out %d ws %zu need %zu)\n", n_in, out_size, ws_size, (size_t)WS_END); grid = -1; return; }
        int dev = 0, cus = 0;
        if (hipGetDevice(&dev) != hipSuccess || hipDeviceGetAttribute(&cus, hipDeviceAttributeMultiprocessorCount, dev) != hipSuccess) { grid = -1; return; }
        grid = cus;
    }
    if (grid < 0) return;
    (void)hipMemsetAsync((char*)d_ws + WS_CTL, 0, CTL_BYTES, stream);
    Args a{};
    a.x = (const float*)d_in[0]; a.emb_g = (const float*)d_in[1]; a.emb_b = (const float*)d_in[2]; a.w_in = (const float*)d_in[3]; a.b_in = (const float*)d_in[4];
    a.conv_w = (const float*)d_in[5]; a.ml_nw = (const float*)d_in[6]; a.ret_nw = (const float*)d_in[7]; a.w_out = (const float*)d_in[8];
    a.ln1_g = (const float*)d_in[9]; a.ln1_b = (const float*)d_in[10]; a.w_router = (const float*)d_in[11]; a.b_router = (const float*)d_in[12];
    a.w1 = (const float*)d_in[13]; a.b1 = (const float*)d_in[14]; a.w2 = (const float*)d_in[15]; a.b2 = (const float*)d_in[16]; a.ln2_g = (const float*)d_in[17]; a.ln2_b = (const float*)d_in[18];
    a.out = (float*)d_out; a.ws = (unsigned char*)d_ws;
#if MK_MULTI
    a.ph_lo = 0; a.ph_hi = 1; launch_one<0x400>(grid, stream, a);
#define LAUNDER() do { unsigned _lp = (unsigned)(uintptr_t)F.lds; unsigned long long _cp = (unsigned long long)(uintptr_t)F.ctl; unsigned long long _wp = (unsigned long long)(uintptr_t)ws; \
        F.tid = threadIdx.x; asm volatile("" : "+v"(F.tid)); F.lane = F.tid & 63; F.wave = __builtin_amdgcn_readfirstlane(F.tid >> 6); F.bid = blockIdx.x; F.G = gridDim.x; \
        asm volatile("" : "+s"(F.bid), "+s"(F.G), "+s"(_lp), "+s"(_cp), "+s"(_wp)); \
        F.lds = (LAS unsigned char*)(uintptr_t)_lp; F.ctl = (unsigned*)(uintptr_t)_cp; ws = (unsigned char*)(uintptr_t)_wp; } while (0)
    for (int l = 0; l < NL; ++l) {
        const int pb = 1 + l * NPH_LAYER;
#define LP(j) a.ph_lo = pb + (j); a.ph_hi = pb + (j) + 1; launch_one<(1 << (j))>(grid, stream, a);
        LP(0) LP(1) LP(2) LP(3) LP(4) LP(5) LP(6) LP(7) LP(8) LP(9)
#undef LP
    }
#else
    a.ph_lo = 0; a.ph_hi = NPH; launch_one<0x7ff>(grid, stream, a);
#endif
}
```

```cpp
#include <hip/hip_runtime.h>
#include <cstdio>
#include <cstdint>

#ifndef MK_MULTI
#define MK_MULTI 0
#endif

#define LAS __attribute__((address_space(3)))
#define GAS __attribute__((address_space(1)))
typedef unsigned short bf16_t;
typedef short bf16x8 __attribute__((ext_vector_type(8)));
typedef float f32x4 __attribute__((ext_vector_type(4)));
typedef float f32x2 __attribute__((ext_vector_type(2)));
typedef unsigned u32x4 __attribute__((ext_vector_type(4)));
typedef unsigned u32x2 __attribute__((ext_vector_type(2)));

constexpr int D = 1024, NB = 4, S = 8192, T = NB * S, NL = 4;
constexpr int CH = 128, NCH = S / CH;
constexpr int PW = 2576, PWF = 256, PW2 = PW - PWF, PWP = 2560;
constexpr int COL_MQK = 0, COL_MV = 384, COL_MO = 768, COL_MG = 1152, COL_RQ = 1168, COL_RK = 1360, COL_RV = 1552, COL_RG = 1936;
constexpr int NH = 4, DK = 48, DV = 96;
constexpr int NE = 32, TOPK = 4, FF = 1024;
constexpr int ROWS_PAD = T * TOPK + NE * 256;
constexpr int MT_MAX = ROWS_PAD / 256;
constexpr float LN_EPS = 1e-5f;
constexpr float DN_ALPHA = 1.6817928305074290f;
constexpr float SW_ALPHA = 1.702f, SW_LIMIT = 7.0f;

constexpr size_t MiB = 1u << 20;
constexpr size_t WS_CTL = 0, CTL_BYTES = 1 * MiB;
constexpr size_t WS_WIN = 1 * MiB;
constexpr size_t WS_WOUT = WS_WIN + 22 * MiB;
constexpr size_t WS_W1 = WS_WOUT + 8 * MiB;
constexpr size_t WS_W2 = WS_W1 + 512 * MiB;
constexpr size_t WS_BIN = WS_W2 + 256 * MiB;
constexpr size_t WS_ROT = WS_BIN + 1 * MiB;
constexpr size_t WS_XF = WS_ROT + 2 * MiB;
constexpr size_t WS_XB = WS_XF + 128 * MiB;
constexpr size_t WS_P = WS_XB + 64 * MiB;
constexpr size_t WS_MIX = WS_P + 176 * MiB;
constexpr size_t WS_PRE = WS_MIX + 64 * MiB;
constexpr size_t WS_X1F = WS_PRE + 128 * MiB;
constexpr size_t WS_X1B = WS_X1F + 128 * MiB;
constexpr size_t WS_XS = WS_X1B + 64 * MiB;
constexpr size_t WS_H = WS_XS + 272 * MiB;
constexpr size_t WS_Y = WS_H + 272 * MiB;
constexpr size_t WS_TKE = WS_Y + 272 * MiB;
constexpr size_t WS_TKG = WS_TKE + 1 * MiB;
constexpr size_t WS_TKS = WS_TKG + 1 * MiB;
constexpr size_t WS_LIST = WS_TKS + 1 * MiB;
constexpr size_t WS_MC = WS_LIST + 4 * MiB;
constexpr size_t WS_RS = WS_MC + 36 * MiB;
constexpr size_t WS_MN = WS_RS + 36 * MiB;
constexpr size_t WS_MSC = WS_MN + 1 * MiB;
constexpr size_t WS_UT = WS_MSC + 1 * MiB;
constexpr size_t WS_AT = WS_UT + 32 * MiB;
constexpr size_t WS_WF = WS_AT + 32 * MiB;
constexpr size_t WS_FG = WS_WF + 4 * MiB;
constexpr size_t WS_END = WS_FG + 1 * MiB;
constexpr size_t FG_H_OFF = 32768, FG_BF_OFF = 131072, WRT_OFF = 262144;

constexpr int CW_TMO = 0;
constexpr int CW_BAR = 4096;
constexpr int CW_CNT = 16384;

constexpr int RING_BYTES = 131072;
constexpr int MISC_OFF = RING_BYTES;
constexpr int LDS_BYTES = 147456;

__device__ __forceinline__ unsigned f2bf(float f) { unsigned u = __builtin_bit_cast(unsigned, f); return (u + 0x7fffu + ((u >> 16) & 1u)) >> 16; }
__device__ __forceinline__ unsigned pk2(float lo, float hi) { return f2bf(lo) | (f2bf(hi) << 16); }
__device__ __forceinline__ float bf2f(bf16_t b) { return __builtin_bit_cast(float, (unsigned)b << 16); }
__device__ __forceinline__ float wave_sum(float v) {
#pragma unroll
    for (int o = 1; o < 64; o <<= 1) v += __shfl_xor(v, o);
    return v;
}
__device__ __forceinline__ float wave_max(float v) {
#pragma unroll
    for (int o = 1; o < 64; o <<= 1) v = fmaxf(v, __shfl_xor(v, o));
    return v;
}
__device__ __forceinline__ float sigmoidf_(float x) { return 1.0f / (1.0f + __expf(-x)); }
__device__ __forceinline__ float siluf_(float x) { return x / (1.0f + __expf(-x)); }
__device__ __forceinline__ float logsigmoidf_(float x) { return x >= 0.f ? -log1pf(__expf(-x)) : x - log1pf(__expf(x)); }

namespace pg8 {
constexpr int BM = 256, BK = 64, HALF = 128, HTB = HALF * BK * 2, STAGE_BYTES = 8 * HTB;
__host__ __device__ __forceinline__ int lds_byte(int r, int c) { const int st = (r >> 4) * 2 + (c >> 5), rr = r & 15, cc = c & 31, ob = rr * 64 + cc * 2; return st * 1024 + (ob ^ (((ob >> 9) & 1) << 5)); }
__host__ __device__ __forceinline__ void stage_rc(int b, int& R, int& C) { const int st = b / 1024, sb = b % 1024, swz = sb ^ (((sb >> 9) & 1) << 5); R = (st >> 1) * 16 + swz / 64; C = (st & 1) * 32 + (swz % 64) / 2; }
__host__ __device__ __forceinline__ int perm32(int rho) { const int n = rho >> 4, i = rho & 15; return 8 * (i >> 2) + 4 * n + (i & 3); }
struct Unit { int pm, pn, e; };
__device__ __forceinline__ unsigned cvt_pk_bf16(float lo, float hi) { unsigned r; asm volatile("v_cvt_pk_bf16_f32 %0, %1, %2" : "=v"(r) : "v"(lo), "v"(hi)); return r; }

template <class Epi, class Sched, bool ALIGN_EPI = false, bool SP2 = false>
__device__ __forceinline__ void gemm_phase(LAS unsigned char* lds, const int K, const Sched& S, const Epi& E, const int tid) {
    const int wid = __builtin_amdgcn_readfirstlane(tid >> 6), lane = tid & 63, wr = wid >> 2, wc = wid & 3, fr = lane & 15, fq = lane >> 4;
    const int nt = K / BK;
    unsigned voffA[2], voffB[2];
#pragma unroll
    for (int i = 0; i < 2; ++i) { int R, C; stage_rc(tid * 16 + i * 8192, R, C); const int Rb = Epi::PERM ? ((R & ~31) + perm32(R & 31)) : R;
        voffA[i] = S.a_off(R, C); voffB[i] = S.b_off(Rb, C); }
    const size_t kstep = (size_t)(BK * 2);
    const size_t hstepA = S.hstep_a(), hstepB = S.hstep_b();
    const unsigned ldsw = (unsigned)wid * 1024u;
    const int aoff = lds_byte(wr * 64 + fr, fq * 8), boff = lds_byte(wc * 32 + fr, fq * 8);
#define PG8_SA(b, h) (((b) * 2 + (h)) * HTB)
#define PG8_SB(b, h) ((4 + (b) * 2 + (h)) * HTB)
#define PG8_STAGE(bufoff, gbase, voff) do { _Pragma("unroll") for (int _i = 0; _i < 2; ++_i) \
        __builtin_amdgcn_global_load_lds((const unsigned*)((const char*)(gbase) + (voff)[_i]), (LAS unsigned*)(lds + (bufoff) + ldsw + _i * 8192), 16, 0, 0); } while (0)
#define PG8_LDA(dst, b, h) do { _Pragma("unroll") for (int m = 0; m < 4; ++m) _Pragma("unroll") for (int k = 0; k < 2; ++k) dst[m][k] = *(const LAS bf16x8*)(lds + PG8_SA(b, h) + aoff + m * 2048 + k * 1024); } while (0)
#define PG8_LDB(dst, b, h) do { _Pragma("unroll") for (int n = 0; n < 2; ++n) _Pragma("unroll") for (int k = 0; k < 2; ++k) dst[n][k] = *(const LAS bf16x8*)(lds + PG8_SB(b, h) + boff + n * 2048 + k * 1024); } while (0)
#define PG8_MMA(ai, bj, At, Bt) do { __builtin_amdgcn_s_setprio(1); _Pragma("unroll") for (int m = 0; m < 4; ++m) _Pragma("unroll") for (int n = 0; n < 2; ++n) _Pragma("unroll") for (int k = 0; k < 2; ++k) \
        acc[ai][bj][m][n] = __builtin_amdgcn_mfma_f32_16x16x32_bf16(Bt[n][k], At[m][k], acc[ai][bj][m][n], 0, 0, 0); __builtin_amdgcn_s_setprio(0); } while (0)
#define PG8_WAIT_V(n) asm volatile("s_waitcnt vmcnt(" #n ")" ::: "memory")
#define PG8_WAIT_L(n) asm volatile("s_waitcnt lgkmcnt(" #n ")" ::: "memory")
#define PG8_BAR __builtin_amdgcn_s_barrier()
#define PG8_SCHED __builtin_amdgcn_sched_barrier(0)
    Unit cur, nxt; int ui = 0;
    if (!S.next(0, cur)) return;
    f32x4 acc[2][2][4][2];
#pragma unroll
    for (int a = 0; a < 2; ++a)
#pragma unroll
        for (int b = 0; b < 2; ++b)
#pragma unroll
            for (int m = 0; m < 4; ++m)
#pragma unroll
                for (int n = 0; n < 2; ++n) acc[a][b][m][n] = (f32x4){0.f, 0.f, 0.f, 0.f};
    bf16x8 At[4][2], B0[2][2], B1[2][2];
    const char* cA = S.a_base(cur); const char* cB = S.b_base(cur);
    if constexpr (SP2) {
        PG8_STAGE(PG8_SB(0, 0), cB, voffB); PG8_STAGE(PG8_SB(0, 1), cB + hstepB, voffB); PG8_STAGE(PG8_SA(0, 0), cA, voffA); PG8_STAGE(PG8_SA(0, 1), cA + hstepA, voffA);
        if (wr == 1) PG8_BAR;
        PG8_WAIT_V(2); PG8_BAR;
        PG8_STAGE(PG8_SB(1, 0), cB + kstep, voffB); PG8_STAGE(PG8_SA(1, 0), cA + kstep, voffA); PG8_STAGE(PG8_SB(1, 1), cB + hstepB + kstep, voffB);
        PG8_WAIT_V(6); PG8_BAR;
    } else {
        PG8_STAGE(PG8_SB(0, 0), cB, voffB); PG8_STAGE(PG8_SA(0, 0), cA, voffA); PG8_STAGE(PG8_SB(0, 1), cB + hstepB, voffB); PG8_STAGE(PG8_SA(0, 1), cA + hstepA, voffA);
        if (wr == 1) PG8_BAR;
        PG8_WAIT_V(4); PG8_BAR;
        PG8_STAGE(PG8_SB(1, 0), cB + kstep, voffB); PG8_STAGE(PG8_SA(1, 0), cA + kstep, voffA); PG8_STAGE(PG8_SB(1, 1), cB + hstepB + kstep, voffB);
        PG8_WAIT_V(6); PG8_BAR;
    }
    for (;;) {
        const bool has_next = S.next(ui + 1, nxt);
        const char* nA = has_next ? S.a_base(nxt) : cA; const char* nB = has_next ? S.b_base(nxt) : cB;
        for (int t = 0; t < nt; t += 2) {
            const bool last = (t == nt - 2);
            const char* a1 = cA + (size_t)(t + 1) * kstep;
            const char* a2 = last ? nA : cA + (size_t)(t + 2) * kstep; const char* b2 = last ? nB : cB + (size_t)(t + 2) * kstep;
            const char* a3 = a2 + kstep; const char* b3 = b2 + kstep;
            if constexpr (SP2) {
            PG8_LDB(B0, 0, 0); PG8_LDB(B1, 0, 1); PG8_SCHED; PG8_LDA(At, 0, 0); PG8_STAGE(PG8_SA(1, 1), a1 + hstepA, voffA);
            PG8_WAIT_V(8); PG8_WAIT_L(0); PG8_BAR; PG8_MMA(0, 0, At, B0); PG8_MMA(0, 1, At, B1); PG8_BAR; PG8_SCHED;
            PG8_LDA(At, 0, 1); PG8_STAGE(PG8_SB(0, 0), b2, voffB); PG8_STAGE(PG8_SB(0, 1), b2 + hstepB, voffB); PG8_STAGE(PG8_SA(0, 0), a2, voffA);
            PG8_WAIT_V(8); PG8_WAIT_L(0); PG8_BAR; PG8_MMA(1, 0, At, B0); PG8_MMA(1, 1, At, B1); PG8_BAR; PG8_SCHED;
            PG8_LDB(B0, 1, 0); PG8_LDB(B1, 1, 1); PG8_SCHED; PG8_LDA(At, 1, 0); PG8_STAGE(PG8_SA(0, 1), a2 + hstepA, voffA);
            PG8_WAIT_V(8); PG8_WAIT_L(0); PG8_BAR; PG8_MMA(0, 0, At, B0); PG8_MMA(0, 1, At, B1); PG8_BAR; PG8_SCHED;
            PG8_LDA(At, 1, 1); PG8_STAGE(PG8_SB(1, 0), b3, voffB); PG8_STAGE(PG8_SB(1, 1), b3 + hstepB, voffB); PG8_STAGE(PG8_SA(1, 0), a3, voffA);
            PG8_WAIT_V(8); PG8_WAIT_L(0); PG8_BAR; PG8_MMA(1, 0, At, B0); PG8_MMA(1, 1, At, B1); PG8_BAR; PG8_SCHED;
            } else {
            PG8_LDB(B0, 0, 0); PG8_SCHED; PG8_LDA(At, 0, 0); PG8_STAGE(PG8_SA(1, 1), a1 + hstepA, voffA);
            PG8_WAIT_L(8); PG8_BAR; PG8_WAIT_L(0); PG8_MMA(0, 0, At, B0); PG8_BAR; PG8_SCHED;
            PG8_LDB(B1, 0, 1); PG8_STAGE(PG8_SB(0, 0), b2, voffB);
            PG8_BAR; PG8_WAIT_L(0); PG8_MMA(0, 1, At, B1); PG8_BAR;
            PG8_LDA(At, 0, 1); PG8_STAGE(PG8_SA(0, 0), a2, voffA);
            PG8_BAR; PG8_WAIT_L(0); PG8_MMA(1, 0, At, B0); PG8_BAR; PG8_SCHED;
            PG8_STAGE(PG8_SB(0, 1), b2 + hstepB, voffB);
            PG8_WAIT_V(6); PG8_BAR; PG8_MMA(1, 1, At, B1); PG8_BAR;
            PG8_LDB(B0, 1, 0); PG8_SCHED; PG8_LDA(At, 1, 0); PG8_STAGE(PG8_SA(0, 1), a2 + hstepA, voffA);
            PG8_WAIT_L(8); PG8_BAR; PG8_WAIT_L(0); PG8_MMA(0, 0, At, B0); PG8_BAR; PG8_SCHED;
            PG8_LDB(B1, 1, 1); PG8_STAGE(PG8_SB(1, 0), b3, voffB);
            PG8_BAR; PG8_WAIT_L(0); PG8_MMA(0, 1, At, B1); PG8_BAR;
            PG8_LDA(At, 1, 1); PG8_STAGE(PG8_SA(1, 0), a3, voffA);
            PG8_BAR; PG8_WAIT_L(0); PG8_MMA(1, 0, At, B0); PG8_BAR; PG8_SCHED;
            PG8_STAGE(PG8_SB(1, 1), b3 + hstepB, voffB);
            PG8_WAIT_V(6); PG8_BAR; PG8_MMA(1, 1, At, B1); PG8_BAR;
            }
        }
        if constexpr (ALIGN_EPI) { if (wr == 0) PG8_BAR; }
        E(acc, cur, wr, wc, fr, fq);
        if (!has_next) break;
#pragma unroll
        for (int a = 0; a < 2; ++a)
#pragma unroll
            for (int b = 0; b < 2; ++b)
#pragma unroll
                for (int m = 0; m < 4; ++m)
#pragma unroll
                    for (int n = 0; n < 2; ++n) acc[a][b][m][n] = (f32x4){0.f, 0.f, 0.f, 0.f};
        cur = nxt; cA = nA; cB = nB; ++ui;
        if constexpr (ALIGN_EPI) { if (wr == 1) PG8_BAR; }
    }
    PG8_WAIT_V(0);
    if constexpr (!ALIGN_EPI) { if (wr == 0) PG8_BAR; }
    PG8_BAR;
#undef PG8_SA
#undef PG8_SB
#undef PG8_STAGE
#undef PG8_LDA
#undef PG8_LDB
#undef PG8_MMA
#undef PG8_WAIT_V
#undef PG8_WAIT_L
#undef PG8_BAR
#undef PG8_SCHED
}

struct PlainOrder {
    const char* A; const char* Bt; int K; int nM, nN, nwg, G, c;
    __device__ __forceinline__ void init(const void* A_, const void* Bt_, int M, int N, int K_, int G_, int c_) { A = (const char*)A_; Bt = (const char*)Bt_; K = K_; nM = M / BM; nN = N / BM; nwg = nM * nN; G = G_; c = c_; }
    __device__ __forceinline__ bool next(int i, Unit& u) const {
        const long Lq = (long)i * G + c; if (Lq >= nwg) return false;
        int wgid = (int)Lq; { const int q = nwg / 8, r = nwg % 8, xcd = wgid % 8, off = wgid / 8; wgid = (xcd < r ? xcd * (q + 1) : r * (q + 1) + (xcd - r) * q) + off; }
        const int nig = 8 * nN, gid = wgid / nig, fm = gid * 8, gsz = (nM - fm) < 8 ? (nM - fm) : 8;
        u.pm = fm + ((wgid % nig) % gsz); u.pn = (wgid % nig) / gsz; u.e = 0; return true;
    }
    __device__ __forceinline__ const char* a_base(const Unit& u) const { return A + (size_t)u.pm * 256 * K * 2; }
    __device__ __forceinline__ const char* b_base(const Unit& u) const { return Bt + (size_t)u.pn * 256 * K * 2; }
    __device__ __forceinline__ unsigned a_off(int R, int C) const { return (unsigned)(R * K + C) * 2u; }
    __device__ __forceinline__ unsigned b_off(int R, int C) const { return (unsigned)(R * K + C) * 2u; }
    __device__ __forceinline__ size_t hstep_a() const { return (size_t)HALF * K * 2; }
    __device__ __forceinline__ size_t hstep_b() const { return (size_t)HALF * K * 2; }
};
struct FourierOrder {
    const char* A; const char* X; int K, G, c;
    __device__ __forceinline__ bool next(int i, Unit& u) const { const int Lq = i * G + c; if (Lq >= 256) return false; u.pm = Lq & 1; u.pn = Lq >> 1; u.e = 0; return true; }
    __device__ __forceinline__ const char* a_base(const Unit& u) const { return A + (size_t)u.pm * 256 * K * 2; }
    __device__ __forceinline__ const char* b_base(const Unit& u) const { return X + (size_t)((u.pn >> 5) * 8192 + (u.pn & 31) * 4) * K * 2; }
    __device__ __forceinline__ unsigned a_off(int R, int C) const { return (unsigned)(R * K + C) * 2u; }
    __device__ __forceinline__ unsigned b_off(int R, int C) const { return (unsigned)((((R & 63) * 128 + (R >> 6)) * K + C) * 2); }
    __device__ __forceinline__ size_t hstep_a() const { return (size_t)HALF * K * 2; }
    __device__ __forceinline__ size_t hstep_b() const { return (size_t)2 * K * 2; }
};
struct GroupOrder {
    const char* A; const char* Bt; int K; int nN, ntot, G, c; size_t bstride; const LAS unsigned char* tile_e;
    __device__ __forceinline__ bool next(int i, Unit& u) const {
        const long Lq = (long)i * G + c; if (Lq >= (long)ntot * nN) return false;
        u.pm = (int)(Lq / nN); u.pn = (int)(Lq % nN); u.e = __builtin_amdgcn_readfirstlane((int)tile_e[u.pm]); return true;
    }
    __device__ __forceinline__ const char* a_base(const Unit& u) const { return A + (size_t)u.pm * 256 * K * 2; }
    __device__ __forceinline__ const char* b_base(const Unit& u) const { return Bt + (size_t)u.e * bstride + (size_t)u.pn * 256 * K * 2; }
    __device__ __forceinline__ unsigned a_off(int R, int C) const { return (unsigned)(R * K + C) * 2u; }
    __device__ __forceinline__ unsigned b_off(int R, int C) const { return (unsigned)(R * K + C) * 2u; }
    __device__ __forceinline__ size_t hstep_a() const { return (size_t)HALF * K * 2; }
    __device__ __forceinline__ size_t hstep_b() const { return (size_t)HALF * K * 2; }
};

struct EpiBf16Bias {
    static constexpr bool PERM = true;
    bf16_t* O; int ldc; const float* bias;
    __device__ __forceinline__ void operator()(const f32x4 (&acc)[2][2][4][2], const Unit& u, int wr, int wc, int fr, int fq) const {
        const int row0 = u.pm * BM + wr * 64 + fr, col0 = u.pn * BM + wc * 32 + 8 * fq;
        f32x4 bv[2][2];
#pragma unroll
        for (int bj = 0; bj < 2; ++bj)
#pragma unroll
            for (int n = 0; n < 2; ++n) bv[bj][n] = *(const f32x4*)(bias + col0 + bj * HALF + 4 * n);
#pragma unroll
        for (int ai = 0; ai < 2; ++ai)
#pragma unroll
            for (int m = 0; m < 4; ++m) { bf16_t* rowp = O + (size_t)(row0 + ai * HALF + m * 16) * ldc + col0;
#pragma unroll
                for (int bj = 0; bj < 2; ++bj) { const f32x4 v0 = acc[ai][bj][m][0] + bv[bj][0], v1 = acc[ai][bj][m][1] + bv[bj][1];
                    u32x4 w; w.x = cvt_pk_bf16(v0[0], v0[1]); w.y = cvt_pk_bf16(v0[2], v0[3]); w.z = cvt_pk_bf16(v1[0], v1[1]); w.w = cvt_pk_bf16(v1[2], v1[3]);
                    *(u32x4*)(rowp + bj * HALF) = w; } }
    }
};
struct EpiFourierT {
    static constexpr bool PERM = true;
    bf16_t* UT; const float* bF;
    __device__ __forceinline__ void operator()(const f32x4 (&acc)[2][2][4][2], const Unit& u, int wr, int wc, int fr, int fq) const {
        const int b = u.pn >> 5, q = u.pn & 31, cs = u.pm;
#pragma unroll
        for (int ai = 0; ai < 2; ++ai)
#pragma unroll
            for (int m = 0; m < 4; ++m) { const int ch = ai * HALF + wr * 64 + m * 16 + fr; const float bv = bF[cs * 256 + ch];
#pragma unroll
                for (int bj = 0; bj < 2; ++bj) { const int s2 = 4 * q + 2 * bj + (wc >> 1), s1 = 32 * (wc & 1) + 8 * fq;
                    const f32x4 v0 = acc[ai][bj][m][0] + bv, v1 = acc[ai][bj][m][1] + bv;
                    u32x4 w; w.x = cvt_pk_bf16(v0[0], v0[1]); w.y = cvt_pk_bf16(v0[2], v0[3]); w.z = cvt_pk_bf16(v1[0], v1[1]); w.w = cvt_pk_bf16(v1[2], v1[3]);
                    *(u32x4*)(UT + ((size_t)((b * 256 + ch) * 128 + s2) * 2 + cs) * 64 + s1) = w; } }
    }
};
struct EpiResF32 {
    static constexpr bool PERM = false;
    float* C; const float* R; int ldc; float alpha;
    __device__ __forceinline__ void operator()(const f32x4 (&acc)[2][2][4][2], const Unit& u, int wr, int wc, int fr, int fq) const {
        const int row0 = u.pm * BM + wr * 64 + fr, col0 = u.pn * BM + wc * 32 + 4 * fq;
#pragma unroll
        for (int ai = 0; ai < 2; ++ai)
#pragma unroll
            for (int m = 0; m < 4; ++m) { const size_t off = (size_t)(row0 + ai * HALF + m * 16) * ldc + col0;
#pragma unroll
                for (int bj = 0; bj < 2; ++bj)
#pragma unroll
                    for (int n = 0; n < 2; ++n) { const f32x4 r = *(const f32x4*)(R + off + bj * HALF + n * 16); *(f32x4*)(C + off + bj * HALF + n * 16) = acc[ai][bj][m][n] + r * alpha; } }
    }
};
struct EpiSwiglu {
    static constexpr bool PERM = true;
    bf16_t* H; const float* b1;
    __device__ __forceinline__ void operator()(const f32x4 (&acc)[2][2][4][2], const Unit& u, int wr, int wc, int fr, int fq) const {
        const int row0 = u.pm * BM + wr * 64 + fr, col0 = u.pn * HALF + wc * 32 + 8 * fq;
        const float* bg = b1 + (size_t)u.e * 2048 + col0; const float* bu = bg + 1024;
        f32x4 g0 = *(const f32x4*)(bg), g1 = *(const f32x4*)(bg + 4), u0 = *(const f32x4*)(bu), u1 = *(const f32x4*)(bu + 4);
#pragma unroll
        for (int ai = 0; ai < 2; ++ai)
#pragma unroll
            for (int m = 0; m < 4; ++m) { bf16_t* rowp = H + (size_t)(row0 + ai * HALF + m * 16) * FF + col0;
                float o[8];
#pragma unroll
                for (int n = 0; n < 2; ++n)
#pragma unroll
                    for (int j = 0; j < 4; ++j) { float g = acc[ai][0][m][n][j] + (n ? g1[j] : g0[j]); float up = acc[ai][1][m][n][j] + (n ? u1[j] : u0[j]);
                        g = fminf(g, SW_LIMIT); up = fminf(fmaxf(up, -SW_LIMIT), SW_LIMIT);
                        const float glu = g / (1.0f + __expf(-SW_ALPHA * g)); o[n * 4 + j] = (up + 1.0f) * glu; }
                u32x4 w; w.x = cvt_pk_bf16(o[0], o[1]); w.y = cvt_pk_bf16(o[2], o[3]); w.z = cvt_pk_bf16(o[4], o[5]); w.w = cvt_pk_bf16(o[6], o[7]);
                *(u32x4*)rowp = w; }
    }
};
struct EpiExpertOut {
    static constexpr bool PERM = true;
    bf16_t* Y; const float* b2;
    __device__ __forceinline__ void operator()(const f32x4 (&acc)[2][2][4][2], const Unit& u, int wr, int wc, int fr, int fq) const {
        const int row0 = u.pm * BM + wr * 64 + fr, col0 = u.pn * BM + wc * 32 + 8 * fq;
        const float* bb = b2 + (size_t)u.e * D + col0;
        f32x4 bv[2][2];
#pragma unroll
        for (int bj = 0; bj < 2; ++bj)
#pragma unroll
            for (int n = 0; n < 2; ++n) bv[bj][n] = *(const f32x4*)(bb + bj * HALF + 4 * n);
#pragma unroll
        for (int ai = 0; ai < 2; ++ai)
#pragma unroll
            for (int m = 0; m < 4; ++m) { bf16_t* rowp = Y + (size_t)(row0 + ai * HALF + m * 16) * D + col0;
#pragma unroll
                for (int bj = 0; bj < 2; ++bj) { const f32x4 v0 = acc[ai][bj][m][0] + bv[bj][0], v1 = acc[ai][bj][m][1] + bv[bj][1];
                    u32x4 w; w.x = cvt_pk_bf16(v0[0], v0[1]); w.y = cvt_pk_bf16(v0[2], v0[3]); w.z = cvt_pk_bf16(v1[0], v1[1]); w.w = cvt_pk_bf16(v1[2], v1[3]);
                    *(u32x4*)(rowp + bj * HALF) = w; } }
    }
};
}

#define XB_TMO      128
#define XB_XCNT(j)  (256  + 64 * (j))
#define XB_XSUB(j)  (1280 + 64 * (j))
#define XB_XGEN(j)  (2304 + 64 * (j))
#define XB_TOP      3328
#define XB_TOPGEN   3392
#define XCD_BAR_WORDS 3456
#define XB_SPIN_CAP (1u << 22)
__device__ __forceinline__ unsigned xb_ld(unsigned* p)              { return __hip_atomic_load(p, __ATOMIC_RELAXED, __HIP_MEMORY_SCOPE_AGENT); }
__device__ __forceinline__ unsigned xb_add(unsigned* p, unsigned v) { return __hip_atomic_fetch_add(p, v, __ATOMIC_RELAXED, __HIP_MEMORY_SCOPE_AGENT); }
__device__ __forceinline__ unsigned xb_xcc_id() { return (unsigned)__builtin_amdgcn_s_getreg((3 << 11) | 20) & 0xFu; }
#define XB_SPIN(cond, bar) do { unsigned _sp = 0; while (cond) { __builtin_amdgcn_s_sleep(1); \
    if ((++_sp & 255u) == 0u) { if (xb_ld(&(bar)[XB_TMO])) break; if (_sp > XB_SPIN_CAP) { atomicAdd(&(bar)[XB_TMO], 1u); break; } } } } while (0)
struct XcdBarrier { unsigned* bar; unsigned x; volatile LAS unsigned* st; };
__device__ __forceinline__ XcdBarrier xcd_barrier_post(unsigned* bar, volatile LAS unsigned* st) {
    XcdBarrier b; b.bar = bar; b.x = xb_xcc_id(); b.st = st;
    if (threadIdx.x == 0) (void)xb_add(&bar[XB_XCNT(b.x)], 1u);
    return b;
}
__device__ __forceinline__ void xcd_barrier_complete(unsigned* bar, unsigned x, unsigned& nloc, unsigned& nx) {
    const unsigned G = gridDim.x * gridDim.y * gridDim.z;
    unsigned sum, cnt, mine, sp = 0u;
    for (;;) {
        sum = 0u; cnt = 0u; mine = 0u;
#pragma unroll
        for (unsigned j = 0; j < 16; ++j) { const unsigned c = xb_ld(&bar[XB_XCNT(j)]); sum += c; cnt += (c > 0u) ? 1u : 0u; mine = (j == x) ? c : mine; }
        if (sum == G) break;
        __builtin_amdgcn_s_sleep(1);
        if ((++sp & 255u) == 0u) { if (xb_ld(&bar[XB_TMO])) break; if (sp > XB_SPIN_CAP) { atomicAdd(&bar[XB_TMO], 1u); break; } }
    }
    nloc = mine > 0u ? mine : 1u; nx = cnt > 0u ? cnt : 1u;
}
__device__ __forceinline__ void xcd_barrier(const XcdBarrier& b) {
    asm volatile("s_waitcnt vmcnt(0)" ::: "memory");
    __syncthreads();
    if (threadIdx.x == 0) {
        unsigned* bar = b.bar;
        __builtin_amdgcn_s_waitcnt(0);
        unsigned nloc = b.st[0], nx = b.st[1];
        if (nloc == 0u) { xcd_barrier_complete(bar, b.x, nloc, nx); b.st[0] = nloc; b.st[1] = nx; }
        const unsigned old = xb_add(&bar[XB_XSUB(b.x)], 1u);
        const unsigned gen = old / nloc;
        if (old + 1u == (gen + 1u) * nloc) {
            __builtin_amdgcn_fence(__ATOMIC_RELEASE, "agent");
            asm volatile("s_waitcnt vmcnt(0)" ::: "memory");
            const unsigned og = xb_add(&bar[XB_TOP], 1u);
            const unsigned tg = og / nx;
            if (og + 1u == (tg + 1u) * nx) xb_add(&bar[XB_TOPGEN], 1u);
            else XB_SPIN(xb_ld(&bar[XB_TOPGEN]) == tg, bar);
            __builtin_amdgcn_fence(__ATOMIC_ACQUIRE, "agent");
            xb_add(&bar[XB_XGEN(b.x)], 1u);
            asm volatile("s_waitcnt vmcnt(0)" ::: "memory");
        } else {
            XB_SPIN(xb_ld(&bar[XB_XGEN(b.x)]) == gen, bar);
            __builtin_amdgcn_fence(__ATOMIC_ACQUIRE, "agent");
            asm volatile("s_waitcnt vmcnt(0)" ::: "memory");
        }
    }
    __syncthreads();
}

struct Args {
    const float* x; const float* emb_g; const float* emb_b; const float* w_in; const float* b_in; const float* conv_w; const float* ml_nw; const float* ret_nw;
    const float* w_out; const float* ln1_g; const float* ln1_b; const float* w_router; const float* b_router; const float* w1; const float* b1; const float* w2; const float* b2;
    const float* ln2_g; const float* ln2_b;
    float* out; unsigned char* ws; int ph_lo, ph_hi;
};
#define KA(f) (((const volatile __attribute__((address_space(4))) Args*)__builtin_amdgcn_kernarg_segment_ptr())->f)
constexpr int NWAVES = 8, NTHR = 512;
constexpr int NPH_LAYER = 10;
constexpr int NPH = 1 + NL * NPH_LAYER;

struct Frame {
    LAS unsigned char* lds;
    unsigned* ctl;
    int tid, lane, wave, G, bid;
};

__device__ __forceinline__ int sidx(int b, int h, int dir, int c) { return ((b * NH + h) * 2 + dir) * NCH + c; }

template <class RowMap>
__device__ __forceinline__ void transpose_item(const float* W, int K, int Nsrc, bf16_t* WT, LAS float* scr, int kb, int nb, int lane, const RowMap& rm, int coff = 0) {
    const int k0 = 64 * kb, n0 = 32 * nb;
    const int nn = n0 + (lane & 31) + coff;
#pragma unroll 8
    for (int i = 0; i < 32; ++i) { const int kk = 2 * i + (lane >> 5); scr[kk * 33 + (lane & 31)] = nn < Nsrc ? W[(size_t)(k0 + kk) * Nsrc + nn] : 0.f; }
    asm volatile("s_waitcnt lgkmcnt(0)" ::: "memory");
    const int c = lane & 7;
#pragma unroll
    for (int j = 0; j < 4; ++j) { const int n = (lane >> 3) + 8 * j; const LAS float* s = scr + (8 * c) * 33 + n;
        u32x4 o; o.x = pk2(s[0 * 33], s[1 * 33]); o.y = pk2(s[2 * 33], s[3 * 33]); o.z = pk2(s[4 * 33], s[5 * 33]); o.w = pk2(s[6 * 33], s[7 * 33]);
        *(u32x4*)(WT + (size_t)rm(n0 + n) * K + k0 + 8 * c) = o; }
    asm volatile("s_waitcnt lgkmcnt(0)" ::: "memory");
}
struct RowId { __device__ __forceinline__ int operator()(int n) const { return n; } };
struct RowW1 { __device__ __forceinline__ int operator()(int n) const { const int up = n >> 10, j = n & 1023; return (j >> 7) * 256 + up * 128 + (j & 127); } };

__device__ __forceinline__ void ln_row(const f32x4 (&vin)[4], const float* g, const float* b, float* of, bf16_t* ob, float* of2, int lane) {
    f32x4 v[4]; float s = 0.f;
#pragma unroll
    for (int j = 0; j < 4; ++j) { v[j] = vin[j]; s += (v[j].x + v[j].y) + (v[j].z + v[j].w); }
    const float mean = wave_sum(s) * (1.f / D); float s2 = 0.f;
#pragma unroll
    for (int j = 0; j < 4; ++j) { v[j] = v[j] - mean; s2 += (v[j].x * v[j].x + v[j].y * v[j].y) + (v[j].z * v[j].z + v[j].w * v[j].w); }
    const float rstd = 1.f / sqrtf(wave_sum(s2) * (1.f / D) + LN_EPS);
#pragma unroll
    for (int j = 0; j < 4; ++j) { const f32x4 gg = *(const f32x4*)(g + 4 * lane + 256 * j), bb = *(const f32x4*)(b + 4 * lane + 256 * j);
        const f32x4 o = v[j] * rstd * gg + bb;
        if (of) *(f32x4*)(of + 4 * lane + 256 * j) = o;
        if (of2) *(f32x4*)(of2 + 4 * lane + 256 * j) = o;
        if (ob) { u32x2 w; w.x = pk2(o.x, o.y); w.y = pk2(o.z, o.w); *(u32x2*)(ob + 4 * lane + 256 * j) = w; } }
}

__device__ __forceinline__ void p0_prologue(const Frame& F, const Args& a) {
    unsigned char* ws = KA(ws);
    LAS float* scr = (LAS float*)(F.lds + F.wave * 16384);
    const int gw = F.bid * NWAVES + F.wave, NGW = F.G * NWAVES;
    const float* w_in_ = KA(w_in); const float* w_out_ = KA(w_out); const float* w1_ = KA(w1); const float* w2_ = KA(w2);
    constexpr int I_IN = NL * 16 * 80, I_OUT = NL * 16 * 32, I_W1 = NL * NE * 16 * 64, I_W2 = NL * NE * 16 * 32;
    for (int it = gw; it < I_IN + I_OUT + I_W1 + I_W2; it += NGW) {
        int r = it;
        if (r < I_IN) { const int l = r / (16 * 80), q = r % (16 * 80); transpose_item(w_in_ + (size_t)l * D * PW, D, PW, (bf16_t*)(ws + WS_WIN) + (size_t)l * PWP * D, scr, q / 80, q % 80, F.lane, RowId(), PWF); continue; } r -= I_IN;
        if (r < I_OUT) { const int l = r / (16 * 32), q = r % (16 * 32); transpose_item(w_out_ + (size_t)l * D * D, D, D, (bf16_t*)(ws + WS_WOUT) + (size_t)l * D * D, scr, q / 32, q % 32, F.lane, RowId()); continue; } r -= I_OUT;
        if (r < I_W1) { const int le = r / (16 * 64), q = r % (16 * 64); transpose_item(w1_ + (size_t)le * D * 2048, D, 2048, (bf16_t*)(ws + WS_W1) + (size_t)le * 2048 * D, scr, q / 64, q % 64, F.lane, RowW1()); continue; } r -= I_W1;
        { const int le = r / (16 * 32), q = r % (16 * 32); transpose_item(w2_ + (size_t)le * FF * D, FF, D, (bf16_t*)(ws + WS_W2) + (size_t)le * D * FF, scr, q / 32, q % 32, F.lane, RowId()); }
    }
    const int gt = F.bid * NTHR + F.tid, NGT = F.G * NTHR;
    float* binp = (float*)(ws + WS_BIN); const float* bin_ = KA(b_in);
    for (int i = gt; i < NL * PWP; i += NGT) { const int l = i / PWP, c = i % PWP; binp[i] = c < PW2 ? bin_[l * PW + PWF + c] : 0.f; }
    { bf16_t* WF = (bf16_t*)(ws + WS_WF); float* bF = (float*)(ws + WS_FG + FG_BF_OFF);
      for (int i = gt; i < NL * 512 * D; i += NGT) { const int l = i / (512 * D), r = (i / D) % 512, k = i % D, cs = r >> 8, g = (r >> 6) & 3, cp = r & 63;
          const float* wrow = w_in_ + ((size_t)l * D + k) * PW + g * 64; float acc = 0.f;
          for (int c = 0; c < 64; ++c) { const float rev = (float)((c * cp) & 63) * (1.0f / 64.0f); acc += wrow[c] * (cs ? __builtin_amdgcn_sinf(rev) : __builtin_amdgcn_cosf(rev)); }
          WF[i] = (bf16_t)f2bf(acc); }
      for (int i = gt; i < NL * 512; i += NGT) { const int l = i / 512, r = i % 512, cs = r >> 8, g = (r >> 6) & 3, cp = r & 63; float acc = 0.f;
          for (int c = 0; c < 64; ++c) { const float rev = (float)((c * cp) & 63) * (1.0f / 64.0f); acc += bin_[l * PW + g * 64 + c] * (cs ? __builtin_amdgcn_sinf(rev) : __builtin_amdgcn_cosf(rev)); }
          bF[i] = acc; }
      bf16_t* Gm = (bf16_t*)(ws + WS_FG);
      for (int i = gt; i < 128 * 128; i += NGT) { const int ro = i >> 13, k1 = (i >> 7) & 63, ri = (i >> 6) & 1, s1 = i & 63; const float rev = (float)((k1 * s1) & 63) * (1.0f / 64.0f);
          const float c = __builtin_amdgcn_cosf(rev), sn = __builtin_amdgcn_sinf(rev); Gm[i] = (bf16_t)f2bf(ro == 0 ? (ri == 0 ? c : -sn) : (ri == 0 ? -sn : -c)); }
      bf16_t* Hm = (bf16_t*)(ws + WS_FG + FG_H_OFF);
      for (int i = gt; i < 128 * 256; i += NGT) { const int k2 = i >> 8, ri = (i >> 7) & 1, s2 = i & 127; const float rev = (float)((k2 * s2) & 127) * (1.0f / 128.0f);
          Hm[i] = (bf16_t)f2bf(0.0013810679320049757f * (ri ? __builtin_amdgcn_sinf(rev) : __builtin_amdgcn_cosf(rev))); } }
    float* rot = (float*)(ws + WS_ROT);
    for (int i = gt; i < S * 24; i += NGT) { const int pos = i / 24, j = i % 24; const float inv = 1.0f / powf(10000.0f, (float)(2 * j) / 48.0f); const float ang = (float)pos * inv;
        float sn, cs; sincosf(ang, &sn, &cs); rot[2 * i] = cs; rot[2 * i + 1] = sn; }
    float* xf = (float*)(ws + WS_XF); bf16_t* xb = (bf16_t*)(ws + WS_XB); const float* xin = KA(x); const float* eg = KA(emb_g); const float* eb = KA(emb_b);
    for (int m = gw; m < T; m += NGW) { f32x4 v[4];
#pragma unroll
        for (int j = 0; j < 4; ++j) v[j] = *(const f32x4*)(xin + (size_t)m * D + 4 * F.lane + 256 * j);
        ln_row(v, eg, eb, xf + (size_t)m * D, xb + (size_t)m * D, nullptr, F.lane); }
}

template <bool REV, bool MAXOP> __device__ __forceinline__ void wave_scan128(LAS float* arr, int lane) {
    const int i0 = REV ? 127 - 2 * lane : 2 * lane, i1 = REV ? 126 - 2 * lane : 2 * lane + 1;
    const float a = arr[i0], b = arr[i1];
    float s = MAXOP ? fmaxf(a, b) : a + b;
#pragma unroll
    for (int o = 1; o < 64; o <<= 1) { const float t = __shfl_up(s, o); if (lane >= o) s = MAXOP ? fmaxf(s, t) : s + t; }
    float ex = __shfl_up(s, 1); if (lane == 0) ex = MAXOP ? -INFINITY : 0.f;
    arr[i0] = MAXOP ? fmaxf(ex, a) : ex + a; arr[i1] = MAXOP ? fmaxf(fmaxf(ex, a), b) : ex + a + b;
}
__device__ __forceinline__ float ret_lg(int h, float off) { return log1pf(-exp2f(-(5.0f + off) - (float)h)); }

__device__ __forceinline__ float mlstm_qk(const bf16_t* P, const float* convw, int b, int s, int ch) {
    float acc = 0.f;
#pragma unroll
    for (int d = 0; d < 3; ++d) { const int sp = s + d - 1; if (sp >= 0 && sp < S) acc += bf2f(P[(size_t)(b * S + sp) * PWP + COL_MQK + ch]) * convw[d * 384 + ch]; }
    return siluf_(acc);
}
__device__ __forceinline__ float ret_rot(const bf16_t* P, const float* rot, int b, int s, int colbase, int h, int kk) {
    const bf16_t* p = P + (size_t)(b * S + s) * PWP + colbase + h * DK + (kk & ~1);
    const float t1 = bf2f(p[0]), t2 = bf2f(p[1]);
    const float cs = rot[(s * 24 + (kk >> 1)) * 2], sn = rot[(s * 24 + (kk >> 1)) * 2 + 1];
    return (kk & 1) ? t1 * sn + t2 * cs : t1 * cs - t2 * sn;
}

__device__ __forceinline__ void phaseB_unit(const Frame& F, const Args& a, int l, int u) {
    unsigned char* ws = KA(ws);
    const bf16_t* P = (const bf16_t*)(ws + WS_P);
    const int type = u >> 10, r = u & 1023, b = r >> 8, c = (r >> 2) & 63, h = r & 3;
    LAS float* kS = (LAS float*)F.lds;
    LAS float* vS = kS + 128 * 49;
    LAS float* ga = vS + 128 * 97;
    LAS float* lff = ga, *lfb = ga + 128, *iff = ga + 256, *ibb = ga + 384, *pf = ga + 512, *pb = ga + 640, *scal = ga + 768;
    const int t0 = b * S + c * CH;
    const float kscale = 0.14433756729740643f;
    if (type == 0) {
        const float* convw = KA(conv_w) + (size_t)l * 3 * 384;
        for (int idx = F.tid; idx < 128 * DK; idx += NTHR) { const int j = idx / DK, kk = idx % DK; kS[j * 49 + kk] = mlstm_qk(P, convw, b, c * CH + j, 192 + h * DK + kk) * kscale; }
        for (int idx = F.tid; idx < 128 * DV; idx += NTHR) { const int j = idx / DV, vv = idx % DV; vS[j * 97 + vv] = bf2f(P[(size_t)(t0 + j) * PWP + COL_MV + h * DV + vv]); }
        if (F.tid < 128) { const bf16_t* g = P + (size_t)(t0 + F.tid) * PWP + COL_MG;
            iff[F.tid] = bf2f(g[h]); lff[F.tid] = logsigmoidf_(bf2f(g[4 + h])); ibb[F.tid] = bf2f(g[8 + h]); lfb[F.tid] = logsigmoidf_(bf2f(g[12 + h])); }
        __syncthreads();
        if (F.wave == 0) wave_scan128<false, false>(lff, F.lane);
        if (F.wave == 1) wave_scan128<true, false>(lfb, F.lane);
        __syncthreads();
        if (F.tid < 128) pf[F.tid] = lff[127] - lff[F.tid] + iff[F.tid];
        else if (F.tid < 256) { const int j = F.tid - 128; pb[j] = lfb[0] - lfb[j] + ibb[j]; }
        __syncthreads();
        if (F.wave == 0) { const float m = wave_max(fmaxf(pf[2 * F.lane], pf[2 * F.lane + 1])); if (F.lane == 0) scal[0] = m; }
        if (F.wave == 1) { const float m = wave_max(fmaxf(pb[2 * F.lane], pb[2 * F.lane + 1])); if (F.lane == 0) scal[1] = m; }
        __syncthreads();
        if (F.tid < 128) pf[F.tid] = __expf(pf[F.tid] - scal[0]);
        else if (F.tid < 256) { const int j = F.tid - 128; pb[j] = __expf(pb[j] - scal[1]); }
        __syncthreads();
        float* mC = (float*)(ws + WS_MC); float* mN = (float*)(ws + WS_MN); float* msc = (float*)(ws + WS_MSC);
        for (int idx = F.tid; idx < 2 * DV * DK; idx += NTHR) { const int dir = idx / (DV * DK), e = idx % (DV * DK), vv = e / DK, kk = e % DK; const LAS float* p = dir ? pb : pf;
            float s = 0.f;
            for (int j = 0; j < 128; ++j) s += p[j] * vS[j * 97 + vv] * kS[j * 49 + kk];
            mC[(size_t)sidx(b, h, dir, c) * (DV * DK) + e] = s; }
        if (F.tid < 2 * DK) { const int dir = F.tid / DK, kk = F.tid % DK; const LAS float* p = dir ? pb : pf; float s = 0.f;
            for (int j = 0; j < 128; ++j) s += p[j] * kS[j * 49 + kk];
            mN[(size_t)sidx(b, h, dir, c) * DK + kk] = s; }
        if (F.tid == 0) { msc[sidx(b, h, 0, c)] = scal[0]; msc[sidx(b, h, 1, c)] = scal[1]; msc[2048 + sidx(b, h, 0, c)] = lff[127]; msc[2048 + sidx(b, h, 1, c)] = lfb[0]; }
    } else {
        const float* rot = (const float*)(ws + WS_ROT);
        for (int idx = F.tid; idx < 128 * DK; idx += NTHR) { const int j = idx / DK, kk = idx % DK; kS[j * 49 + kk] = ret_rot(P, rot, b, c * CH + j, COL_RK, h, kk) * kscale; }
        for (int idx = F.tid; idx < 128 * DV; idx += NTHR) { const int j = idx / DV, vv = idx % DV; vS[j * 97 + vv] = bf2f(P[(size_t)(t0 + j) * PWP + COL_RV + h * DV + vv]); }
        const float lgf = ret_lg(h, 0.f), lgb = ret_lg(h, 0.5f);
        if (F.tid < 128) pf[F.tid] = __expf(lgf * (float)(127 - F.tid));
        else if (F.tid < 256) { const int j = F.tid - 128; pb[j] = __expf(lgb * (float)j); }
        __syncthreads();
        float* rS = (float*)(ws + WS_RS);
        for (int idx = F.tid; idx < 2 * DV * DK; idx += NTHR) { const int dir = idx / (DV * DK), e = idx % (DV * DK), vv = e / DK, kk = e % DK; const LAS float* p = dir ? pb : pf;
            float s = 0.f;
            for (int j = 0; j < 128; ++j) s += p[j] * vS[j * 97 + vv] * kS[j * 49 + kk];
            rS[(size_t)sidx(b, h, dir, c) * (DV * DK) + e] = s; }
    }
    __syncthreads();
}

typedef short s16x4 __attribute__((ext_vector_type(4)));
__device__ __forceinline__ bf16x8 tr_frag(const LAS bf16_t* tile, int stride, int row0, int col0, int lane) {
    const LAS bf16_t* a0 = tile + (row0 + 8 * (lane >> 4) + ((lane & 15) >> 2)) * stride + col0 + 4 * (lane & 3);
    const s16x4 lo = __builtin_amdgcn_ds_read_tr16_b64_v4i16((LAS s16x4*)a0);
    const s16x4 hi = __builtin_amdgcn_ds_read_tr16_b64_v4i16((LAS s16x4*)(a0 + 4 * stride));
    return (bf16x8){lo[0], lo[1], lo[2], lo[3], hi[0], hi[1], hi[2], hi[3]};
}
constexpr int QKS = 72, VSS = 104, WSS = 136, KPS = 56;

__device__ __forceinline__ void load_k_or_q(const Frame& F, const bf16_t* P, const float* convw, const float* rot, int type, int b, int c, int h, int which  , float scale, LAS bf16_t* dst) {
    for (int idx = F.tid; idx < 128 * 64; idx += NTHR) { const int j = idx >> 6, kk = idx & 63; float v = 0.f;
        if (kk < DK) v = (type == 0 ? mlstm_qk(P, convw, b, c * CH + j, which * 192 + h * DK + kk) : ret_rot(P, rot, b, c * CH + j, which ? COL_RK : COL_RQ, h, kk)) * scale;
        dst[j * QKS + kk] = (bf16_t)f2bf(v); }
}
__device__ __forceinline__ void load_v(const Frame& F, const bf16_t* P, int type, int t0, int h, LAS bf16_t* Vs) {
    for (int idx = F.tid; idx < 128 * 12; idx += NTHR) { const int j = idx / 12, vc = idx % 12;
        *(LAS u32x4*)(Vs + j * VSS + 8 * vc) = *(const u32x4*)(P + (size_t)(t0 + j) * PWP + (type ? COL_RV : COL_MV) + h * DV + 8 * vc); }
}

__device__ __forceinline__ void phaseB_mfma(const Frame& F, const Args& a, int l, int u) {
    unsigned char* ws = KA(ws);
    const bf16_t* P = (const bf16_t*)(ws + WS_P);
    const int type = u >> 10, r_ = u & 1023, b = r_ >> 8, c = (r_ >> 2) & 63, h = r_ & 3;
    LAS bf16_t* Kf = (LAS bf16_t*)F.lds;
    LAS bf16_t* Kb = Kf + 128 * KPS;
    LAS bf16_t* Vs = Kb + 128 * KPS;
    LAS float* ga = (LAS float*)(Vs + 128 * VSS);
    LAS float* lff = ga, *lfb = ga + 128, *iff = ga + 256, *ibb = ga + 384, *pf = ga + 512, *pb = ga + 640, *scal = ga + 768;
    const int t0 = b * S + c * CH;
    const float kscale = 0.14433756729740643f;
    const float* rot = (const float*)(ws + WS_ROT);
    const float* convw = KA(conv_w) + (size_t)l * 3 * 384;
    float* msc = (float*)(ws + WS_MSC);
    load_v(F, P, type, t0, h, Vs);
    if (type == 0) {
        if (F.tid < 128) { const bf16_t* g = P + (size_t)(t0 + F.tid) * PWP + COL_MG;
            iff[F.tid] = bf2f(g[h]); lff[F.tid] = logsigmoidf_(bf2f(g[4 + h])); ibb[F.tid] = bf2f(g[8 + h]); lfb[F.tid] = logsigmoidf_(bf2f(g[12 + h])); }
        __syncthreads();
        if (F.wave == 0) wave_scan128<false, false>(lff, F.lane);
        if (F.wave == 1) wave_scan128<true, false>(lfb, F.lane);
        __syncthreads();
        if (F.tid < 128) pf[F.tid] = lff[127] - lff[F.tid] + iff[F.tid];
        else if (F.tid < 256) { const int j = F.tid - 128; pb[j] = lfb[0] - lfb[j] + ibb[j]; }
        __syncthreads();
        if (F.wave == 0) { const float m = wave_max(fmaxf(pf[2 * F.lane], pf[2 * F.lane + 1])); if (F.lane == 0) scal[0] = m; }
        if (F.wave == 1) { const float m = wave_max(fmaxf(pb[2 * F.lane], pb[2 * F.lane + 1])); if (F.lane == 0) scal[1] = m; }
        __syncthreads();
        if (F.tid < 128) pf[F.tid] = __expf(pf[F.tid] - scal[0]);
        else if (F.tid < 256) { const int j = F.tid - 128; pb[j] = __expf(pb[j] - scal[1]); }
        if (F.tid == 0) { msc[sidx(b, h, 0, c)] = scal[0]; msc[sidx(b, h, 1, c)] = scal[1]; msc[2048 + sidx(b, h, 0, c)] = lff[127]; msc[2048 + sidx(b, h, 1, c)] = lfb[0]; }
    } else {
        const float lgf = ret_lg(h, 0.f), lgb = ret_lg(h, 0.5f);
        if (F.tid < 128) pf[F.tid] = __expf(lgf * (float)(127 - F.tid));
        else if (F.tid < 256) { const int j = F.tid - 128; pb[j] = __expf(lgb * (float)j); }
    }
    __syncthreads();
    for (int idx = F.tid; idx < 128 * DK; idx += NTHR) { const int j = idx / DK, kk = idx % DK;
        const float kv = (type == 0 ? mlstm_qk(P, convw, b, c * CH + j, 192 + h * DK + kk) : ret_rot(P, rot, b, c * CH + j, COL_RK, h, kk)) * kscale;
        Kf[j * KPS + kk] = (bf16_t)f2bf(kv * pf[j]); Kb[j * KPS + kk] = (bf16_t)f2bf(kv * pb[j]); }
    __syncthreads();
    float* X = (float*)(ws + (type ? WS_RS : WS_MC));
    const int l15 = F.lane & 15, lq = F.lane >> 4;
    for (int tt = F.wave; tt < 36; tt += NWAVES) { const int dir = tt / 18, mt = (tt % 18) / 6, nt = tt % 6; const LAS bf16_t* Ksrc = dir ? Kb : Kf;
        f32x4 acc = (f32x4){0.f, 0.f, 0.f, 0.f};
#pragma unroll
        for (int ks = 0; ks < 4; ++ks) { const bf16x8 af = tr_frag(Ksrc, KPS, 32 * ks, 16 * mt, F.lane), bfv = tr_frag(Vs, VSS, 32 * ks, 16 * nt, F.lane);
            acc = __builtin_amdgcn_mfma_f32_16x16x32_bf16(af, bfv, acc, 0, 0, 0); }
        *(f32x4*)(X + (size_t)sidx(b, h, dir, c) * (DV * DK) + (16 * nt + l15) * DK + 16 * mt + 4 * lq) = acc; }
    if (type == 0 && F.tid < 2 * DK) { const int dir = F.tid / DK, kk = F.tid % DK; const LAS bf16_t* Ksrc = dir ? Kb : Kf; float sN = 0.f;
        for (int j = 0; j < 128; ++j) sN += bf2f(Ksrc[j * KPS + kk]);
        ((float*)(ws + WS_MN))[(size_t)sidx(b, h, dir, c) * DK + kk] = sN; }
    __syncthreads();
}

__device__ __forceinline__ void phaseD_mfma(const Frame& F, const Args& a, int l, int u) {
    unsigned char* ws = KA(ws);
    const bf16_t* P = (const bf16_t*)(ws + WS_P); bf16_t* mix = (bf16_t*)(ws + WS_MIX);
    const int type = u >> 10, r_ = u & 1023, b = r_ >> 8, c = (r_ >> 2) & 63, h = r_ & 3;
    LAS bf16_t* Qs = (LAS bf16_t*)F.lds;
    LAS bf16_t* Ks = Qs + 128 * QKS;
    LAS bf16_t* Vs = Ks + 128 * QKS;
    LAS bf16_t* Wm = Vs + 128 * VSS;
    LAS bf16_t* Cf = Wm + 128 * WSS;
    LAS bf16_t* Cb = Cf + 96 * QKS;
    LAS float* ar = (LAS float*)(Cb + 96 * QKS);
    LAS float* af = ar, *ab = ar + 128, *iff = ar + 256, *ibb = ar + 384, *gxf = ar + 512, *gxb = ar + 640, *mtf = ar + 768, *mtb = ar + 896;
    static_assert((128 * QKS * 2 + 128 * VSS + 128 * WSS + 2 * 96 * QKS) * 2 + 8 * 128 * 4 <= RING_BYTES, "phase D LDS");
    const int t0 = b * S + c * CH;
    const float kscale = 0.14433756729740643f;
    const float* rot = (const float*)(ws + WS_ROT);
    const float* convw = KA(conv_w) + (size_t)l * 3 * 384;
    load_k_or_q(F, P, convw, rot, type, b, c, h, 0, 1.0f, Qs);
    load_k_or_q(F, P, convw, rot, type, b, c, h, 1, kscale, Ks);
    load_v(F, P, type, t0, h, Vs);
    { const float* Cg = (const float*)(ws + (type ? WS_RS : WS_MC));
      for (int idx = F.tid; idx < 2 * 96 * 64; idx += NTHR) { const int dir = idx / (96 * 64), v = (idx >> 6) % 96, kk = idx & 63;
          const float x = kk < DK ? Cg[(size_t)sidx(b, h, dir, c) * (DV * DK) + v * DK + kk] : 0.f; (dir ? Cb : Cf)[v * QKS + kk] = (bf16_t)f2bf(x); } }
    float mpf = 0.f, mpb = 0.f;
    if (type == 0) {
        const float* msc = (const float*)(ws + WS_MSC);
        mpf = msc[4096 + sidx(b, h, 0, c)]; mpb = msc[4096 + sidx(b, h, 1, c)];
        if (F.tid < 128) { const bf16_t* g = P + (size_t)(t0 + F.tid) * PWP + COL_MG;
            iff[F.tid] = bf2f(g[h]); af[F.tid] = logsigmoidf_(bf2f(g[4 + h])); ibb[F.tid] = bf2f(g[8 + h]); ab[F.tid] = logsigmoidf_(bf2f(g[12 + h])); }
        __syncthreads();
        if (F.wave == 0) wave_scan128<false, false>(af, F.lane);
        if (F.wave == 1) wave_scan128<true, false>(ab, F.lane);
        __syncthreads();
        if (F.tid < 128) gxf[F.tid] = iff[F.tid] - af[F.tid]; else if (F.tid < 256) gxb[F.tid - 128] = ibb[F.tid - 128] - ab[F.tid - 128];
        __syncthreads();
        if (F.wave == 0) wave_scan128<false, true>(gxf, F.lane);
        if (F.wave == 1) wave_scan128<true, true>(gxb, F.lane);
        __syncthreads();
        if (F.tid < 128) mtf[F.tid] = fmaxf(af[F.tid] + mpf, af[F.tid] + gxf[F.tid]); else if (F.tid < 256) { const int q = F.tid - 128; mtb[q] = fmaxf(ab[q] + mpb, ab[q] + gxb[q]); }
    }
    __syncthreads();
    const int w = F.wave, l15 = F.lane & 15, lq = F.lane >> 4, j = 16 * w + l15;
    bf16x8 qf[2];
#pragma unroll
    for (int ks = 0; ks < 2; ++ks) qf[ks] = *(const LAS bf16x8*)(Qs + j * QKS + 32 * ks + 8 * lq);
    f32x4 If[6], Ib[6];
#pragma unroll
    for (int n = 0; n < 6; ++n) { If[n] = (f32x4){0.f, 0.f, 0.f, 0.f}; Ib[n] = (f32x4){0.f, 0.f, 0.f, 0.f};
#pragma unroll
        for (int ks = 0; ks < 2; ++ks) { const bf16x8 cf = *(const LAS bf16x8*)(Cf + (16 * n + l15) * QKS + 32 * ks + 8 * lq), cb = *(const LAS bf16x8*)(Cb + (16 * n + l15) * QKS + 32 * ks + 8 * lq);
            If[n] = __builtin_amdgcn_mfma_f32_16x16x32_bf16(cf, qf[ks], If[n], 0, 0, 0); Ib[n] = __builtin_amdgcn_mfma_f32_16x16x32_bf16(cb, qf[ks], Ib[n], 0, 0, 0); } }
    f32x4 St[8];
#pragma unroll
    for (int m = 0; m < 8; ++m) { St[m] = (f32x4){0.f, 0.f, 0.f, 0.f};
#pragma unroll
        for (int ks = 0; ks < 2; ++ks) { const bf16x8 kf = *(const LAS bf16x8*)(Ks + (16 * m + l15) * QKS + 32 * ks + 8 * lq); St[m] = __builtin_amdgcn_mfma_f32_16x16x32_bf16(kf, qf[ks], St[m], 0, 0, 0); } }
    float cfj, cbj;
    if (type == 0) {
        const float afj = af[j], abj = ab[j], mtfj = mtf[j], mtbj = mtb[j];
        float denf = 0.f, denb = 0.f; f32x4 sd = (f32x4){0.f, 0.f, 0.f, 0.f};
#pragma unroll
        for (int m = 0; m < 8; ++m) { const f32x4 a4 = *(const LAS f32x4*)((m <= w ? af : ab) + 16 * m + 4 * lq), i4 = *(const LAS f32x4*)((m <= w ? iff : ibb) + 16 * m + 4 * lq);
            if (m < w) {
#pragma unroll
                for (int r = 0; r < 4; ++r) { St[m][r] *= __expf(afj - a4[r] + i4[r] - mtfj); denf += St[m][r]; }
            } else if (m > w) {
#pragma unroll
                for (int r = 0; r < 4; ++r) { St[m][r] *= __expf(abj - a4[r] + i4[r] - mtbj); denb += St[m][r]; }
            } else {
                const f32x4 a4b = *(const LAS f32x4*)(ab + 16 * m + 4 * lq), i4b = *(const LAS f32x4*)(ibb + 16 * m + 4 * lq);
#pragma unroll
                for (int r = 0; r < 4; ++r) { const int s = 16 * m + 4 * lq + r; const float raw = St[m][r];
                    const float ef = s <= j ? __expf(afj - a4[r] + i4[r] - mtfj) : 0.f, eb = s >= j ? __expf(abj - a4b[r] + i4b[r] - mtbj) : 0.f;
                    St[m][r] = raw * ef; sd[r] = raw * eb; denf += St[m][r]; denb += sd[r]; }
            } }
        const float* npf = (const float*)(ws + WS_MN) + (size_t)sidx(b, h, 0, c) * DK + 12 * lq; const float* npb = (const float*)(ws + WS_MN) + (size_t)sidx(b, h, 1, c) * DK + 12 * lq;
        float nqf = 0.f, nqb = 0.f;
#pragma unroll
        for (int kk = 0; kk < 12; ++kk) { const float qv = bf2f(Qs[j * QKS + 12 * lq + kk]); nqf += npf[kk] * qv; nqb += npb[kk] * qv; }
        denf += __shfl_xor(denf, 16); denf += __shfl_xor(denf, 32); denb += __shfl_xor(denb, 16); denb += __shfl_xor(denb, 32);
        nqf += __shfl_xor(nqf, 16); nqf += __shfl_xor(nqf, 32); nqb += __shfl_xor(nqb, 16); nqb += __shfl_xor(nqb, 32);
        const float sif = __expf(afj + mpf - mtfj), sib = __expf(abj + mpb - mtbj);
        const float rdf = 1.0f / fmaxf(fabsf(denf + sif * nqf), __expf(-mtfj)), rdb = 1.0f / fmaxf(fabsf(denb + sib * nqb), __expf(-mtbj));
        cfj = sif * rdf; cbj = sib * rdb;
#pragma unroll
        for (int m = 0; m < 8; ++m) { const float sc = m <= w ? rdf : rdb; f32x4 wv = St[m] * sc; if (m == w) wv += sd * rdb;
            u32x2 pk; pk.x = pk2(wv[0], wv[1]); pk.y = pk2(wv[2], wv[3]); *(LAS u32x2*)(Wm + j * WSS + 16 * m + 4 * lq) = pk; }
    } else {
        const float lgf = ret_lg(h, 0.f), lgb = ret_lg(h, 0.5f);
#pragma unroll
        for (int m = 0; m < 8; ++m) { f32x4 wv;
#pragma unroll
            for (int r = 0; r < 4; ++r) { const int s = 16 * m + 4 * lq + r; wv[r] = St[m][r] * (s <= j ? __expf(lgf * (float)(j - s)) : __expf(lgb * (float)(s - j))); }
            u32x2 pk; pk.x = pk2(wv[0], wv[1]); pk.y = pk2(wv[2], wv[3]); *(LAS u32x2*)(Wm + j * WSS + 16 * m + 4 * lq) = pk; }
        cfj = __expf(lgf * (float)(j + 1)); cbj = __expf(lgb * (float)(128 - j));
    }
    f32x4 O[6];
#pragma unroll
    for (int n = 0; n < 6; ++n) O[n] = If[n] * cfj + Ib[n] * cbj;
#pragma unroll
    for (int ks = 0; ks < 4; ++ks) { const bf16x8 wf = *(const LAS bf16x8*)(Wm + j * WSS + 32 * ks + 8 * lq);
#pragma unroll
        for (int n = 0; n < 6; ++n) { const bf16x8 vf = tr_frag(Vs, VSS, 32 * ks, 16 * n, F.lane); O[n] = __builtin_amdgcn_mfma_f32_16x16x32_bf16(vf, wf, O[n], 0, 0, 0); } }
    const bf16_t* prow = P + (size_t)(t0 + j) * PWP + (type ? COL_RG : COL_MO) + h * DV + 4 * lq;
    float s1 = 0.f;
    f32x4 gt[6];
#pragma unroll
    for (int n = 0; n < 6; ++n) { const u32x2 gw = *(const u32x2*)(prow + 16 * n);
        gt[n] = (f32x4){__builtin_bit_cast(float, gw.x << 16), __builtin_bit_cast(float, gw.x & 0xffff0000u), __builtin_bit_cast(float, gw.y << 16), __builtin_bit_cast(float, gw.y & 0xffff0000u)};
        if (type == 0) {
#pragma unroll
            for (int r = 0; r < 4; ++r) O[n][r] *= sigmoidf_(gt[n][r]); }
        s1 += (O[n][0] + O[n][1]) + (O[n][2] + O[n][3]); }
    s1 += __shfl_xor(s1, 16); s1 += __shfl_xor(s1, 32);
    const float mean = s1 * (1.0f / 96.0f); float s2 = 0.f;
#pragma unroll
    for (int n = 0; n < 6; ++n) { O[n] = O[n] - mean; s2 += (O[n][0] * O[n][0] + O[n][1] * O[n][1]) + (O[n][2] * O[n][2] + O[n][3] * O[n][3]); }
    s2 += __shfl_xor(s2, 16); s2 += __shfl_xor(s2, 32);
    const float rstd = 1.0f / sqrtf(s2 * (1.0f / 96.0f) + LN_EPS);
    const float* nwp = (type ? KA(ret_nw) : KA(ml_nw));
    const float* nw = nwp + (size_t)l * 384 + h * DV + 4 * lq;
    bf16_t* o = mix + (size_t)(t0 + j) * D + (type ? 640 : 256) + h * DV + 4 * lq;
#pragma unroll
    for (int n = 0; n < 6; ++n) { const f32x4 wv = *(const f32x4*)(nw + 16 * n); f32x4 y = O[n] * rstd * wv;
        if (type == 1) {
#pragma unroll
            for (int r = 0; r < 4; ++r) y[r] *= siluf_(gt[n][r]); }
        u32x2 pk; pk.x = pk2(y[0], y[1]); pk.y = pk2(y[2], y[3]); *(u32x2*)(o + 16 * n) = pk; }
    __syncthreads();
}

__device__ __forceinline__ void phaseC_unit(const Frame& F, const Args& a, int u) {
    unsigned char* ws = KA(ws);
    const int type = u >> 7, seq = (u & 127) >> 2, part = u & 3, dir = seq & 1;
    LAS float* sp = (LAS float*)F.lds; LAS float* sc = sp + 64;
    float* msc = (float*)(ws + WS_MSC);
    if (type == 0) {
        if (F.tid == 0) { float m = 0.f;
            for (int n = 0; n < NCH; ++n) { const int c = dir ? NCH - 1 - n : n; const int si = seq * NCH + c; const float mc = msc[si], ae = msc[2048 + si];
                if (part == 0) msc[4096 + si] = m;
                const float mn = fmaxf(ae + m, mc); sp[n] = __expf(ae + m - mn); sc[n] = __expf(mc - mn); m = mn; } }
    } else {
        if (F.tid < 64) { const int h = (seq >> 1) & 3; const float lg = ret_lg(h, dir ? 0.5f : 0.f); sp[F.tid] = __expf(lg * 128.0f); sc[F.tid] = 1.0f; }
    }
    __syncthreads();
    float* X = (float*)(ws + (type ? WS_RS : WS_MC));
    for (int e = F.tid; e < 1152; e += NTHR) { float st = 0.f; float* p = X + (size_t)seq * NCH * (DV * DK) + part * 1152 + e;
#pragma unroll 8
        for (int n = 0; n < NCH; ++n) { const int c = dir ? NCH - 1 - n : n; float* q = p + (size_t)c * (DV * DK); const float v = *q; *q = st; st = sp[n] * st + sc[n] * v; } }
    if (type == 0 && part == 0 && F.tid < DK) { float st = 0.f; float* p = (float*)(ws + WS_MN) + (size_t)seq * NCH * DK + F.tid;
        for (int n = 0; n < NCH; ++n) { const int c = dir ? NCH - 1 - n : n; float* q = p + (size_t)c * DK; const float v = *q; *q = st; st = sp[n] * st + sc[n] * v; } }
    __syncthreads();
}

__device__ __forceinline__ void phaseD_unit(const Frame& F, const Args& a, int l, int u) {
    unsigned char* ws = KA(ws);
    const bf16_t* P = (const bf16_t*)(ws + WS_P); bf16_t* mix = (bf16_t*)(ws + WS_MIX);
    const int type = u >> 10, r = u & 1023, b = r >> 8, c = (r >> 2) & 63, h = r & 3;
    LAS bf16_t* qS = (LAS bf16_t*)F.lds;
    LAS bf16_t* kS = qS + 128 * 50;
    LAS bf16_t* vS = kS + 128 * 50;
    LAS float* SS = (LAS float*)(vS + 128 * 98);
    LAS float* ar = SS + 128 * 129;
    LAS float* af = ar, *ab = ar + 128, *iff = ar + 256, *ibb = ar + 384, *gxf = ar + 512, *gxb = ar + 640, *mtf = ar + 768, *mtb = ar + 896, *rdf = ar + 1024, *rdb = ar + 1152, *sif = ar + 1280, *sib = ar + 1408;
    LAS float* ps = ar + 1536;
    const int t0 = b * S + c * CH;
    const float kscale = 0.14433756729740643f;
    const float* rot = (const float*)(ws + WS_ROT);
    if (type == 0) {
        const float* convw = KA(conv_w) + (size_t)l * 3 * 384;
        for (int idx = F.tid; idx < 128 * DK; idx += NTHR) { const int j = idx / DK, kk = idx % DK;
            qS[j * 50 + kk] = (bf16_t)f2bf(mlstm_qk(P, convw, b, c * CH + j, h * DK + kk));
            kS[j * 50 + kk] = (bf16_t)f2bf(mlstm_qk(P, convw, b, c * CH + j, 192 + h * DK + kk) * kscale); }
        for (int idx = F.tid; idx < 128 * DV; idx += NTHR) { const int j = idx / DV, vv = idx % DV; vS[j * 98 + vv] = P[(size_t)(t0 + j) * PWP + COL_MV + h * DV + vv]; }
        if (F.tid < 128) { const bf16_t* g = P + (size_t)(t0 + F.tid) * PWP + COL_MG;
            iff[F.tid] = bf2f(g[h]); af[F.tid] = logsigmoidf_(bf2f(g[4 + h])); ibb[F.tid] = bf2f(g[8 + h]); ab[F.tid] = logsigmoidf_(bf2f(g[12 + h])); }
    } else {
        for (int idx = F.tid; idx < 128 * DK; idx += NTHR) { const int j = idx / DK, kk = idx % DK;
            qS[j * 50 + kk] = (bf16_t)f2bf(ret_rot(P, rot, b, c * CH + j, COL_RQ, h, kk));
            kS[j * 50 + kk] = (bf16_t)f2bf(ret_rot(P, rot, b, c * CH + j, COL_RK, h, kk) * kscale); }
        for (int idx = F.tid; idx < 128 * DV; idx += NTHR) { const int j = idx / DV, vv = idx % DV; vS[j * 98 + vv] = P[(size_t)(t0 + j) * PWP + COL_RV + h * DV + vv]; }
    }
    __syncthreads();
    { const int j = F.tid >> 2, s0 = (F.tid & 3) * 32;
#pragma unroll 1
      for (int s = s0; s < s0 + 32; ++s) { float d = 0.f;
#pragma unroll 8
          for (int kk = 0; kk < DK; ++kk) d += bf2f(qS[j * 50 + kk]) * bf2f(kS[s * 50 + kk]);
          SS[j * 129 + s] = d; } }
    const int j = F.tid & 127, vq = F.tid >> 7;
    float acc[24];
#pragma unroll
    for (int x = 0; x < 24; ++x) acc[x] = 0.f;
    if (type == 0) {
        const float* msc = (const float*)(ws + WS_MSC);
        const float mpf = msc[4096 + sidx(b, h, 0, c)], mpb = msc[4096 + sidx(b, h, 1, c)];
        if (F.wave == 0) wave_scan128<false, false>(af, F.lane);
        if (F.wave == 1) wave_scan128<true, false>(ab, F.lane);
        __syncthreads();
        if (F.tid < 128) gxf[F.tid] = iff[F.tid] - af[F.tid]; else if (F.tid < 256) gxb[F.tid - 128] = ibb[F.tid - 128] - ab[F.tid - 128];
        __syncthreads();
        if (F.wave == 0) wave_scan128<false, true>(gxf, F.lane);
        if (F.wave == 1) wave_scan128<true, true>(gxb, F.lane);
        __syncthreads();
        if (F.tid < 128) mtf[F.tid] = fmaxf(af[F.tid] + mpf, af[F.tid] + gxf[F.tid]); else if (F.tid < 256) { const int q = F.tid - 128; mtb[q] = fmaxf(ab[q] + mpb, ab[q] + gxb[q]); }
        __syncthreads();
        if (F.tid < 256) { const int dir = F.tid >> 7, jj = F.tid & 127; const LAS float* A_ = dir ? ab : af; const LAS float* I_ = dir ? ibb : iff; const float mt = dir ? mtb[jj] : mtf[jj];
            float den = 0.f; const int lo = dir ? jj : 0, hi = dir ? 127 : jj;
            for (int s = lo; s <= hi; ++s) den += SS[jj * 129 + s] * __expf(A_[jj] - A_[s] + I_[s] - mt);
            const float si = __expf(A_[jj] + (dir ? mpb : mpf) - mt);
            const float* np = (const float*)(ws + WS_MN) + (size_t)sidx(b, h, dir, c) * DK; float nq = 0.f;
            for (int kk = 0; kk < DK; ++kk) nq += np[kk] * bf2f(qS[jj * 50 + kk]);
            den += si * nq;
            const float dn = fmaxf(fabsf(den), __expf(-mt));
            if (dir) { rdb[jj] = 1.0f / dn; sib[jj] = si; } else { rdf[jj] = 1.0f / dn; sif[jj] = si; } }
        __syncthreads();
#pragma unroll 1
        for (int dir = 0; dir < 2; ++dir) {
            const LAS float* A_ = dir ? ab : af; const LAS float* I_ = dir ? ibb : iff; const float mt = dir ? mtb[j] : mtf[j]; const float rd = dir ? rdb[j] : rdf[j]; const float si = dir ? sib[j] : sif[j];
            const int lo = dir ? j : 0, hi = dir ? 127 : j;
            for (int s = lo; s <= hi; ++s) { const float w = SS[j * 129 + s] * __expf(A_[j] - A_[s] + I_[s] - mt) * rd;
#pragma unroll
                for (int x = 0; x < 24; ++x) acc[x] += w * bf2f(vS[s * 98 + vq * 24 + x]); }
            const float* cp = (const float*)(ws + WS_MC) + (size_t)sidx(b, h, dir, c) * (DV * DK) + (size_t)(vq * 24) * DK;
            for (int kk = 0; kk < DK; ++kk) { const float qv = bf2f(qS[j * 50 + kk]) * si * rd;
#pragma unroll
                for (int x = 0; x < 24; ++x) acc[x] += qv * cp[x * DK + kk]; }
        }
        const bf16_t* og = P + (size_t)(t0 + j) * PWP + COL_MO + h * DV + vq * 24;
#pragma unroll
        for (int x = 0; x < 24; ++x) acc[x] *= sigmoidf_(bf2f(og[x]));
    } else {
        const float lgf = ret_lg(h, 0.f), lgb = ret_lg(h, 0.5f);
        __syncthreads();
        for (int s = 0; s < 128; ++s) { const float w = SS[j * 129 + s] * (s <= j ? __expf(lgf * (float)(j - s)) : __expf(lgb * (float)(s - j)));
#pragma unroll
            for (int x = 0; x < 24; ++x) acc[x] += w * bf2f(vS[s * 98 + vq * 24 + x]); }
#pragma unroll 1
        for (int dir = 0; dir < 2; ++dir) {
            const float wi = dir ? __expf(lgb * (float)(128 - j)) : __expf(lgf * (float)(j + 1));
            const float* cp = (const float*)(ws + WS_RS) + (size_t)sidx(b, h, dir, c) * (DV * DK) + (size_t)(vq * 24) * DK;
            for (int kk = 0; kk < DK; ++kk) { const float qv = bf2f(qS[j * 50 + kk]) * wi;
#pragma unroll
                for (int x = 0; x < 24; ++x) acc[x] += qv * cp[x * DK + kk]; }
        }
    }
    float s1 = 0.f;
#pragma unroll
    for (int x = 0; x < 24; ++x) s1 += acc[x];
    ps[vq * 128 + j] = s1;
    __syncthreads();
    const float mean = (ps[j] + ps[128 + j] + ps[256 + j] + ps[384 + j]) * (1.0f / 96.0f);
    __syncthreads();
    float s2 = 0.f;
#pragma unroll
    for (int x = 0; x < 24; ++x) { acc[x] -= mean; s2 += acc[x] * acc[x]; }
    ps[vq * 128 + j] = s2;
    __syncthreads();
    const float rstd = 1.0f / sqrtf((ps[j] + ps[128 + j] + ps[256 + j] + ps[384 + j]) * (1.0f / 96.0f) + LN_EPS);
    bf16_t* o = mix + (size_t)(t0 + j) * D + (type ? 640 : 256) + h * DV + vq * 24;
    if (type == 0) {
        const float* nw = KA(ml_nw) + (size_t)l * 384 + h * DV + vq * 24;
#pragma unroll
        for (int x = 0; x < 24; x += 2) *(unsigned*)(o + x) = pk2(acc[x] * rstd * nw[x], acc[x + 1] * rstd * nw[x + 1]);
    } else {
        const float* nw = KA(ret_nw) + (size_t)l * 384 + h * DV + vq * 24;
        const bf16_t* gg = P + (size_t)(t0 + j) * PWP + COL_RG + h * DV + vq * 24;
#pragma unroll
        for (int x = 0; x < 24; x += 2) *(unsigned*)(o + x) = pk2(acc[x] * rstd * nw[x] * siluf_(bf2f(gg[x])), acc[x + 1] * rstd * nw[x + 1] * siluf_(bf2f(gg[x + 1])));
    }
    __syncthreads();
}

__device__ __forceinline__ void fourier_stage1(const Frame& F, unsigned char* ws) {
    const bf16_t* UT = (const bf16_t*)(ws + WS_UT); bf16_t* AT = (bf16_t*)(ws + WS_AT);
    LAS bf16_t* Gs = (LAS bf16_t*)F.lds;
    { const bf16_t* Gg = (const bf16_t*)(ws + WS_FG);
      for (int i = F.tid; i < 128 * 16; i += NTHR) { const int r = i >> 4, c8 = i & 15; *(LAS u32x4*)(Gs + r * 136 + c8 * 8) = *(const u32x4*)(Gg + r * 128 + c8 * 8); } }
    __syncthreads();
    const int l15 = F.lane & 15, lq = F.lane >> 4;
    for (int u = F.bid; u < 1024; u += F.G) {
        const int b = u >> 8, ch = u & 255;
        const bf16_t* xr = UT + ((size_t)u * 128 + 16 * F.wave + l15) * 128 + 8 * lq;
        bf16x8 af[4];
#pragma unroll
        for (int ks = 0; ks < 4; ++ks) af[ks] = *(const bf16x8*)(xr + 32 * ks);
        f32x4 acc[8];
#pragma unroll
        for (int n = 0; n < 8; ++n) { acc[n] = (f32x4){0.f, 0.f, 0.f, 0.f};
#pragma unroll
            for (int ks = 0; ks < 4; ++ks) { const bf16x8 bfr = *(const LAS bf16x8*)(Gs + (16 * n + l15) * 136 + 32 * ks + 8 * lq);
                acc[n] = __builtin_amdgcn_mfma_f32_16x16x32_bf16(af[ks], bfr, acc[n], 0, 0, 0); } }
#pragma unroll
        for (int n = 0; n < 4; ++n) { const int k1 = 16 * n + l15; u32x2 wre, wim; float ore[4], oim[4];
#pragma unroll
            for (int r = 0; r < 4; ++r) { const int s2 = 16 * F.wave + 4 * lq + r; const float rev = (float)(k1 * s2) * (1.0f / 8192.0f);
                const float cs = __builtin_amdgcn_cosf(rev), sn = __builtin_amdgcn_sinf(rev); const float re = acc[n][r], im = acc[n + 4][r];
                ore[r] = re * cs + im * sn; oim[r] = im * cs - re * sn; }
            wre.x = pk2(ore[0], ore[1]); wre.y = pk2(ore[2], ore[3]); wim.x = pk2(oim[0], oim[1]); wim.y = pk2(oim[2], oim[3]);
            bf16_t* o = AT + ((size_t)((b * 64 + k1) * 256 + ch)) * 256 + 16 * F.wave + 4 * lq;
            *(u32x2*)o = wre; *(u32x2*)(o + 128) = wim; }
    }
    __syncthreads();
}
__device__ __forceinline__ void fourier_stage2(const Frame& F, unsigned char* ws) {
    const bf16_t* AT = (const bf16_t*)(ws + WS_AT); bf16_t* mix = (bf16_t*)(ws + WS_MIX);
    LAS bf16_t* Hs = (LAS bf16_t*)F.lds;
    { const bf16_t* Hg = (const bf16_t*)(ws + WS_FG + FG_H_OFF);
      for (int i = F.tid; i < 128 * 32; i += NTHR) { const int r = i >> 5, c8 = i & 31; *(LAS u32x4*)(Hs + r * 264 + c8 * 8) = *(const u32x4*)(Hg + r * 256 + c8 * 8); } }
    __syncthreads();
    const int l15 = F.lane & 15, lq = F.lane >> 4;
    for (int u = F.bid; u < 256; u += F.G) {
        const int b = u >> 6, k1 = u & 63;
        f32x4 acc[2][8];
#pragma unroll
        for (int m = 0; m < 2; ++m)
#pragma unroll
            for (int n = 0; n < 8; ++n) acc[m][n] = (f32x4){0.f, 0.f, 0.f, 0.f};
        const bf16_t* ar = AT + ((size_t)u * 256 + 32 * F.wave + l15) * 256 + 8 * lq;
#pragma unroll
        for (int ks = 0; ks < 8; ++ks) { const bf16x8 a0 = *(const bf16x8*)(ar + 32 * ks), a1 = *(const bf16x8*)(ar + 16 * 256 + 32 * ks);
#pragma unroll
            for (int n = 0; n < 8; ++n) { const bf16x8 bfr = *(const LAS bf16x8*)(Hs + (16 * n + l15) * 264 + 32 * ks + 8 * lq);
                acc[0][n] = __builtin_amdgcn_mfma_f32_16x16x32_bf16(a0, bfr, acc[0][n], 0, 0, 0); acc[1][n] = __builtin_amdgcn_mfma_f32_16x16x32_bf16(a1, bfr, acc[1][n], 0, 0, 0); } }
#pragma unroll
        for (int m = 0; m < 2; ++m)
#pragma unroll
            for (int n = 0; n < 8; ++n) { const int k2 = 16 * n + l15, chn = 32 * F.wave + 16 * m + 4 * lq;
                u32x2 w; w.x = pk2(acc[m][n][0], acc[m][n][1]); w.y = pk2(acc[m][n][2], acc[m][n][3]);
                *(u32x2*)(mix + (size_t)(b * S + k1 + 64 * k2) * D + chn) = w; }
    }
    __syncthreads();
}

__device__ __forceinline__ int build_tiles(const Frame& F, unsigned* cnt, LAS int* tst, LAS unsigned char* tile_e) {
    if (F.tid == 0) { int acc = 0; for (int e = 0; e < NE; ++e) { tst[e] = acc; acc += ((int)__hip_atomic_load(cnt + e, __ATOMIC_RELAXED, __HIP_MEMORY_SCOPE_AGENT) + 255) >> 8; } tst[NE] = acc; }
    __syncthreads();
    const int ntot = tst[NE];
    for (int mt = F.tid; mt < ntot; mt += NTHR) { int e = 0; for (int q = 1; q < NE; ++q) if (mt >= tst[q]) e = q; tile_e[mt] = (unsigned char)e; }
    __syncthreads();
    return ntot;
}

__device__ __forceinline__ void phaseF(const Frame& F, const Args& a, int l) {
    unsigned char* ws = KA(ws);
    const float* pre = (const float*)(ws + WS_PRE); float* x1f = (float*)(ws + WS_X1F); bf16_t* x1b = (bf16_t*)(ws + WS_X1B);
    int* tke = (int*)(ws + WS_TKE); float* tkg = (float*)(ws + WS_TKG); int* tks = (int*)(ws + WS_TKS); int* list = (int*)(ws + WS_LIST);
    unsigned* cnt = F.ctl + CW_CNT + l * 64;
    LAS float* wrT = (LAS float*)F.lds;
    LAS int* lcnt = (LAS int*)(F.lds + MISC_OFF + 2048);
    LAS int* lbase = lcnt + 32;
    LAS int* le = lbase + 32;
    LAS int* ls = le + 512;
    const float* wr = KA(w_router) + (size_t)l * D * NE;
    for (int i = F.tid; i < D * NE; i += NTHR) { const int c = i >> 5, e = i & 31; wrT[e * D + c] = wr[i]; }
    if (F.tid < 32) lcnt[F.tid] = 0;
    __syncthreads();
    const float* g1 = KA(ln1_g) + (size_t)l * D; const float* b1 = KA(ln1_b) + (size_t)l * D; const float* br = KA(b_router) + (size_t)l * NE;
    for (int chunk = F.bid; chunk < T / 128; chunk += F.G) {
        for (int q = 0; q < 16; ++q) {
            const int tl = F.wave * 16 + q, t = chunk * 128 + tl;
            f32x4 v[4];
#pragma unroll
            for (int j = 0; j < 4; ++j) v[j] = *(const f32x4*)(pre + (size_t)t * D + 4 * F.lane + 256 * j);
            float s = 0.f;
#pragma unroll
            for (int j = 0; j < 4; ++j) s += (v[j].x + v[j].y) + (v[j].z + v[j].w);
            const float mean = wave_sum(s) * (1.f / D); float s2 = 0.f;
#pragma unroll
            for (int j = 0; j < 4; ++j) { v[j] = v[j] - mean; s2 += (v[j].x * v[j].x + v[j].y * v[j].y) + (v[j].z * v[j].z + v[j].w * v[j].w); }
            const float rstd = 1.f / sqrtf(wave_sum(s2) * (1.f / D) + LN_EPS);
#pragma unroll
            for (int j = 0; j < 4; ++j) { const f32x4 gg = *(const f32x4*)(g1 + 4 * F.lane + 256 * j), bb = *(const f32x4*)(b1 + 4 * F.lane + 256 * j);
                v[j] = v[j] * rstd * gg + bb;
                *(f32x4*)(x1f + (size_t)t * D + 4 * F.lane + 256 * j) = v[j];
                u32x2 w; w.x = pk2(v[j].x, v[j].y); w.y = pk2(v[j].z, v[j].w); *(u32x2*)(x1b + (size_t)t * D + 4 * F.lane + 256 * j) = w; }
            float mylogit = -INFINITY;
            for (int e = 0; e < NE; ++e) { float p = 0.f;
#pragma unroll
                for (int j = 0; j < 4; ++j) { const f32x4 w = *(const LAS f32x4*)(wrT + e * D + 4 * F.lane + 256 * j); p += (v[j].x * w.x + v[j].y * w.y) + (v[j].z * w.z + v[j].w * w.w); }
                p = wave_sum(p);
                if (F.lane == e) mylogit = p + br[e]; }
            float tv[4]; int ti[4];
#pragma unroll
            for (int k = 0; k < 4; ++k) { float bv = mylogit; int bi = F.lane;
#pragma unroll
                for (int o = 1; o < 64; o <<= 1) { const float ov = __shfl_xor(bv, o); const int oi = __shfl_xor(bi, o); if (ov > bv || (ov == bv && oi < bi)) { bv = ov; bi = oi; } }
                tv[k] = bv; ti[k] = bi; if (F.lane == bi) mylogit = -INFINITY; }
            const float w1 = __expf(tv[1] - tv[0]), w2 = __expf(tv[2] - tv[0]), w3 = __expf(tv[3] - tv[0]); const float inv = 1.0f / (1.0f + w1 + w2 + w3);
            if (F.lane < 4) { const int k = F.lane; const int e = k == 0 ? ti[0] : k == 1 ? ti[1] : k == 2 ? ti[2] : ti[3]; const float g = (k == 0 ? 1.0f : k == 1 ? w1 : k == 2 ? w2 : w3) * inv;
                tke[t * 4 + k] = e; tkg[t * 4 + k] = g;
                const int sl = __hip_atomic_fetch_add(lcnt + e, 1, __ATOMIC_RELAXED, __HIP_MEMORY_SCOPE_WORKGROUP);
                le[tl * 4 + k] = e; ls[tl * 4 + k] = sl; }
        }
        __syncthreads();
        if (F.tid < 32) lbase[F.tid] = (int)__hip_atomic_fetch_add(cnt + F.tid, (unsigned)lcnt[F.tid], __ATOMIC_RELAXED, __HIP_MEMORY_SCOPE_AGENT);
        __syncthreads();
        { const int tl = F.tid >> 2, k = F.tid & 3, t = chunk * 128 + tl, e = le[F.tid], slot = lbase[e] + ls[F.tid];
          list[(size_t)e * T + slot] = t; tks[t * 4 + k] = slot; }
        __syncthreads();
        if (F.tid < 32) lcnt[F.tid] = 0;
        __syncthreads();
    }
}

__device__ __forceinline__ void phaseG0(const Frame& F, const Args& a, int l) {
    unsigned char* ws = KA(ws);
    unsigned* cnt = F.ctl + CW_CNT + l * 64;
    LAS int* tst = (LAS int*)(F.lds + MISC_OFF + 256); LAS unsigned char* tile_e = (LAS unsigned char*)(F.lds + MISC_OFF + 512);
    const int ntot = build_tiles(F, cnt, tst, tile_e);
    const bf16_t* x1b = (const bf16_t*)(ws + WS_X1B); bf16_t* xs = (bf16_t*)(ws + WS_XS); const int* list = (const int*)(ws + WS_LIST);
    const int gw = F.bid * NWAVES + F.wave, NGW = F.G * NWAVES;
    for (int r = gw; r < ntot * 256; r += NGW) { const int mt = r >> 8, e = tile_e[mt], within = r - tst[e] * 256;
        const int c = (int)__hip_atomic_load(cnt + e, __ATOMIC_RELAXED, __HIP_MEMORY_SCOPE_AGENT);
        const int tok = within < c ? list[(size_t)e * T + within] : 0;
        const u32x4* src = (const u32x4*)(x1b + (size_t)tok * D); u32x4* dst = (u32x4*)(xs + (size_t)r * D);
        dst[F.lane] = src[F.lane]; dst[64 + F.lane] = src[64 + F.lane]; }
    __syncthreads();
}

__device__ __forceinline__ void phaseI(const Frame& F, const Args& a, int l) {
    unsigned char* ws = KA(ws);
    unsigned* cnt = F.ctl + CW_CNT + l * 64;
    LAS int* tst = (LAS int*)(F.lds + MISC_OFF + 256); LAS unsigned char* tile_e = (LAS unsigned char*)(F.lds + MISC_OFF + 512);
    (void)build_tiles(F, cnt, tst, tile_e);
    const float* x1f = (const float*)(ws + WS_X1F); const bf16_t* Y = (const bf16_t*)(ws + WS_Y);
    const int* tke = (const int*)(ws + WS_TKE); const float* tkg = (const float*)(ws + WS_TKG); const int* tks = (const int*)(ws + WS_TKS);
    float* xf = (float*)(ws + WS_XF); bf16_t* xb = (bf16_t*)(ws + WS_XB);
    const float* g2 = KA(ln2_g) + (size_t)l * D; const float* b2 = KA(ln2_b) + (size_t)l * D;
    const int gw = F.bid * NWAVES + F.wave, NGW = F.G * NWAVES; float* outp = KA(out);
    for (int t = gw; t < T; t += NGW) {
        f32x4 v[4];
#pragma unroll
        for (int j = 0; j < 4; ++j) v[j] = *(const f32x4*)(x1f + (size_t)t * D + 4 * F.lane + 256 * j) * DN_ALPHA;
#pragma unroll
        for (int k = 0; k < 4; ++k) { const int e = tke[t * 4 + k]; const float g = tkg[t * 4 + k]; const size_t row = (size_t)tst[e] * 256 + tks[t * 4 + k];
#pragma unroll
            for (int j = 0; j < 4; ++j) { const u32x2 w = *(const u32x2*)(Y + row * D + 4 * F.lane + 256 * j);
                v[j].x += g * __builtin_bit_cast(float, w.x << 16); v[j].y += g * __builtin_bit_cast(float, w.x & 0xffff0000u);
                v[j].z += g * __builtin_bit_cast(float, w.y << 16); v[j].w += g * __builtin_bit_cast(float, w.y & 0xffff0000u); } }
        ln_row(v, g2, b2, xf + (size_t)t * D, xb + (size_t)t * D, l == NL - 1 ? outp + (size_t)t * D : nullptr, F.lane);
    }
    __syncthreads();
}

template <int PHMASK_T> __global__ void __launch_bounds__(NTHR, 2) hybrid_fwd(Args a) {
    extern __shared__ __attribute__((aligned(16))) unsigned char lds_raw[];
    Frame F;
    F.lds = (LAS unsigned char*)lds_raw;
    F.tid = threadIdx.x; F.lane = F.tid & 63; F.wave = __builtin_amdgcn_readfirstlane(F.tid >> 6);
    F.G = gridDim.x; F.bid = blockIdx.x;
    F.ctl = (unsigned*)(KA(ws) + WS_CTL);
    unsigned char* ws = KA(ws);
    volatile LAS unsigned* MISC = (volatile LAS unsigned*)(F.lds + MISC_OFF);
    if (F.tid < 64) MISC[F.tid] = 0u;
    __syncthreads();
#if MK_MULTI
#define GRID_BAR() do { } while (0)
#else
    XcdBarrier bar = xcd_barrier_post(F.ctl + CW_BAR, MISC);
#define GRID_BAR() do { unsigned long long _bp = (unsigned long long)(uintptr_t)bar.bar; unsigned _bx = bar.x; unsigned _bs = (unsigned)(uintptr_t)bar.st; asm volatile("" : "+s"(_bp), "+s"(_bx), "+s"(_bs)); \
        XcdBarrier _b; _b.bar = (unsigned*)(uintptr_t)_bp; _b.x = _bx; _b.st = (volatile LAS unsigned*)(uintptr_t)_bs; xcd_barrier(_b); } while (0)
#endif
    const int lo = KA(ph_lo), hi = KA(ph_hi);
#define PH_ON(j) (((PHMASK_T) >> (j)) & 1)
#define IN(k) (lo <= (k) && (k) < hi)
#define SEAM(k) do { if (IN(k) && IN((k) + 1)) GRID_BAR(); } while (0)
    if (PH_ON(10) && IN(0)) { p0_prologue(F, a); }
    SEAM(0);
#define LAUNDER() do { unsigned _lp = (unsigned)(uintptr_t)F.lds; unsigned long long _cp = (unsigned long long)(uintptr_t)F.ctl; unsigned long long _wp = (unsigned long long)(uintptr_t)ws; \
        F.tid = threadIdx.x; asm volatile("" : "+v"(F.tid)); F.lane = F.tid & 63; F.wave = __builtin_amdgcn_readfirstlane(F.tid >> 6); F.bid = blockIdx.x; F.G = gridDim.x; \
        asm volatile("" : "+s"(F.bid), "+s"(F.G), "+s"(_lp), "+s"(_cp), "+s"(_wp)); \
        F.lds = (LAS unsigned char*)(uintptr_t)_lp; F.ctl = (unsigned*)(uintptr_t)_cp; ws = (unsigned char*)(uintptr_t)_wp; } while (0)
    for (int l = 0; l < NL; ++l) {
        const int pb = 1 + l * NPH_LAYER;
        LAUNDER();
        if (PH_ON(0) && IN(pb + 0)) {
            pg8::PlainOrder So; So.init(ws + WS_XB, (bf16_t*)(ws + WS_WIN) + (size_t)l * PWP * D, T, PWP, D, F.G, F.bid);
            pg8::EpiBf16Bias E{(bf16_t*)(ws + WS_P), PWP, (const float*)(ws + WS_BIN) + (size_t)l * PWP};
            pg8::gemm_phase<pg8::EpiBf16Bias, pg8::PlainOrder, true, true>(F.lds, D, So, E, F.tid);
            pg8::FourierOrder Sf{(const char*)(ws + WS_WF) + (size_t)l * 512 * D * 2, (const char*)(ws + WS_XB), D, F.G, F.bid};
            pg8::EpiFourierT Ef{(bf16_t*)(ws + WS_UT), (const float*)(ws + WS_FG + FG_BF_OFF) + l * 512};
            pg8::gemm_phase<pg8::EpiFourierT, pg8::FourierOrder, true, true>(F.lds, D, Sf, Ef, F.tid);
        }
        SEAM(pb + 0);
        LAUNDER();
        if (PH_ON(1) && IN(pb + 1)) {
            for (int u = F.bid; u < 2048; u += F.G) phaseB_mfma(F, a, l, u);
            fourier_stage1(F, ws);
        }
        SEAM(pb + 1);
        LAUNDER();
        if (PH_ON(2) && IN(pb + 2)) { for (int u = F.bid; u < 256; u += F.G) phaseC_unit(F, a, u); fourier_stage2(F, ws); }
        SEAM(pb + 2);
        LAUNDER();
        if (PH_ON(3) && IN(pb + 3)) {
            for (int u = F.bid; u < 2048; u += F.G) phaseD_mfma(F, a, l, u);
        }
        SEAM(pb + 3);
        LAUNDER();
        if (PH_ON(4) && IN(pb + 4)) {
            pg8::PlainOrder So; So.init(ws + WS_MIX, (bf16_t*)(ws + WS_WOUT) + (size_t)l * D * D, T, D, D, F.G, F.bid);
            pg8::EpiResF32 E{(float*)(ws + WS_PRE), (const float*)(ws + WS_XF), D, DN_ALPHA};
            pg8::gemm_phase<pg8::EpiResF32, pg8::PlainOrder, true, true>(F.lds, D, So, E, F.tid);
        }
        SEAM(pb + 4);
        LAUNDER();
        if (PH_ON(5) && IN(pb + 5)) phaseF(F, a, l);
        SEAM(pb + 5);
        LAUNDER();
        if (PH_ON(6) && IN(pb + 6)) phaseG0(F, a, l);
        SEAM(pb + 6);
        LAUNDER();
        if (PH_ON(7) && IN(pb + 7)) {
            LAS int* tst = (LAS int*)(F.lds + MISC_OFF + 256); LAS unsigned char* tile_e = (LAS unsigned char*)(F.lds + MISC_OFF + 512);
            const int ntot = build_tiles(F, F.ctl + CW_CNT + l * 64, tst, tile_e);
            pg8::GroupOrder So{(const char*)(ws + WS_XS), (const char*)(ws + WS_W1) + (size_t)l * NE * 2048 * D * 2, D, 8, ntot, F.G, F.bid, (size_t)2048 * D * 2, tile_e};
            pg8::EpiSwiglu E{(bf16_t*)(ws + WS_H), KA(b1) + (size_t)l * NE * 2048};
            pg8::gemm_phase<pg8::EpiSwiglu, pg8::GroupOrder, true, true>(F.lds, D, So, E, F.tid);
        }
        SEAM(pb + 7);
        LAUNDER();
        if (PH_ON(8) && IN(pb + 8)) {
            LAS int* tst = (LAS int*)(F.lds + MISC_OFF + 256); LAS unsigned char* tile_e = (LAS unsigned char*)(F.lds + MISC_OFF + 512);
            const int ntot = build_tiles(F, F.ctl + CW_CNT + l * 64, tst, tile_e);
            pg8::GroupOrder So{(const char*)(ws + WS_H), (const char*)(ws + WS_W2) + (size_t)l * NE * D * FF * 2, FF, 4, ntot, F.G, F.bid, (size_t)D * FF * 2, tile_e};
            pg8::EpiExpertOut E{(bf16_t*)(ws + WS_Y), KA(b2) + (size_t)l * NE * D};
            pg8::gemm_phase<pg8::EpiExpertOut, pg8::GroupOrder, true, true>(F.lds, FF, So, E, F.tid);
        }
        SEAM(pb + 8);
        LAUNDER();
        if (PH_ON(9) && IN(pb + 9)) phaseI(F, a, l);
        SEAM(pb + 9);
    }
#undef IN
#undef SEAM
}

template <int MASK> static void launch_one(int grid, hipStream_t stream, const Args& a) {
    static bool attr = false;
    if (!attr) { (void)hipFuncSetAttribute((const void*)hybrid_fwd<MASK>, hipFuncAttributeMaxDynamicSharedMemorySize, LDS_BYTES); attr = true; }
    hipLaunchKernelGGL(hybrid_fwd<MASK>, dim3(grid), dim3(NTHR), LDS_BYTES, stream, a);
}
extern "C" void kernel_launch(void* const* d_in, const int* in_sizes, int n_in, void* d_out, int out_size, void* d_ws, size_t ws_size, hipStream_t stream) {
    static int grid = 0;
    if (grid == 0) {
        if (n_in != 19 || out_size != T * D || ws_size < WS_END) { fprintf(stderr, "kernel_launch: unexpected shapes (n_in %d out %d ws %zu need %zu)\n", n_in, out_size, ws_size, (size_t)WS_END); grid = -1; return; }
        int dev = 0, cus = 0;
        if (hipGetDevice(&dev) != hipSuccess || hipDeviceGetAttribute(&cus, hipDeviceAttributeMultiprocessorCount, dev) != hipSuccess) { grid = -1; return; }
        grid = cus;
    }
    if (grid < 0) return;
    (void)hipMemsetAsync((char*)d_ws + WS_CTL, 0, CTL_BYTES, stream);
    Args a{};
    a.x = (const float*)d_in[0]; a.emb_g = (const float*)d_in[1]; a.emb_b = (const float*)d_in[2]; a.w_in = (const float*)d_in[3]; a.b_in = (const float*)d_in[4];
    a.conv_w = (const float*)d_in[5]; a.ml_nw = (const float*)d_in[6]; a.ret_nw = (const float*)d_in[7]; a.w_out = (const float*)d_in[8];
    a.ln1_g = (const float*)d_in[9]; a.ln1_b = (const float*)d_in[10]; a.w_router = (const float*)d_in[11]; a.b_router = (const float*)d_in[12];
    a.w1 = (const float*)d_in[13]; a.b1 = (const float*)d_in[14]; a.w2 = (const float*)d_in[15]; a.b2 = (const float*)d_in[16]; a.ln2_g = (const float*)d_in[17]; a.ln2_b = (const float*)d_in[18];
    a.out = (float*)d_out; a.ws = (unsigned char*)d_ws;
#if MK_MULTI
    a.ph_lo = 0; a.ph_hi = 1; launch_one<0x400>(grid, stream, a);
#define LAUNDER() do { unsigned _lp = (unsigned)(uintptr_t)F.lds; unsigned long long _cp = (unsigned long long)(uintptr_t)F.ctl; unsigned long long _wp = (unsigned long long)(uintptr_t)ws; \
        F.tid = threadIdx.x; asm volatile("" : "+v"(F.tid)); F.lane = F.tid & 63; F.wave = __builtin_amdgcn_readfirstlane(F.tid >> 6); F.bid = blockIdx.x; F.G = gridDim.x; \
        asm volatile("" : "+s"(F.bid), "+s"(F.G), "+s"(_lp), "+s"(_cp), "+s"(_wp)); \
        F.lds = (LAS unsigned char*)(uintptr_t)_lp; F.ctl = (unsigned*)(uintptr_t)_cp; ws = (unsigned char*)(uintptr_t)_wp; } while (0)
    for (int l = 0; l < NL; ++l) {
        const int pb = 1 + l * NPH_LAYER;
#define LP(j) a.ph_lo = pb + (j); a.ph_hi = pb + (j) + 1; launch_one<(1 << (j))>(grid, stream, a);
        LP(0) LP(1) LP(2) LP(3) LP(4) LP(5) LP(6) LP(7) LP(8) LP(9)
#undef LP
    }
#else
    a.ph_lo = 0; a.ph_hi = NPH; launch_one<0x7ff>(grid, stream, a);
#endif
}
```

```cpp
#include <hip/hip_runtime.h>
#include <cstdio>
#include <cstdint>

#ifndef MK_MULTI
#define MK_MULTI 0
#endif

#ifndef PROBE_MASK
#define PROBE_MASK 0
#endif
#define LAS __attribute__((address_space(3)))
#define GAS __attribute__((address_space(1)))
typedef unsigned short bf16_t;
typedef short bf16x8 __attribute__((ext_vector_type(8)));
typedef float f32x4 __attribute__((ext_vector_type(4)));
typedef float f32x2 __attribute__((ext_vector_type(2)));
typedef unsigned u32x4 __attribute__((ext_vector_type(4)));
typedef unsigned u32x2 __attribute__((ext_vector_type(2)));
typedef int v4i __attribute__((ext_vector_type(4)));
typedef int v8i __attribute__((ext_vector_type(8)));
typedef int v8i_a16 __attribute__((ext_vector_type(8), aligned(16)));

constexpr int D = 1024, NB = 4, S = 8192, T = NB * S, NL = 4;
constexpr int CH = 128, NCH = S / CH;
constexpr int PW = 2576, PWF = 256, PW2 = PW - PWF, PWP = 2560;
constexpr int COL_MQK = 0, COL_MV = 384, COL_MO = 768, COL_MG = 1152, COL_RQ = 1168, COL_RK = 1360, COL_RV = 1552, COL_RG = 1936;
constexpr int NH = 4, DK = 48, DV = 96;
constexpr int NE = 32, TOPK = 4, FF = 1024;
constexpr int ROWS_PAD = T * TOPK + NE * 256;
constexpr int MT_MAX = ROWS_PAD / 256;
constexpr float LN_EPS = 1e-5f;
constexpr float DN_ALPHA = 1.6817928305074290f;
constexpr float SW_ALPHA = 1.702f, SW_LIMIT = 7.0f;
constexpr float LOG2E = 1.4426950408889634f;
constexpr float XQ_SCALE = 4.0f, WINQ_SCALE = 32.0f, WFQ_SCALE = 8.0f;
constexpr float WOUT_SCALE = 64.0f, MIX_SCALE = 4.0f;
constexpr float W1_SCALE = 32.0f, W2_SCALE = 64.0f, Y_SCALE = 16.0f;

constexpr size_t MiB = 1u << 20;
constexpr size_t WS_CTL = 0, CTL_BYTES = 1 * MiB;
constexpr size_t WS_WIN = 1 * MiB;
constexpr size_t WS_WOUT = WS_WIN + 22 * MiB;
constexpr size_t WS_W1 = WS_WOUT + 8 * MiB;
constexpr size_t WS_W2 = WS_W1 + 512 * MiB;
constexpr size_t WS_BIN = WS_W2 + 256 * MiB;
constexpr size_t WS_ROT = WS_BIN + 1 * MiB;
constexpr size_t WS_XF = WS_ROT + 2 * MiB;
constexpr size_t WS_XB = WS_XF + 128 * MiB;
constexpr size_t WS_P = WS_XB + 64 * MiB;
constexpr size_t WS_MIX = WS_P + 176 * MiB;
constexpr size_t WS_PRE = WS_MIX + 64 * MiB;
constexpr size_t WS_X1F = WS_PRE + 128 * MiB;
constexpr size_t WS_X1B = WS_X1F + 128 * MiB;
constexpr size_t WS_XS = WS_X1B + 64 * MiB;
constexpr size_t WS_CBM = WS_XS + 64 * MiB, WS_CBR = WS_XS + 96 * MiB;
constexpr size_t WS_H = WS_XS + 272 * MiB;
constexpr size_t WS_Y = WS_H + 272 * MiB;
constexpr size_t WS_TKE = WS_Y + 272 * MiB;
constexpr size_t WS_TKG = WS_TKE + 1 * MiB;
constexpr size_t WS_TKS = WS_TKG + 1 * MiB;
constexpr size_t WS_LIST = WS_TKS + 1 * MiB;
constexpr size_t WS_MC = WS_LIST + 4 * MiB;
constexpr size_t WS_RS = WS_MC + 36 * MiB;
constexpr size_t WS_MN = WS_RS + 36 * MiB;
constexpr size_t WS_MSC = WS_MN + 1 * MiB;
constexpr size_t WS_UT = WS_MSC + 1 * MiB;
constexpr size_t WS_AT = WS_UT + 32 * MiB;
constexpr size_t WS_WF = WS_AT + 32 * MiB;
constexpr size_t WS_FG = WS_WF + 4 * MiB;
constexpr size_t WS_END = WS_FG + 1 * MiB;
constexpr size_t WS_XQ = WS_XF;
constexpr size_t WS_WINQ = WS_X1F, WS_WFQ = WS_X1F + 16 * MiB;
constexpr size_t FG_H_OFF = 32768, FG_BF_OFF = 131072, WRT_OFF = 262144;

constexpr int CW_TMO = 0;
constexpr int CW_BAR = 4096;
constexpr int CW_CNT = 16384;

constexpr int RING_BYTES = 131072;
constexpr int MISC_OFF = RING_BYTES;
constexpr int GTAB_OFF = MISC_OFF + 8192;
constexpr int LDS_BYTES = 163840;

typedef __bf16 bf16x2_t __attribute__((ext_vector_type(2)));
__device__ __forceinline__ unsigned pk2(float lo, float hi) { const f32x2 v = {lo, hi}; return __builtin_bit_cast(unsigned, __builtin_convertvector(v, bf16x2_t)); }
__device__ __forceinline__ unsigned f2bf(float f) { return pk2(f, 0.f) & 0xffffu; }
__device__ __forceinline__ float bf2f(bf16_t b) { return __builtin_bit_cast(float, (unsigned)b << 16); }
__device__ __forceinline__ float wave_sum(float v) {
#pragma unroll
    for (int o = 1; o < 64; o <<= 1) v += __shfl_xor(v, o);
    return v;
}
__device__ __forceinline__ float wave_max(float v) {
#pragma unroll
    for (int o = 1; o < 64; o <<= 1) v = fmaxf(v, __shfl_xor(v, o));
    return v;
}
__device__ __forceinline__ float sigmoidf_(float x) { return __builtin_amdgcn_rcpf(1.0f + __builtin_amdgcn_exp2f(x * -1.4426950408889634f)); }
__device__ __forceinline__ float siluf_(float x) { return x * __builtin_amdgcn_rcpf(1.0f + __builtin_amdgcn_exp2f(x * -1.4426950408889634f)); }
__device__ __forceinline__ float logsigmoidf_(float x) { return fminf(x, 0.f) - __logf(1.0f + __expf(-fabsf(x))); }

namespace pg8 {
constexpr int BM = 256, BK = 64, HALF = 128, HTB = HALF * BK * 2, STAGE_BYTES = 8 * HTB;
__host__ __device__ __forceinline__ int lds_byte(int r, int c) { const int st = (r >> 4) * 2 + (c >> 5), rr = r & 15, cc = c & 31, ob = rr * 64 + cc * 2; return st * 1024 + (ob ^ (((ob >> 9) & 1) << 5)); }
__host__ __device__ __forceinline__ void stage_rc(int b, int& R, int& C) { const int st = b / 1024, sb = b % 1024, swz = sb ^ (((sb >> 9) & 1) << 5); R = (st >> 1) * 16 + swz / 64; C = (st & 1) * 32 + (swz % 64) / 2; }
__host__ __device__ __forceinline__ int perm32(int rho) { const int n = rho >> 4, i = rho & 15; return 8 * (i >> 2) + 4 * n + (i & 3); }
__host__ __device__ __forceinline__ int lds_byte8(int r, int byte) { const int st = (r >> 4) * 2 + (byte >> 6), rr = r & 15, c = (byte & 63) >> 4; return st * 1024 + rr * 64 + ((c ^ (rr >> 3)) << 4); }
__host__ __device__ __forceinline__ void stage_rc8(int b, int& R, int& C) { const int st = b / 1024, sb = b % 1024, rr = sb >> 6, c = ((sb & 63) >> 4) ^ (rr >> 3); R = (st >> 1) * 16 + rr; C = (st & 1) * 32 + c * 8; }
struct Unit { int pm, pn, e; };
__device__ __forceinline__ unsigned cvt_pk_bf16(float lo, float hi) { return ::pk2(lo, hi); }

template <class Epi, class Sched, bool ALIGN_EPI = false, bool SP2 = true>
__device__ __forceinline__ void gemm_phase(LAS unsigned char* lds, const int K, const Sched& S, const Epi& E, const int tid) {
    static_assert(SP2, "only the two-MFMA-blocks-per-barrier loop is kept");
    const int wid = __builtin_amdgcn_readfirstlane(tid >> 6), lane = tid & 63, wr = wid >> 2, wc = wid & 3, fr = lane & 15, fq = lane >> 4;
    const int nt = K / BK;
    unsigned vA0[2], vA1[2], voffB[2];
#pragma unroll
    for (int i = 0; i < 2; ++i) { int R, C; stage_rc(tid * 16 + i * 8192, R, C); const int Rb = Epi::PERM ? ((R & ~31) + perm32(R & 31)) : R;
        voffB[i] = S.b_off(Rb, C); if constexpr (!Sched::GATHER) { vA0[i] = S.a_off(R, C); vA1[i] = vA0[i]; } }
    Unit cur, nxt; int ui = 0;
    if (!S.next(0, cur)) return;
    typename Epi::Bias bia; E.load_bias(cur, wr, wc, fr, fq, bia);
    if constexpr (Sched::GATHER) { S.a_offs(0, tid, vA0, vA1); }
    const size_t kstep = (size_t)(BK * 2);
    const size_t hstepA = S.hstep_a(), hstepB = S.hstep_b();
    const unsigned ldsw = (unsigned)wid * 1024u;
    const int aoff = lds_byte(wr * 64 + fr, fq * 8), boff = lds_byte(wc * 32 + fr, fq * 8);
#define PG8_SA(b, h) (((b) * 2 + (h)) * HTB)
#define PG8_SB(b, h) ((4 + (b) * 2 + (h)) * HTB)
#define PG8_STAGE(bufoff, gbase, voff) do { _Pragma("unroll") for (int _i = 0; _i < 2; ++_i) { unsigned _o = (voff)[_i]; asm volatile("" : "+v"(_o)); \
        __builtin_amdgcn_global_load_lds((const unsigned*)((const char*)(gbase) + _o), (LAS unsigned*)(lds + (bufoff) + ldsw + _i * 8192), 16, 0, 0); } } while (0)
#define PG8_LDA(dst, b, h) do { _Pragma("unroll") for (int m = 0; m < 4; ++m) _Pragma("unroll") for (int k = 0; k < 2; ++k) dst[m][k] = *(const LAS bf16x8*)(lds + PG8_SA(b, h) + aoff + m * 2048 + k * 1024); } while (0)
#define PG8_LDB(dst, b, h) do { _Pragma("unroll") for (int n = 0; n < 2; ++n) _Pragma("unroll") for (int k = 0; k < 2; ++k) dst[n][k] = *(const LAS bf16x8*)(lds + PG8_SB(b, h) + boff + n * 2048 + k * 1024); } while (0)
#define PG8_MMA(ai, bj, At, Bt) do { __builtin_amdgcn_s_setprio(1); _Pragma("unroll") for (int m = 0; m < 4; ++m) _Pragma("unroll") for (int n = 0; n < 2; ++n) _Pragma("unroll") for (int k = 0; k < 2; ++k) \
        acc[ai][bj][m][n] = __builtin_amdgcn_mfma_f32_16x16x32_bf16(Bt[n][k], At[m][k], acc[ai][bj][m][n], 0, 0, 0); __builtin_amdgcn_s_setprio(0); } while (0)
#define PG8_WAIT_V(n) asm volatile("s_waitcnt vmcnt(" #n ")" ::: "memory")
#define PG8_WAIT_L(n) asm volatile("s_waitcnt lgkmcnt(" #n ")" ::: "memory")
#define PG8_BAR __builtin_amdgcn_s_barrier()
#define PG8_SCHED __builtin_amdgcn_sched_barrier(0)
    float zf_ = 0.f; asm volatile("" : "+v"(zf_)); const f32x4 zero4 = (f32x4){zf_, zf_, zf_, zf_};
    f32x4 acc[2][2][4][2];
#pragma unroll
    for (int a = 0; a < 2; ++a)
#pragma unroll
        for (int b = 0; b < 2; ++b)
#pragma unroll
            for (int m = 0; m < 4; ++m)
#pragma unroll
                for (int n = 0; n < 2; ++n) acc[a][b][m][n] = zero4;
    bf16x8 At[4][2], B0[2][2], B1[2][2];
    const char* cA = S.a_base(cur); const char* cB = S.b_base(cur);
    PG8_STAGE(PG8_SB(0, 0), cB, voffB); PG8_STAGE(PG8_SB(0, 1), cB + hstepB, voffB); PG8_STAGE(PG8_SA(0, 0), cA, vA0); PG8_STAGE(PG8_SA(0, 1), cA + hstepA, vA1);
    if (wr == 1) PG8_BAR;
    PG8_WAIT_V(2); PG8_BAR;
    PG8_STAGE(PG8_SB(1, 0), cB + kstep, voffB); PG8_STAGE(PG8_SA(1, 0), cA + kstep, vA0); PG8_STAGE(PG8_SB(1, 1), cB + hstepB + kstep, voffB);
    PG8_WAIT_V(6); PG8_BAR;
    for (;;) {
        const bool has_next = S.next(ui + 1, nxt);
        const char* nA = has_next ? S.a_base(nxt) : cA; const char* nB = has_next ? S.b_base(nxt) : cB;
#pragma unroll 1
        for (int t = 0; t < nt; t += 2) {
            const bool last = (t == nt - 2);
            const char* a1 = cA + (size_t)(t + 1) * kstep;
            const char* a2 = last ? nA : cA + (size_t)(t + 2) * kstep; const char* b2 = last ? nB : cB + (size_t)(t + 2) * kstep;
            const char* a3 = a2 + kstep; const char* b3 = b2 + kstep;
            PG8_LDB(B0, 0, 0); PG8_LDB(B1, 0, 1); PG8_SCHED; PG8_LDA(At, 0, 0); PG8_STAGE(PG8_SA(1, 1), a1 + hstepA, vA1);
            if constexpr (Sched::GATHER) { if (last && has_next) S.a_offs(ui + 1, tid, vA0, vA1); }
            PG8_WAIT_V(8); PG8_WAIT_L(0); PG8_BAR; PG8_MMA(0, 0, At, B0); PG8_MMA(0, 1, At, B1); PG8_BAR; PG8_SCHED;
            PG8_LDA(At, 0, 1); PG8_STAGE(PG8_SB(0, 0), b2, voffB); PG8_STAGE(PG8_SB(0, 1), b2 + hstepB, voffB); PG8_STAGE(PG8_SA(0, 0), a2, vA0);
            PG8_WAIT_V(8); PG8_WAIT_L(0); PG8_BAR; PG8_MMA(1, 0, At, B0); PG8_MMA(1, 1, At, B1); PG8_BAR; PG8_SCHED;
            PG8_LDB(B0, 1, 0); PG8_LDB(B1, 1, 1); PG8_SCHED; PG8_LDA(At, 1, 0); PG8_STAGE(PG8_SA(0, 1), a2 + hstepA, vA1);
            PG8_WAIT_V(8); PG8_WAIT_L(0); PG8_BAR; PG8_MMA(0, 0, At, B0); PG8_MMA(0, 1, At, B1); PG8_BAR; PG8_SCHED;
            PG8_LDA(At, 1, 1); PG8_STAGE(PG8_SB(1, 0), b3, voffB); PG8_STAGE(PG8_SB(1, 1), b3 + hstepB, voffB); PG8_STAGE(PG8_SA(1, 0), a3, vA0);
            PG8_WAIT_V(8); PG8_WAIT_L(0); PG8_BAR; PG8_MMA(1, 0, At, B0); PG8_MMA(1, 1, At, B1); PG8_BAR; PG8_SCHED;
        }
        if constexpr (ALIGN_EPI) { if (wr == 0) PG8_BAR; }
        { int te = tid; asm volatile("" : "+v"(te)); const int le_ = te & 63, we_ = __builtin_amdgcn_readfirstlane(te >> 6); E(acc, cur, we_ >> 2, we_ & 3, le_ & 15, le_ >> 4, bia); }
        if (!has_next) break;
#pragma unroll
        for (int a = 0; a < 2; ++a)
#pragma unroll
            for (int b = 0; b < 2; ++b)
#pragma unroll
                for (int m = 0; m < 4; ++m)
#pragma unroll
                    for (int n = 0; n < 2; ++n) acc[a][b][m][n] = zero4;
        cur = nxt; cA = nA; cB = nB; ++ui;
        E.load_bias(cur, wr, wc, fr, fq, bia);
        if constexpr (ALIGN_EPI) { if (wr == 1) PG8_BAR; }
    }
    PG8_WAIT_V(0);
    if constexpr (!ALIGN_EPI) { if (wr == 0) PG8_BAR; }
    PG8_BAR;
#undef PG8_SA
#undef PG8_SB
#undef PG8_STAGE
#undef PG8_LDA
#undef PG8_LDB
#undef PG8_MMA
#undef PG8_WAIT_V
#undef PG8_WAIT_L
#undef PG8_BAR
#undef PG8_SCHED
}

template <class Epi, class Sched, bool ALIGN_EPI = false, bool SP2 = true>
__device__ __forceinline__ void gemm_phase_f8(LAS unsigned char* lds, const int K, const Sched& S, const Epi& E, const int tid) {
    static_assert(SP2, "only the two-MFMA-blocks-per-barrier loop is kept");
    const int wid = __builtin_amdgcn_readfirstlane(tid >> 6), lane = tid & 63, wr = wid >> 2, wc = wid & 3, fr = lane & 15, fq = lane >> 4;
    const int nt = K / 128;
    unsigned vA0[2], vA1[2], voffB[2];
#pragma unroll
    for (int i = 0; i < 2; ++i) { int R, C; stage_rc8(tid * 16 + i * 8192, R, C); const int Rb = Epi::PERM ? ((R & ~31) + perm32(R & 31)) : R;
        voffB[i] = S.b_off(Rb, C); if constexpr (!Sched::GATHER) { vA0[i] = S.a_off(R, C); vA1[i] = vA0[i]; } }
    Unit cur, nxt; int ui = 0;
    if (!S.next(0, cur)) return;
    typename Epi::Bias bia; E.load_bias(cur, wr, wc, fr, fq, bia);
    if constexpr (Sched::GATHER) { S.a_offs(0, tid, vA0, vA1); }
    const size_t kstep = (size_t)(BK * 2);
    const size_t hstepA = S.hstep_a(), hstepB = S.hstep_b();
    const unsigned ldsw = (unsigned)wid * 1024u;
    const int aoff = lds_byte8(wr * 64 + fr, fq * 32), boff = lds_byte8(wc * 32 + fr, fq * 32);
    const int poff = (fr >> 3) ? -16 : 16;
#define PG8_SA(b, h) (((b) * 2 + (h)) * HTB)
#define PG8_SB(b, h) ((4 + (b) * 2 + (h)) * HTB)
#define PG8_STAGE(bufoff, gbase, voff) do { _Pragma("unroll") for (int _i = 0; _i < 2; ++_i) { unsigned _o = (voff)[_i]; asm volatile("" : "+v"(_o)); \
        __builtin_amdgcn_global_load_lds((const unsigned*)((const char*)(gbase) + _o), (LAS unsigned*)(lds + (bufoff) + ldsw + _i * 8192), 16, 0, 0); } } while (0)
#define PG8_LD32(p) __builtin_shufflevector(__builtin_bit_cast(v4i, *(const LAS bf16x8*)(p)), __builtin_bit_cast(v4i, *(const LAS bf16x8*)((p) + poff)), 0, 1, 2, 3, 4, 5, 6, 7)
#define PG8_LDA(dst, b, h) do { _Pragma("unroll") for (int m = 0; m < 4; ++m) dst[m] = PG8_LD32(lds + PG8_SA(b, h) + aoff + m * 2048); } while (0)
#define PG8_LDB(dst, b, h) do { _Pragma("unroll") for (int n = 0; n < 2; ++n) dst[n] = PG8_LD32(lds + PG8_SB(b, h) + boff + n * 2048); } while (0)
#define PG8_F8(x) (x)
#define PG8_MMA(ai, bj, At, Bt) do { __builtin_amdgcn_s_setprio(1); _Pragma("unroll") for (int m = 0; m < 4; ++m) _Pragma("unroll") for (int n = 0; n < 2; ++n) \
        asm volatile("v_mfma_scale_f32_16x16x128_f8f6f4 %0, %1, %2, %0, %3, %3 op_sel_hi:[0,0,0]" : "+v"(acc[ai][bj][m][n]) : "v"(Bt[n]), "v"(At[m]), "v"(sc127)); __builtin_amdgcn_s_setprio(0); } while (0)
#define PG8_WAIT_V(n) asm volatile("s_waitcnt vmcnt(" #n ")" ::: "memory")
#define PG8_WAIT_L(n) asm volatile("s_waitcnt lgkmcnt(" #n ")" ::: "memory")
#define PG8_BAR __builtin_amdgcn_s_barrier()
#define PG8_SCHED __builtin_amdgcn_sched_barrier(0)
    float zf_ = 0.f; asm volatile("" : "+v"(zf_)); const f32x4 zero4 = (f32x4){zf_, zf_, zf_, zf_};
    f32x4 acc[2][2][4][2];
#pragma unroll
    for (int a = 0; a < 2; ++a)
#pragma unroll
        for (int b = 0; b < 2; ++b)
#pragma unroll
            for (int m = 0; m < 4; ++m)
#pragma unroll
                for (int n = 0; n < 2; ++n) acc[a][b][m][n] = zero4;
    v8i At[4], B0[2], B1[2];
    const int sc127 = 0x7F7F7F7F;
    const char* cA = S.a_base(cur); const char* cB = S.b_base(cur);
    PG8_STAGE(PG8_SB(0, 0), cB, voffB); PG8_STAGE(PG8_SB(0, 1), cB + hstepB, voffB); PG8_STAGE(PG8_SA(0, 0), cA, vA0); PG8_STAGE(PG8_SA(0, 1), cA + hstepA, vA1);
    if (wr == 1) PG8_BAR;
    PG8_WAIT_V(2); PG8_BAR;
    PG8_STAGE(PG8_SB(1, 0), cB + kstep, voffB); PG8_STAGE(PG8_SA(1, 0), cA + kstep, vA0); PG8_STAGE(PG8_SB(1, 1), cB + hstepB + kstep, voffB);
    PG8_WAIT_V(6); PG8_BAR;
#if PROBE_MASK & 0x30000
    unsigned long long gts_ = __builtin_amdgcn_s_memrealtime();
#define GSEC(bit) do { if (PROBE_MASK & (bit)) { const unsigned long long d_ = __builtin_amdgcn_s_memrealtime() - gts_; while (__builtin_amdgcn_s_memrealtime() - gts_ < 2 * d_) __builtin_amdgcn_s_sleep(2); } gts_ = __builtin_amdgcn_s_memrealtime(); } while (0)
#else
#define GSEC(bit) do { } while (0)
#endif
    for (;;) {
        const bool has_next = S.next(ui + 1, nxt);
        const char* nA = has_next ? S.a_base(nxt) : cA; const char* nB = has_next ? S.b_base(nxt) : cB;
#pragma unroll 1
        for (int t = 0; t < nt; t += 2) {
            const bool last = (t == nt - 2);
            const char* a1 = cA + (size_t)(t + 1) * kstep;
            const char* a2 = last ? nA : cA + (size_t)(t + 2) * kstep; const char* b2 = last ? nB : cB + (size_t)(t + 2) * kstep;
            const char* a3 = a2 + kstep; const char* b3 = b2 + kstep;
            PG8_LDB(B0, 0, 0); PG8_LDB(B1, 0, 1); PG8_SCHED; PG8_LDA(At, 0, 0); PG8_STAGE(PG8_SA(1, 1), a1 + hstepA, vA1);
            if constexpr (Sched::GATHER) { if (last && has_next) S.a_offs(ui + 1, tid, vA0, vA1); }
            PG8_WAIT_V(8); PG8_WAIT_L(0); PG8_BAR; PG8_MMA(0, 0, At, B0); PG8_MMA(0, 1, At, B1); PG8_BAR; PG8_SCHED;
            PG8_LDA(At, 0, 1); PG8_STAGE(PG8_SB(0, 0), b2, voffB); PG8_STAGE(PG8_SB(0, 1), b2 + hstepB, voffB); PG8_STAGE(PG8_SA(0, 0), a2, vA0);
            PG8_WAIT_V(8); PG8_WAIT_L(0); PG8_BAR; PG8_MMA(1, 0, At, B0); PG8_MMA(1, 1, At, B1); PG8_BAR; PG8_SCHED;
            PG8_LDB(B0, 1, 0); PG8_LDB(B1, 1, 1); PG8_SCHED; PG8_LDA(At, 1, 0); PG8_STAGE(PG8_SA(0, 1), a2 + hstepA, vA1);
            PG8_WAIT_V(8); PG8_WAIT_L(0); PG8_BAR; PG8_MMA(0, 0, At, B0); PG8_MMA(0, 1, At, B1); PG8_BAR; PG8_SCHED;
            PG8_LDA(At, 1, 1); PG8_STAGE(PG8_SB(1, 0), b3, voffB); PG8_STAGE(PG8_SB(1, 1), b3 + hstepB, voffB); PG8_STAGE(PG8_SA(1, 0), a3, vA0);
            PG8_WAIT_V(8); PG8_WAIT_L(0); PG8_BAR; PG8_MMA(1, 0, At, B0); PG8_MMA(1, 1, At, B1); PG8_BAR; PG8_SCHED;
        }
        GSEC(0x10000);
        if constexpr (ALIGN_EPI) { if (wr == 0) PG8_BAR; }
        asm volatile("s_nop 15\n\ts_nop 15" ::: "memory");
        { int te = tid; asm volatile("" : "+v"(te)); const int le_ = te & 63, we_ = __builtin_amdgcn_readfirstlane(te >> 6); E(acc, cur, we_ >> 2, we_ & 3, le_ & 15, le_ >> 4, bia); }
        if (!has_next) break;
#pragma unroll
        for (int a = 0; a < 2; ++a)
#pragma unroll
            for (int b = 0; b < 2; ++b)
#pragma unroll
                for (int m = 0; m < 4; ++m)
#pragma unroll
                    for (int n = 0; n < 2; ++n) acc[a][b][m][n] = zero4;
        cur = nxt; cA = nA; cB = nB; ++ui;
        E.load_bias(cur, wr, wc, fr, fq, bia);
        GSEC(0x20000);
        if constexpr (ALIGN_EPI) { if (wr == 1) PG8_BAR; }
    }
    PG8_WAIT_V(0);
    if constexpr (!ALIGN_EPI) { if (wr == 0) PG8_BAR; }
    PG8_BAR;
#undef PG8_SA
#undef PG8_SB
#undef PG8_STAGE
#undef PG8_LDA
#undef PG8_LDB
#undef PG8_MMA
#undef PG8_F8
#undef GSEC
#undef PG8_LD32
#undef PG8_WAIT_V
#undef PG8_WAIT_L
#undef PG8_BAR
#undef PG8_SCHED
}

struct PlainOrder {
    static constexpr bool GATHER = false;
    const char* A; const char* Bt; int K; int nM, nN, nwg, G, c;
    __device__ __forceinline__ void init(const void* A_, const void* Bt_, int M, int N, int K_, int G_, int c_) { A = (const char*)A_; Bt = (const char*)Bt_; K = K_; nM = M / BM; nN = N / BM; nwg = nM * nN; G = G_; c = c_; }
    __device__ __forceinline__ bool next(int i, Unit& u) const {
        const long Lq = (long)i * G + c; if (Lq >= nwg) return false;
        int wgid = (int)Lq; { const int q = nwg / 8, r = nwg % 8, xcd = wgid % 8, off = wgid / 8; wgid = (xcd < r ? xcd * (q + 1) : r * (q + 1) + (xcd - r) * q) + off; }
        const int nig = 8 * nN, gid = wgid / nig, fm = gid * 8, gsz = (nM - fm) < 8 ? (nM - fm) : 8;
        u.pm = fm + ((wgid % nig) % gsz); u.pn = (wgid % nig) / gsz; u.e = 0; return true;
    }
    __device__ __forceinline__ const char* a_base(const Unit& u) const { return A + (size_t)u.pm * 256 * K * 2; }
    __device__ __forceinline__ const char* b_base(const Unit& u) const { return Bt + (size_t)u.pn * 256 * K * 2; }
    __device__ __forceinline__ unsigned a_off(int R, int C) const { return (unsigned)(R * K + C) * 2u; }
    __device__ __forceinline__ unsigned b_off(int R, int C) const { return (unsigned)(R * K + C) * 2u; }
    __device__ __forceinline__ size_t hstep_a() const { return (size_t)HALF * K * 2; }
    __device__ __forceinline__ size_t hstep_b() const { return (size_t)HALF * K * 2; }
};
struct PlainOrder8 : PlainOrder {
    __device__ __forceinline__ const char* a_base(const Unit& u) const { return A + (size_t)u.pm * 256 * K; }
    __device__ __forceinline__ const char* b_base(const Unit& u) const { return Bt + (size_t)u.pn * 256 * K; }
    __device__ __forceinline__ unsigned a_off(int R, int C) const { return (unsigned)(R * K + C * 2); }
    __device__ __forceinline__ unsigned b_off(int R, int C) const { return (unsigned)(R * K + C * 2); }
    __device__ __forceinline__ size_t hstep_a() const { return (size_t)HALF * K; }
    __device__ __forceinline__ size_t hstep_b() const { return (size_t)HALF * K; }
};
struct PlainOrderBf : PlainOrder {
    __device__ __forceinline__ bool next(int i, Unit& u) const { if (!PlainOrder::next(i, u)) return false; u.pn = u.pn < 2 ? u.pn : u.pn + 2; return true; }
};
struct PlainOrderF8 : PlainOrder8 {
    __device__ __forceinline__ bool next(int i, Unit& u) const { if (!PlainOrder::next(i, u)) return false; u.pn = u.pn < 2 ? u.pn + 2 : u.pn + 4; return true; }
};
struct FourierOrder {
    static constexpr bool GATHER = false;
    const char* A; const char* X; int K, G, c;
    __device__ __forceinline__ bool next(int i, Unit& u) const { const int Lq = i * G + c; if (Lq >= 256) return false; u.pm = Lq & 1; u.pn = Lq >> 1; u.e = 0; return true; }
    __device__ __forceinline__ const char* a_base(const Unit& u) const { return A + (size_t)u.pm * 256 * K * 2; }
    __device__ __forceinline__ const char* b_base(const Unit& u) const { return X + (size_t)((u.pn >> 5) * 8192 + (u.pn & 31) * 4) * K * 2; }
    __device__ __forceinline__ unsigned a_off(int R, int C) const { return (unsigned)(R * K + C) * 2u; }
    __device__ __forceinline__ unsigned b_off(int R, int C) const { return (unsigned)((((R & 63) * 128 + (R >> 6)) * K + C) * 2); }
    __device__ __forceinline__ size_t hstep_a() const { return (size_t)HALF * K * 2; }
    __device__ __forceinline__ size_t hstep_b() const { return (size_t)2 * K * 2; }
};
struct FourierOrder8 {
    static constexpr bool GATHER = false;
    const char* A; const char* X; int K, G, c;
    __device__ __forceinline__ bool next(int i, Unit& u) const { const int Lq = i * G + c; if (Lq >= 256) return false; u.pm = Lq & 1; u.pn = Lq >> 1; u.e = 0; return true; }
    __device__ __forceinline__ const char* a_base(const Unit& u) const { return A + (size_t)u.pm * 256 * K; }
    __device__ __forceinline__ const char* b_base(const Unit& u) const { return X + (size_t)((u.pn >> 5) * 8192 + (u.pn & 31) * 4) * K; }
    __device__ __forceinline__ unsigned a_off(int R, int C) const { return (unsigned)(R * K + C * 2); }
    __device__ __forceinline__ unsigned b_off(int R, int C) const { return (unsigned)(((R & 63) * 128 + (R >> 6)) * K + C * 2); }
    __device__ __forceinline__ size_t hstep_a() const { return (size_t)HALF * K; }
    __device__ __forceinline__ size_t hstep_b() const { return (size_t)2 * K; }
};
__device__ __forceinline__ bool moe_unit(int i, int c, int G, int nN, int ntot, int& pm, int& pn) {
    if (G == 256) { const int x = c & 7, j = c >> 3;
        if (nN == 8) { pm = i * 32 + x * 4 + (j >> 3); pn = j & 7; } else { pm = i * 64 + x * 8 + (j >> 2); pn = j & 3; }
        return pm < ntot; }
    const long Lq = (long)i * G + c; pm = (int)(Lq / nN); pn = (int)(Lq % nN); return pm < ntot;
}
struct GroupOrder {
    static constexpr bool GATHER = false;
    const char* A; const char* Bt; int K  ; int nN, ntot, G, c; size_t bstride; const LAS unsigned char* tile_e;
    __device__ __forceinline__ bool next(int i, Unit& u) const {
        if (!moe_unit(i, c, G, nN, ntot, u.pm, u.pn)) return false;
        u.e = __builtin_amdgcn_readfirstlane((int)tile_e[u.pm]); return true;
    }
    __device__ __forceinline__ const char* a_base(const Unit& u) const { return A + (size_t)u.pm * 256 * K; }
    __device__ __forceinline__ const char* b_base(const Unit& u) const { return Bt + (size_t)u.e * bstride + (size_t)u.pn * 256 * K; }
    __device__ __forceinline__ unsigned a_off(int R, int C) const { return (unsigned)(R * K + C * 2); }
    __device__ __forceinline__ unsigned b_off(int R, int C) const { return (unsigned)(R * K + C * 2); }
    __device__ __forceinline__ size_t hstep_a() const { return (size_t)HALF * K; }
    __device__ __forceinline__ size_t hstep_b() const { return (size_t)HALF * K; }
};

struct GatherOrder {
    static constexpr bool GATHER = true;
    const char* X; const char* Bt; int K  ; int nN, ntot, G, c; size_t bstride; const LAS unsigned char* tile_e; const LAS unsigned* gtab;
    __device__ __forceinline__ bool next(int i, Unit& u) const {
        if (!moe_unit(i, c, G, nN, ntot, u.pm, u.pn)) return false;
        u.e = __builtin_amdgcn_readfirstlane((int)tile_e[u.pm]); return true;
    }
    __device__ __forceinline__ const char* a_base(const Unit&) const { return X; }
    __device__ __forceinline__ const char* b_base(const Unit& u) const { return Bt + (size_t)u.e * bstride + (size_t)u.pn * 256 * K; }
    __device__ __forceinline__ unsigned a_off(int, int) const { return 0u; }
    __device__ __forceinline__ void a_offs(int ui, int tid, unsigned (&v0)[2], unsigned (&v1)[2]) const {
#pragma unroll
        for (int i = 0; i < 2; ++i) { int R, C; stage_rc8(tid * 16 + i * 8192, R, C); v0[i] = gtab[ui * 256 + R] + (unsigned)C * 2u; v1[i] = gtab[ui * 256 + 128 + R] + (unsigned)C * 2u; } }
    __device__ __forceinline__ unsigned b_off(int R, int C) const { return (unsigned)(R * K + C * 2); }
    __device__ __forceinline__ size_t hstep_a() const { return 0; }
    __device__ __forceinline__ size_t hstep_b() const { return (size_t)HALF * K; }
};

struct EpiBf16Bias {
    static constexpr bool PERM = true;
    bf16_t* O; int ldc; const float* bias; float ascale;
    struct Bias { f32x4 v[2][2]; };
    __device__ __forceinline__ void load_bias(const Unit& u, int wr, int wc, int fr, int fq, Bias& B) const {
        const int col0 = u.pn * BM + wc * 32 + 8 * fq;
#pragma unroll
        for (int bj = 0; bj < 2; ++bj)
#pragma unroll
            for (int n = 0; n < 2; ++n) B.v[bj][n] = *(const f32x4*)(bias + col0 + bj * HALF + 4 * n);
    }
    __device__ __forceinline__ void operator()(const f32x4 (&acc)[2][2][4][2], const Unit& u, int wr, int wc, int fr, int fq, const Bias& B) const {
        const int row0 = u.pm * BM + wr * 64 + fr, col0 = u.pn * BM + wc * 32 + 8 * fq;
        const f32x4 (&bv)[2][2] = B.v;
#pragma unroll
        for (int ai = 0; ai < 2; ++ai)
#pragma unroll
            for (int m = 0; m < 4; ++m) { bf16_t* rowp = O + (size_t)(row0 + ai * HALF + m * 16) * ldc + col0;
#pragma unroll
                for (int bj = 0; bj < 2; ++bj) { const f32x4 v0 = acc[ai][bj][m][0] * ascale + bv[bj][0], v1 = acc[ai][bj][m][1] * ascale + bv[bj][1];
                    u32x4 w; w.x = cvt_pk_bf16(v0[0], v0[1]); w.y = cvt_pk_bf16(v0[2], v0[3]); w.z = cvt_pk_bf16(v1[0], v1[1]); w.w = cvt_pk_bf16(v1[2], v1[3]);
                    *(u32x4*)(rowp + bj * HALF) = w; } }
    }
};
struct EpiFourierT {
    static constexpr bool PERM = true;
    bf16_t* UT; const float* bF; float ascale;
    struct Bias { float v[2][4]; };
    __device__ __forceinline__ void load_bias(const Unit& u, int wr, int wc, int fr, int fq, Bias& B) const {
#pragma unroll
        for (int ai = 0; ai < 2; ++ai)
#pragma unroll
            for (int m = 0; m < 4; ++m) B.v[ai][m] = bF[u.pm * 256 + ai * HALF + wr * 64 + m * 16 + fr];
    }
    __device__ __forceinline__ void operator()(const f32x4 (&acc)[2][2][4][2], const Unit& u, int wr, int wc, int fr, int fq, const Bias& B) const {
        const int b = u.pn >> 5, q = u.pn & 31, cs = u.pm;
#pragma unroll
        for (int ai = 0; ai < 2; ++ai)
#pragma unroll
            for (int m = 0; m < 4; ++m) { const int ch = ai * HALF + wr * 64 + m * 16 + fr; const float bv = B.v[ai][m];
#pragma unroll
                for (int bj = 0; bj < 2; ++bj) { const int s2 = 4 * q + 2 * bj + (wc >> 1), s1 = 32 * (wc & 1) + 8 * fq;
                    const f32x4 v0 = acc[ai][bj][m][0] * ascale + bv, v1 = acc[ai][bj][m][1] * ascale + bv;
                    u32x4 w; w.x = cvt_pk_bf16(v0[0], v0[1]); w.y = cvt_pk_bf16(v0[2], v0[3]); w.z = cvt_pk_bf16(v1[0], v1[1]); w.w = cvt_pk_bf16(v1[2], v1[3]);
                    *(u32x4*)(UT + ((size_t)((b * 256 + ch) * 128 + s2) * 2 + cs) * 64 + s1) = w; } }
    }
};
struct EpiResBf16 {
    static constexpr bool PERM = true;
    bf16_t* O; const bf16_t* R; int ldc; float alpha, ascale;
    struct Bias { };
    __device__ __forceinline__ void load_bias(const Unit&, int, int, int, int, Bias&) const { }
    __device__ __forceinline__ void operator()(const f32x4 (&acc)[2][2][4][2], const Unit& u, int wr, int wc, int fr, int fq, const Bias&) const {
        const int row0 = u.pm * BM + wr * 64 + fr, col0 = u.pn * BM + wc * 32 + 8 * fq;
        u32x4 rall[2][4][2];
#pragma unroll
        for (int ai = 0; ai < 2; ++ai)
#pragma unroll
            for (int m = 0; m < 4; ++m)
#pragma unroll
                for (int bj = 0; bj < 2; ++bj) rall[ai][m][bj] = *(const u32x4*)(R + (size_t)(row0 + ai * HALF + m * 16) * ldc + col0 + bj * HALF);
#pragma unroll
        for (int ai = 0; ai < 2; ++ai)
#pragma unroll
            for (int m = 0; m < 4; ++m) { const size_t off = (size_t)(row0 + ai * HALF + m * 16) * ldc + col0;
#pragma unroll
                for (int bj = 0; bj < 2; ++bj) { const u32x4 rv = rall[ai][m][bj]; const f32x4 a0 = acc[ai][bj][m][0] * ascale, a1 = acc[ai][bj][m][1] * ascale;
                    u32x4 w;
                    w.x = cvt_pk_bf16(a0[0] + alpha * __builtin_bit_cast(float, rv.x << 16), a0[1] + alpha * __builtin_bit_cast(float, rv.x & 0xffff0000u));
                    w.y = cvt_pk_bf16(a0[2] + alpha * __builtin_bit_cast(float, rv.y << 16), a0[3] + alpha * __builtin_bit_cast(float, rv.y & 0xffff0000u));
                    w.z = cvt_pk_bf16(a1[0] + alpha * __builtin_bit_cast(float, rv.z << 16), a1[1] + alpha * __builtin_bit_cast(float, rv.z & 0xffff0000u));
                    w.w = cvt_pk_bf16(a1[2] + alpha * __builtin_bit_cast(float, rv.w << 16), a1[3] + alpha * __builtin_bit_cast(float, rv.w & 0xffff0000u));
                    *(u32x4*)(O + off + bj * HALF) = w; } }
    }
};
__device__ __forceinline__ unsigned pk4_fp8(float a, float b, float c, float d) { int w = 0; w = __builtin_amdgcn_cvt_pk_fp8_f32(a, b, w, false); w = __builtin_amdgcn_cvt_pk_fp8_f32(c, d, w, true); return (unsigned)w; }
struct EpiSwiglu8 {
    static constexpr bool PERM = true;
    unsigned char* H; const float* b1; float ascale;
    struct Bias { f32x4 v[4]; };
    __device__ __forceinline__ void load_bias(const Unit& u, int wr, int wc, int fr, int fq, Bias& B) const {
        const float* bg = b1 + (size_t)u.e * 2048 + u.pn * HALF + wc * 32 + 8 * fq; const float* bu = bg + 1024;
        B.v[0] = *(const f32x4*)(bg); B.v[1] = *(const f32x4*)(bg + 4); B.v[2] = *(const f32x4*)(bu); B.v[3] = *(const f32x4*)(bu + 4);
    }
    __device__ __forceinline__ void operator()(const f32x4 (&acc)[2][2][4][2], const Unit& u, int wr, int wc, int fr, int fq, const Bias& B) const {
        const int row0 = u.pm * BM + wr * 64 + fr, col0 = u.pn * HALF + wc * 32 + 8 * fq;
        const f32x4 g0 = B.v[0], g1 = B.v[1], u0 = B.v[2], u1 = B.v[3];
#pragma unroll
        for (int ai = 0; ai < 2; ++ai)
#pragma unroll
            for (int m = 0; m < 4; ++m) { unsigned char* rowp = H + (size_t)(row0 + ai * HALF + m * 16) * FF + col0;
                u32x2 w;
#pragma unroll
                for (int n = 0; n < 2; ++n) { f32x4 g = acc[ai][0][m][n] * ascale + (n ? g1 : g0), up = acc[ai][1][m][n] * ascale + (n ? u1 : u0);
#pragma unroll
                    for (int j = 0; j < 4; ++j) { g[j] = fminf(g[j], SW_LIMIT); up[j] = fminf(fmaxf(up[j], -SW_LIMIT), SW_LIMIT); }
                    const f32x4 z = g * (-SW_ALPHA * LOG2E); f32x4 e;
#pragma unroll
                    for (int j = 0; j < 4; ++j) e[j] = __builtin_amdgcn_exp2f(z[j]);
                    const f32x4 d = e + 1.0f; f32x4 r;
#pragma unroll
                    for (int j = 0; j < 4; ++j) r[j] = __builtin_amdgcn_rcpf(d[j]);
                    const f32x4 o = (up + 1.0f) * (g * r);
                    if (n == 0) w.x = pk4_fp8(o[0], o[1], o[2], o[3]); else w.y = pk4_fp8(o[0], o[1], o[2], o[3]); }
                *(u32x2*)rowp = w; }
    }
};
struct EpiExpertOut {
    static constexpr bool PERM = true;
    unsigned char* Y; const float* b2; float ascale;
    struct Bias { f32x4 v[2][2]; };
    __device__ __forceinline__ void load_bias(const Unit& u, int wr, int wc, int fr, int fq, Bias& B) const {
        const float* bb = b2 + (size_t)u.e * D + u.pn * BM + wc * 32 + 8 * fq;
#pragma unroll
        for (int bj = 0; bj < 2; ++bj)
#pragma unroll
            for (int n = 0; n < 2; ++n) B.v[bj][n] = *(const f32x4*)(bb + bj * HALF + 4 * n) * Y_SCALE;
    }
    __device__ __forceinline__ void operator()(const f32x4 (&acc)[2][2][4][2], const Unit& u, int wr, int wc, int fr, int fq, const Bias& B) const {
        const int row0 = u.pm * BM + wr * 64 + fr, col0 = u.pn * BM + wc * 32 + 8 * fq;
        const f32x4 (&bv)[2][2] = B.v; const float sc = ascale * Y_SCALE;
#pragma unroll
        for (int ai = 0; ai < 2; ++ai)
#pragma unroll
            for (int m = 0; m < 4; ++m) { unsigned char* rowp = Y + (size_t)(row0 + ai * HALF + m * 16) * D + col0;
#pragma unroll
                for (int bj = 0; bj < 2; ++bj) { const f32x4 v0 = acc[ai][bj][m][0] * sc + bv[bj][0], v1 = acc[ai][bj][m][1] * sc + bv[bj][1];
                    u32x2 w; w.x = pk4_fp8(v0[0], v0[1], v0[2], v0[3]); w.y = pk4_fp8(v1[0], v1[1], v1[2], v1[3]);
                    *(u32x2*)(rowp + bj * HALF) = w; } }
    }
};
}

#define XB_TMO      128
#define XB_XCNT(j)  (256  + 64 * (j))
#define XB_XSUB(j)  (1280 + 64 * (j))
#define XB_XGEN(j)  (2304 + 64 * (j))
#define XB_TOP      3328
#define XB_TOPGEN   3392
#define XCD_BAR_WORDS 3456
#define XB_SPIN_CAP (1u << 22)
__device__ __forceinline__ unsigned xb_ld(unsigned* p)              { return __hip_atomic_load(p, __ATOMIC_RELAXED, __HIP_MEMORY_SCOPE_AGENT); }
__device__ __forceinline__ unsigned xb_add(unsigned* p, unsigned v) { return __hip_atomic_fetch_add(p, v, __ATOMIC_RELAXED, __HIP_MEMORY_SCOPE_AGENT); }
__device__ __forceinline__ unsigned xb_xcc_id() { return (unsigned)__builtin_amdgcn_s_getreg((3 << 11) | 20) & 0xFu; }
#define XB_SPIN(cond, bar) do { unsigned _sp = 0; while (cond) { __builtin_amdgcn_s_sleep(1); \
    if ((++_sp & 255u) == 0u) { if (xb_ld(&(bar)[XB_TMO])) break; if (_sp > XB_SPIN_CAP) { atomicAdd(&(bar)[XB_TMO], 1u); break; } } } } while (0)
struct XcdBarrier { unsigned* bar; unsigned x; volatile LAS unsigned* st; };
__device__ __forceinline__ XcdBarrier xcd_barrier_post(unsigned* bar, volatile LAS unsigned* st) {
    XcdBarrier b; b.bar = bar; b.x = xb_xcc_id(); b.st = st;
    if (threadIdx.x == 0) (void)xb_add(&bar[XB_XCNT(b.x)], 1u);
    return b;
}
__device__ __forceinline__ void xcd_barrier_complete(unsigned* bar, unsigned x, unsigned& nloc, unsigned& nx) {
    const unsigned G = gridDim.x * gridDim.y * gridDim.z;
    unsigned sum, cnt, mine, sp = 0u;
    for (;;) {
        sum = 0u; cnt = 0u; mine = 0u;
#pragma unroll
        for (unsigned j = 0; j < 16; ++j) { const unsigned c = xb_ld(&bar[XB_XCNT(j)]); sum += c; cnt += (c > 0u) ? 1u : 0u; mine = (j == x) ? c : mine; }
        if (sum == G) break;
        __builtin_amdgcn_s_sleep(1);
        if ((++sp & 255u) == 0u) { if (xb_ld(&bar[XB_TMO])) break; if (sp > XB_SPIN_CAP) { atomicAdd(&bar[XB_TMO], 1u); break; } }
    }
    nloc = mine > 0u ? mine : 1u; nx = cnt > 0u ? cnt : 1u;
}
__device__ __forceinline__ void xcd_barrier(const XcdBarrier& b) {
    asm volatile("s_waitcnt vmcnt(0)" ::: "memory");
    __syncthreads();
    if (threadIdx.x == 0) {
        unsigned* bar = b.bar;
        __builtin_amdgcn_s_waitcnt(0);
        unsigned nloc = b.st[0], nx = b.st[1];
        if (nloc == 0u) { xcd_barrier_complete(bar, b.x, nloc, nx); b.st[0] = nloc; b.st[1] = nx; }
        const unsigned old = xb_add(&bar[XB_XSUB(b.x)], 1u);
        const unsigned gen = old / nloc;
        if (old + 1u == (gen + 1u) * nloc) {
            __builtin_amdgcn_fence(__ATOMIC_RELEASE, "agent");
            asm volatile("s_waitcnt vmcnt(0)" ::: "memory");
            const unsigned og = xb_add(&bar[XB_TOP], 1u);
            const unsigned tg = og / nx;
            if (og + 1u == (tg + 1u) * nx) xb_add(&bar[XB_TOPGEN], 1u);
            else XB_SPIN(xb_ld(&bar[XB_TOPGEN]) == tg, bar);
            __builtin_amdgcn_fence(__ATOMIC_ACQUIRE, "agent");
            xb_add(&bar[XB_XGEN(b.x)], 1u);
            asm volatile("s_waitcnt vmcnt(0)" ::: "memory");
        } else {
            XB_SPIN(xb_ld(&bar[XB_XGEN(b.x)]) == gen, bar);
            __builtin_amdgcn_fence(__ATOMIC_ACQUIRE, "agent");
            asm volatile("s_waitcnt vmcnt(0)" ::: "memory");
        }
    }
    __syncthreads();
}

struct Args {
    const float* x; const float* emb_g; const float* emb_b; const float* w_in; const float* b_in; const float* conv_w; const float* ml_nw; const float* ret_nw;
    const float* w_out; const float* ln1_g; const float* ln1_b; const float* w_router; const float* b_router; const float* w1; const float* b1; const float* w2; const float* b2;
    const float* ln2_g; const float* ln2_b;
    float* out; unsigned char* ws; int ph_lo, ph_hi;
};
template <class Tp> __device__ __forceinline__ Tp* as_global(Tp* p) { return (Tp*)(__attribute__((address_space(1))) Tp*)p; }
__device__ __forceinline__ int as_global(int v) { return v; }
#define KA(f) as_global(((const volatile __attribute__((address_space(4))) Args*)__builtin_amdgcn_kernarg_segment_ptr())->f)
constexpr int NWAVES = 8, NTHR = 512;
constexpr int NPH_LAYER = 9;
constexpr int NPH = 1 + NL * NPH_LAYER;

struct Frame {
    LAS unsigned char* lds;
    unsigned* ctl;
    int tid, lane, wave, G, bid;
};

__device__ __forceinline__ int sidx(int b, int h, int dir, int c) { return ((b * NH + h) * 2 + dir) * NCH + c; }

template <class RowMap>
__device__ __forceinline__ void transpose_item(const float* W, int K, int Nsrc, bf16_t* WT, LAS float* scr, int kb, int nb, int lane, const RowMap& rm, int coff = 0) {
    const int k0 = 64 * kb, n0 = 32 * nb;
    const int nn = n0 + (lane & 31) + coff;
    float tv[32];
#pragma unroll
    for (int i = 0; i < 32; ++i) { const int kk = 2 * i + (lane >> 5); tv[i] = nn < Nsrc ? __builtin_nontemporal_load(W + (size_t)(k0 + kk) * Nsrc + nn) : 0.f; }
#pragma unroll
    for (int i = 0; i < 32; ++i) { const int kk = 2 * i + (lane >> 5); scr[kk * 33 + (lane & 31)] = tv[i]; }
    asm volatile("s_waitcnt lgkmcnt(0)" ::: "memory");
    const int c = lane & 7;
#pragma unroll
    for (int j = 0; j < 4; ++j) { const int n = (lane >> 3) + 8 * j; const LAS float* s = scr + (8 * c) * 33 + n;
        u32x4 o; o.x = pk2(s[0 * 33], s[1 * 33]); o.y = pk2(s[2 * 33], s[3 * 33]); o.z = pk2(s[4 * 33], s[5 * 33]); o.w = pk2(s[6 * 33], s[7 * 33]);
        *(u32x4*)(WT + (size_t)rm(n0 + n) * K + k0 + 8 * c) = o; }
    asm volatile("s_waitcnt lgkmcnt(0)" ::: "memory");
}
template <class RowMap>
__device__ __forceinline__ void transpose_item_f8(const float* W, int K, int Nsrc, unsigned char* WT, LAS float* scr, int kb, int nb, int lane, const RowMap& rm, float scale) {
    const int k0 = 64 * kb, n0 = 32 * nb;
    const int nn = n0 + (lane & 31);
    float tv[32];
#pragma unroll
    for (int i = 0; i < 32; ++i) { const int kk = 2 * i + (lane >> 5); tv[i] = __builtin_nontemporal_load(W + (size_t)(k0 + kk) * Nsrc + nn); }
#pragma unroll
    for (int i = 0; i < 32; ++i) { const int kk = 2 * i + (lane >> 5); scr[kk * 33 + (lane & 31)] = tv[i] * scale; }
    asm volatile("s_waitcnt lgkmcnt(0)" ::: "memory");
    const int c = lane & 7;
#pragma unroll
    for (int j = 0; j < 4; ++j) { const int n = (lane >> 3) + 8 * j; const LAS float* sp = scr + (8 * c) * 33 + n;
        u32x2 o; o.x = pg8::pk4_fp8(sp[0 * 33], sp[1 * 33], sp[2 * 33], sp[3 * 33]); o.y = pg8::pk4_fp8(sp[4 * 33], sp[5 * 33], sp[6 * 33], sp[7 * 33]);
        *(u32x2*)(WT + (size_t)rm(n0 + n) * K + k0 + 8 * c) = o; }
    asm volatile("s_waitcnt lgkmcnt(0)" ::: "memory");
}
template <class RowMap>
__device__ __forceinline__ void transpose_item128_f8(const float* W, int K, int Nsrc, unsigned char* WT, LAS unsigned* scr, int kb, int nb, int lane, const RowMap& rm, float scale, int coff = 0) {
    const int k0 = 128 * kb, n0 = 32 * nb, n4 = lane & 7, kq = lane >> 3; const bool inb = n0 + 4 * n4 + coff < Nsrc;
    f32x4 x[4][4];
#pragma unroll
    for (int it = 0; it < 4; ++it)
#pragma unroll
        for (int r = 0; r < 4; ++r) x[it][r] = inb ? __builtin_nontemporal_load((const f32x4*)(W + (size_t)(k0 + 32 * it + 4 * kq + r) * Nsrc + n0 + 4 * n4 + coff)) : (f32x4){0.f, 0.f, 0.f, 0.f};
#pragma unroll
    for (int it = 0; it < 4; ++it)
#pragma unroll
        for (int j = 0; j < 4; ++j) scr[(4 * n4 + j) * 33 + 8 * it + kq] = pg8::pk4_fp8(x[it][0][j] * scale, x[it][1][j] * scale, x[it][2][j] * scale, x[it][3][j] * scale);
    asm volatile("s_waitcnt lgkmcnt(0)" ::: "memory");
#pragma unroll
    for (int q = 0; q < 4; ++q) { const int n = 8 * q + (lane >> 3), c = lane & 7; const LAS unsigned* sp = scr + n * 33 + 4 * c;
        u32x4 o; o.x = sp[0]; o.y = sp[1]; o.z = sp[2]; o.w = sp[3];
        *(u32x4*)(WT + (size_t)rm(n0 + n) * K + k0 + 16 * c) = o; }
    asm volatile("s_waitcnt lgkmcnt(0)" ::: "memory");
}
struct RowId { __device__ __forceinline__ int operator()(int n) const { return n; } };
struct RowW1 { __device__ __forceinline__ int operator()(int n) const { const int up = n >> 10, j = n & 1023; return (j >> 7) * 256 + up * 128 + (j & 127); } };

__device__ __forceinline__ void ln_row(const f32x4 (&vin)[4], const float* g, const float* b, float* of, bf16_t* ob, float* of2, int lane, unsigned char* oq = nullptr) {
    f32x4 v[4]; float s = 0.f;
#pragma unroll
    for (int j = 0; j < 4; ++j) { v[j] = vin[j]; s += (v[j].x + v[j].y) + (v[j].z + v[j].w); }
    const float mean = wave_sum(s) * (1.f / D); float s2 = 0.f;
#pragma unroll
    for (int j = 0; j < 4; ++j) { v[j] = v[j] - mean; s2 += (v[j].x * v[j].x + v[j].y * v[j].y) + (v[j].z * v[j].z + v[j].w * v[j].w); }
    const float rstd = 1.f / sqrtf(wave_sum(s2) * (1.f / D) + LN_EPS);
#pragma unroll
    for (int j = 0; j < 4; ++j) { const f32x4 gg = *(const f32x4*)(g + 4 * lane + 256 * j), bb = *(const f32x4*)(b + 4 * lane + 256 * j);
        const f32x4 o = v[j] * rstd * gg + bb;
        if (of) *(f32x4*)(of + 4 * lane + 256 * j) = o;
        if (of2) *(f32x4*)(of2 + 4 * lane + 256 * j) = o;
        if (ob) { u32x2 w; w.x = pk2(o.x, o.y); w.y = pk2(o.z, o.w); *(u32x2*)(ob + 4 * lane + 256 * j) = w; }
        if (oq) { const f32x4 q = o * XQ_SCALE; *(unsigned*)(oq + 4 * lane + 256 * j) = pg8::pk4_fp8(q.x, q.y, q.z, q.w); } }
}

__device__ __forceinline__ void p0_prologue(const Frame& F, const Args& a) {
    unsigned char* ws = KA(ws);
    LAS float* scr = (LAS float*)(F.lds + F.wave * 16384);
    const int gw = F.bid * NWAVES + F.wave, NGW = F.G * NWAVES;
    const float* w_in_ = KA(w_in); const float* w_out_ = KA(w_out); const float* w1_ = KA(w1); const float* w2_ = KA(w2);
    constexpr int I_INQ = NL * 8 * 80; constexpr int I_IN = NL * 16 * 80, I_OUT = NL * 8 * 32, I_W1 = NL * NE * 8 * 64, I_W2 = NL * NE * 8 * 32;
    for (int it = gw; it < I_INQ + I_IN + I_OUT + I_W1 + I_W2; it += NGW) {
        int r = it;
        if (r < I_INQ) { const int l = r / (8 * 80), q = r % (8 * 80); transpose_item128_f8(w_in_ + (size_t)l * D * PW, D, PW, (unsigned char*)(ws + WS_WINQ) + (size_t)l * PWP * D, (LAS unsigned*)scr, q / 80, q % 80, F.lane, RowId(), WINQ_SCALE, PWF); continue; } r -= I_INQ;
        if (r < I_IN) { const int l = r / (16 * 80), q = r % (16 * 80); transpose_item(w_in_ + (size_t)l * D * PW, D, PW, (bf16_t*)(ws + WS_WIN) + (size_t)l * PWP * D, scr, q / 80, q % 80, F.lane, RowId(), PWF); continue; } r -= I_IN;
        if (r < I_OUT) { const int l = r / (8 * 32), q = r % (8 * 32); transpose_item128_f8(w_out_ + (size_t)l * D * D, D, D, (unsigned char*)(ws + WS_WOUT) + (size_t)l * D * D, (LAS unsigned*)scr, q / 32, q % 32, F.lane, RowId(), WOUT_SCALE); continue; } r -= I_OUT;
        if (r < I_W1) { const int le = r / (8 * 64), q = r % (8 * 64); transpose_item128_f8(w1_ + (size_t)le * D * 2048, D, 2048, (unsigned char*)(ws + WS_W1) + (size_t)le * 2048 * D, (LAS unsigned*)scr, q / 64, q % 64, F.lane, RowW1(), W1_SCALE); continue; } r -= I_W1;
        { const int le = r / (8 * 32), q = r % (8 * 32); transpose_item128_f8(w2_ + (size_t)le * FF * D, FF, D, (unsigned char*)(ws + WS_W2) + (size_t)le * D * FF, (LAS unsigned*)scr, q / 32, q % 32, F.lane, RowId(), W2_SCALE); }
    }
    const int gt = F.bid * NTHR + F.tid, NGT = F.G * NTHR;
    float* binp = (float*)(ws + WS_BIN); const float* bin_ = KA(b_in);
    for (int i = gt; i < NL * PWP; i += NGT) { const int l = i / PWP, c = i % PWP; binp[i] = c < PW2 ? bin_[l * PW + PWF + c] : 0.f; }
    { bf16_t* WF = (bf16_t*)(ws + WS_WF); float* bF = (float*)(ws + WS_FG + FG_BF_OFF);
      {
        LAS float* wr8 = scr;
        LAS float* tab = scr + 2048;
        tab[F.lane] = __builtin_amdgcn_cosf((float)F.lane * (1.0f / 64.0f)); tab[64 + F.lane] = __builtin_amdgcn_sinf((float)F.lane * (1.0f / 64.0f));
        for (int rg = gw; rg < NL * D / 8; rg += NGW) { const int l = rg / (D / 8), k0 = (rg % (D / 8)) * 8;
#pragma unroll
            for (int kr = 0; kr < 8; ++kr) *(LAS f32x4*)(wr8 + kr * 256 + 4 * F.lane) = *(const f32x4*)(w_in_ + ((size_t)l * D + k0 + kr) * PW + 4 * F.lane);
            asm volatile("s_waitcnt lgkmcnt(0)" ::: "memory");
#pragma unroll 1
            for (int q = 0; q < 8; ++q) { const int cs = q >> 2, g = q & 3; float acc[8];
#pragma unroll
                for (int kr = 0; kr < 8; ++kr) acc[kr] = 0.f;
#pragma unroll 4
                for (int c = 0; c < 64; ++c) { const float tv = tab[cs * 64 + ((c * F.lane) & 63)];
#pragma unroll
                    for (int kr = 0; kr < 8; ++kr) acc[kr] += wr8[kr * 256 + g * 64 + c] * tv; }
                u32x4 o; o.x = pk2(acc[0], acc[1]); o.y = pk2(acc[2], acc[3]); o.z = pk2(acc[4], acc[5]); o.w = pk2(acc[6], acc[7]);
                *(u32x4*)(WF + ((size_t)l * 512 + cs * 256 + g * 64 + F.lane) * D + k0) = o;
                u32x2 oq; oq.x = pg8::pk4_fp8(acc[0] * WFQ_SCALE, acc[1] * WFQ_SCALE, acc[2] * WFQ_SCALE, acc[3] * WFQ_SCALE); oq.y = pg8::pk4_fp8(acc[4] * WFQ_SCALE, acc[5] * WFQ_SCALE, acc[6] * WFQ_SCALE, acc[7] * WFQ_SCALE);
                *(u32x2*)((unsigned char*)(ws + WS_WFQ) + ((size_t)l * 512 + cs * 256 + g * 64 + F.lane) * D + k0) = oq; }
            asm volatile("s_waitcnt lgkmcnt(0)" ::: "memory"); } }
      for (int i = gt; i < NL * 512; i += NGT) { const int l = i / 512, r = i % 512, cs = r >> 8, g = (r >> 6) & 3, cp = r & 63; float acc = 0.f;
          for (int c = 0; c < 64; ++c) { const float rev = (float)((c * cp) & 63) * (1.0f / 64.0f); acc += bin_[l * PW + g * 64 + c] * (cs ? __builtin_amdgcn_sinf(rev) : __builtin_amdgcn_cosf(rev)); }
          bF[i] = acc; }
      bf16_t* Gm = (bf16_t*)(ws + WS_FG);
      for (int i = gt; i < 128 * 128; i += NGT) { const int ro = i >> 13, k1 = (i >> 7) & 63, ri = (i >> 6) & 1, s1 = i & 63; const float rev = (float)((k1 * s1) & 63) * (1.0f / 64.0f);
          const float c = __builtin_amdgcn_cosf(rev), sn = __builtin_amdgcn_sinf(rev); Gm[i] = (bf16_t)f2bf(ro == 0 ? (ri == 0 ? c : -sn) : (ri == 0 ? -sn : -c)); }
      bf16_t* Hm = (bf16_t*)(ws + WS_FG + FG_H_OFF);
      for (int i = gt; i < 128 * 256; i += NGT) { const int k2 = i >> 8, ri = (i >> 7) & 1, s2 = i & 127; const float rev = (float)((k2 * s2) & 127) * (1.0f / 128.0f);
          Hm[i] = (bf16_t)f2bf(0.0013810679320049757f * (ri ? __builtin_amdgcn_sinf(rev) : __builtin_amdgcn_cosf(rev))); } }
    float* rot = (float*)(ws + WS_ROT);
    for (int i = gt; i < S * 24; i += NGT) { const int pos = i / 24, j = i % 24; const float inv = 1.0f / powf(10000.0f, (float)(2 * j) / 48.0f); const float ang = (float)pos * inv;
        float sn, cs; sincosf(ang, &sn, &cs); rot[2 * i] = cs; rot[2 * i + 1] = sn; }
    float* xf = (float*)(ws + WS_XF); bf16_t* xb = (bf16_t*)(ws + WS_XB); const float* xin = KA(x); const float* eg = KA(emb_g); const float* eb = KA(emb_b);
    for (int m = gw; m < T; m += NGW) { f32x4 v[4];
#pragma unroll
        for (int j = 0; j < 4; ++j) v[j] = *(const f32x4*)(xin + (size_t)m * D + 4 * F.lane + 256 * j);
        ln_row(v, eg, eb, nullptr, xb + (size_t)m * D, nullptr, F.lane, (unsigned char*)(ws + WS_XQ) + (size_t)m * D); }
    { float* wrt = (float*)(ws + WS_BIN + WRT_OFF); const float* wrs = KA(w_router);
      for (int i = gt; i < NL * NE * D; i += NGT) { const int l = i / (NE * D), e = (i / D) % NE, k = i % D; wrt[i] = wrs[((size_t)l * D + k) * NE + e]; } }
}

template <bool REV, bool MAXOP> __device__ __forceinline__ void scan2(float& x0, float& x1, int lane) {
    float s = MAXOP ? fmaxf(x0, x1) : x0 + x1;
#pragma unroll
    for (int o = 1; o < 64; o <<= 1) { const float t = REV ? __shfl_down(s, o) : __shfl_up(s, o); const bool ok = REV ? (lane + o < 64) : (lane >= o); if (ok) s = MAXOP ? fmaxf(s, t) : s + t; }
    float ex = REV ? __shfl_down(s, 1) : __shfl_up(s, 1); if (REV ? lane == 63 : lane == 0) ex = MAXOP ? -INFINITY : 0.f;
    if (!REV) { x0 = MAXOP ? fmaxf(ex, x0) : ex + x0; x1 = MAXOP ? fmaxf(x0, x1) : x0 + x1; }
    else      { x1 = MAXOP ? fmaxf(ex, x1) : ex + x1; x0 = MAXOP ? fmaxf(x1, x0) : x1 + x0; }
}
__device__ __forceinline__ float ret_lg(int h, float off) {
    return off == 0.f ? (h == 0 ? -0.0317486983145803f : h == 1 ? -0.015748356968139168f : h == 2 ? -0.007843177461025893f : -0.003913899321136329f)
                      : (h == 0 ? -0.02234488474624582f : h == 1 ? -0.01111003193719751f : h == 2 ? -0.005539586946744796f : -0.002765957600334473f);
}

typedef short s16x4 __attribute__((ext_vector_type(4)));
__device__ __forceinline__ bf16x8 tr_frag(const LAS bf16_t* tile, int stride, int row0, int col0, int lane) {
    const LAS bf16_t* a0 = tile + (row0 + 8 * (lane >> 4) + ((lane & 15) >> 2)) * stride + col0 + 4 * (lane & 3);
    const s16x4 lo = __builtin_amdgcn_ds_read_tr16_b64_v4i16((LAS s16x4*)a0);
    const s16x4 hi = __builtin_amdgcn_ds_read_tr16_b64_v4i16((LAS s16x4*)(a0 + 4 * stride));
    return (bf16x8){lo[0], lo[1], lo[2], lo[3], hi[0], hi[1], hi[2], hi[3]};
}
constexpr int QKS = 72, VSS = 104, WSS = 136, KPS = 56;

__device__ __forceinline__ void qk_chunk8(const bf16_t* P, const float* convw, const float* rot, int type, int b, int s, int h, int isk, int cc, float (&o)[8]) {
    if (type == 0) {
        const int ch0 = isk * 192 + h * DK + 8 * cc;
        const bf16_t* p0 = P + (size_t)(b * S + s) * PWP + COL_MQK + ch0;
        const u32x4 z = (u32x4){0u, 0u, 0u, 0u};
        const u32x4 xm = s > 0 ? *(const u32x4*)(p0 - PWP) : z, x0 = *(const u32x4*)p0, xp = s < S - 1 ? *(const u32x4*)(p0 + PWP) : z;
        const float* w = convw + ch0;
        const f32x4 w0a = *(const f32x4*)w, w0b = *(const f32x4*)(w + 4), w1a = *(const f32x4*)(w + 384), w1b = *(const f32x4*)(w + 388), w2a = *(const f32x4*)(w + 768), w2b = *(const f32x4*)(w + 772);
#pragma unroll
        for (int i = 0; i < 4; ++i) { const unsigned am = xm[i], a0 = x0[i], ap = xp[i];
            const float wl0 = i < 2 ? w0a[2 * i] : w0b[2 * i - 4], wh0 = i < 2 ? w0a[2 * i + 1] : w0b[2 * i - 3];
            const float wl1 = i < 2 ? w1a[2 * i] : w1b[2 * i - 4], wh1 = i < 2 ? w1a[2 * i + 1] : w1b[2 * i - 3];
            const float wl2 = i < 2 ? w2a[2 * i] : w2b[2 * i - 4], wh2 = i < 2 ? w2a[2 * i + 1] : w2b[2 * i - 3];
            const float lo = __builtin_bit_cast(float, am << 16) * wl0 + __builtin_bit_cast(float, a0 << 16) * wl1 + __builtin_bit_cast(float, ap << 16) * wl2;
            const float hi = __builtin_bit_cast(float, am & 0xffff0000u) * wh0 + __builtin_bit_cast(float, a0 & 0xffff0000u) * wh1 + __builtin_bit_cast(float, ap & 0xffff0000u) * wh2;
            o[2 * i] = siluf_(lo); o[2 * i + 1] = siluf_(hi); }
    } else {
        const u32x4 x0 = *(const u32x4*)(P + (size_t)(b * S + s) * PWP + (isk ? COL_RK : COL_RQ) + h * DK + 8 * cc);
        const float* rp = rot + (size_t)(s * 24 + 4 * cc) * 2;
        const f32x4 ra = *(const f32x4*)rp, rb = *(const f32x4*)(rp + 4);
#pragma unroll
        for (int i = 0; i < 4; ++i) { const float t1 = __builtin_bit_cast(float, x0[i] << 16), t2 = __builtin_bit_cast(float, x0[i] & 0xffff0000u);
            const float cs = i < 2 ? ra[2 * i] : rb[2 * i - 4], sn = i < 2 ? ra[2 * i + 1] : rb[2 * i - 3];
            o[2 * i] = t1 * cs - t2 * sn; o[2 * i + 1] = t1 * sn + t2 * cs; }
    }
}
__device__ __forceinline__ void load_qk(const Frame& F, const bf16_t* P, const float* convw, const float* rot, int type, int b, int c, int h, float kscale, LAS bf16_t* Qs, LAS bf16_t* Ks) {
#pragma unroll
    for (int it = 0; it < 3; ++it) { const int item = F.tid + NTHR * it, j = item / 12, ck = item % 12, isk = ck >= 6, cc = isk ? ck - 6 : ck;
        float o[8]; qk_chunk8(P, convw, rot, type, b, c * CH + j, h, isk, cc, o);
        const float sc = isk ? kscale : 1.0f;
        u32x4 w; w.x = pk2(o[0] * sc, o[1] * sc); w.y = pk2(o[2] * sc, o[3] * sc); w.z = pk2(o[4] * sc, o[5] * sc); w.w = pk2(o[6] * sc, o[7] * sc);
        *(LAS u32x4*)((isk ? Ks : Qs) + j * QKS + 8 * cc) = w; }
}
__device__ __forceinline__ void load_v(const Frame& F, const bf16_t* P, int type, int t0, int h, LAS bf16_t* Vs) {
    u32x4 vv[3];
#pragma unroll
    for (int it = 0; it < 3; ++it) { const int idx = F.tid + NTHR * it, j = idx / 12, vc = idx % 12; vv[it] = *(const u32x4*)(P + (size_t)(t0 + j) * PWP + (type ? COL_RV : COL_MV) + h * DV + 8 * vc); }
#pragma unroll
    for (int it = 0; it < 3; ++it) { const int idx = F.tid + NTHR * it, j = idx / 12, vc = idx % 12; *(LAS u32x4*)(Vs + j * VSS + 8 * vc) = vv[it]; }
}

__device__ __forceinline__ void phaseB_mfma(const Frame& F0, const Args& a, int l, int u) {
    Frame F = F0; asm volatile("" : "+v"(F.tid), "+v"(F.lane)); asm volatile("" : "+s"(F.wave));
    unsigned char* ws = KA(ws);
    const bf16_t* P = (const bf16_t*)(ws + WS_P);
    const int type = u >> 10, r_ = u & 1023, b = r_ >> 8, c = (r_ >> 2) & 63, h = r_ & 3;
    LAS bf16_t* Kf = (LAS bf16_t*)F.lds;
    LAS bf16_t* Kb = Kf + 128 * KPS;
    LAS bf16_t* Vs = Kb + 128 * KPS;
    LAS float* ga = (LAS float*)(Vs + 128 * VSS);
    LAS float* lff = ga, *lfb = ga + 128, *iff = ga + 256, *ibb = ga + 384, *pf = ga + 512, *pb = ga + 640, *scal = ga + 768;
    const int t0 = b * S + c * CH;
    const float kscale = 0.14433756729740643f;
    const float* rot = (const float*)(ws + WS_ROT);
    const float* convw = KA(conv_w) + (size_t)l * 3 * 384;
    float* msc = (float*)(ws + WS_MSC);
    load_v(F, P, type, t0, h, Vs);
    { float pf0, pf1, pb0, pb1;
      if (type == 0) {
        const bf16_t* g0 = P + (size_t)(t0 + 2 * F.lane) * PWP + COL_MG; const bf16_t* g1 = g0 + PWP;
        const float if0 = bf2f(g0[h]), if1 = bf2f(g1[h]), ib0 = bf2f(g0[8 + h]), ib1 = bf2f(g1[8 + h]);
        float af0 = logsigmoidf_(bf2f(g0[4 + h])), af1 = logsigmoidf_(bf2f(g1[4 + h])), ab0 = logsigmoidf_(bf2f(g0[12 + h])), ab1 = logsigmoidf_(bf2f(g1[12 + h]));
        scan2<false, false>(af0, af1, F.lane); scan2<true, false>(ab0, ab1, F.lane);
        const float aend_f = __shfl(af1, 63), aend_b = __shfl(ab0, 0);
        pf0 = aend_f - af0 + if0; pf1 = aend_f - af1 + if1; pb0 = aend_b - ab0 + ib0; pb1 = aend_b - ab1 + ib1;
        const float mf = wave_max(fmaxf(pf0, pf1)), mb = wave_max(fmaxf(pb0, pb1));
        pf0 = __expf(pf0 - mf); pf1 = __expf(pf1 - mf); pb0 = __expf(pb0 - mb); pb1 = __expf(pb1 - mb);
        if (F.tid == 0) { msc[sidx(b, h, 0, c)] = mf; msc[sidx(b, h, 1, c)] = mb; msc[2048 + sidx(b, h, 0, c)] = aend_f; msc[2048 + sidx(b, h, 1, c)] = aend_b; }
      } else {
        const float lgf = ret_lg(h, 0.f), lgb = ret_lg(h, 0.5f);
        pf0 = __expf(lgf * (float)(127 - 2 * F.lane)); pf1 = __expf(lgf * (float)(126 - 2 * F.lane)); pb0 = __expf(lgb * (float)(2 * F.lane)); pb1 = __expf(lgb * (float)(2 * F.lane + 1));
      }
      *(LAS f32x2*)(pf + 2 * F.lane) = (f32x2){pf0, pf1}; *(LAS f32x2*)(pb + 2 * F.lane) = (f32x2){pb0, pb1}; }
#pragma unroll
    for (int it = 0; it < 2; ++it) { const int item = F.tid + NTHR * it;
        if (item < 128 * 6) { const int j = item / 6, cc = item % 6; float o[8]; qk_chunk8(P, convw, rot, type, b, c * CH + j, h, 1, cc, o);
            const float sf = kscale * pf[j], sb = kscale * pb[j];
            u32x4 w; w.x = pk2(o[0] * sf, o[1] * sf); w.y = pk2(o[2] * sf, o[3] * sf); w.z = pk2(o[4] * sf, o[5] * sf); w.w = pk2(o[6] * sf, o[7] * sf);
            *(LAS u32x4*)(Kf + j * KPS + 8 * cc) = w;
            w.x = pk2(o[0] * sb, o[1] * sb); w.y = pk2(o[2] * sb, o[3] * sb); w.z = pk2(o[4] * sb, o[5] * sb); w.w = pk2(o[6] * sb, o[7] * sb);
            *(LAS u32x4*)(Kb + j * KPS + 8 * cc) = w; } }
    __syncthreads();
    float* X = (float*)(ws + (type ? WS_RS : WS_MC));
    const int l15 = F.lane & 15, lq = F.lane >> 4;
    for (int tt = F.wave; tt < 36; tt += NWAVES) { const int dir = tt / 18, mt = (tt % 18) / 6, nt = tt % 6; const LAS bf16_t* Ksrc = dir ? Kb : Kf;
        f32x4 acc = (f32x4){0.f, 0.f, 0.f, 0.f};
#pragma unroll
        for (int ks = 0; ks < 4; ++ks) { const bf16x8 af = tr_frag(Ksrc, KPS, 32 * ks, 16 * mt, F.lane), bfv = tr_frag(Vs, VSS, 32 * ks, 16 * nt, F.lane);
            acc = __builtin_amdgcn_mfma_f32_16x16x32_bf16(af, bfv, acc, 0, 0, 0); }
        *(f32x4*)(X + (size_t)sidx(b, h, dir, c) * (DV * DK) + (16 * nt + l15) * DK + 16 * mt + 4 * lq) = acc; }
    if (type == 0 && F.tid < 2 * DK) { const int dir = F.tid / DK, kk = F.tid % DK; const LAS bf16_t* Ksrc = dir ? Kb : Kf; float sN = 0.f;
        for (int j = 0; j < 128; ++j) sN += bf2f(Ksrc[j * KPS + kk]);
        ((float*)(ws + WS_MN))[(size_t)sidx(b, h, dir, c) * DK + kk] = sN; }
    __syncthreads();
}

__device__ __forceinline__ void phaseD_mfma(const Frame& F0, const Args& a, int l, int u) {
    Frame F = F0; asm volatile("" : "+v"(F.tid), "+v"(F.lane)); asm volatile("" : "+s"(F.wave));
    unsigned char* ws = KA(ws);
    const bf16_t* P = (const bf16_t*)(ws + WS_P); unsigned char* mix = (unsigned char*)(ws + WS_MIX);
    const int type = u >> 10, r_ = u & 1023, b = r_ >> 8, c = (r_ >> 2) & 63, h = r_ & 3;
    LAS bf16_t* Qs = (LAS bf16_t*)F.lds;
    LAS bf16_t* Ks = Qs + 128 * QKS;
    LAS bf16_t* Vs = Ks + 128 * QKS;
    LAS bf16_t* Wm = Vs + 128 * VSS;
    LAS bf16_t* Cf = Wm + 128 * WSS;
    LAS bf16_t* Cb = Cf + 96 * QKS;
    LAS float* ar = (LAS float*)(Cb + 96 * QKS);
    LAS float* af = ar, *ab = ar + 128, *iff = ar + 256, *ibb = ar + 384, *gxf = ar + 512, *gxb = ar + 640, *mtf = ar + 768, *mtb = ar + 896;
    static_assert((128 * QKS * 2 + 128 * VSS + 128 * WSS + 2 * 96 * QKS) * 2 + 8 * 128 * 4 <= RING_BYTES, "phase D LDS");
    const int t0 = b * S + c * CH;
    const float kscale = 0.14433756729740643f;
    const float* rot = (const float*)(ws + WS_ROT);
    const float* convw = KA(conv_w) + (size_t)l * 3 * 384;
#if PROBE_MASK & 0xF000
    unsigned long long dts_ = __builtin_amdgcn_s_memrealtime();
#define DSEC(bit) do { if (PROBE_MASK & (bit)) { const unsigned long long d_ = __builtin_amdgcn_s_memrealtime() - dts_; while (__builtin_amdgcn_s_memrealtime() - dts_ < 2 * d_) __builtin_amdgcn_s_sleep(2); } dts_ = __builtin_amdgcn_s_memrealtime(); } while (0)
#else
#define DSEC(bit) do { } while (0)
#endif
    const int w = F.wave, l15 = F.lane & 15, lq = F.lane >> 4, j = 16 * w + l15;
    float npfv[12], npbv[12];
    if (type == 0) { const float* npf = (const float*)(ws + WS_MN) + (size_t)sidx(b, h, 0, c) * DK + 12 * lq; const float* npb = (const float*)(ws + WS_MN) + (size_t)sidx(b, h, 1, c) * DK + 12 * lq;
#pragma unroll
        for (int q4 = 0; q4 < 3; ++q4) { const f32x4 x = *(const f32x4*)(npf + 4 * q4), y = *(const f32x4*)(npb + 4 * q4);
#pragma unroll
            for (int e = 0; e < 4; ++e) { npfv[4 * q4 + e] = x[e]; npbv[4 * q4 + e] = y[e]; } } }
    u32x2 gtw[6]; f32x4 nwv[6];
    { const bf16_t* prow = P + (size_t)(t0 + j) * PWP + (type ? COL_RG : COL_MO) + h * DV + 4 * lq;
      const float* nwp = (type ? KA(ret_nw) : KA(ml_nw)); const float* nw = nwp + (size_t)l * 384 + h * DV + 4 * lq;
#pragma unroll
      for (int n = 0; n < 6; ++n) { gtw[n] = *(const u32x2*)(prow + 16 * n); nwv[n] = *(const f32x4*)(nw + 16 * n); } }
    load_qk(F, P, convw, rot, type, b, c, h, kscale, Qs, Ks);
    load_v(F, P, type, t0, h, Vs);
    {
      for (int idx = F.tid; idx < 448 * 2; idx += NTHR) { const int rr = idx >> 1, hh = idx & 1; LAS bf16_t* base = rr < 128 ? Qs + rr * QKS : rr < 256 ? Ks + (rr - 128) * QKS : rr < 352 ? Cf + (rr - 256) * QKS : Cb + (rr - 352) * QKS;
          *(LAS u32x4*)(base + 48 + 8 * hh) = (u32x4){0u, 0u, 0u, 0u}; }
      const bf16_t* Cg = (const bf16_t*)(ws + (type ? WS_CBR : WS_CBM));
#pragma unroll
      for (int it = 0; it < 3; ++it) { const int idx = F.tid + NTHR * it; if (idx < 2 * 96 * 6) { const int dir = idx / (96 * 6), rem = idx % (96 * 6), v = rem / 6, ch = rem % 6;
          *(LAS u32x4*)((dir ? Cb : Cf) + v * QKS + 8 * ch) = *(const u32x4*)(Cg + (size_t)sidx(b, h, dir, c) * (DV * DK) + v * DK + 8 * ch); } } }
#if PROBE_MASK & 0xF000
    asm volatile("s_waitcnt vmcnt(0) lgkmcnt(0)" ::: "memory"); DSEC(0x1000);
#endif
    float mpf = 0.f, mpb = 0.f;
    if (type == 0) {
        const float* msc = (const float*)(ws + WS_MSC);
        mpf = msc[4096 + sidx(b, h, 0, c)]; mpb = msc[4096 + sidx(b, h, 1, c)];
        const bf16_t* g0 = P + (size_t)(t0 + 2 * F.lane) * PWP + COL_MG; const bf16_t* g1 = g0 + PWP;
        const float if0 = bf2f(g0[h]), if1 = bf2f(g1[h]), ib0 = bf2f(g0[8 + h]), ib1 = bf2f(g1[8 + h]);
        float af0 = logsigmoidf_(bf2f(g0[4 + h])), af1 = logsigmoidf_(bf2f(g1[4 + h])), ab0 = logsigmoidf_(bf2f(g0[12 + h])), ab1 = logsigmoidf_(bf2f(g1[12 + h]));
        scan2<false, false>(af0, af1, F.lane); scan2<true, false>(ab0, ab1, F.lane);
        float gf0 = if0 - af0, gf1 = if1 - af1, gb0 = ib0 - ab0, gb1 = ib1 - ab1;
        scan2<false, true>(gf0, gf1, F.lane); scan2<true, true>(gb0, gb1, F.lane);
        *(LAS f32x2*)(af + 2 * F.lane) = (f32x2){af0, af1}; *(LAS f32x2*)(ab + 2 * F.lane) = (f32x2){ab0, ab1};
        *(LAS f32x2*)(gxf + 2 * F.lane) = (f32x2){(if0 - af0) * LOG2E, (if1 - af1) * LOG2E}; *(LAS f32x2*)(gxb + 2 * F.lane) = (f32x2){(ib0 - ab0) * LOG2E, (ib1 - ab1) * LOG2E};
        *(LAS f32x2*)(mtf + 2 * F.lane) = (f32x2){fmaxf(af0 + mpf, af0 + gf0), fmaxf(af1 + mpf, af1 + gf1)};
        *(LAS f32x2*)(mtb + 2 * F.lane) = (f32x2){fmaxf(ab0 + mpb, ab0 + gb0), fmaxf(ab1 + mpb, ab1 + gb1)};
    }
    __syncthreads();
    DSEC(0x2000);
    bf16x8 qf[2];
#pragma unroll
    for (int ks = 0; ks < 2; ++ks) qf[ks] = *(const LAS bf16x8*)(Qs + j * QKS + 32 * ks + 8 * lq);
    f32x4 If[6], Ib[6];
#pragma unroll
    for (int n = 0; n < 6; ++n) { If[n] = (f32x4){0.f, 0.f, 0.f, 0.f}; Ib[n] = (f32x4){0.f, 0.f, 0.f, 0.f};
#pragma unroll
        for (int ks = 0; ks < 2; ++ks) { const bf16x8 cf = *(const LAS bf16x8*)(Cf + (16 * n + l15) * QKS + 32 * ks + 8 * lq), cb = *(const LAS bf16x8*)(Cb + (16 * n + l15) * QKS + 32 * ks + 8 * lq);
            If[n] = __builtin_amdgcn_mfma_f32_16x16x32_bf16(cf, qf[ks], If[n], 0, 0, 0); Ib[n] = __builtin_amdgcn_mfma_f32_16x16x32_bf16(cb, qf[ks], Ib[n], 0, 0, 0); } }
    f32x4 St[8];
#pragma unroll
    for (int m = 0; m < 8; ++m) { St[m] = (f32x4){0.f, 0.f, 0.f, 0.f};
#pragma unroll
        for (int ks = 0; ks < 2; ++ks) { const bf16x8 kf = *(const LAS bf16x8*)(Ks + (16 * m + l15) * QKS + 32 * ks + 8 * lq); St[m] = __builtin_amdgcn_mfma_f32_16x16x32_bf16(kf, qf[ks], St[m], 0, 0, 0); } }
    float cfj, cbj;
    if (type == 0) {
        const float afj = af[j], abj = ab[j], mtfj = mtf[j], mtbj = mtb[j];
        const float cjf = (afj - mtfj) * LOG2E, cjb = (abj - mtbj) * LOG2E;
        float denf = 0.f, denb = 0.f; f32x4 sd = (f32x4){0.f, 0.f, 0.f, 0.f};
#pragma unroll
        for (int m = 0; m < 8; ++m) { const f32x4 g4 = *(const LAS f32x4*)((m <= w ? gxf : gxb) + 16 * m + 4 * lq);
            if (m < w) {
#pragma unroll
                for (int r = 0; r < 4; ++r) { St[m][r] *= __builtin_amdgcn_exp2f(cjf + g4[r]); denf += St[m][r]; }
            } else if (m > w) {
#pragma unroll
                for (int r = 0; r < 4; ++r) { St[m][r] *= __builtin_amdgcn_exp2f(cjb + g4[r]); denb += St[m][r]; }
            } else {
                const f32x4 g4b = *(const LAS f32x4*)(gxb + 16 * m + 4 * lq);
#pragma unroll
                for (int r = 0; r < 4; ++r) { const int s = 16 * m + 4 * lq + r; const float raw = St[m][r];
                    const float ef = s <= j ? __builtin_amdgcn_exp2f(cjf + g4[r]) : 0.f, eb = s >= j ? __builtin_amdgcn_exp2f(cjb + g4b[r]) : 0.f;
                    St[m][r] = raw * ef; sd[r] = raw * eb; denf += St[m][r]; denb += sd[r]; }
            } }
        float nqf = 0.f, nqb = 0.f;
#pragma unroll
        for (int kk = 0; kk < 12; ++kk) { const float qv = bf2f(Qs[j * QKS + 12 * lq + kk]); nqf += npfv[kk] * qv; nqb += npbv[kk] * qv; }
        denf += __shfl_xor(denf, 16); denf += __shfl_xor(denf, 32); denb += __shfl_xor(denb, 16); denb += __shfl_xor(denb, 32);
        nqf += __shfl_xor(nqf, 16); nqf += __shfl_xor(nqf, 32); nqb += __shfl_xor(nqb, 16); nqb += __shfl_xor(nqb, 32);
        const float sif = __expf(afj + mpf - mtfj), sib = __expf(abj + mpb - mtbj);
        const float rdf = 1.0f / fmaxf(fabsf(denf + sif * nqf), __expf(-mtfj)), rdb = 1.0f / fmaxf(fabsf(denb + sib * nqb), __expf(-mtbj));
        cfj = sif * rdf; cbj = sib * rdb;
#pragma unroll
        for (int m = 0; m < 8; ++m) { const float sc = m <= w ? rdf : rdb; f32x4 wv = St[m] * sc; if (m == w) wv += sd * rdb;
            u32x2 pk; pk.x = pk2(wv[0], wv[1]); pk.y = pk2(wv[2], wv[3]); *(LAS u32x2*)(Wm + j * WSS + 16 * m + 4 * lq) = pk; }
    } else {
        const float l2f = ret_lg(h, 0.f) * LOG2E, l2b = ret_lg(h, 0.5f) * LOG2E;
        const float dj = (float)(j - 4 * lq);
#pragma unroll
        for (int m = 0; m < 8; ++m) { f32x4 wv;
#pragma unroll
            for (int r = 0; r < 4; ++r) { const float d = dj - (float)(16 * m + r); wv[r] = St[m][r] * __builtin_amdgcn_exp2f(d >= 0.f ? l2f * d : -l2b * d); }
            u32x2 pk; pk.x = pk2(wv[0], wv[1]); pk.y = pk2(wv[2], wv[3]); *(LAS u32x2*)(Wm + j * WSS + 16 * m + 4 * lq) = pk; }
        cfj = __builtin_amdgcn_exp2f(l2f * (float)(j + 1)); cbj = __builtin_amdgcn_exp2f(l2b * (float)(128 - j));
    }
    DSEC(0x4000);
    f32x4 O[6];
#pragma unroll
    for (int n = 0; n < 6; ++n) O[n] = If[n] * cfj + Ib[n] * cbj;
#pragma unroll
    for (int ks = 0; ks < 4; ++ks) { const bf16x8 wf = *(const LAS bf16x8*)(Wm + j * WSS + 32 * ks + 8 * lq);
#pragma unroll
        for (int n = 0; n < 6; ++n) { const bf16x8 vf = tr_frag(Vs, VSS, 32 * ks, 16 * n, F.lane); O[n] = __builtin_amdgcn_mfma_f32_16x16x32_bf16(vf, wf, O[n], 0, 0, 0); } }
    float s1 = 0.f;
    f32x4 gt[6];
#pragma unroll
    for (int n = 0; n < 6; ++n) { const u32x2 gw = gtw[n];
        gt[n] = (f32x4){__builtin_bit_cast(float, gw.x << 16), __builtin_bit_cast(float, gw.x & 0xffff0000u), __builtin_bit_cast(float, gw.y << 16), __builtin_bit_cast(float, gw.y & 0xffff0000u)};
        if (type == 0) {
#pragma unroll
            for (int r = 0; r < 4; ++r) O[n][r] *= sigmoidf_(gt[n][r]); }
        s1 += (O[n][0] + O[n][1]) + (O[n][2] + O[n][3]); }
    s1 += __shfl_xor(s1, 16); s1 += __shfl_xor(s1, 32);
    const float mean = s1 * (1.0f / 96.0f); float s2 = 0.f;
#pragma unroll
    for (int n = 0; n < 6; ++n) { O[n] = O[n] - mean; s2 += (O[n][0] * O[n][0] + O[n][1] * O[n][1]) + (O[n][2] * O[n][2] + O[n][3] * O[n][3]); }
    s2 += __shfl_xor(s2, 16); s2 += __shfl_xor(s2, 32);
    const float rstd = 1.0f / sqrtf(s2 * (1.0f / 96.0f) + LN_EPS);
    unsigned char* o = mix + (size_t)(t0 + j) * D + (type ? 640 : 256) + h * DV + 4 * lq;
#pragma unroll
    for (int n = 0; n < 6; ++n) { const f32x4 wv = nwv[n]; f32x4 y = O[n] * rstd * wv;
        if (type == 1) {
#pragma unroll
            for (int r = 0; r < 4; ++r) y[r] *= siluf_(gt[n][r]); }
        y = y * MIX_SCALE; *(unsigned*)(o + 16 * n) = pg8::pk4_fp8(y[0], y[1], y[2], y[3]); }
    DSEC(0x8000);
#undef DSEC
    __syncthreads();
}

__device__ __forceinline__ void phaseC_unit(const Frame& F, const Args& a, int u) {
    unsigned char* ws = KA(ws);
    const int type = u >> 7, seq = (u & 127) >> 2, part = u & 3, dir = seq & 1;
    LAS float* sp = (LAS float*)F.lds; LAS float* sc = sp + 64;
    float* msc = (float*)(ws + WS_MSC);
    if (type == 0) {
        if (F.wave == 0) { const int cn = dir ? NCH - 1 - F.lane : F.lane, sin_ = seq * NCH + cn; const float mcl = msc[sin_], ael = msc[2048 + sin_];
            float m = 0.f, my_sp = 0.f, my_sc = 0.f, my_mp = 0.f;
#pragma unroll 1
            for (int n = 0; n < NCH; ++n) { const float mc = __shfl(mcl, n), ae = __shfl(ael, n);
                const float mn = fmaxf(ae + m, mc); const float spn = __expf(ae + m - mn), scn = __expf(mc - mn);
                if (F.lane == n) { my_sp = spn; my_sc = scn; my_mp = m; }
                m = mn; }
            sp[F.lane] = my_sp; sc[F.lane] = my_sc; if (part == 0) msc[4096 + sin_] = my_mp; }
    } else {
        if (F.tid < 64) { const int h = (seq >> 1) & 3; const float lg = ret_lg(h, dir ? 0.5f : 0.f); sp[F.tid] = __expf(lg * 128.0f); sc[F.tid] = 1.0f; }
    }
    __syncthreads();
    const float* X = (const float*)(ws + (type ? WS_RS : WS_MC)); bf16_t* Xo = (bf16_t*)(ws + (type ? WS_CBR : WS_CBM));
    { const size_t o0 = (size_t)seq * NCH * (DV * DK) + part * 1152 + F.tid; const bool has3 = F.tid < 1152 - 2 * NTHR;
      float st0 = 0.f, st1 = 0.f, st2 = 0.f;
#pragma unroll 1
      for (int n0 = 0; n0 < NCH; n0 += 8) { float v0[8], v1[8], v2[8];
#pragma unroll
          for (int i = 0; i < 8; ++i) { const int c = dir ? NCH - 1 - (n0 + i) : n0 + i; const size_t o = o0 + (size_t)c * (DV * DK); v0[i] = X[o]; v1[i] = X[o + NTHR]; v2[i] = has3 ? X[o + 2 * NTHR] : 0.f; }
#pragma unroll
          for (int i = 0; i < 8; ++i) { const int c = dir ? NCH - 1 - (n0 + i) : n0 + i; const size_t o = o0 + (size_t)c * (DV * DK); const float a_ = sp[n0 + i], b_ = sc[n0 + i];
              Xo[o] = (bf16_t)f2bf(st0); Xo[o + NTHR] = (bf16_t)f2bf(st1); if (has3) Xo[o + 2 * NTHR] = (bf16_t)f2bf(st2);
              st0 = a_ * st0 + b_ * v0[i]; st1 = a_ * st1 + b_ * v1[i]; st2 = a_ * st2 + b_ * v2[i]; } } }
    if (type == 0 && part == 0 && F.tid < DK) { float st = 0.f; float* p = (float*)(ws + WS_MN) + (size_t)seq * NCH * DK + F.tid;
#pragma unroll 1
        for (int n0 = 0; n0 < NCH; n0 += 16) { float v[16];
#pragma unroll
            for (int i = 0; i < 16; ++i) { const int c = dir ? NCH - 1 - (n0 + i) : n0 + i; v[i] = p[(size_t)c * DK]; }
#pragma unroll
            for (int i = 0; i < 16; ++i) { const int c = dir ? NCH - 1 - (n0 + i) : n0 + i; p[(size_t)c * DK] = st; st = sp[n0 + i] * st + sc[n0 + i] * v[i]; } } }
    __syncthreads();
}

__device__ __forceinline__ void fourier_stage1(const Frame& F, unsigned char* ws) {
    const bf16_t* UT = (const bf16_t*)(ws + WS_UT); bf16_t* AT = (bf16_t*)(ws + WS_AT);
    LAS bf16_t* Gs = (LAS bf16_t*)F.lds;
    { const bf16_t* Gg = (const bf16_t*)(ws + WS_FG);
      for (int i = F.tid; i < 128 * 16; i += NTHR) { const int r = i >> 4, c8 = i & 15; *(LAS u32x4*)(Gs + r * 136 + c8 * 8) = *(const u32x4*)(Gg + r * 128 + c8 * 8); } }
    __syncthreads();
    const int l15 = F.lane & 15, lq = F.lane >> 4;
    for (int u = F.bid; u < 1024; u += F.G) {
        const int b = u >> 8, ch = u & 255;
        const bf16_t* xr = UT + ((size_t)u * 128 + 16 * F.wave + l15) * 128 + 8 * lq;
        bf16x8 af[4];
#pragma unroll
        for (int ks = 0; ks < 4; ++ks) af[ks] = *(const bf16x8*)(xr + 32 * ks);
        f32x4 acc[8];
#pragma unroll
        for (int n = 0; n < 8; ++n) { acc[n] = (f32x4){0.f, 0.f, 0.f, 0.f};
#pragma unroll
            for (int ks = 0; ks < 4; ++ks) { const bf16x8 bfr = *(const LAS bf16x8*)(Gs + (16 * n + l15) * 136 + 32 * ks + 8 * lq);
                acc[n] = __builtin_amdgcn_mfma_f32_16x16x32_bf16(af[ks], bfr, acc[n], 0, 0, 0); }
            if (n & 1) __builtin_amdgcn_sched_barrier(0); }
#pragma unroll
        for (int n = 0; n < 4; ++n) { const int k1 = 16 * n + l15; u32x2 wre, wim; float ore[4], oim[4];
#pragma unroll
            for (int r = 0; r < 4; ++r) { const int s2 = 16 * F.wave + 4 * lq + r; const float rev = (float)(k1 * s2) * (1.0f / 8192.0f);
                const float cs = __builtin_amdgcn_cosf(rev), sn = __builtin_amdgcn_sinf(rev); const float re = acc[n][r], im = acc[n + 4][r];
                ore[r] = re * cs + im * sn; oim[r] = im * cs - re * sn; }
            wre.x = pk2(ore[0], ore[1]); wre.y = pk2(ore[2], ore[3]); wim.x = pk2(oim[0], oim[1]); wim.y = pk2(oim[2], oim[3]);
            bf16_t* o = AT + ((size_t)((b * 64 + k1) * 256 + ch)) * 256 + 16 * F.wave + 4 * lq;
            *(u32x2*)o = wre; *(u32x2*)(o + 128) = wim; }
    }
    __syncthreads();
}
__device__ __forceinline__ void fourier_stage2(const Frame& F, unsigned char* ws) {
    const bf16_t* AT = (const bf16_t*)(ws + WS_AT); unsigned char* mix = (unsigned char*)(ws + WS_MIX);
    LAS bf16_t* Hs = (LAS bf16_t*)F.lds;
    { const bf16_t* Hg = (const bf16_t*)(ws + WS_FG + FG_H_OFF);
      for (int i = F.tid; i < 128 * 32; i += NTHR) { const int r = i >> 5, c8 = i & 31; *(LAS u32x4*)(Hs + r * 264 + c8 * 8) = *(const u32x4*)(Hg + r * 256 + c8 * 8); } }
    __syncthreads();
    const int l15 = F.lane & 15, lq = F.lane >> 4;
    for (int u = F.bid; u < 256; u += F.G) {
        const int b = u >> 6, k1 = u & 63;
        f32x4 acc[2][8];
#pragma unroll
        for (int m = 0; m < 2; ++m)
#pragma unroll
            for (int n = 0; n < 8; ++n) acc[m][n] = (f32x4){0.f, 0.f, 0.f, 0.f};
        const bf16_t* ar = AT + ((size_t)u * 256 + 32 * F.wave + l15) * 256 + 8 * lq;
#pragma unroll
        for (int ks = 0; ks < 8; ++ks) { const bf16x8 a0 = *(const bf16x8*)(ar + 32 * ks), a1 = *(const bf16x8*)(ar + 16 * 256 + 32 * ks);
#pragma unroll
            for (int n = 0; n < 8; ++n) { const bf16x8 bfr = *(const LAS bf16x8*)(Hs + (16 * n + l15) * 264 + 32 * ks + 8 * lq);
                acc[0][n] = __builtin_amdgcn_mfma_f32_16x16x32_bf16(a0, bfr, acc[0][n], 0, 0, 0); acc[1][n] = __builtin_amdgcn_mfma_f32_16x16x32_bf16(a1, bfr, acc[1][n], 0, 0, 0); }
            if (ks & 1) __builtin_amdgcn_sched_barrier(0); }
#pragma unroll
        for (int m = 0; m < 2; ++m)
#pragma unroll
            for (int n = 0; n < 8; ++n) { const int k2 = 16 * n + l15, chn = 32 * F.wave + 16 * m + 4 * lq;
                const f32x4 y = acc[m][n] * MIX_SCALE;
                *(unsigned*)(mix + (size_t)(b * S + k1 + 64 * k2) * D + chn) = pg8::pk4_fp8(y[0], y[1], y[2], y[3]); }
    }
    __syncthreads();
}

__device__ __forceinline__ int build_tiles(const Frame& F, unsigned* cnt, LAS int* tst, LAS unsigned char* tile_e) {
    if (F.wave == 0) { const int cv = F.lane < NE ? (int)__hip_atomic_load(cnt + (F.lane & (NE - 1)), __ATOMIC_RELAXED, __HIP_MEMORY_SCOPE_AGENT) : 0; const int ntl = (cv + 255) >> 8;
        int inc = ntl;
#pragma unroll
        for (int o = 1; o < NE; o <<= 1) { const int t = __shfl_up(inc, o); if (F.lane >= o) inc += t; }
        if (F.lane < NE) { tst[F.lane] = inc - ntl; ((LAS int*)(F.lds + MISC_OFF + 1280))[F.lane] = cv; }
        if (F.lane == NE - 1) tst[NE] = inc; }
    __syncthreads();
    const int ntot = tst[NE];
    for (int mt = F.tid; mt < ntot; mt += NTHR) { int e = 0; for (int q = 1; q < NE; ++q) if (mt >= tst[q]) e = q; tile_e[mt] = (unsigned char)e; }
    __syncthreads();
    return ntot;
}

__device__ __forceinline__ f32x4 unpack4(u32x2 w) { return (f32x4){__builtin_bit_cast(float, w.x << 16), __builtin_bit_cast(float, w.x & 0xffff0000u), __builtin_bit_cast(float, w.y << 16), __builtin_bit_cast(float, w.y & 0xffff0000u)}; }

__device__ __forceinline__ void phaseF(const Frame& F0, const Args& a, int l) {
    Frame F = F0; asm volatile("" : "+v"(F.tid), "+v"(F.lane)); asm volatile("" : "+s"(F.wave));
    unsigned char* ws = KA(ws);
    const bf16_t* pre = (const bf16_t*)(ws + WS_PRE); float* x1st = (float*)(ws + WS_X1B); unsigned char* x1q = (unsigned char*)(ws + WS_XS);
    int* tke = (int*)(ws + WS_TKE); float* tkg = (float*)(ws + WS_TKG); int* tks = (int*)(ws + WS_TKS); int* list = (int*)(ws + WS_LIST);
    unsigned* cnt = F.ctl + CW_CNT + l * 64;
    constexpr int XST = 1032;
    LAS bf16_t* Xh = (LAS bf16_t*)F.lds;
    LAS bf16_t* Xl = Xh + 16 * XST;
    LAS float* red = (LAS float*)(Xl + 16 * XST);
    LAS int* lcnt = (LAS int*)(F.lds + MISC_OFF + 2048);
    LAS int* lbase = lcnt + 32;
    LAS int* le = lbase + 32;
    LAS int* ls = le + 512;
    const int w = F.wave, l15 = F.lane & 15, lq = F.lane >> 4;
    bf16x8 Bh[2][4], Bl[2][4];
    { const float* wrt = (const float*)(ws + WS_BIN + WRT_OFF) + (size_t)l * NE * D;
#pragma unroll
      for (int n = 0; n < 2; ++n)
#pragma unroll
          for (int ks = 0; ks < 4; ++ks) { const float* p = wrt + (size_t)(16 * n + l15) * D + 128 * w + 32 * ks + 8 * lq; const f32x4 x0 = *(const f32x4*)p, x1 = *(const f32x4*)(p + 4);
              unsigned hw[4], lw[4];
#pragma unroll
              for (int i = 0; i < 4; ++i) { const float a0 = i < 2 ? x0[2 * i] : x1[2 * i - 4], a1 = i < 2 ? x0[2 * i + 1] : x1[2 * i - 3];
                  const unsigned h0 = f2bf(a0), h1 = f2bf(a1); hw[i] = h0 | (h1 << 16);
                  lw[i] = pk2(a0 - __builtin_bit_cast(float, h0 << 16), a1 - __builtin_bit_cast(float, h1 << 16)); }
              Bh[n][ks] = __builtin_bit_cast(bf16x8, (u32x4){hw[0], hw[1], hw[2], hw[3]}); Bl[n][ks] = __builtin_bit_cast(bf16x8, (u32x4){lw[0], lw[1], lw[2], lw[3]}); } }
    if (F.tid < 32) lcnt[F.tid] = 0;
    const float* g1 = KA(ln1_g) + (size_t)l * D; const float* b1 = KA(ln1_b) + (size_t)l * D; const float* br = KA(b_router) + (size_t)l * NE;
    f32x4 gg[4], bb[4];
#pragma unroll
    for (int j = 0; j < 4; ++j) { gg[j] = *(const f32x4*)(g1 + 4 * F.lane + 256 * j); bb[j] = *(const f32x4*)(b1 + 4 * F.lane + 256 * j); }
    const float brv = br[F.tid & 31];
    __syncthreads();
    for (int chunk = F.bid; chunk < T / 128; chunk += F.G) {
        u32x2 nx[2][4];
#pragma unroll
        for (int q = 0; q < 2; ++q)
#pragma unroll
            for (int j = 0; j < 4; ++j) nx[q][j] = *(const u32x2*)(pre + (size_t)(chunk * 128 + 2 * w + q) * D + 4 * F.lane + 256 * j);
#pragma unroll 1
        for (int g = 0; g < 8; ++g) {
            u32x2 cx[2][4];
#pragma unroll
            for (int q = 0; q < 2; ++q)
#pragma unroll
                for (int j = 0; j < 4; ++j) cx[q][j] = nx[q][j];
            if (g < 7) {
#pragma unroll
                for (int q = 0; q < 2; ++q)
#pragma unroll
                    for (int j = 0; j < 4; ++j) nx[q][j] = *(const u32x2*)(pre + (size_t)(chunk * 128 + (g + 1) * 16 + 2 * w + q) * D + 4 * F.lane + 256 * j); }
#pragma unroll
            for (int q = 0; q < 2; ++q) { const int tl = 2 * w + q, t = chunk * 128 + g * 16 + tl;
                f32x4 v[4]; float s = 0.f;
#pragma unroll
                for (int j = 0; j < 4; ++j) { v[j] = unpack4(cx[q][j]); s += (v[j].x + v[j].y) + (v[j].z + v[j].w); }
                const float mean = wave_sum(s) * (1.f / D); float s2 = 0.f;
#pragma unroll
                for (int j = 0; j < 4; ++j) { v[j] = v[j] - mean; s2 += (v[j].x * v[j].x + v[j].y * v[j].y) + (v[j].z * v[j].z + v[j].w * v[j].w); }
                const float rstd = 1.f / sqrtf(wave_sum(s2) * (1.f / D) + LN_EPS);
                if (F.lane == 0) *(f32x2*)(x1st + 2 * (size_t)t) = (f32x2){mean, rstd};
#pragma unroll
                for (int j = 0; j < 4; ++j) { const f32x4 o = v[j] * rstd * gg[j] + bb[j];
                    const unsigned h0 = f2bf(o.x), h1 = f2bf(o.y), h2 = f2bf(o.z), h3 = f2bf(o.w);
                    u32x2 hw; hw.x = h0 | (h1 << 16); hw.y = h2 | (h3 << 16);
                    u32x2 lw; lw.x = pk2(o.x - __builtin_bit_cast(float, h0 << 16), o.y - __builtin_bit_cast(float, h1 << 16)); lw.y = pk2(o.z - __builtin_bit_cast(float, h2 << 16), o.w - __builtin_bit_cast(float, h3 << 16));
                    *(unsigned*)(x1q + (size_t)t * D + 4 * F.lane + 256 * j) = pg8::pk4_fp8(o.x, o.y, o.z, o.w);
                    *(LAS u32x2*)(Xh + tl * XST + 4 * F.lane + 256 * j) = hw; *(LAS u32x2*)(Xl + tl * XST + 4 * F.lane + 256 * j) = lw; } }
            __syncthreads();
            f32x4 acc[2] = {(f32x4){0.f, 0.f, 0.f, 0.f}, (f32x4){0.f, 0.f, 0.f, 0.f}};
#pragma unroll
            for (int ks = 0; ks < 4; ++ks) { const bf16x8 ah = *(const LAS bf16x8*)(Xh + l15 * XST + 128 * w + 32 * ks + 8 * lq), al = *(const LAS bf16x8*)(Xl + l15 * XST + 128 * w + 32 * ks + 8 * lq);
#pragma unroll
                for (int n = 0; n < 2; ++n) { acc[n] = __builtin_amdgcn_mfma_f32_16x16x32_bf16(ah, Bh[n][ks], acc[n], 0, 0, 0); acc[n] = __builtin_amdgcn_mfma_f32_16x16x32_bf16(al, Bh[n][ks], acc[n], 0, 0, 0);
                    acc[n] = __builtin_amdgcn_mfma_f32_16x16x32_bf16(ah, Bl[n][ks], acc[n], 0, 0, 0); } }
#pragma unroll
            for (int n = 0; n < 2; ++n)
#pragma unroll
                for (int r = 0; r < 4; ++r) red[(w * 16 + 4 * lq + r) * 32 + 16 * n + l15] = acc[n][r];
            __syncthreads();
            { const int tl = F.tid >> 5, e = F.tid & 31, t = chunk * 128 + g * 16 + tl;
              float lg = brv;
#pragma unroll
              for (int ww = 0; ww < 8; ++ww) lg += red[(ww * 16 + tl) * 32 + e];
              float tv[4]; int ti[4];
#pragma unroll
              for (int k = 0; k < 4; ++k) { float bv = lg; int bi = e;
#pragma unroll
                  for (int o = 1; o < 32; o <<= 1) { const float ov = __shfl_xor(bv, o); const int oi = __shfl_xor(bi, o); if (ov > bv || (ov == bv && oi < bi)) { bv = ov; bi = oi; } }
                  tv[k] = bv; ti[k] = bi; if (e == bi) lg = -INFINITY; }
              const float w1 = __expf(tv[1] - tv[0]), w2 = __expf(tv[2] - tv[0]), w3 = __expf(tv[3] - tv[0]); const float inv = 1.0f / (1.0f + w1 + w2 + w3);
              if (e < 4) { const int ek = e == 0 ? ti[0] : e == 1 ? ti[1] : e == 2 ? ti[2] : ti[3]; const float gk = (e == 0 ? 1.0f : e == 1 ? w1 : e == 2 ? w2 : w3) * inv;
                  tke[t * 4 + e] = ek; tkg[t * 4 + e] = gk;
                  const int sl = __hip_atomic_fetch_add(lcnt + ek, 1, __ATOMIC_RELAXED, __HIP_MEMORY_SCOPE_WORKGROUP);
                  le[(g * 16 + tl) * 4 + e] = ek; ls[(g * 16 + tl) * 4 + e] = sl; } }
        }
        __syncthreads();
        if (F.tid < 32) lbase[F.tid] = (int)__hip_atomic_fetch_add(cnt + F.tid, (unsigned)lcnt[F.tid], __ATOMIC_RELAXED, __HIP_MEMORY_SCOPE_AGENT);
        __syncthreads();
        { const int tl = F.tid >> 2, k = F.tid & 3, t = chunk * 128 + tl, e = le[F.tid], slot = lbase[e] + ls[F.tid];
          list[(size_t)e * T + slot] = t; tks[t * 4 + k] = slot; }
        __syncthreads();
        if (F.tid < 32) lcnt[F.tid] = 0;
        __syncthreads();
    }
}

struct IRows { u32x2 x[4]; unsigned y[4][4]; f32x4 g; f32x2 ms; };
__device__ __forceinline__ f32x4 unpack4_fp8(unsigned w) { const f32x2 lo = __builtin_amdgcn_cvt_pk_f32_fp8((int)w, false), hi = __builtin_amdgcn_cvt_pk_f32_fp8((int)w, true); return (f32x4){lo.x, lo.y, hi.x, hi.y}; }
struct IIdx { u32x4 e, s; f32x4 g; };
__device__ __forceinline__ void phaseI(const Frame& F0, const Args& a, int l) {
    Frame F = F0; asm volatile("" : "+v"(F.tid), "+v"(F.lane)); asm volatile("" : "+s"(F.wave));
    unsigned char* ws = KA(ws);
    unsigned* cnt = F.ctl + CW_CNT + l * 64;
    LAS int* tst = (LAS int*)(F.lds + MISC_OFF + 256); LAS unsigned char* tile_e = (LAS unsigned char*)(F.lds + MISC_OFF + 512);
    (void)build_tiles(F, cnt, tst, tile_e);
    const bf16_t* pre = (const bf16_t*)(ws + WS_PRE); const float* x1st = (const float*)(ws + WS_X1B); const unsigned char* Y = (const unsigned char*)(ws + WS_Y);
    f32x4 ga[4], ba[4];
    { const float* g1 = KA(ln1_g) + (size_t)l * D; const float* b1 = KA(ln1_b) + (size_t)l * D;
#pragma unroll
      for (int j = 0; j < 4; ++j) { ga[j] = *(const f32x4*)(g1 + 4 * F.lane + 256 * j) * DN_ALPHA; ba[j] = *(const f32x4*)(b1 + 4 * F.lane + 256 * j) * DN_ALPHA; } }
    const int* tke = (const int*)(ws + WS_TKE); const float* tkg = (const float*)(ws + WS_TKG); const int* tks = (const int*)(ws + WS_TKS);
    bf16_t* xb = (bf16_t*)(ws + WS_XB);
    const float* g2 = KA(ln2_g) + (size_t)l * D; const float* b2 = KA(ln2_b) + (size_t)l * D;
    const int gw = F.bid * NWAVES + F.wave, NGW = F.G * NWAVES; float* outp = KA(out);
#define I_LOAD_IDX(ix, t_) do { const int tq_ = min((t_), T - 1); (ix).e = *(const u32x4*)(tke + tq_ * 4); (ix).s = *(const u32x4*)(tks + tq_ * 4); (ix).g = *(const f32x4*)(tkg + tq_ * 4); } while (0)
#define I_LOAD_ROWS(rw, ix, t_) do { const int tq_ = min((t_), T - 1); (rw).g = (ix).g * (1.0f / Y_SCALE); \
        _Pragma("unroll") for (int k = 0; k < 4; ++k) { const size_t row = (size_t)tst[(ix).e[k]] * 256 + (ix).s[k]; \
            _Pragma("unroll") for (int j = 0; j < 4; ++j) (rw).y[k][j] = *(const unsigned*)(Y + row * D + 4 * F.lane + 256 * j); } \
        (rw).ms = *(const f32x2*)(x1st + 2 * (size_t)tq_); \
        _Pragma("unroll") for (int j = 0; j < 4; ++j) (rw).x[j] = *(const u32x2*)(pre + (size_t)tq_ * D + 4 * F.lane + 256 * j); } while (0)
#define I_FINISH(rw, t_) do { const int tq_ = (t_); if (tq_ < T) { f32x4 v[4]; \
        _Pragma("unroll") for (int j = 0; j < 4; ++j) v[j] = (unpack4((rw).x[j]) - (rw).ms.x) * (rw).ms.y * ga[j] + ba[j]; \
        _Pragma("unroll") for (int k = 0; k < 4; ++k) _Pragma("unroll") for (int j = 0; j < 4; ++j) v[j] += unpack4_fp8((rw).y[k][j]) * (rw).g[k]; \
        ln_row(v, g2, b2, nullptr, xb + (size_t)tq_ * D, l == NL - 1 ? outp + (size_t)tq_ * D : nullptr, F.lane, (unsigned char*)(ws + WS_XQ) + (size_t)tq_ * D); } } while (0)
    IIdx ix; IRows r0, r1, r2;
    int t = gw;
    I_LOAD_IDX(ix, t); I_LOAD_ROWS(r0, ix, t); I_LOAD_IDX(ix, t + NGW); I_LOAD_ROWS(r1, ix, t + NGW); I_LOAD_IDX(ix, t + 2 * NGW);
#pragma unroll 1
    for (; t < T; t += 3 * NGW) {
        I_LOAD_ROWS(r2, ix, t + 2 * NGW); I_LOAD_IDX(ix, t + 3 * NGW); I_FINISH(r0, t);
        I_LOAD_ROWS(r0, ix, t + 3 * NGW); I_LOAD_IDX(ix, t + 4 * NGW); I_FINISH(r1, t + NGW);
        I_LOAD_ROWS(r1, ix, t + 4 * NGW); I_LOAD_IDX(ix, t + 5 * NGW); I_FINISH(r2, t + 2 * NGW);
    }
#undef I_LOAD_IDX
#undef I_LOAD_ROWS
#undef I_FINISH
    __syncthreads();
}

template <int PHMASK_T> __global__ void __launch_bounds__(NTHR, 2) hybrid_fwd(Args a) {
    extern __shared__ __attribute__((aligned(16))) unsigned char lds_raw[];
    Frame F;
    F.lds = (LAS unsigned char*)lds_raw;
    F.tid = threadIdx.x; F.lane = F.tid & 63; F.wave = __builtin_amdgcn_readfirstlane(F.tid >> 6);
    F.G = gridDim.x; F.bid = blockIdx.x;
    F.ctl = (unsigned*)(KA(ws) + WS_CTL);
    unsigned char* ws = KA(ws);
    volatile LAS unsigned* MISC = (volatile LAS unsigned*)(F.lds + MISC_OFF);
    if (F.tid < 64) MISC[F.tid] = 0u;
    __syncthreads();
#if MK_MULTI
#define GRID_BAR() do { } while (0)
#else
    XcdBarrier bar = xcd_barrier_post(F.ctl + CW_BAR, MISC);
#define GRID_BAR() do { GAS unsigned* _bp = (GAS unsigned*)bar.bar; unsigned _bx = bar.x; unsigned _bs = (unsigned)(uintptr_t)bar.st; asm volatile("" : "+s"(_bp), "+s"(_bx), "+s"(_bs)); \
        XcdBarrier _b; _b.bar = (unsigned*)_bp; _b.x = _bx; _b.st = (volatile LAS unsigned*)(uintptr_t)_bs; xcd_barrier(_b); } while (0)
#endif
    const int lo = KA(ph_lo), hi = KA(ph_hi);
#if PROBE_MASK
    unsigned long long pt0 = 0;
#define PROBE_BEGIN() do { pt0 = __builtin_amdgcn_s_memrealtime(); } while (0)
#define PROBE_END(j) do { if ((PROBE_MASK >> (j)) & 1) { const unsigned long long d_ = __builtin_amdgcn_s_memrealtime() - pt0; while (__builtin_amdgcn_s_memrealtime() - pt0 < 2 * d_) __builtin_amdgcn_s_sleep(8); } } while (0)
#else
#define PROBE_BEGIN() do { } while (0)
#define PROBE_END(j) do { } while (0)
#endif
#define PH_ON(j) (((PHMASK_T) >> (j)) & 1)
#define IN(k) (lo <= (k) && (k) < hi)
#if PROBE_MASK & 0xC00
#define SEAM(k) do { if (IN(k) && IN((k) + 1)) { const unsigned long long b0_ = __builtin_amdgcn_s_memrealtime(); GRID_BAR(); if (PROBE_MASK & 0x400) GRID_BAR(); \
        if (PROBE_MASK & 0x800) { const unsigned long long d_ = __builtin_amdgcn_s_memrealtime() - b0_; while (__builtin_amdgcn_s_memrealtime() - b0_ < 2 * d_) __builtin_amdgcn_s_sleep(8); } } } while (0)
#else
#define SEAM(k) do { if (IN(k) && IN((k) + 1)) GRID_BAR(); } while (0)
#endif
    PROBE_BEGIN();
    if (PH_ON(9) && IN(0)) { p0_prologue(F, a); }
    PROBE_END(9);
    SEAM(0);
#define LAUNDER() do { unsigned _lp = (unsigned)(uintptr_t)F.lds; GAS unsigned* _cp = (GAS unsigned*)F.ctl; GAS unsigned char* _wp = (GAS unsigned char*)ws;     \
        F.tid = threadIdx.x; asm volatile("" : "+v"(F.tid)); F.lane = F.tid & 63; F.wave = __builtin_amdgcn_readfirstlane(F.tid >> 6); F.bid = blockIdx.x; F.G = gridDim.x; \
        asm volatile("" : "+s"(F.bid), "+s"(F.G), "+s"(_lp), "+s"(_cp), "+s"(_wp)); \
        F.lds = (LAS unsigned char*)(uintptr_t)_lp; F.ctl = (unsigned*)_cp; ws = (unsigned char*)_wp; } while (0)
    for (int l = 0; l < NL; ++l) {
        const int pb = 1 + l * NPH_LAYER;
        LAUNDER(); PROBE_BEGIN();
        if (PH_ON(0) && IN(pb + 0)) {
            pg8::PlainOrderBf So; So.init(ws + WS_XB, (bf16_t*)(ws + WS_WIN) + (size_t)l * PWP * D, T, 4 * 256, D, F.G, F.bid);
            pg8::EpiBf16Bias E{(bf16_t*)(ws + WS_P), PWP, (const float*)(ws + WS_BIN) + (size_t)l * PWP, 1.0f};
            pg8::gemm_phase<pg8::EpiBf16Bias, pg8::PlainOrderBf, true, true>(F.lds, D, So, E, F.tid);
            pg8::PlainOrderF8 Sq; Sq.init(ws + WS_XQ, (unsigned char*)(ws + WS_WINQ) + (size_t)l * PWP * D, T, 6 * 256, D, F.G, F.bid);
            pg8::EpiBf16Bias Eq{(bf16_t*)(ws + WS_P), PWP, (const float*)(ws + WS_BIN) + (size_t)l * PWP, 1.0f / (XQ_SCALE * WINQ_SCALE)};
            pg8::gemm_phase_f8<pg8::EpiBf16Bias, pg8::PlainOrderF8, true, true>(F.lds, D, Sq, Eq, F.tid);
            pg8::FourierOrder8 Sf{(const char*)(ws + WS_WFQ) + (size_t)l * 512 * D, (const char*)(ws + WS_XQ), D, F.G, F.bid};
            pg8::EpiFourierT Ef{(bf16_t*)(ws + WS_UT), (const float*)(ws + WS_FG + FG_BF_OFF) + l * 512, 1.0f / (XQ_SCALE * WFQ_SCALE)};
            pg8::gemm_phase_f8<pg8::EpiFourierT, pg8::FourierOrder8, true, true>(F.lds, D, Sf, Ef, F.tid);
        }
        PROBE_END(0);
        SEAM(pb + 0);
        LAUNDER(); PROBE_BEGIN();
        if (PH_ON(1) && IN(pb + 1)) {
            for (int u = F.bid; u < 2048; u += F.G) phaseB_mfma(F, a, l, u);
            fourier_stage1(F, ws);
        }
        PROBE_END(1);
        SEAM(pb + 1);
        LAUNDER(); PROBE_BEGIN();
        if (PH_ON(2) && IN(pb + 2)) { for (int u = F.bid; u < 256; u += F.G) phaseC_unit(F, a, u); fourier_stage2(F, ws); }
        PROBE_END(2);
        SEAM(pb + 2);
        LAUNDER(); PROBE_BEGIN();
        if (PH_ON(3) && IN(pb + 3)) {
            for (int rep_ = 0; rep_ < ((PROBE_MASK & 0x40000) ? 2 : 1); ++rep_)
            for (int u = F.bid; u < 2048; u += F.G) phaseD_mfma(F, a, l, u);
        }
        PROBE_END(3);
        SEAM(pb + 3);
        LAUNDER(); PROBE_BEGIN();
        if (PH_ON(4) && IN(pb + 4)) {
            pg8::PlainOrder8 So; So.init(ws + WS_MIX, (unsigned char*)(ws + WS_WOUT) + (size_t)l * D * D, T, D, D, F.G, F.bid);
            pg8::EpiResBf16 E{(bf16_t*)(ws + WS_PRE), (const bf16_t*)(ws + WS_XB), D, DN_ALPHA, 1.0f / (MIX_SCALE * WOUT_SCALE)};
            pg8::gemm_phase_f8<pg8::EpiResBf16, pg8::PlainOrder8, true, true>(F.lds, D, So, E, F.tid);
        }
        PROBE_END(4);
        SEAM(pb + 4);
        LAUNDER(); PROBE_BEGIN();
        if (PH_ON(5) && IN(pb + 5)) phaseF(F, a, l);
        PROBE_END(5);
        SEAM(pb + 5);
        LAUNDER(); PROBE_BEGIN();
        if (PH_ON(6) && IN(pb + 6)) {
            LAS int* tst = (LAS int*)(F.lds + MISC_OFF + 256); LAS unsigned char* tile_e = (LAS unsigned char*)(F.lds + MISC_OFF + 512); LAS unsigned* gtab = (LAS unsigned*)(F.lds + GTAB_OFF);
            unsigned* cnt = F.ctl + CW_CNT + l * 64;
            const int ntot = build_tiles(F, cnt, tst, tile_e);
            { const int* list = (const int*)(ws + WS_LIST); int nun = 0; { int pm_, pn_; while (nun < 18 && pg8::moe_unit(nun, F.bid, F.G, 8, ntot, pm_, pn_)) ++nun; }
              for (int idx = F.tid; idx < nun * 256; idx += NTHR) { const int i = idx >> 8, r = idx & 255; int mt, pn_; (void)pg8::moe_unit(i, F.bid, F.G, 8, ntot, mt, pn_); const int e = tile_e[mt], within = (mt - tst[e]) * 256 + r;
                  const int ce = ((const LAS int*)(F.lds + MISC_OFF + 1280))[e];
                  const int tok = within < ce ? list[(size_t)e * T + within] : 0; gtab[idx] = (unsigned)tok * (unsigned)D; }
              __syncthreads(); }
            pg8::GatherOrder So{(const char*)(ws + WS_XS), (const char*)(ws + WS_W1) + (size_t)l * NE * 2048 * D, D, 8, ntot, F.G, F.bid, (size_t)2048 * D, tile_e, gtab};
            pg8::EpiSwiglu8 E{(unsigned char*)(ws + WS_H), KA(b1) + (size_t)l * NE * 2048, 1.0f / W1_SCALE};
            for (int rep_ = 0; rep_ < ((PROBE_MASK & 0x80000) ? 2 : 1); ++rep_)
            pg8::gemm_phase_f8<pg8::EpiSwiglu8, pg8::GatherOrder, true, true>(F.lds, D, So, E, F.tid);
        }
        PROBE_END(6);
        SEAM(pb + 6);
        LAUNDER(); PROBE_BEGIN();
        if (PH_ON(7) && IN(pb + 7)) {
            LAS int* tst = (LAS int*)(F.lds + MISC_OFF + 256); LAS unsigned char* tile_e = (LAS unsigned char*)(F.lds + MISC_OFF + 512);
            const int ntot = build_tiles(F, F.ctl + CW_CNT + l * 64, tst, tile_e);
            pg8::GroupOrder So{(const char*)(ws + WS_H), (const char*)(ws + WS_W2) + (size_t)l * NE * D * FF, FF, 4, ntot, F.G, F.bid, (size_t)D * FF, tile_e};
            pg8::EpiExpertOut E{(unsigned char*)(ws + WS_Y), KA(b2) + (size_t)l * NE * D, 1.0f / W2_SCALE};
            pg8::gemm_phase_f8<pg8::EpiExpertOut, pg8::GroupOrder, true, true>(F.lds, FF, So, E, F.tid);
        }
        PROBE_END(7);
        SEAM(pb + 7);
        LAUNDER(); PROBE_BEGIN();
        if (PH_ON(8) && IN(pb + 8)) phaseI(F, a, l);
        PROBE_END(8);
        SEAM(pb + 8);
    }
#undef IN
#undef SEAM
}

template <int MASK> static void launch_one(int grid, hipStream_t stream, const Args& a) {
    static bool attr = false;
    if (!attr) { (void)hipFuncSetAttribute((const void*)hybrid_fwd<MASK>, hipFuncAttributeMaxDynamicSharedMemorySize, LDS_BYTES); attr = true; }
    hipLaunchKernelGGL(hybrid_fwd<MASK>, dim3(grid), dim3(NTHR), LDS_BYTES, stream, a);
}
extern "C" void kernel_launch(void* const* d_in, const int* in_sizes, int n_in, void* d_out, int out_size, void* d_ws, size_t ws_size, hipStream_t stream) {
    static int grid = 0;
    if (grid == 0) {
        if (n_in != 19 || out_size != T * D || ws_size < WS_END) { fprintf(stderr, "kernel_launch: unexpected shapes (n_in %d out %d ws %zu need %zu)\n", n_in, out_size, ws_size, (size_t)WS_END); grid = -1; return; }
        int dev = 0, cus = 0;
        if (hipGetDevice(&dev) != hipSuccess || hipDeviceGetAttribute(&cus, hipDeviceAttributeMultiprocessorCount, dev) != hipSuccess) { grid = -1; return; }
        grid = cus;
    }
    if (grid < 0) return;
    (void)hipMemsetAsync((char*)d_ws + WS_CTL, 0, CTL_BYTES, stream);
    Args a{};
    a.x = (const float*)d_in[0]; a.emb_g = (const float*)d_in[1]; a.emb_b = (const float*)d_in[2]; a.w_in = (const float*)d_in[3]; a.b_in = (const float*)d_in[4];
    a.conv_w = (const float*)d_in[5]; a.ml_nw = (const float*)d_in[6]; a.ret_nw = (const float*)d_in[7]; a.w_out = (const float*)d_in[8];
    a.ln1_g = (const float*)d_in[9]; a.ln1_b = (const float*)d_in[10]; a.w_router = (const float*)d_in[11]; a.b_router = (const float*)d_in[12];
    a.w1 = (const float*)d_in[13]; a.b1 = (const float*)d_in[14]; a.w2 = (const float*)d_in[15]; a.b2 = (const float*)d_in[16]; a.ln2_g = (const float*)d_in[17]; a.ln2_b = (const float*)d_in[18];
    a.out = (float*)d_out; a.ws = (unsigned char*)d_ws;
#if MK_MULTI
    a.ph_lo = 0; a.ph_hi = 1; launch_one<0x200>(grid, stream, a);
#define LAUNDER() do { unsigned _lp = (unsigned)(uintptr_t)F.lds; GAS unsigned* _cp = (GAS unsigned*)F.ctl; GAS unsigned char* _wp = (GAS unsigned char*)ws;     \
        F.tid = threadIdx.x; asm volatile("" : "+v"(F.tid)); F.lane = F.tid & 63; F.wave = __builtin_amdgcn_readfirstlane(F.tid >> 6); F.bid = blockIdx.x; F.G = gridDim.x; \
        asm volatile("" : "+s"(F.bid), "+s"(F.G), "+s"(_lp), "+s"(_cp), "+s"(_wp)); \
        F.lds = (LAS unsigned char*)(uintptr_t)_lp; F.ctl = (unsigned*)_cp; ws = (unsigned char*)_wp; } while (0)
    for (int l = 0; l < NL; ++l) {
        const int pb = 1 + l * NPH_LAYER;
#define LP(j) a.ph_lo = pb + (j); a.ph_hi = pb + (j) + 1; launch_one<(1 << (j))>(grid, stream, a);
        LP(0) LP(1) LP(2) LP(3) LP(4) LP(5) LP(6) LP(7) LP(8)
#undef LP
    }
#else
    a.ph_lo = 0; a.ph_hi = NPH; launch_one<0x3ff>(grid, stream, a);
#endif
}
```

```cpp
#include <hip/hip_runtime.h>
#include <cstdio>
#include <cstdint>

#ifndef MK_MULTI
#define MK_MULTI 0
#endif

#ifndef PROBE_MASK
#define PROBE_MASK 0
#endif
#define LAS __attribute__((address_space(3)))
#define GAS __attribute__((address_space(1)))
typedef unsigned short bf16_t;
typedef short bf16x8 __attribute__((ext_vector_type(8)));
typedef float f32x4 __attribute__((ext_vector_type(4)));
typedef float f32x2 __attribute__((ext_vector_type(2)));
typedef unsigned u32x4 __attribute__((ext_vector_type(4)));
typedef unsigned u32x2 __attribute__((ext_vector_type(2)));
typedef int v4i __attribute__((ext_vector_type(4)));
typedef int v8i __attribute__((ext_vector_type(8)));
typedef int v8i_a16 __attribute__((ext_vector_type(8), aligned(16)));

constexpr int D = 1024, NB = 4, S = 8192, T = NB * S, NL = 4;
constexpr int CH = 128, NCH = S / CH;
constexpr int PW = 2576, PWF = 256, PW2 = PW - PWF, PWP = 2560;
constexpr int COL_MQK = 0, COL_MV = 384, COL_MO = 768, COL_MG = 1152, COL_RQ = 1168, COL_RK = 1360, COL_RV = 1552, COL_RG = 1936;
constexpr int NH = 4, DK = 48, DV = 96;
constexpr int NE = 32, TOPK = 4, FF = 1024;
constexpr int ROWS_PAD = T * TOPK + NE * 256;
constexpr int MT_MAX = ROWS_PAD / 256;
constexpr float LN_EPS = 1e-5f;
constexpr float DN_ALPHA = 1.6817928305074290f;
constexpr float SW_ALPHA = 1.702f, SW_LIMIT = 7.0f;
constexpr float LOG2E = 1.4426950408889634f;
constexpr float XQ_SCALE = 4.0f, WINQ_SCALE = 32.0f, WFQ_SCALE = 8.0f;
constexpr float WOUT_SCALE = 64.0f, MIX_SCALE = 4.0f;
constexpr float W1_SCALE = 32.0f, W2_SCALE = 64.0f, Y_SCALE = 16.0f;

constexpr size_t MiB = 1u << 20;
constexpr size_t WS_CTL = 0, CTL_BYTES = 1 * MiB;
constexpr size_t WS_WIN = 1 * MiB;
constexpr size_t WS_WOUT = WS_WIN + 22 * MiB;
constexpr size_t WS_W1 = WS_WOUT + 8 * MiB;
constexpr size_t WS_W2 = WS_W1 + 512 * MiB;
constexpr size_t WS_BIN = WS_W2 + 256 * MiB;
constexpr size_t WS_ROT = WS_BIN + 1 * MiB;
constexpr size_t WS_XF = WS_ROT + 2 * MiB;
constexpr size_t WS_XB = WS_XF + 128 * MiB;
constexpr size_t WS_P = WS_XB + 64 * MiB;
constexpr size_t WS_MIX = WS_P + 176 * MiB;
constexpr size_t WS_PRE = WS_MIX + 64 * MiB;
constexpr size_t WS_X1F = WS_PRE + 128 * MiB;
constexpr size_t WS_X1B = WS_X1F + 128 * MiB;
constexpr size_t WS_XS = WS_X1B + 64 * MiB;
constexpr size_t WS_CBM = WS_XS + 64 * MiB, WS_CBR = WS_XS + 96 * MiB;
constexpr size_t WS_H = WS_XS + 272 * MiB;
constexpr size_t WS_Y = WS_H + 272 * MiB;
constexpr size_t WS_TKE = WS_Y + 272 * MiB;
constexpr size_t WS_TKG = WS_TKE + 1 * MiB;
constexpr size_t WS_TKS = WS_TKG + 1 * MiB;
constexpr size_t WS_LIST = WS_TKS + 1 * MiB;
constexpr size_t WS_MC = WS_LIST + 4 * MiB;
constexpr size_t WS_RS = WS_MC + 36 * MiB;
constexpr size_t WS_MN = WS_RS + 36 * MiB;
constexpr size_t WS_MSC = WS_MN + 1 * MiB;
constexpr size_t WS_UT = WS_MSC + 1 * MiB;
constexpr size_t WS_AT = WS_UT + 32 * MiB;
constexpr size_t WS_WF = WS_AT + 32 * MiB;
constexpr size_t WS_FG = WS_WF + 4 * MiB;
constexpr size_t WS_END = WS_FG + 1 * MiB;
constexpr size_t WS_XQ = WS_XF;
constexpr size_t WS_WINQ = WS_X1F, WS_WFQ = WS_X1F + 16 * MiB;
constexpr size_t FG_H_OFF = 32768, FG_BF_OFF = 131072, WRT_OFF = 262144;

constexpr int CW_TMO = 0;
constexpr int CW_BAR = 4096;
constexpr int CW_CNT = 16384;

constexpr int RING_BYTES = 131072;
constexpr int MISC_OFF = RING_BYTES;
constexpr int GTAB_OFF = MISC_OFF + 8192;
constexpr int LDS_BYTES = 163840;

typedef __bf16 bf16x2_t __attribute__((ext_vector_type(2)));
__device__ __forceinline__ unsigned pk2(float lo, float hi) { const f32x2 v = {lo, hi}; return __builtin_bit_cast(unsigned, __builtin_convertvector(v, bf16x2_t)); }
__device__ __forceinline__ unsigned f2bf(float f) { return pk2(f, 0.f) & 0xffffu; }
__device__ __forceinline__ float bf2f(bf16_t b) { return __builtin_bit_cast(float, (unsigned)b << 16); }
__device__ __forceinline__ float wave_sum(float v) {
#pragma unroll
    for (int o = 1; o < 64; o <<= 1) v += __shfl_xor(v, o);
    return v;
}
__device__ __forceinline__ float wave_max(float v) {
#pragma unroll
    for (int o = 1; o < 64; o <<= 1) v = fmaxf(v, __shfl_xor(v, o));
    return v;
}
__device__ __forceinline__ float sigmoidf_(float x) { return __builtin_amdgcn_rcpf(1.0f + __builtin_amdgcn_exp2f(x * -1.4426950408889634f)); }
__device__ __forceinline__ float siluf_(float x) { return x * __builtin_amdgcn_rcpf(1.0f + __builtin_amdgcn_exp2f(x * -1.4426950408889634f)); }
__device__ __forceinline__ float logsigmoidf_(float x) { return fminf(x, 0.f) - __logf(1.0f + __expf(-fabsf(x))); }

namespace pg8 {
constexpr int BM = 256, BK = 64, HALF = 128, HTB = HALF * BK * 2, STAGE_BYTES = 8 * HTB;
__host__ __device__ __forceinline__ int lds_byte(int r, int c) { const int st = (r >> 4) * 2 + (c >> 5), rr = r & 15, cc = c & 31, ob = rr * 64 + cc * 2; return st * 1024 + (ob ^ (((ob >> 9) & 1) << 5)); }
__host__ __device__ __forceinline__ void stage_rc(int b, int& R, int& C) { const int st = b / 1024, sb = b % 1024, swz = sb ^ (((sb >> 9) & 1) << 5); R = (st >> 1) * 16 + swz / 64; C = (st & 1) * 32 + (swz % 64) / 2; }
__host__ __device__ __forceinline__ int perm32(int rho) { const int n = rho >> 4, i = rho & 15; return 8 * (i >> 2) + 4 * n + (i & 3); }
__host__ __device__ __forceinline__ int lds_byte8(int r, int byte) { const int st = (r >> 4) * 2 + (byte >> 6), rr = r & 15, c = (byte & 63) >> 4; return st * 1024 + rr * 64 + ((c ^ (rr >> 3)) << 4); }
__host__ __device__ __forceinline__ void stage_rc8(int b, int& R, int& C) { const int st = b / 1024, sb = b % 1024, rr = sb >> 6, c = ((sb & 63) >> 4) ^ (rr >> 3); R = (st >> 1) * 16 + rr; C = (st & 1) * 32 + c * 8; }
struct Unit { int pm, pn, e; };
__device__ __forceinline__ unsigned cvt_pk_bf16(float lo, float hi) { return ::pk2(lo, hi); }

template <class Epi, class Sched, bool ALIGN_EPI = false, bool SP2 = true>
__device__ __forceinline__ void gemm_phase(LAS unsigned char* lds, const int K, const Sched& S, const Epi& E, const int tid) {
    static_assert(SP2, "only the two-MFMA-blocks-per-barrier loop is kept");
    const int wid = __builtin_amdgcn_readfirstlane(tid >> 6), lane = tid & 63, wr = wid >> 2, wc = wid & 3, fr = lane & 15, fq = lane >> 4;
    const int nt = K / BK;
    unsigned vA0[2], vA1[2], voffB[2];
#pragma unroll
    for (int i = 0; i < 2; ++i) { int R, C; stage_rc(tid * 16 + i * 8192, R, C); const int Rb = Epi::PERM ? ((R & ~31) + perm32(R & 31)) : R;
        voffB[i] = S.b_off(Rb, C); if constexpr (!Sched::GATHER) { vA0[i] = S.a_off(R, C); vA1[i] = vA0[i]; } }
    Unit cur, nxt; int ui = 0;
    if (!S.next(0, cur)) return;
    typename Epi::Bias bia; E.load_bias(cur, wr, wc, fr, fq, bia);
    if constexpr (Sched::GATHER) { S.a_offs(0, tid, vA0, vA1); }
    const size_t kstep = (size_t)(BK * 2);
    const size_t hstepA = S.hstep_a(), hstepB = S.hstep_b();
    const unsigned ldsw = (unsigned)wid * 1024u;
    const int aoff = lds_byte(wr * 64 + fr, fq * 8), boff = lds_byte(wc * 32 + fr, fq * 8);
#define PG8_SA(b, h) (((b) * 2 + (h)) * HTB)
#define PG8_SB(b, h) ((4 + (b) * 2 + (h)) * HTB)
#define PG8_STAGE(bufoff, gbase, voff) do { _Pragma("unroll") for (int _i = 0; _i < 2; ++_i) { unsigned _o = (voff)[_i]; asm volatile("" : "+v"(_o)); \
        __builtin_amdgcn_global_load_lds((const unsigned*)((const char*)(gbase) + _o), (LAS unsigned*)(lds + (bufoff) + ldsw + _i * 8192), 16, 0, 0); } } while (0)
#define PG8_LDA(dst, b, h) do { _Pragma("unroll") for (int m = 0; m < 4; ++m) _Pragma("unroll") for (int k = 0; k < 2; ++k) dst[m][k] = *(const LAS bf16x8*)(lds + PG8_SA(b, h) + aoff + m * 2048 + k * 1024); } while (0)
#define PG8_LDB(dst, b, h) do { _Pragma("unroll") for (int n = 0; n < 2; ++n) _Pragma("unroll") for (int k = 0; k < 2; ++k) dst[n][k] = *(const LAS bf16x8*)(lds + PG8_SB(b, h) + boff + n * 2048 + k * 1024); } while (0)
#define PG8_MMA(ai, bj, At, Bt) do { __builtin_amdgcn_s_setprio(1); _Pragma("unroll") for (int m = 0; m < 4; ++m) _Pragma("unroll") for (int n = 0; n < 2; ++n) _Pragma("unroll") for (int k = 0; k < 2; ++k) \
        acc[ai][bj][m][n] = __builtin_amdgcn_mfma_f32_16x16x32_bf16(Bt[n][k], At[m][k], acc[ai][bj][m][n], 0, 0, 0); __builtin_amdgcn_s_setprio(0); } while (0)
#define PG8_WAIT_V(n) asm volatile("s_waitcnt vmcnt(" #n ")" ::: "memory")
#define PG8_WAIT_L(n) asm volatile("s_waitcnt lgkmcnt(" #n ")" ::: "memory")
#define PG8_BAR __builtin_amdgcn_s_barrier()
#define PG8_SCHED __builtin_amdgcn_sched_barrier(0)
    float zf_ = 0.f; asm volatile("" : "+v"(zf_)); const f32x4 zero4 = (f32x4){zf_, zf_, zf_, zf_};
    f32x4 acc[2][2][4][2];
#pragma unroll
    for (int a = 0; a < 2; ++a)
#pragma unroll
        for (int b = 0; b < 2; ++b)
#pragma unroll
            for (int m = 0; m < 4; ++m)
#pragma unroll
                for (int n = 0; n < 2; ++n) acc[a][b][m][n] = zero4;
    bf16x8 At[4][2], B0[2][2], B1[2][2];
    const char* cA = S.a_base(cur); const char* cB = S.b_base(cur);
    PG8_STAGE(PG8_SB(0, 0), cB, voffB); PG8_STAGE(PG8_SB(0, 1), cB + hstepB, voffB); PG8_STAGE(PG8_SA(0, 0), cA, vA0); PG8_STAGE(PG8_SA(0, 1), cA + hstepA, vA1);
    if (wr == 1) PG8_BAR;
    PG8_WAIT_V(2); PG8_BAR;
    PG8_STAGE(PG8_SB(1, 0), cB + kstep, voffB); PG8_STAGE(PG8_SA(1, 0), cA + kstep, vA0); PG8_STAGE(PG8_SB(1, 1), cB + hstepB + kstep, voffB);
    PG8_WAIT_V(6); PG8_BAR;
    for (;;) {
        const bool has_next = S.next(ui + 1, nxt);
        const char* nA = has_next ? S.a_base(nxt) : cA; const char* nB = has_next ? S.b_base(nxt) : cB;
#pragma unroll 1
        for (int t = 0; t < nt; t += 2) {
            const bool last = (t == nt - 2);
            const char* a1 = cA + (size_t)(t + 1) * kstep;
            const char* a2 = last ? nA : cA + (size_t)(t + 2) * kstep; const char* b2 = last ? nB : cB + (size_t)(t + 2) * kstep;
            const char* a3 = a2 + kstep; const char* b3 = b2 + kstep;
            PG8_LDB(B0, 0, 0); PG8_LDB(B1, 0, 1); PG8_SCHED; PG8_LDA(At, 0, 0); PG8_STAGE(PG8_SA(1, 1), a1 + hstepA, vA1);
            if constexpr (Sched::GATHER) { if (last && has_next) S.a_offs(ui + 1, tid, vA0, vA1); }
            PG8_WAIT_V(8); PG8_WAIT_L(0); PG8_BAR; PG8_MMA(0, 0, At, B0); PG8_MMA(0, 1, At, B1); PG8_BAR; PG8_SCHED;
            PG8_LDA(At, 0, 1); PG8_STAGE(PG8_SB(0, 0), b2, voffB); PG8_STAGE(PG8_SB(0, 1), b2 + hstepB, voffB); PG8_STAGE(PG8_SA(0, 0), a2, vA0);
            PG8_WAIT_V(8); PG8_WAIT_L(0); PG8_BAR; PG8_MMA(1, 0, At, B0); PG8_MMA(1, 1, At, B1); PG8_BAR; PG8_SCHED;
            PG8_LDB(B0, 1, 0); PG8_LDB(B1, 1, 1); PG8_SCHED; PG8_LDA(At, 1, 0); PG8_STAGE(PG8_SA(0, 1), a2 + hstepA, vA1);
            PG8_WAIT_V(8); PG8_WAIT_L(0); PG8_BAR; PG8_MMA(0, 0, At, B0); PG8_MMA(0, 1, At, B1); PG8_BAR; PG8_SCHED;
            PG8_LDA(At, 1, 1); PG8_STAGE(PG8_SB(1, 0), b3, voffB); PG8_STAGE(PG8_SB(1, 1), b3 + hstepB, voffB); PG8_STAGE(PG8_SA(1, 0), a3, vA0);
            PG8_WAIT_V(8); PG8_WAIT_L(0); PG8_BAR; PG8_MMA(1, 0, At, B0); PG8_MMA(1, 1, At, B1); PG8_BAR; PG8_SCHED;
        }
        if constexpr (ALIGN_EPI) { if (wr == 0) PG8_BAR; }
        { int te = tid; asm volatile("" : "+v"(te)); const int le_ = te & 63, we_ = __builtin_amdgcn_readfirstlane(te >> 6); E(acc, cur, we_ >> 2, we_ & 3, le_ & 15, le_ >> 4, bia); }
        if (!has_next) break;
#pragma unroll
        for (int a = 0; a < 2; ++a)
#pragma unroll
            for (int b = 0; b < 2; ++b)
#pragma unroll
                for (int m = 0; m < 4; ++m)
#pragma unroll
                    for (int n = 0; n < 2; ++n) acc[a][b][m][n] = zero4;
        cur = nxt; cA = nA; cB = nB; ++ui;
        E.load_bias(cur, wr, wc, fr, fq, bia);
        if constexpr (ALIGN_EPI) { if (wr == 1) PG8_BAR; }
    }
    PG8_WAIT_V(0);
    if constexpr (!ALIGN_EPI) { if (wr == 0) PG8_BAR; }
    PG8_BAR;
#undef PG8_SA
#undef PG8_SB
#undef PG8_STAGE
#undef PG8_LDA
#undef PG8_LDB
#undef PG8_MMA
#undef PG8_WAIT_V
#undef PG8_WAIT_L
#undef PG8_BAR
#undef PG8_SCHED
}

template <class Epi, class Sched, bool ALIGN_EPI = false, bool SP2 = true>
__device__ __forceinline__ void gemm_phase_f8(LAS unsigned char* lds, const int K, const Sched& S, const Epi& E, const int tid) {
    static_assert(SP2, "only the two-MFMA-blocks-per-barrier loop is kept");
    const int wid = __builtin_amdgcn_readfirstlane(tid >> 6), lane = tid & 63, wr = wid >> 2, wc = wid & 3, fr = lane & 15, fq = lane >> 4;
    const int nt = K / 128;
    unsigned vA0[2], vA1[2], voffB[2];
#pragma unroll
    for (int i = 0; i < 2; ++i) { int R, C; stage_rc8(tid * 16 + i * 8192, R, C); const int Rb = Epi::PERM ? ((R & ~31) + perm32(R & 31)) : R;
        voffB[i] = S.b_off(Rb, C); if constexpr (!Sched::GATHER) { vA0[i] = S.a_off(R, C); vA1[i] = vA0[i]; } }
    Unit cur, nxt; int ui = 0;
    if (!S.next(0, cur)) return;
    typename Epi::Bias bia; E.load_bias(cur, wr, wc, fr, fq, bia);
    if constexpr (Sched::GATHER) { S.a_offs(0, tid, vA0, vA1); }
    const size_t kstep = (size_t)(BK * 2);
    const size_t hstepA = S.hstep_a(), hstepB = S.hstep_b();
    const unsigned ldsw = (unsigned)wid * 1024u;
    const int aoff = lds_byte8(wr * 64 + fr, fq * 32), boff = lds_byte8(wc * 32 + fr, fq * 32);
    const int poff = (fr >> 3) ? -16 : 16;
#define PG8_SA(b, h) (((b) * 2 + (h)) * HTB)
#define PG8_SB(b, h) ((4 + (b) * 2 + (h)) * HTB)
#define PG8_STAGE(bufoff, gbase, voff) do { _Pragma("unroll") for (int _i = 0; _i < 2; ++_i) { unsigned _o = (voff)[_i]; asm volatile("" : "+v"(_o)); \
        __builtin_amdgcn_global_load_lds((const unsigned*)((const char*)(gbase) + _o), (LAS unsigned*)(lds + (bufoff) + ldsw + _i * 8192), 16, 0, 0); } } while (0)
#define PG8_LD32(p) __builtin_shufflevector(__builtin_bit_cast(v4i, *(const LAS bf16x8*)(p)), __builtin_bit_cast(v4i, *(const LAS bf16x8*)((p) + poff)), 0, 1, 2, 3, 4, 5, 6, 7)
#define PG8_LDA(dst, b, h) do { _Pragma("unroll") for (int m = 0; m < 4; ++m) dst[m] = PG8_LD32(lds + PG8_SA(b, h) + aoff + m * 2048); } while (0)
#define PG8_LDB(dst, b, h) do { _Pragma("unroll") for (int n = 0; n < 2; ++n) dst[n] = PG8_LD32(lds + PG8_SB(b, h) + boff + n * 2048); } while (0)
#define PG8_F8(x) (x)
#define PG8_MMA(ai, bj, At, Bt) do { __builtin_amdgcn_s_setprio(1); _Pragma("unroll") for (int m = 0; m < 4; ++m) _Pragma("unroll") for (int n = 0; n < 2; ++n) \
        asm volatile("v_mfma_scale_f32_16x16x128_f8f6f4 %0, %1, %2, %0, %3, %3 op_sel_hi:[0,0,0]" : "+v"(acc[ai][bj][m][n]) : "v"(Bt[n]), "v"(At[m]), "v"(sc127)); __builtin_amdgcn_s_setprio(0); } while (0)
#define PG8_WAIT_V(n) asm volatile("s_waitcnt vmcnt(" #n ")" ::: "memory")
#define PG8_WAIT_L(n) asm volatile("s_waitcnt lgkmcnt(" #n ")" ::: "memory")
#define PG8_BAR __builtin_amdgcn_s_barrier()
#define PG8_SCHED __builtin_amdgcn_sched_barrier(0)
    float zf_ = 0.f; asm volatile("" : "+v"(zf_)); const f32x4 zero4 = (f32x4){zf_, zf_, zf_, zf_};
    f32x4 acc[2][2][4][2];
#pragma unroll
    for (int a = 0; a < 2; ++a)
#pragma unroll
        for (int b = 0; b < 2; ++b)
#pragma unroll
            for (int m = 0; m < 4; ++m)
#pragma unroll
                for (int n = 0; n < 2; ++n) acc[a][b][m][n] = zero4;
    v8i At[4], B0[2], B1[2];
    const int sc127 = 0x7F7F7F7F;
    const char* cA = S.a_base(cur); const char* cB = S.b_base(cur);
    PG8_STAGE(PG8_SB(0, 0), cB, voffB); PG8_STAGE(PG8_SB(0, 1), cB + hstepB, voffB); PG8_STAGE(PG8_SA(0, 0), cA, vA0); PG8_STAGE(PG8_SA(0, 1), cA + hstepA, vA1);
    if (wr == 1) PG8_BAR;
    PG8_WAIT_V(2); PG8_BAR;
    PG8_STAGE(PG8_SB(1, 0), cB + kstep, voffB); PG8_STAGE(PG8_SA(1, 0), cA + kstep, vA0); PG8_STAGE(PG8_SB(1, 1), cB + hstepB + kstep, voffB);
    PG8_WAIT_V(6); PG8_BAR;
#if PROBE_MASK & 0x30000
    unsigned long long gts_ = __builtin_amdgcn_s_memrealtime();
#define GSEC(bit) do { if (PROBE_MASK & (bit)) { const unsigned long long d_ = __builtin_amdgcn_s_memrealtime() - gts_; while (__builtin_amdgcn_s_memrealtime() - gts_ < 2 * d_) __builtin_amdgcn_s_sleep(2); } gts_ = __builtin_amdgcn_s_memrealtime(); } while (0)
#else
#define GSEC(bit) do { } while (0)
#endif
    for (;;) {
        const bool has_next = S.next(ui + 1, nxt);
        const char* nA = has_next ? S.a_base(nxt) : cA; const char* nB = has_next ? S.b_base(nxt) : cB;
#pragma unroll 1
        for (int t = 0; t < nt; t += 2) {
            const bool last = (t == nt - 2);
            const char* a1 = cA + (size_t)(t + 1) * kstep;
            const char* a2 = last ? nA : cA + (size_t)(t + 2) * kstep; const char* b2 = last ? nB : cB + (size_t)(t + 2) * kstep;
            const char* a3 = a2 + kstep; const char* b3 = b2 + kstep;
            PG8_LDB(B0, 0, 0); PG8_LDB(B1, 0, 1); PG8_SCHED; PG8_LDA(At, 0, 0); PG8_STAGE(PG8_SA(1, 1), a1 + hstepA, vA1);
            if constexpr (Sched::GATHER) { if (last && has_next) S.a_offs(ui + 1, tid, vA0, vA1); }
            PG8_WAIT_V(8); PG8_WAIT_L(0); PG8_BAR; PG8_MMA(0, 0, At, B0); PG8_MMA(0, 1, At, B1); PG8_BAR; PG8_SCHED;
            PG8_LDA(At, 0, 1); PG8_STAGE(PG8_SB(0, 0), b2, voffB); PG8_STAGE(PG8_SB(0, 1), b2 + hstepB, voffB); PG8_STAGE(PG8_SA(0, 0), a2, vA0);
            PG8_WAIT_V(8); PG8_WAIT_L(0); PG8_BAR; PG8_MMA(1, 0, At, B0); PG8_MMA(1, 1, At, B1); PG8_BAR; PG8_SCHED;
            PG8_LDB(B0, 1, 0); PG8_LDB(B1, 1, 1); PG8_SCHED; PG8_LDA(At, 1, 0); PG8_STAGE(PG8_SA(0, 1), a2 + hstepA, vA1);
            PG8_WAIT_V(8); PG8_WAIT_L(0); PG8_BAR; PG8_MMA(0, 0, At, B0); PG8_MMA(0, 1, At, B1); PG8_BAR; PG8_SCHED;
            PG8_LDA(At, 1, 1); PG8_STAGE(PG8_SB(1, 0), b3, voffB); PG8_STAGE(PG8_SB(1, 1), b3 + hstepB, voffB); PG8_STAGE(PG8_SA(1, 0), a3, vA0);
            PG8_WAIT_V(8); PG8_WAIT_L(0); PG8_BAR; PG8_MMA(1, 0, At, B0); PG8_MMA(1, 1, At, B1); PG8_BAR; PG8_SCHED;
        }
        GSEC(0x10000);
        if constexpr (ALIGN_EPI) { if (wr == 0) PG8_BAR; }
        asm volatile("s_nop 15\n\ts_nop 15" ::: "memory");
        { int te = tid; asm volatile("" : "+v"(te)); const int le_ = te & 63, we_ = __builtin_amdgcn_readfirstlane(te >> 6); E(acc, cur, we_ >> 2, we_ & 3, le_ & 15, le_ >> 4, bia); }
        if (!has_next) break;
#pragma unroll
        for (int a = 0; a < 2; ++a)
#pragma unroll
            for (int b = 0; b < 2; ++b)
#pragma unroll
                for (int m = 0; m < 4; ++m)
#pragma unroll
                    for (int n = 0; n < 2; ++n) acc[a][b][m][n] = zero4;
        cur = nxt; cA = nA; cB = nB; ++ui;
        E.load_bias(cur, wr, wc, fr, fq, bia);
        GSEC(0x20000);
        if constexpr (ALIGN_EPI) { if (wr == 1) PG8_BAR; }
    }
    PG8_WAIT_V(0);
    if constexpr (!ALIGN_EPI) { if (wr == 0) PG8_BAR; }
    PG8_BAR;
#undef PG8_SA
#undef PG8_SB
#undef PG8_STAGE
#undef PG8_LDA
#undef PG8_LDB
#undef PG8_MMA
#undef PG8_F8
#undef GSEC
#undef PG8_LD32
#undef PG8_WAIT_V
#undef PG8_WAIT_L
#undef PG8_BAR
#undef PG8_SCHED
}

struct PlainOrder {
    static constexpr bool GATHER = false;
    const char* A; const char* Bt; int K; int nM, nN, nwg, G, c;
    __device__ __forceinline__ void init(const void* A_, const void* Bt_, int M, int N, int K_, int G_, int c_) { A = (const char*)A_; Bt = (const char*)Bt_; K = K_; nM = M / BM; nN = N / BM; nwg = nM * nN; G = G_; c = c_; }
    __device__ __forceinline__ bool next(int i, Unit& u) const {
        const long Lq = (long)i * G + c; if (Lq >= nwg) return false;
        int wgid = (int)Lq; { const int q = nwg / 8, r = nwg % 8, xcd = wgid % 8, off = wgid / 8; wgid = (xcd < r ? xcd * (q + 1) : r * (q + 1) + (xcd - r) * q) + off; }
        const int nig = 8 * nN, gid = wgid / nig, fm = gid * 8, gsz = (nM - fm) < 8 ? (nM - fm) : 8;
        u.pm = fm + ((wgid % nig) % gsz); u.pn = (wgid % nig) / gsz; u.e = 0; return true;
    }
    __device__ __forceinline__ const char* a_base(const Unit& u) const { return A + (size_t)u.pm * 256 * K * 2; }
    __device__ __forceinline__ const char* b_base(const Unit& u) const { return Bt + (size_t)u.pn * 256 * K * 2; }
    __device__ __forceinline__ unsigned a_off(int R, int C) const { return (unsigned)(R * K + C) * 2u; }
    __device__ __forceinline__ unsigned b_off(int R, int C) const { return (unsigned)(R * K + C) * 2u; }
    __device__ __forceinline__ size_t hstep_a() const { return (size_t)HALF * K * 2; }
    __device__ __forceinline__ size_t hstep_b() const { return (size_t)HALF * K * 2; }
};
struct PlainOrder8 : PlainOrder {
    __device__ __forceinline__ const char* a_base(const Unit& u) const { return A + (size_t)u.pm * 256 * K; }
    __device__ __forceinline__ const char* b_base(const Unit& u) const { return Bt + (size_t)u.pn * 256 * K; }
    __device__ __forceinline__ unsigned a_off(int R, int C) const { return (unsigned)(R * K + C * 2); }
    __device__ __forceinline__ unsigned b_off(int R, int C) const { return (unsigned)(R * K + C * 2); }
    __device__ __forceinline__ size_t hstep_a() const { return (size_t)HALF * K; }
    __device__ __forceinline__ size_t hstep_b() const { return (size_t)HALF * K; }
};
struct PlainOrderBf : PlainOrder {
    __device__ __forceinline__ bool next(int i, Unit& u) const { if (!PlainOrder::next(i, u)) return false; u.pn = u.pn < 2 ? u.pn : u.pn + 2; return true; }
};
struct PlainOrderF8 : PlainOrder8 {
    __device__ __forceinline__ bool next(int i, Unit& u) const { if (!PlainOrder::next(i, u)) return false; u.pn = u.pn < 2 ? u.pn + 2 : u.pn + 4; return true; }
};
struct FourierOrder {
    static constexpr bool GATHER = false;
    const char* A; const char* X; int K, G, c;
    __device__ __forceinline__ bool next(int i, Unit& u) const { const int Lq = i * G + c; if (Lq >= 256) return false; u.pm = Lq & 1; u.pn = Lq >> 1; u.e = 0; return true; }
    __device__ __forceinline__ const char* a_base(const Unit& u) const { return A + (size_t)u.pm * 256 * K * 2; }
    __device__ __forceinline__ const char* b_base(const Unit& u) const { return X + (size_t)((u.pn >> 5) * 8192 + (u.pn & 31) * 4) * K * 2; }
    __device__ __forceinline__ unsigned a_off(int R, int C) const { return (unsigned)(R * K + C) * 2u; }
    __device__ __forceinline__ unsigned b_off(int R, int C) const { return (unsigned)((((R & 63) * 128 + (R >> 6)) * K + C) * 2); }
    __device__ __forceinline__ size_t hstep_a() const { return (size_t)HALF * K * 2; }
    __device__ __forceinline__ size_t hstep_b() const { return (size_t)2 * K * 2; }
};
struct FourierOrder8 {
    static constexpr bool GATHER = false;
    const char* A; const char* X; int K, G, c;
    __device__ __forceinline__ bool next(int i, Unit& u) const { const int Lq = i * G + c; if (Lq >= 256) return false; u.pm = Lq & 1; u.pn = Lq >> 1; u.e = 0; return true; }
    __device__ __forceinline__ const char* a_base(const Unit& u) const { return A + (size_t)u.pm * 256 * K; }
    __device__ __forceinline__ const char* b_base(const Unit& u) const { return X + (size_t)((u.pn >> 5) * 8192 + (u.pn & 31) * 4) * K; }
    __device__ __forceinline__ unsigned a_off(int R, int C) const { return (unsigned)(R * K + C * 2); }
    __device__ __forceinline__ unsigned b_off(int R, int C) const { return (unsigned)(((R & 63) * 128 + (R >> 6)) * K + C * 2); }
    __device__ __forceinline__ size_t hstep_a() const { return (size_t)HALF * K; }
    __device__ __forceinline__ size_t hstep_b() const { return (size_t)2 * K; }
};
__device__ __forceinline__ bool moe_unit(int i, int c, int G, int nN, int ntot, int& pm, int& pn) {
    if (G == 256) { const int x = c & 7, j = c >> 3;
        if (nN == 8) { pm = i * 32 + x * 4 + (j >> 3); pn = j & 7; } else { pm = i * 64 + x * 8 + (j >> 2); pn = j & 3; }
        return pm < ntot; }
    const long Lq = (long)i * G + c; pm = (int)(Lq / nN); pn = (int)(Lq % nN); return pm < ntot;
}
struct GroupOrder {
    static constexpr bool GATHER = false;
    const char* A; const char* Bt; int K  ; int nN, ntot, G, c; size_t bstride; const LAS unsigned char* tile_e;
    __device__ __forceinline__ bool next(int i, Unit& u) const {
        if (!moe_unit(i, c, G, nN, ntot, u.pm, u.pn)) return false;
        u.e = __builtin_amdgcn_readfirstlane((int)tile_e[u.pm]); return true;
    }
    __device__ __forceinline__ const char* a_base(const Unit& u) const { return A + (size_t)u.pm * 256 * K; }
    __device__ __forceinline__ const char* b_base(const Unit& u) const { return Bt + (size_t)u.e * bstride + (size_t)u.pn * 256 * K; }
    __device__ __forceinline__ unsigned a_off(int R, int C) const { return (unsigned)(R * K + C * 2); }
    __device__ __forceinline__ unsigned b_off(int R, int C) const { return (unsigned)(R * K + C * 2); }
    __device__ __forceinline__ size_t hstep_a() const { return (size_t)HALF * K; }
    __device__ __forceinline__ size_t hstep_b() const { return (size_t)HALF * K; }
};

struct GatherOrder {
    static constexpr bool GATHER = true;
    const char* X; const char* Bt; int K  ; int nN, ntot, G, c; size_t bstride; const LAS unsigned char* tile_e; const LAS unsigned* gtab;
    __device__ __forceinline__ bool next(int i, Unit& u) const {
        if (!moe_unit(i, c, G, nN, ntot, u.pm, u.pn)) return false;
        u.e = __builtin_amdgcn_readfirstlane((int)tile_e[u.pm]); return true;
    }
    __device__ __forceinline__ const char* a_base(const Unit&) const { return X; }
    __device__ __forceinline__ const char* b_base(const Unit& u) const { return Bt + (size_t)u.e * bstride + (size_t)u.pn * 256 * K; }
    __device__ __forceinline__ unsigned a_off(int, int) const { return 0u; }
    __device__ __forceinline__ void a_offs(int ui, int tid, unsigned (&v0)[2], unsigned (&v1)[2]) const {
#pragma unroll
        for (int i = 0; i < 2; ++i) { int R, C; stage_rc8(tid * 16 + i * 8192, R, C); v0[i] = gtab[ui * 256 + R] + (unsigned)C * 2u; v1[i] = gtab[ui * 256 + 128 + R] + (unsigned)C * 2u; } }
    __device__ __forceinline__ unsigned b_off(int R, int C) const { return (unsigned)(R * K + C * 2); }
    __device__ __forceinline__ size_t hstep_a() const { return 0; }
    __device__ __forceinline__ size_t hstep_b() const { return (size_t)HALF * K; }
};

struct EpiBf16Bias {
    static constexpr bool PERM = true;
    bf16_t* O; int ldc; const float* bias; float ascale;
    struct Bias { f32x4 v[2][2]; };
    __device__ __forceinline__ void load_bias(const Unit& u, int wr, int wc, int fr, int fq, Bias& B) const {
        const int col0 = u.pn * BM + wc * 32 + 8 * fq;
#pragma unroll
        for (int bj = 0; bj < 2; ++bj)
#pragma unroll
            for (int n = 0; n < 2; ++n) B.v[bj][n] = *(const f32x4*)(bias + col0 + bj * HALF + 4 * n);
    }
    __device__ __forceinline__ void operator()(const f32x4 (&acc)[2][2][4][2], const Unit& u, int wr, int wc, int fr, int fq, const Bias& B) const {
        const int row0 = u.pm * BM + wr * 64 + fr, col0 = u.pn * BM + wc * 32 + 8 * fq;
        const f32x4 (&bv)[2][2] = B.v;
#pragma unroll
        for (int ai = 0; ai < 2; ++ai)
#pragma unroll
            for (int m = 0; m < 4; ++m) { bf16_t* rowp = O + (size_t)(row0 + ai * HALF + m * 16) * ldc + col0;
#pragma unroll
                for (int bj = 0; bj < 2; ++bj) { const f32x4 v0 = acc[ai][bj][m][0] * ascale + bv[bj][0], v1 = acc[ai][bj][m][1] * ascale + bv[bj][1];
                    u32x4 w; w.x = cvt_pk_bf16(v0[0], v0[1]); w.y = cvt_pk_bf16(v0[2], v0[3]); w.z = cvt_pk_bf16(v1[0], v1[1]); w.w = cvt_pk_bf16(v1[2], v1[3]);
                    *(u32x4*)(rowp + bj * HALF) = w; } }
    }
};
struct EpiFourierT {
    static constexpr bool PERM = true;
    bf16_t* UT; const float* bF; float ascale;
    struct Bias { float v[2][4]; };
    __device__ __forceinline__ void load_bias(const Unit& u, int wr, int wc, int fr, int fq, Bias& B) const {
#pragma unroll
        for (int ai = 0; ai < 2; ++ai)
#pragma unroll
            for (int m = 0; m < 4; ++m) B.v[ai][m] = bF[u.pm * 256 + ai * HALF + wr * 64 + m * 16 + fr];
    }
    __device__ __forceinline__ void operator()(const f32x4 (&acc)[2][2][4][2], const Unit& u, int wr, int wc, int fr, int fq, const Bias& B) const {
        const int b = u.pn >> 5, q = u.pn & 31, cs = u.pm;
#pragma unroll
        for (int ai = 0; ai < 2; ++ai)
#pragma unroll
            for (int m = 0; m < 4; ++m) { const int ch = ai * HALF + wr * 64 + m * 16 + fr; const float bv = B.v[ai][m];
#pragma unroll
                for (int bj = 0; bj < 2; ++bj) { const int s2 = 4 * q + 2 * bj + (wc >> 1), s1 = 32 * (wc & 1) + 8 * fq;
                    const f32x4 v0 = acc[ai][bj][m][0] * ascale + bv, v1 = acc[ai][bj][m][1] * ascale + bv;
                    u32x4 w; w.x = cvt_pk_bf16(v0[0], v0[1]); w.y = cvt_pk_bf16(v0[2], v0[3]); w.z = cvt_pk_bf16(v1[0], v1[1]); w.w = cvt_pk_bf16(v1[2], v1[3]);
                    *(u32x4*)(UT + ((size_t)((b * 256 + ch) * 128 + s2) * 2 + cs) * 64 + s1) = w; } }
    }
};
struct EpiResBf16 {
    static constexpr bool PERM = true;
    bf16_t* O; const bf16_t* R; int ldc; float alpha, ascale;
    struct Bias { };
    __device__ __forceinline__ void load_bias(const Unit&, int, int, int, int, Bias&) const { }
    __device__ __forceinline__ void operator()(const f32x4 (&acc)[2][2][4][2], const Unit& u, int wr, int wc, int fr, int fq, const Bias&) const {
        const int row0 = u.pm * BM + wr * 64 + fr, col0 = u.pn * BM + wc * 32 + 8 * fq;
        u32x4 rall[2][4][2];
#pragma unroll
        for (int ai = 0; ai < 2; ++ai)
#pragma unroll
            for (int m = 0; m < 4; ++m)
#pragma unroll
                for (int bj = 0; bj < 2; ++bj) rall[ai][m][bj] = *(const u32x4*)(R + (size_t)(row0 + ai * HALF + m * 16) * ldc + col0 + bj * HALF);
#pragma unroll
        for (int ai = 0; ai < 2; ++ai)
#pragma unroll
            for (int m = 0; m < 4; ++m) { const size_t off = (size_t)(row0 + ai * HALF + m * 16) * ldc + col0;
#pragma unroll
                for (int bj = 0; bj < 2; ++bj) { const u32x4 rv = rall[ai][m][bj]; const f32x4 a0 = acc[ai][bj][m][0] * ascale, a1 = acc[ai][bj][m][1] * ascale;
                    u32x4 w;
                    w.x = cvt_pk_bf16(a0[0] + alpha * __builtin_bit_cast(float, rv.x << 16), a0[1] + alpha * __builtin_bit_cast(float, rv.x & 0xffff0000u));
                    w.y = cvt_pk_bf16(a0[2] + alpha * __builtin_bit_cast(float, rv.y << 16), a0[3] + alpha * __builtin_bit_cast(float, rv.y & 0xffff0000u));
                    w.z = cvt_pk_bf16(a1[0] + alpha * __builtin_bit_cast(float, rv.z << 16), a1[1] + alpha * __builtin_bit_cast(float, rv.z & 0xffff0000u));
                    w.w = cvt_pk_bf16(a1[2] + alpha * __builtin_bit_cast(float, rv.w << 16), a1[3] + alpha * __builtin_bit_cast(float, rv.w & 0xffff0000u));
                    *(u32x4*)(O + off + bj * HALF) = w; } }
    }
};
__device__ __forceinline__ unsigned pk4_fp8(float a, float b, float c, float d) { int w = 0; w = __builtin_amdgcn_cvt_pk_fp8_f32(a, b, w, false); w = __builtin_amdgcn_cvt_pk_fp8_f32(c, d, w, true); return (unsigned)w; }
struct EpiSwiglu8 {
    static constexpr bool PERM = true;
    unsigned char* H; const float* b1; float ascale;
    struct Bias { f32x4 v[4]; };
    __device__ __forceinline__ void load_bias(const Unit& u, int wr, int wc, int fr, int fq, Bias& B) const {
        const float* bg = b1 + (size_t)u.e * 2048 + u.pn * HALF + wc * 32 + 8 * fq; const float* bu = bg + 1024;
        B.v[0] = *(const f32x4*)(bg); B.v[1] = *(const f32x4*)(bg + 4); B.v[2] = *(const f32x4*)(bu); B.v[3] = *(const f32x4*)(bu + 4);
    }
    __device__ __forceinline__ void operator()(const f32x4 (&acc)[2][2][4][2], const Unit& u, int wr, int wc, int fr, int fq, const Bias& B) const {
        const int row0 = u.pm * BM + wr * 64 + fr, col0 = u.pn * HALF + wc * 32 + 8 * fq;
        const f32x4 g0 = B.v[0], g1 = B.v[1], u0 = B.v[2], u1 = B.v[3];
#pragma unroll
        for (int ai = 0; ai < 2; ++ai)
#pragma unroll
            for (int m = 0; m < 4; ++m) { unsigned char* rowp = H + (size_t)(row0 + ai * HALF + m * 16) * FF + col0;
                u32x2 w;
#pragma unroll
                for (int n = 0; n < 2; ++n) { f32x4 g = acc[ai][0][m][n] * ascale + (n ? g1 : g0), up = acc[ai][1][m][n] * ascale + (n ? u1 : u0);
#pragma unroll
                    for (int j = 0; j < 4; ++j) { g[j] = fminf(g[j], SW_LIMIT); up[j] = fminf(fmaxf(up[j], -SW_LIMIT), SW_LIMIT); }
                    const f32x4 z = g * (-SW_ALPHA * LOG2E); f32x4 e;
#pragma unroll
                    for (int j = 0; j < 4; ++j) e[j] = __builtin_amdgcn_exp2f(z[j]);
                    const f32x4 d = e + 1.0f; f32x4 r;
#pragma unroll
                    for (int j = 0; j < 4; ++j) r[j] = __builtin_amdgcn_rcpf(d[j]);
                    const f32x4 o = (up + 1.0f) * (g * r);
                    if (n == 0) w.x = pk4_fp8(o[0], o[1], o[2], o[3]); else w.y = pk4_fp8(o[0], o[1], o[2], o[3]); }
                *(u32x2*)rowp = w; }
    }
};
struct EpiExpertOut {
    static constexpr bool PERM = true;
    unsigned char* Y; const float* b2; float ascale;
    struct Bias { f32x4 v[2][2]; };
    __device__ __forceinline__ void load_bias(const Unit& u, int wr, int wc, int fr, int fq, Bias& B) const {
        const float* bb = b2 + (size_t)u.e * D + u.pn * BM + wc * 32 + 8 * fq;
#pragma unroll
        for (int bj = 0; bj < 2; ++bj)
#pragma unroll
            for (int n = 0; n < 2; ++n) B.v[bj][n] = *(const f32x4*)(bb + bj * HALF + 4 * n) * Y_SCALE;
    }
    __device__ __forceinline__ void operator()(const f32x4 (&acc)[2][2][4][2], const Unit& u, int wr, int wc, int fr, int fq, const Bias& B) const {
        const int row0 = u.pm * BM + wr * 64 + fr, col0 = u.pn * BM + wc * 32 + 8 * fq;
        const f32x4 (&bv)[2][2] = B.v; const float sc = ascale * Y_SCALE;
#pragma unroll
        for (int ai = 0; ai < 2; ++ai)
#pragma unroll
            for (int m = 0; m < 4; ++m) { unsigned char* rowp = Y + (size_t)(row0 + ai * HALF + m * 16) * D + col0;
#pragma unroll
                for (int bj = 0; bj < 2; ++bj) { const f32x4 v0 = acc[ai][bj][m][0] * sc + bv[bj][0], v1 = acc[ai][bj][m][1] * sc + bv[bj][1];
                    u32x2 w; w.x = pk4_fp8(v0[0], v0[1], v0[2], v0[3]); w.y = pk4_fp8(v1[0], v1[1], v1[2], v1[3]);
                    *(u32x2*)(rowp + bj * HALF) = w; } }
    }
};
}

#define XB_TMO      128
#define XB_XCNT(j)  (256  + 64 * (j))
#define XB_XSUB(j)  (1280 + 64 * (j))
#define XB_XGEN(j)  (2304 + 64 * (j))
#define XB_TOP      3328
#define XB_TOPGEN   3392
#define XCD_BAR_WORDS 3456
#define XB_SPIN_CAP (1u << 22)
__device__ __forceinline__ unsigned xb_ld(unsigned* p)              { return __hip_atomic_load(p, __ATOMIC_RELAXED, __HIP_MEMORY_SCOPE_AGENT); }
__device__ __forceinline__ unsigned xb_add(unsigned* p, unsigned v) { return __hip_atomic_fetch_add(p, v, __ATOMIC_RELAXED, __HIP_MEMORY_SCOPE_AGENT); }
__device__ __forceinline__ unsigned xb_xcc_id() { return (unsigned)__builtin_amdgcn_s_getreg((3 << 11) | 20) & 0xFu; }
#define XB_SPIN(cond, bar) do { unsigned _sp = 0; while (cond) { __builtin_amdgcn_s_sleep(1); \
    if ((++_sp & 255u) == 0u) { if (xb_ld(&(bar)[XB_TMO])) break; if (_sp > XB_SPIN_CAP) { atomicAdd(&(bar)[XB_TMO], 1u); break; } } } } while (0)
struct XcdBarrier { unsigned* bar; unsigned x; volatile LAS unsigned* st; };
__device__ __forceinline__ XcdBarrier xcd_barrier_post(unsigned* bar, volatile LAS unsigned* st) {
    XcdBarrier b; b.bar = bar; b.x = xb_xcc_id(); b.st = st;
    if (threadIdx.x == 0) (void)xb_add(&bar[XB_XCNT(b.x)], 1u);
    return b;
}
__device__ __forceinline__ void xcd_barrier_complete(unsigned* bar, unsigned x, unsigned& nloc, unsigned& nx) {
    const unsigned G = gridDim.x * gridDim.y * gridDim.z;
    unsigned sum, cnt, mine, sp = 0u;
    for (;;) {
        sum = 0u; cnt = 0u; mine = 0u;
#pragma unroll
        for (unsigned j = 0; j < 16; ++j) { const unsigned c = xb_ld(&bar[XB_XCNT(j)]); sum += c; cnt += (c > 0u) ? 1u : 0u; mine = (j == x) ? c : mine; }
        if (sum == G) break;
        __builtin_amdgcn_s_sleep(1);
        if ((++sp & 255u) == 0u) { if (xb_ld(&bar[XB_TMO])) break; if (sp > XB_SPIN_CAP) { atomicAdd(&bar[XB_TMO], 1u); break; } }
    }
    nloc = mine > 0u ? mine : 1u; nx = cnt > 0u ? cnt : 1u;
}
__device__ __forceinline__ void xcd_barrier(const XcdBarrier& b) {
    asm volatile("s_waitcnt vmcnt(0)" ::: "memory");
    __syncthreads();
    if (threadIdx.x == 0) {
        unsigned* bar = b.bar;
        __builtin_amdgcn_s_waitcnt(0);
        unsigned nloc = b.st[0], nx = b.st[1];
        if (nloc == 0u) { xcd_barrier_complete(bar, b.x, nloc, nx); b.st[0] = nloc; b.st[1] = nx; }
        const unsigned old = xb_add(&bar[XB_XSUB(b.x)], 1u);
        const unsigned gen = old / nloc;
        if (old + 1u == (gen + 1u) * nloc) {
            __builtin_amdgcn_fence(__ATOMIC_RELEASE, "agent");
            asm volatile("s_waitcnt vmcnt(0)" ::: "memory");
            const unsigned og = xb_add(&bar[XB_TOP], 1u);
            const unsigned tg = og / nx;
            if (og + 1u == (tg + 1u) * nx) xb_add(&bar[XB_TOPGEN], 1u);
            else XB_SPIN(xb_ld(&bar[XB_TOPGEN]) == tg, bar);
            __builtin_amdgcn_fence(__ATOMIC_ACQUIRE, "agent");
            xb_add(&bar[XB_XGEN(b.x)], 1u);
            asm volatile("s_waitcnt vmcnt(0)" ::: "memory");
        } else {
            XB_SPIN(xb_ld(&bar[XB_XGEN(b.x)]) == gen, bar);
            __builtin_amdgcn_fence(__ATOMIC_ACQUIRE, "agent");
            asm volatile("s_waitcnt vmcnt(0)" ::: "memory");
        }
    }
    __syncthreads();
}

struct Args {
    const float* x; const float* emb_g; const float* emb_b; const float* w_in; const float* b_in; const float* conv_w; const float* ml_nw; const float* ret_nw;
    const float* w_out; const float* ln1_g; const float* ln1_b; const float* w_router; const float* b_router; const float* w1; const float* b1; const float* w2; const float* b2;
    const float* ln2_g; const float* ln2_b;
    float* out; unsigned char* ws; int ph_lo, ph_hi;
};
template <class Tp> __device__ __forceinline__ Tp* as_global(Tp* p) { return (Tp*)(__attribute__((address_space(1))) Tp*)p; }
__device__ __forceinline__ int as_global(int v) { return v; }
#define KA(f) as_global(((const volatile __attribute__((address_space(4))) Args*)__builtin_amdgcn_kernarg_segment_ptr())->f)
constexpr int NWAVES = 8, NTHR = 512;
constexpr int NPH_LAYER = 9;
constexpr int NPH = 1 + NL * NPH_LAYER;

struct Frame {
    LAS unsigned char* lds;
    unsigned* ctl;
    int tid, lane, wave, G, bid;
};

__device__ __forceinline__ int sidx(int b, int h, int dir, int c) { return ((b * NH + h) * 2 + dir) * NCH + c; }

template <class RowMap>
__device__ __forceinline__ void transpose_item(const float* W, int K, int Nsrc, bf16_t* WT, LAS float* scr, int kb, int nb, int lane, const RowMap& rm, int coff = 0) {
    const int k0 = 64 * kb, n0 = 32 * nb;
    const int nn = n0 + (lane & 31) + coff;
    float tv[32];
#pragma unroll
    for (int i = 0; i < 32; ++i) { const int kk = 2 * i + (lane >> 5); tv[i] = nn < Nsrc ? __builtin_nontemporal_load(W + (size_t)(k0 + kk) * Nsrc + nn) : 0.f; }
#pragma unroll
    for (int i = 0; i < 32; ++i) { const int kk = 2 * i + (lane >> 5); scr[kk * 33 + (lane & 31)] = tv[i]; }
    asm volatile("s_waitcnt lgkmcnt(0)" ::: "memory");
    const int c = lane & 7;
#pragma unroll
    for (int j = 0; j < 4; ++j) { const int n = (lane >> 3) + 8 * j; const LAS float* s = scr + (8 * c) * 33 + n;
        u32x4 o; o.x = pk2(s[0 * 33], s[1 * 33]); o.y = pk2(s[2 * 33], s[3 * 33]); o.z = pk2(s[4 * 33], s[5 * 33]); o.w = pk2(s[6 * 33], s[7 * 33]);
        *(u32x4*)(WT + (size_t)rm(n0 + n) * K + k0 + 8 * c) = o; }
    asm volatile("s_waitcnt lgkmcnt(0)" ::: "memory");
}
template <class RowMap>
__device__ __forceinline__ void transpose_item_f8(const float* W, int K, int Nsrc, unsigned char* WT, LAS float* scr, int kb, int nb, int lane, const RowMap& rm, float scale) {
    const int k0 = 64 * kb, n0 = 32 * nb;
    const int nn = n0 + (lane & 31);
    float tv[32];
#pragma unroll
    for (int i = 0; i < 32; ++i) { const int kk = 2 * i + (lane >> 5); tv[i] = __builtin_nontemporal_load(W + (size_t)(k0 + kk) * Nsrc + nn); }
#pragma unroll
    for (int i = 0; i < 32; ++i) { const int kk = 2 * i + (lane >> 5); scr[kk * 33 + (lane & 31)] = tv[i] * scale; }
    asm volatile("s_waitcnt lgkmcnt(0)" ::: "memory");
    const int c = lane & 7;
#pragma unroll
    for (int j = 0; j < 4; ++j) { const int n = (lane >> 3) + 8 * j; const LAS float* sp = scr + (8 * c) * 33 + n;
        u32x2 o; o.x = pg8::pk4_fp8(sp[0 * 33], sp[1 * 33], sp[2 * 33], sp[3 * 33]); o.y = pg8::pk4_fp8(sp[4 * 33], sp[5 * 33], sp[6 * 33], sp[7 * 33]);
        *(u32x2*)(WT + (size_t)rm(n0 + n) * K + k0 + 8 * c) = o; }
    asm volatile("s_waitcnt lgkmcnt(0)" ::: "memory");
}
template <class RowMap>
__device__ __forceinline__ void transpose_item128_f8(const float* W, int K, int Nsrc, unsigned char* WT, LAS unsigned* scr, int kb, int nb, int lane, const RowMap& rm, float scale, int coff = 0) {
    const int k0 = 128 * kb, n0 = 32 * nb, n4 = lane & 7, kq = lane >> 3; const bool inb = n0 + 4 * n4 + coff < Nsrc;
    f32x4 x[4][4];
#pragma unroll
    for (int it = 0; it < 4; ++it)
#pragma unroll
        for (int r = 0; r < 4; ++r) x[it][r] = inb ? __builtin_nontemporal_load((const f32x4*)(W + (size_t)(k0 + 32 * it + 4 * kq + r) * Nsrc + n0 + 4 * n4 + coff)) : (f32x4){0.f, 0.f, 0.f, 0.f};
#pragma unroll
    for (int it = 0; it < 4; ++it)
#pragma unroll
        for (int j = 0; j < 4; ++j) scr[(4 * n4 + j) * 33 + 8 * it + kq] = pg8::pk4_fp8(x[it][0][j] * scale, x[it][1][j] * scale, x[it][2][j] * scale, x[it][3][j] * scale);
    asm volatile("s_waitcnt lgkmcnt(0)" ::: "memory");
#pragma unroll
    for (int q = 0; q < 4; ++q) { const int n = 8 * q + (lane >> 3), c = lane & 7; const LAS unsigned* sp = scr + n * 33 + 4 * c;
        u32x4 o; o.x = sp[0]; o.y = sp[1]; o.z = sp[2]; o.w = sp[3];
        *(u32x4*)(WT + (size_t)rm(n0 + n) * K + k0 + 16 * c) = o; }
    asm volatile("s_waitcnt lgkmcnt(0)" ::: "memory");
}
__device__ __forceinline__ void t128_load(const float* W, int Nsrc, int kb, int nb, int lane, f32x4 (&x)[4][4]) {
    const int k0 = 128 * kb, n0 = 32 * nb, n4 = lane & 7, kq = lane >> 3;
#pragma unroll
    for (int it = 0; it < 4; ++it)
#pragma unroll
        for (int r = 0; r < 4; ++r) x[it][r] = __builtin_nontemporal_load((const f32x4*)(W + (size_t)(k0 + 32 * it + 4 * kq + r) * Nsrc + n0 + 4 * n4));
}
template <class RowMap>
__device__ __forceinline__ void t128_finish(const f32x4 (&x)[4][4], int K, unsigned char* WT, LAS unsigned* scr, int kb, int nb, int lane, const RowMap& rm, float scale) {
    const int k0 = 128 * kb, n0 = 32 * nb, n4 = lane & 7, kq = lane >> 3;
#pragma unroll
    for (int it = 0; it < 4; ++it)
#pragma unroll
        for (int j = 0; j < 4; ++j) scr[(4 * n4 + j) * 33 + 8 * it + kq] = pg8::pk4_fp8(x[it][0][j] * scale, x[it][1][j] * scale, x[it][2][j] * scale, x[it][3][j] * scale);
    asm volatile("s_waitcnt lgkmcnt(0)" ::: "memory");
#pragma unroll
    for (int q = 0; q < 4; ++q) { const int n = 8 * q + (lane >> 3), c = lane & 7; const LAS unsigned* sp = scr + n * 33 + 4 * c;
        u32x4 o; o.x = sp[0]; o.y = sp[1]; o.z = sp[2]; o.w = sp[3];
        *(u32x4*)(WT + (size_t)rm(n0 + n) * K + k0 + 16 * c) = o; }
    asm volatile("s_waitcnt lgkmcnt(0)" ::: "memory");
}
struct RowId { __device__ __forceinline__ int operator()(int n) const { return n; } };
struct RowW1 { __device__ __forceinline__ int operator()(int n) const { const int up = n >> 10, j = n & 1023; return (j >> 7) * 256 + up * 128 + (j & 127); } };

__device__ __forceinline__ void ln_row(const f32x4 (&vin)[4], const float* g, const float* b, float* of, bf16_t* ob, float* of2, int lane, unsigned char* oq = nullptr) {
    f32x4 v[4]; float s = 0.f;
#pragma unroll
    for (int j = 0; j < 4; ++j) { v[j] = vin[j]; s += (v[j].x + v[j].y) + (v[j].z + v[j].w); }
    const float mean = wave_sum(s) * (1.f / D); float s2 = 0.f;
#pragma unroll
    for (int j = 0; j < 4; ++j) { v[j] = v[j] - mean; s2 += (v[j].x * v[j].x + v[j].y * v[j].y) + (v[j].z * v[j].z + v[j].w * v[j].w); }
    const float rstd = 1.f / sqrtf(wave_sum(s2) * (1.f / D) + LN_EPS);
#pragma unroll
    for (int j = 0; j < 4; ++j) { const f32x4 gg = *(const f32x4*)(g + 4 * lane + 256 * j), bb = *(const f32x4*)(b + 4 * lane + 256 * j);
        const f32x4 o = v[j] * rstd * gg + bb;
        if (of) *(f32x4*)(of + 4 * lane + 256 * j) = o;
        if (of2) *(f32x4*)(of2 + 4 * lane + 256 * j) = o;
        if (ob) { u32x2 w; w.x = pk2(o.x, o.y); w.y = pk2(o.z, o.w); *(u32x2*)(ob + 4 * lane + 256 * j) = w; }
        if (oq) { const f32x4 q = o * XQ_SCALE; *(unsigned*)(oq + 4 * lane + 256 * j) = pg8::pk4_fp8(q.x, q.y, q.z, q.w); } }
}

__device__ __forceinline__ void p0_prologue(const Frame& F, const Args& a) {
    unsigned char* ws = KA(ws);
    LAS float* scr = (LAS float*)(F.lds + F.wave * 16384);
    const int gw = F.bid * NWAVES + F.wave, NGW = F.G * NWAVES;
    const float* w_in_ = KA(w_in); const float* w_out_ = KA(w_out); const float* w1_ = KA(w1); const float* w2_ = KA(w2);
    constexpr int I_INQ = NL * 8 * 80; constexpr int I_IN = NL * 16 * 80, I_OUT = NL * 8 * 32, I_W1 = NL * NE * 8 * 64, I_W2 = NL * NE * 8 * 32;
    for (int it = gw; it < I_INQ + I_IN + I_OUT; it += NGW) {
        int r = it;
        if (r < I_INQ) { const int l = r / (8 * 80), q = r % (8 * 80); transpose_item128_f8(w_in_ + (size_t)l * D * PW, D, PW, (unsigned char*)(ws + WS_WINQ) + (size_t)l * PWP * D, (LAS unsigned*)scr, q / 80, q % 80, F.lane, RowId(), WINQ_SCALE, PWF); continue; } r -= I_INQ;
        if (r < I_IN) { const int l = r / (16 * 80), q = r % (16 * 80); transpose_item(w_in_ + (size_t)l * D * PW, D, PW, (bf16_t*)(ws + WS_WIN) + (size_t)l * PWP * D, scr, q / 80, q % 80, F.lane, RowId(), PWF); continue; } r -= I_IN;
        { const int l = r / (8 * 32), q = r % (8 * 32); transpose_item128_f8(w_out_ + (size_t)l * D * D, D, D, (unsigned char*)(ws + WS_WOUT) + (size_t)l * D * D, (LAS unsigned*)scr, q / 32, q % 32, F.lane, RowId(), WOUT_SCALE); }
    }
    {
#define XW_LOAD(r_, x_) do { const int rr_ = (r_); if (rr_ < I_W1) { const int le = rr_ / (8 * 64), q = rr_ % (8 * 64); t128_load(w1_ + (size_t)le * D * 2048, 2048, q / 64, q % 64, F.lane, x_); } \
            else { const int r2 = rr_ - I_W1, le = r2 / (8 * 32), q = r2 % (8 * 32); t128_load(w2_ + (size_t)le * FF * D, D, q / 32, q % 32, F.lane, x_); } } while (0)
#define XW_FINISH(r_, x_) do { const int rr_ = (r_); if (rr_ < I_W1) { const int le = rr_ / (8 * 64), q = rr_ % (8 * 64); t128_finish(x_, D, (unsigned char*)(ws + WS_W1) + (size_t)le * 2048 * D, (LAS unsigned*)scr, q / 64, q % 64, F.lane, RowW1(), W1_SCALE); } \
            else { const int r2 = rr_ - I_W1, le = r2 / (8 * 32), q = r2 % (8 * 32); t128_finish(x_, FF, (unsigned char*)(ws + WS_W2) + (size_t)le * D * FF, (LAS unsigned*)scr, q / 32, q % 32, F.lane, RowId(), W2_SCALE); } } while (0)
        constexpr int NX = I_W1 + I_W2;
        f32x4 xa[4][4], xb_[4][4];
        int r = gw; if (r < NX) XW_LOAD(r, xa);
#pragma unroll 1
        for (; r < NX; r += 2 * NGW) {
            if (r + NGW < NX) XW_LOAD(r + NGW, xb_);
            XW_FINISH(r, xa);
            if (r + 2 * NGW < NX) XW_LOAD(r + 2 * NGW, xa);
            if (r + NGW < NX) XW_FINISH(r + NGW, xb_);
        }
#undef XW_LOAD
#undef XW_FINISH
    }
    const int gt = F.bid * NTHR + F.tid, NGT = F.G * NTHR;
    float* binp = (float*)(ws + WS_BIN); const float* bin_ = KA(b_in);
    for (int i = gt; i < NL * PWP; i += NGT) { const int l = i / PWP, c = i % PWP; binp[i] = c < PW2 ? bin_[l * PW + PWF + c] : 0.f; }
    { bf16_t* WF = (bf16_t*)(ws + WS_WF); float* bF = (float*)(ws + WS_FG + FG_BF_OFF);
      {
        LAS float* wr8 = scr;
        LAS float* tab = scr + 2048;
        tab[F.lane] = __builtin_amdgcn_cosf((float)F.lane * (1.0f / 64.0f)); tab[64 + F.lane] = __builtin_amdgcn_sinf((float)F.lane * (1.0f / 64.0f));
        for (int rg = gw; rg < NL * D / 8; rg += NGW) { const int l = rg / (D / 8), k0 = (rg % (D / 8)) * 8;
#pragma unroll
            for (int kr = 0; kr < 8; ++kr) *(LAS f32x4*)(wr8 + kr * 256 + 4 * F.lane) = *(const f32x4*)(w_in_ + ((size_t)l * D + k0 + kr) * PW + 4 * F.lane);
            asm volatile("s_waitcnt lgkmcnt(0)" ::: "memory");
#pragma unroll 1
            for (int q = 0; q < 8; ++q) { const int cs = q >> 2, g = q & 3; float acc[8];
#pragma unroll
                for (int kr = 0; kr < 8; ++kr) acc[kr] = 0.f;
#pragma unroll 4
                for (int c = 0; c < 64; ++c) { const float tv = tab[cs * 64 + ((c * F.lane) & 63)];
#pragma unroll
                    for (int kr = 0; kr < 8; ++kr) acc[kr] += wr8[kr * 256 + g * 64 + c] * tv; }
                u32x4 o; o.x = pk2(acc[0], acc[1]); o.y = pk2(acc[2], acc[3]); o.z = pk2(acc[4], acc[5]); o.w = pk2(acc[6], acc[7]);
                *(u32x4*)(WF + ((size_t)l * 512 + cs * 256 + g * 64 + F.lane) * D + k0) = o;
                u32x2 oq; oq.x = pg8::pk4_fp8(acc[0] * WFQ_SCALE, acc[1] * WFQ_SCALE, acc[2] * WFQ_SCALE, acc[3] * WFQ_SCALE); oq.y = pg8::pk4_fp8(acc[4] * WFQ_SCALE, acc[5] * WFQ_SCALE, acc[6] * WFQ_SCALE, acc[7] * WFQ_SCALE);
                *(u32x2*)((unsigned char*)(ws + WS_WFQ) + ((size_t)l * 512 + cs * 256 + g * 64 + F.lane) * D + k0) = oq; }
            asm volatile("s_waitcnt lgkmcnt(0)" ::: "memory"); } }
      for (int i = gt; i < NL * 512; i += NGT) { const int l = i / 512, r = i % 512, cs = r >> 8, g = (r >> 6) & 3, cp = r & 63; float acc = 0.f;
          for (int c = 0; c < 64; ++c) { const float rev = (float)((c * cp) & 63) * (1.0f / 64.0f); acc += bin_[l * PW + g * 64 + c] * (cs ? __builtin_amdgcn_sinf(rev) : __builtin_amdgcn_cosf(rev)); }
          bF[i] = acc; }
      bf16_t* Gm = (bf16_t*)(ws + WS_FG);
      for (int i = gt; i < 128 * 128; i += NGT) { const int ro = i >> 13, k1 = (i >> 7) & 63, ri = (i >> 6) & 1, s1 = i & 63; const float rev = (float)((k1 * s1) & 63) * (1.0f / 64.0f);
          const float c = __builtin_amdgcn_cosf(rev), sn = __builtin_amdgcn_sinf(rev); Gm[i] = (bf16_t)f2bf(ro == 0 ? (ri == 0 ? c : -sn) : (ri == 0 ? -sn : -c)); }
      bf16_t* Hm = (bf16_t*)(ws + WS_FG + FG_H_OFF);
      for (int i = gt; i < 128 * 256; i += NGT) { const int k2 = i >> 8, ri = (i >> 7) & 1, s2 = i & 127; const float rev = (float)((k2 * s2) & 127) * (1.0f / 128.0f);
          Hm[i] = (bf16_t)f2bf(0.0013810679320049757f * (ri ? __builtin_amdgcn_sinf(rev) : __builtin_amdgcn_cosf(rev))); } }
    float* rot = (float*)(ws + WS_ROT);
    for (int i = gt; i < S * 24; i += NGT) { const int pos = i / 24, j = i % 24; const float inv = 1.0f / powf(10000.0f, (float)(2 * j) / 48.0f); const float ang = (float)pos * inv;
        float sn, cs; sincosf(ang, &sn, &cs); rot[2 * i] = cs; rot[2 * i + 1] = sn; }
    float* xf = (float*)(ws + WS_XF); bf16_t* xb = (bf16_t*)(ws + WS_XB); const float* xin = KA(x); const float* eg = KA(emb_g); const float* eb = KA(emb_b);
    for (int m = gw; m < T; m += NGW) { f32x4 v[4];
#pragma unroll
        for (int j = 0; j < 4; ++j) v[j] = *(const f32x4*)(xin + (size_t)m * D + 4 * F.lane + 256 * j);
        ln_row(v, eg, eb, nullptr, xb + (size_t)m * D, nullptr, F.lane, (unsigned char*)(ws + WS_XQ) + (size_t)m * D); }
    { float* wrt = (float*)(ws + WS_BIN + WRT_OFF); const float* wrs = KA(w_router);
      for (int i = gt; i < NL * NE * D; i += NGT) { const int l = i / (NE * D), e = (i / D) % NE, k = i % D; wrt[i] = wrs[((size_t)l * D + k) * NE + e]; } }
}

template <bool REV, bool MAXOP> __device__ __forceinline__ void scan2(float& x0, float& x1, int lane) {
    float s = MAXOP ? fmaxf(x0, x1) : x0 + x1;
#pragma unroll
    for (int o = 1; o < 64; o <<= 1) { const float t = REV ? __shfl_down(s, o) : __shfl_up(s, o); const bool ok = REV ? (lane + o < 64) : (lane >= o); if (ok) s = MAXOP ? fmaxf(s, t) : s + t; }
    float ex = REV ? __shfl_down(s, 1) : __shfl_up(s, 1); if (REV ? lane == 63 : lane == 0) ex = MAXOP ? -INFINITY : 0.f;
    if (!REV) { x0 = MAXOP ? fmaxf(ex, x0) : ex + x0; x1 = MAXOP ? fmaxf(x0, x1) : x0 + x1; }
    else      { x1 = MAXOP ? fmaxf(ex, x1) : ex + x1; x0 = MAXOP ? fmaxf(x1, x0) : x1 + x0; }
}
__device__ __forceinline__ float ret_lg(int h, float off) {
    return off == 0.f ? (h == 0 ? -0.0317486983145803f : h == 1 ? -0.015748356968139168f : h == 2 ? -0.007843177461025893f : -0.003913899321136329f)
                      : (h == 0 ? -0.02234488474624582f : h == 1 ? -0.01111003193719751f : h == 2 ? -0.005539586946744796f : -0.002765957600334473f);
}

typedef short s16x4 __attribute__((ext_vector_type(4)));
__device__ __forceinline__ bf16x8 tr_frag(const LAS bf16_t* tile, int stride, int row0, int col0, int lane) {
    const LAS bf16_t* a0 = tile + (row0 + 8 * (lane >> 4) + ((lane & 15) >> 2)) * stride + col0 + 4 * (lane & 3);
    const s16x4 lo = __builtin_amdgcn_ds_read_tr16_b64_v4i16((LAS s16x4*)a0);
    const s16x4 hi = __builtin_amdgcn_ds_read_tr16_b64_v4i16((LAS s16x4*)(a0 + 4 * stride));
    return (bf16x8){lo[0], lo[1], lo[2], lo[3], hi[0], hi[1], hi[2], hi[3]};
}
constexpr int QKS = 72, VSS = 104, WSS = 136, KPS = 56;

__device__ __forceinline__ void qk_chunk8(const bf16_t* P, const float* convw, const float* rot, int type, int b, int s, int h, int isk, int cc, float (&o)[8]) {
    if (type == 0) {
        const int ch0 = isk * 192 + h * DK + 8 * cc;
        const bf16_t* p0 = P + (size_t)(b * S + s) * PWP + COL_MQK + ch0;
        const u32x4 z = (u32x4){0u, 0u, 0u, 0u};
        const u32x4 xm = s > 0 ? *(const u32x4*)(p0 - PWP) : z, x0 = *(const u32x4*)p0, xp = s < S - 1 ? *(const u32x4*)(p0 + PWP) : z;
        const float* w = convw + ch0;
        const f32x4 w0a = *(const f32x4*)w, w0b = *(const f32x4*)(w + 4), w1a = *(const f32x4*)(w + 384), w1b = *(const f32x4*)(w + 388), w2a = *(const f32x4*)(w + 768), w2b = *(const f32x4*)(w + 772);
#pragma unroll
        for (int i = 0; i < 4; ++i) { const unsigned am = xm[i], a0 = x0[i], ap = xp[i];
            const float wl0 = i < 2 ? w0a[2 * i] : w0b[2 * i - 4], wh0 = i < 2 ? w0a[2 * i + 1] : w0b[2 * i - 3];
            const float wl1 = i < 2 ? w1a[2 * i] : w1b[2 * i - 4], wh1 = i < 2 ? w1a[2 * i + 1] : w1b[2 * i - 3];
            const float wl2 = i < 2 ? w2a[2 * i] : w2b[2 * i - 4], wh2 = i < 2 ? w2a[2 * i + 1] : w2b[2 * i - 3];
            const float lo = __builtin_bit_cast(float, am << 16) * wl0 + __builtin_bit_cast(float, a0 << 16) * wl1 + __builtin_bit_cast(float, ap << 16) * wl2;
            const float hi = __builtin_bit_cast(float, am & 0xffff0000u) * wh0 + __builtin_bit_cast(float, a0 & 0xffff0000u) * wh1 + __builtin_bit_cast(float, ap & 0xffff0000u) * wh2;
            o[2 * i] = siluf_(lo); o[2 * i + 1] = siluf_(hi); }
    } else {
        const u32x4 x0 = *(const u32x4*)(P + (size_t)(b * S + s) * PWP + (isk ? COL_RK : COL_RQ) + h * DK + 8 * cc);
        const float* rp = rot + (size_t)(s * 24 + 4 * cc) * 2;
        const f32x4 ra = *(const f32x4*)rp, rb = *(const f32x4*)(rp + 4);
#pragma unroll
        for (int i = 0; i < 4; ++i) { const float t1 = __builtin_bit_cast(float, x0[i] << 16), t2 = __builtin_bit_cast(float, x0[i] & 0xffff0000u);
            const float cs = i < 2 ? ra[2 * i] : rb[2 * i - 4], sn = i < 2 ? ra[2 * i + 1] : rb[2 * i - 3];
            o[2 * i] = t1 * cs - t2 * sn; o[2 * i + 1] = t1 * sn + t2 * cs; }
    }
}
__device__ __forceinline__ void load_qk(const Frame& F, const bf16_t* P, const float* convw, const float* rot, int type, int b, int c, int h, float kscale, LAS bf16_t* Qs, LAS bf16_t* Ks) {
#pragma unroll
    for (int it = 0; it < 3; ++it) { const int item = F.tid + NTHR * it, j = item / 12, ck = item % 12, isk = ck >= 6, cc = isk ? ck - 6 : ck;
        float o[8]; qk_chunk8(P, convw, rot, type, b, c * CH + j, h, isk, cc, o);
        const float sc = isk ? kscale : 1.0f;
        u32x4 w; w.x = pk2(o[0] * sc, o[1] * sc); w.y = pk2(o[2] * sc, o[3] * sc); w.z = pk2(o[4] * sc, o[5] * sc); w.w = pk2(o[6] * sc, o[7] * sc);
        *(LAS u32x4*)((isk ? Ks : Qs) + j * QKS + 8 * cc) = w; }
}
__device__ __forceinline__ void load_v(const Frame& F, const bf16_t* P, int type, int t0, int h, LAS bf16_t* Vs) {
    u32x4 vv[3];
#pragma unroll
    for (int it = 0; it < 3; ++it) { const int idx = F.tid + NTHR * it, j = idx / 12, vc = idx % 12; vv[it] = *(const u32x4*)(P + (size_t)(t0 + j) * PWP + (type ? COL_RV : COL_MV) + h * DV + 8 * vc); }
#pragma unroll
    for (int it = 0; it < 3; ++it) { const int idx = F.tid + NTHR * it, j = idx / 12, vc = idx % 12; *(LAS u32x4*)(Vs + j * VSS + 8 * vc) = vv[it]; }
}

__device__ __forceinline__ void phaseB_mfma(const Frame& F0, const Args& a, int l, int u) {
    Frame F = F0; asm volatile("" : "+v"(F.tid), "+v"(F.lane)); asm volatile("" : "+s"(F.wave));
    unsigned char* ws = KA(ws);
    const bf16_t* P = (const bf16_t*)(ws + WS_P);
    const int type = u >> 10, r_ = u & 1023, b = r_ >> 8, c = (r_ >> 2) & 63, h = r_ & 3;
    LAS bf16_t* Kf = (LAS bf16_t*)F.lds;
    LAS bf16_t* Kb = Kf + 128 * KPS;
    LAS bf16_t* Vs = Kb + 128 * KPS;
    LAS float* ga = (LAS float*)(Vs + 128 * VSS);
    LAS float* lff = ga, *lfb = ga + 128, *iff = ga + 256, *ibb = ga + 384, *pf = ga + 512, *pb = ga + 640, *scal = ga + 768;
    const int t0 = b * S + c * CH;
    const float kscale = 0.14433756729740643f;
    const float* rot = (const float*)(ws + WS_ROT);
    const float* convw = KA(conv_w) + (size_t)l * 3 * 384;
    float* msc = (float*)(ws + WS_MSC);
    load_v(F, P, type, t0, h, Vs);
    { float pf0, pf1, pb0, pb1;
      if (type == 0) {
        const bf16_t* g0 = P + (size_t)(t0 + 2 * F.lane) * PWP + COL_MG; const bf16_t* g1 = g0 + PWP;
        const float if0 = bf2f(g0[h]), if1 = bf2f(g1[h]), ib0 = bf2f(g0[8 + h]), ib1 = bf2f(g1[8 + h]);
        float af0 = logsigmoidf_(bf2f(g0[4 + h])), af1 = logsigmoidf_(bf2f(g1[4 + h])), ab0 = logsigmoidf_(bf2f(g0[12 + h])), ab1 = logsigmoidf_(bf2f(g1[12 + h]));
        scan2<false, false>(af0, af1, F.lane); scan2<true, false>(ab0, ab1, F.lane);
        const float aend_f = __shfl(af1, 63), aend_b = __shfl(ab0, 0);
        pf0 = aend_f - af0 + if0; pf1 = aend_f - af1 + if1; pb0 = aend_b - ab0 + ib0; pb1 = aend_b - ab1 + ib1;
        const float mf = wave_max(fmaxf(pf0, pf1)), mb = wave_max(fmaxf(pb0, pb1));
        pf0 = __expf(pf0 - mf); pf1 = __expf(pf1 - mf); pb0 = __expf(pb0 - mb); pb1 = __expf(pb1 - mb);
        if (F.tid == 0) { msc[sidx(b, h, 0, c)] = mf; msc[sidx(b, h, 1, c)] = mb; msc[2048 + sidx(b, h, 0, c)] = aend_f; msc[2048 + sidx(b, h, 1, c)] = aend_b; }
      } else {
        const float lgf = ret_lg(h, 0.f), lgb = ret_lg(h, 0.5f);
        pf0 = __expf(lgf * (float)(127 - 2 * F.lane)); pf1 = __expf(lgf * (float)(126 - 2 * F.lane)); pb0 = __expf(lgb * (float)(2 * F.lane)); pb1 = __expf(lgb * (float)(2 * F.lane + 1));
      }
      *(LAS f32x2*)(pf + 2 * F.lane) = (f32x2){pf0, pf1}; *(LAS f32x2*)(pb + 2 * F.lane) = (f32x2){pb0, pb1}; }
#pragma unroll
    for (int it = 0; it < 2; ++it) { const int item = F.tid + NTHR * it;
        if (item < 128 * 6) { const int j = item / 6, cc = item % 6; float o[8]; qk_chunk8(P, convw, rot, type, b, c * CH + j, h, 1, cc, o);
            const float sf = kscale * pf[j], sb = kscale * pb[j];
            u32x4 w; w.x = pk2(o[0] * sf, o[1] * sf); w.y = pk2(o[2] * sf, o[3] * sf); w.z = pk2(o[4] * sf, o[5] * sf); w.w = pk2(o[6] * sf, o[7] * sf);
            *(LAS u32x4*)(Kf + j * KPS + 8 * cc) = w;
            w.x = pk2(o[0] * sb, o[1] * sb); w.y = pk2(o[2] * sb, o[3] * sb); w.z = pk2(o[4] * sb, o[5] * sb); w.w = pk2(o[6] * sb, o[7] * sb);
            *(LAS u32x4*)(Kb + j * KPS + 8 * cc) = w; } }
    __syncthreads();
    float* X = (float*)(ws + (type ? WS_RS : WS_MC));
    const int l15 = F.lane & 15, lq = F.lane >> 4;
    for (int tt = F.wave; tt < 36; tt += NWAVES) { const int dir = tt / 18, mt = (tt % 18) / 6, nt = tt % 6; const LAS bf16_t* Ksrc = dir ? Kb : Kf;
        f32x4 acc = (f32x4){0.f, 0.f, 0.f, 0.f};
#pragma unroll
        for (int ks = 0; ks < 4; ++ks) { const bf16x8 af = tr_frag(Ksrc, KPS, 32 * ks, 16 * mt, F.lane), bfv = tr_frag(Vs, VSS, 32 * ks, 16 * nt, F.lane);
            acc = __builtin_amdgcn_mfma_f32_16x16x32_bf16(af, bfv, acc, 0, 0, 0); }
        *(f32x4*)(X + (size_t)sidx(b, h, dir, c) * (DV * DK) + (16 * nt + l15) * DK + 16 * mt + 4 * lq) = acc; }
    if (type == 0 && F.tid < 2 * DK) { const int dir = F.tid / DK, kk = F.tid % DK; const LAS bf16_t* Ksrc = dir ? Kb : Kf; float sN = 0.f;
        for (int j = 0; j < 128; ++j) sN += bf2f(Ksrc[j * KPS + kk]);
        ((float*)(ws + WS_MN))[(size_t)sidx(b, h, dir, c) * DK + kk] = sN; }
    __syncthreads();
}

__device__ __forceinline__ void phaseD_mfma(const Frame& F0, const Args& a, int l, int u) {
    Frame F = F0; asm volatile("" : "+v"(F.tid), "+v"(F.lane)); asm volatile("" : "+s"(F.wave));
    unsigned char* ws = KA(ws);
    const bf16_t* P = (const bf16_t*)(ws + WS_P); unsigned char* mix = (unsigned char*)(ws + WS_MIX);
    const int type = u >> 10, r_ = u & 1023, b = r_ >> 8, c = (r_ >> 2) & 63, h = r_ & 3;
    LAS bf16_t* Qs = (LAS bf16_t*)F.lds;
    LAS bf16_t* Ks = Qs + 128 * QKS;
    LAS bf16_t* Vs = Ks + 128 * QKS;
    LAS bf16_t* Wm = Vs + 128 * VSS;
    LAS bf16_t* Cf = Wm + 128 * WSS;
    LAS bf16_t* Cb = Cf + 96 * QKS;
    LAS float* ar = (LAS float*)(Cb + 96 * QKS);
    LAS float* af = ar, *ab = ar + 128, *iff = ar + 256, *ibb = ar + 384, *gxf = ar + 512, *gxb = ar + 640, *mtf = ar + 768, *mtb = ar + 896;
    static_assert((128 * QKS * 2 + 128 * VSS + 128 * WSS + 2 * 96 * QKS) * 2 + 8 * 128 * 4 <= RING_BYTES, "phase D LDS");
    const int t0 = b * S + c * CH;
    const float kscale = 0.14433756729740643f;
    const float* rot = (const float*)(ws + WS_ROT);
    const float* convw = KA(conv_w) + (size_t)l * 3 * 384;
#if PROBE_MASK & 0xF000
    unsigned long long dts_ = __builtin_amdgcn_s_memrealtime();
#define DSEC(bit) do { if (PROBE_MASK & (bit)) { const unsigned long long d_ = __builtin_amdgcn_s_memrealtime() - dts_; while (__builtin_amdgcn_s_memrealtime() - dts_ < 2 * d_) __builtin_amdgcn_s_sleep(2); } dts_ = __builtin_amdgcn_s_memrealtime(); } while (0)
#else
#define DSEC(bit) do { } while (0)
#endif
    const int w = F.wave, l15 = F.lane & 15, lq = F.lane >> 4, j = 16 * w + l15;
    float npfv[12], npbv[12];
    if (type == 0) { const float* npf = (const float*)(ws + WS_MN) + (size_t)sidx(b, h, 0, c) * DK + 12 * lq; const float* npb = (const float*)(ws + WS_MN) + (size_t)sidx(b, h, 1, c) * DK + 12 * lq;
#pragma unroll
        for (int q4 = 0; q4 < 3; ++q4) { const f32x4 x = *(const f32x4*)(npf + 4 * q4), y = *(const f32x4*)(npb + 4 * q4);
#pragma unroll
            for (int e = 0; e < 4; ++e) { npfv[4 * q4 + e] = x[e]; npbv[4 * q4 + e] = y[e]; } } }
    u32x2 gtw[6]; f32x4 nwv[6];
    { const bf16_t* prow = P + (size_t)(t0 + j) * PWP + (type ? COL_RG : COL_MO) + h * DV + 4 * lq;
      const float* nwp = (type ? KA(ret_nw) : KA(ml_nw)); const float* nw = nwp + (size_t)l * 384 + h * DV + 4 * lq;
#pragma unroll
      for (int n = 0; n < 6; ++n) { gtw[n] = *(const u32x2*)(prow + 16 * n); nwv[n] = *(const f32x4*)(nw + 16 * n); } }
    load_qk(F, P, convw, rot, type, b, c, h, kscale, Qs, Ks);
    load_v(F, P, type, t0, h, Vs);
    {
      for (int idx = F.tid; idx < 448 * 2; idx += NTHR) { const int rr = idx >> 1, hh = idx & 1; LAS bf16_t* base = rr < 128 ? Qs + rr * QKS : rr < 256 ? Ks + (rr - 128) * QKS : rr < 352 ? Cf + (rr - 256) * QKS : Cb + (rr - 352) * QKS;
          *(LAS u32x4*)(base + 48 + 8 * hh) = (u32x4){0u, 0u, 0u, 0u}; }
      const bf16_t* Cg = (const bf16_t*)(ws + (type ? WS_CBR : WS_CBM));
#pragma unroll
      for (int it = 0; it < 3; ++it) { const int idx = F.tid + NTHR * it; if (idx < 2 * 96 * 6) { const int dir = idx / (96 * 6), rem = idx % (96 * 6), v = rem / 6, ch = rem % 6;
          *(LAS u32x4*)((dir ? Cb : Cf) + v * QKS + 8 * ch) = *(const u32x4*)(Cg + (size_t)sidx(b, h, dir, c) * (DV * DK) + v * DK + 8 * ch); } } }
#if PROBE_MASK & 0xF000
    asm volatile("s_waitcnt vmcnt(0) lgkmcnt(0)" ::: "memory"); DSEC(0x1000);
#endif
    float mpf = 0.f, mpb = 0.f;
    if (type == 0) {
        const float* msc = (const float*)(ws + WS_MSC);
        mpf = msc[4096 + sidx(b, h, 0, c)]; mpb = msc[4096 + sidx(b, h, 1, c)];
        const bf16_t* g0 = P + (size_t)(t0 + 2 * F.lane) * PWP + COL_MG; const bf16_t* g1 = g0 + PWP;
        const float if0 = bf2f(g0[h]), if1 = bf2f(g1[h]), ib0 = bf2f(g0[8 + h]), ib1 = bf2f(g1[8 + h]);
        float af0 = logsigmoidf_(bf2f(g0[4 + h])), af1 = logsigmoidf_(bf2f(g1[4 + h])), ab0 = logsigmoidf_(bf2f(g0[12 + h])), ab1 = logsigmoidf_(bf2f(g1[12 + h]));
        scan2<false, false>(af0, af1, F.lane); scan2<true, false>(ab0, ab1, F.lane);
        float gf0 = if0 - af0, gf1 = if1 - af1, gb0 = ib0 - ab0, gb1 = ib1 - ab1;
        scan2<false, true>(gf0, gf1, F.lane); scan2<true, true>(gb0, gb1, F.lane);
        *(LAS f32x2*)(af + 2 * F.lane) = (f32x2){af0, af1}; *(LAS f32x2*)(ab + 2 * F.lane) = (f32x2){ab0, ab1};
        *(LAS f32x2*)(gxf + 2 * F.lane) = (f32x2){(if0 - af0) * LOG2E, (if1 - af1) * LOG2E}; *(LAS f32x2*)(gxb + 2 * F.lane) = (f32x2){(ib0 - ab0) * LOG2E, (ib1 - ab1) * LOG2E};
        *(LAS f32x2*)(mtf + 2 * F.lane) = (f32x2){fmaxf(af0 + mpf, af0 + gf0), fmaxf(af1 + mpf, af1 + gf1)};
        *(LAS f32x2*)(mtb + 2 * F.lane) = (f32x2){fmaxf(ab0 + mpb, ab0 + gb0), fmaxf(ab1 + mpb, ab1 + gb1)};
    }
    __syncthreads();
    DSEC(0x2000);
    bf16x8 qf[2];
#pragma unroll
    for (int ks = 0; ks < 2; ++ks) qf[ks] = *(const LAS bf16x8*)(Qs + j * QKS + 32 * ks + 8 * lq);
    f32x4 If[6], Ib[6];
#pragma unroll
    for (int n = 0; n < 6; ++n) { If[n] = (f32x4){0.f, 0.f, 0.f, 0.f}; Ib[n] = (f32x4){0.f, 0.f, 0.f, 0.f};
#pragma unroll
        for (int ks = 0; ks < 2; ++ks) { const bf16x8 cf = *(const LAS bf16x8*)(Cf + (16 * n + l15) * QKS + 32 * ks + 8 * lq), cb = *(const LAS bf16x8*)(Cb + (16 * n + l15) * QKS + 32 * ks + 8 * lq);
            If[n] = __builtin_amdgcn_mfma_f32_16x16x32_bf16(cf, qf[ks], If[n], 0, 0, 0); Ib[n] = __builtin_amdgcn_mfma_f32_16x16x32_bf16(cb, qf[ks], Ib[n], 0, 0, 0); } }
    f32x4 St[8];
#pragma unroll
    for (int m = 0; m < 8; ++m) { St[m] = (f32x4){0.f, 0.f, 0.f, 0.f};
#pragma unroll
        for (int ks = 0; ks < 2; ++ks) { const bf16x8 kf = *(const LAS bf16x8*)(Ks + (16 * m + l15) * QKS + 32 * ks + 8 * lq); St[m] = __builtin_amdgcn_mfma_f32_16x16x32_bf16(kf, qf[ks], St[m], 0, 0, 0); } }
    float cfj, cbj;
    if (type == 0) {
        const float afj = af[j], abj = ab[j], mtfj = mtf[j], mtbj = mtb[j];
        const float cjf = (afj - mtfj) * LOG2E, cjb = (abj - mtbj) * LOG2E;
        float denf = 0.f, denb = 0.f; f32x4 sd = (f32x4){0.f, 0.f, 0.f, 0.f};
#pragma unroll
        for (int m = 0; m < 8; ++m) { const f32x4 g4 = *(const LAS f32x4*)((m <= w ? gxf : gxb) + 16 * m + 4 * lq);
            if (m < w) {
#pragma unroll
                for (int r = 0; r < 4; ++r) { St[m][r] *= __builtin_amdgcn_exp2f(cjf + g4[r]); denf += St[m][r]; }
            } else if (m > w) {
#pragma unroll
                for (int r = 0; r < 4; ++r) { St[m][r] *= __builtin_amdgcn_exp2f(cjb + g4[r]); denb += St[m][r]; }
            } else {
                const f32x4 g4b = *(const LAS f32x4*)(gxb + 16 * m + 4 * lq);
#pragma unroll
                for (int r = 0; r < 4; ++r) { const int s = 16 * m + 4 * lq + r; const float raw = St[m][r];
                    const float ef = s <= j ? __builtin_amdgcn_exp2f(cjf + g4[r]) : 0.f, eb = s >= j ? __builtin_amdgcn_exp2f(cjb + g4b[r]) : 0.f;
                    St[m][r] = raw * ef; sd[r] = raw * eb; denf += St[m][r]; denb += sd[r]; }
            } }
        float nqf = 0.f, nqb = 0.f;
#pragma unroll
        for (int kk = 0; kk < 12; ++kk) { const float qv = bf2f(Qs[j * QKS + 12 * lq + kk]); nqf += npfv[kk] * qv; nqb += npbv[kk] * qv; }
        denf += __shfl_xor(denf, 16); denf += __shfl_xor(denf, 32); denb += __shfl_xor(denb, 16); denb += __shfl_xor(denb, 32);
        nqf += __shfl_xor(nqf, 16); nqf += __shfl_xor(nqf, 32); nqb += __shfl_xor(nqb, 16); nqb += __shfl_xor(nqb, 32);
        const float sif = __expf(afj + mpf - mtfj), sib = __expf(abj + mpb - mtbj);
        const float rdf = 1.0f / fmaxf(fabsf(denf + sif * nqf), __expf(-mtfj)), rdb = 1.0f / fmaxf(fabsf(denb + sib * nqb), __expf(-mtbj));
        cfj = sif * rdf; cbj = sib * rdb;
#pragma unroll
        for (int m = 0; m < 8; ++m) { const float sc = m <= w ? rdf : rdb; f32x4 wv = St[m] * sc; if (m == w) wv += sd * rdb;
            u32x2 pk; pk.x = pk2(wv[0], wv[1]); pk.y = pk2(wv[2], wv[3]); *(LAS u32x2*)(Wm + j * WSS + 16 * m + 4 * lq) = pk; }
    } else {
        const float l2f = ret_lg(h, 0.f) * LOG2E, l2b = ret_lg(h, 0.5f) * LOG2E;
        const float dj = (float)(j - 4 * lq);
#pragma unroll
        for (int m = 0; m < 8; ++m) { f32x4 wv;
#pragma unroll
            for (int r = 0; r < 4; ++r) { const float d = dj - (float)(16 * m + r); wv[r] = St[m][r] * __builtin_amdgcn_exp2f(d >= 0.f ? l2f * d : -l2b * d); }
            u32x2 pk; pk.x = pk2(wv[0], wv[1]); pk.y = pk2(wv[2], wv[3]); *(LAS u32x2*)(Wm + j * WSS + 16 * m + 4 * lq) = pk; }
        cfj = __builtin_amdgcn_exp2f(l2f * (float)(j + 1)); cbj = __builtin_amdgcn_exp2f(l2b * (float)(128 - j));
    }
    DSEC(0x4000);
    f32x4 O[6];
#pragma unroll
    for (int n = 0; n < 6; ++n) O[n] = If[n] * cfj + Ib[n] * cbj;
#pragma unroll
    for (int ks = 0; ks < 4; ++ks) { const bf16x8 wf = *(const LAS bf16x8*)(Wm + j * WSS + 32 * ks + 8 * lq);
#pragma unroll
        for (int n = 0; n < 6; ++n) { const bf16x8 vf = tr_frag(Vs, VSS, 32 * ks, 16 * n, F.lane); O[n] = __builtin_amdgcn_mfma_f32_16x16x32_bf16(vf, wf, O[n], 0, 0, 0); } }
    float s1 = 0.f;
    f32x4 gt[6];
#pragma unroll
    for (int n = 0; n < 6; ++n) { const u32x2 gw = gtw[n];
        gt[n] = (f32x4){__builtin_bit_cast(float, gw.x << 16), __builtin_bit_cast(float, gw.x & 0xffff0000u), __builtin_bit_cast(float, gw.y << 16), __builtin_bit_cast(float, gw.y & 0xffff0000u)};
        if (type == 0) {
#pragma unroll
            for (int r = 0; r < 4; ++r) O[n][r] *= sigmoidf_(gt[n][r]); }
        s1 += (O[n][0] + O[n][1]) + (O[n][2] + O[n][3]); }
    s1 += __shfl_xor(s1, 16); s1 += __shfl_xor(s1, 32);
    const float mean = s1 * (1.0f / 96.0f); float s2 = 0.f;
#pragma unroll
    for (int n = 0; n < 6; ++n) { O[n] = O[n] - mean; s2 += (O[n][0] * O[n][0] + O[n][1] * O[n][1]) + (O[n][2] * O[n][2] + O[n][3] * O[n][3]); }
    s2 += __shfl_xor(s2, 16); s2 += __shfl_xor(s2, 32);
    const float rstd = 1.0f / sqrtf(s2 * (1.0f / 96.0f) + LN_EPS);
    unsigned char* o = mix + (size_t)(t0 + j) * D + (type ? 640 : 256) + h * DV + 4 * lq;
#pragma unroll
    for (int n = 0; n < 6; ++n) { const f32x4 wv = nwv[n]; f32x4 y = O[n] * rstd * wv;
        if (type == 1) {
#pragma unroll
            for (int r = 0; r < 4; ++r) y[r] *= siluf_(gt[n][r]); }
        y = y * MIX_SCALE; *(unsigned*)(o + 16 * n) = pg8::pk4_fp8(y[0], y[1], y[2], y[3]); }
    DSEC(0x8000);
#undef DSEC
    __syncthreads();
}

__device__ __forceinline__ void phaseC_unit(const Frame& F, const Args& a, int u) {
    unsigned char* ws = KA(ws);
    const int type = u >> 7, seq = (u & 127) >> 2, part = u & 3, dir = seq & 1;
    LAS float* sp = (LAS float*)F.lds; LAS float* sc = sp + 64;
    float* msc = (float*)(ws + WS_MSC);
    if (type == 0) {
        if (F.wave == 0) { const int cn = dir ? NCH - 1 - F.lane : F.lane, sin_ = seq * NCH + cn; const float mcl = msc[sin_], ael = msc[2048 + sin_];
            float m = 0.f, my_sp = 0.f, my_sc = 0.f, my_mp = 0.f;
#pragma unroll 1
            for (int n = 0; n < NCH; ++n) { const float mc = __shfl(mcl, n), ae = __shfl(ael, n);
                const float mn = fmaxf(ae + m, mc); const float spn = __expf(ae + m - mn), scn = __expf(mc - mn);
                if (F.lane == n) { my_sp = spn; my_sc = scn; my_mp = m; }
                m = mn; }
            sp[F.lane] = my_sp; sc[F.lane] = my_sc; if (part == 0) msc[4096 + sin_] = my_mp; }
    } else {
        if (F.tid < 64) { const int h = (seq >> 1) & 3; const float lg = ret_lg(h, dir ? 0.5f : 0.f); sp[F.tid] = __expf(lg * 128.0f); sc[F.tid] = 1.0f; }
    }
    __syncthreads();
    const float* X = (const float*)(ws + (type ? WS_RS : WS_MC)); bf16_t* Xo = (bf16_t*)(ws + (type ? WS_CBR : WS_CBM));
    { const size_t o0 = (size_t)seq * NCH * (DV * DK) + part * 1152 + F.tid; const bool has3 = F.tid < 1152 - 2 * NTHR;
      float st0 = 0.f, st1 = 0.f, st2 = 0.f;
#pragma unroll 1
      for (int n0 = 0; n0 < NCH; n0 += 8) { float v0[8], v1[8], v2[8];
#pragma unroll
          for (int i = 0; i < 8; ++i) { const int c = dir ? NCH - 1 - (n0 + i) : n0 + i; const size_t o = o0 + (size_t)c * (DV * DK); v0[i] = X[o]; v1[i] = X[o + NTHR]; v2[i] = has3 ? X[o + 2 * NTHR] : 0.f; }
#pragma unroll
          for (int i = 0; i < 8; ++i) { const int c = dir ? NCH - 1 - (n0 + i) : n0 + i; const size_t o = o0 + (size_t)c * (DV * DK); const float a_ = sp[n0 + i], b_ = sc[n0 + i];
              Xo[o] = (bf16_t)f2bf(st0); Xo[o + NTHR] = (bf16_t)f2bf(st1); if (has3) Xo[o + 2 * NTHR] = (bf16_t)f2bf(st2);
              st0 = a_ * st0 + b_ * v0[i]; st1 = a_ * st1 + b_ * v1[i]; st2 = a_ * st2 + b_ * v2[i]; } } }
    if (type == 0 && part == 0 && F.tid < DK) { float st = 0.f; float* p = (float*)(ws + WS_MN) + (size_t)seq * NCH * DK + F.tid;
#pragma unroll 1
        for (int n0 = 0; n0 < NCH; n0 += 16) { float v[16];
#pragma unroll
            for (int i = 0; i < 16; ++i) { const int c = dir ? NCH - 1 - (n0 + i) : n0 + i; v[i] = p[(size_t)c * DK]; }
#pragma unroll
            for (int i = 0; i < 16; ++i) { const int c = dir ? NCH - 1 - (n0 + i) : n0 + i; p[(size_t)c * DK] = st; st = sp[n0 + i] * st + sc[n0 + i] * v[i]; } } }
    __syncthreads();
}

__device__ __forceinline__ void fourier_stage1(const Frame& F, unsigned char* ws) {
    const bf16_t* UT = (const bf16_t*)(ws + WS_UT); bf16_t* AT = (bf16_t*)(ws + WS_AT);
    LAS bf16_t* Gs = (LAS bf16_t*)F.lds;
    { const bf16_t* Gg = (const bf16_t*)(ws + WS_FG);
      for (int i = F.tid; i < 128 * 16; i += NTHR) { const int r = i >> 4, c8 = i & 15; *(LAS u32x4*)(Gs + r * 136 + c8 * 8) = *(const u32x4*)(Gg + r * 128 + c8 * 8); } }
    __syncthreads();
    const int l15 = F.lane & 15, lq = F.lane >> 4;
    for (int u = F.bid; u < 1024; u += F.G) {
        const int b = u >> 8, ch = u & 255;
        const bf16_t* xr = UT + ((size_t)u * 128 + 16 * F.wave + l15) * 128 + 8 * lq;
        bf16x8 af[4];
#pragma unroll
        for (int ks = 0; ks < 4; ++ks) af[ks] = *(const bf16x8*)(xr + 32 * ks);
        f32x4 acc[8];
#pragma unroll
        for (int n = 0; n < 8; ++n) { acc[n] = (f32x4){0.f, 0.f, 0.f, 0.f};
#pragma unroll
            for (int ks = 0; ks < 4; ++ks) { const bf16x8 bfr = *(const LAS bf16x8*)(Gs + (16 * n + l15) * 136 + 32 * ks + 8 * lq);
                acc[n] = __builtin_amdgcn_mfma_f32_16x16x32_bf16(af[ks], bfr, acc[n], 0, 0, 0); }
            if (n & 1) __builtin_amdgcn_sched_barrier(0); }
#pragma unroll
        for (int n = 0; n < 4; ++n) { const int k1 = 16 * n + l15; u32x2 wre, wim; float ore[4], oim[4];
#pragma unroll
            for (int r = 0; r < 4; ++r) { const int s2 = 16 * F.wave + 4 * lq + r; const float rev = (float)(k1 * s2) * (1.0f / 8192.0f);
                const float cs = __builtin_amdgcn_cosf(rev), sn = __builtin_amdgcn_sinf(rev); const float re = acc[n][r], im = acc[n + 4][r];
                ore[r] = re * cs + im * sn; oim[r] = im * cs - re * sn; }
            wre.x = pk2(ore[0], ore[1]); wre.y = pk2(ore[2], ore[3]); wim.x = pk2(oim[0], oim[1]); wim.y = pk2(oim[2], oim[3]);
            bf16_t* o = AT + ((size_t)((b * 64 + k1) * 256 + ch)) * 256 + 16 * F.wave + 4 * lq;
            *(u32x2*)o = wre; *(u32x2*)(o + 128) = wim; }
    }
    __syncthreads();
}
__device__ __forceinline__ void fourier_stage2(const Frame& F, unsigned char* ws) {
    const bf16_t* AT = (const bf16_t*)(ws + WS_AT); unsigned char* mix = (unsigned char*)(ws + WS_MIX);
    LAS bf16_t* Hs = (LAS bf16_t*)F.lds;
    { const bf16_t* Hg = (const bf16_t*)(ws + WS_FG + FG_H_OFF);
      for (int i = F.tid; i < 128 * 32; i += NTHR) { const int r = i >> 5, c8 = i & 31; *(LAS u32x4*)(Hs + r * 264 + c8 * 8) = *(const u32x4*)(Hg + r * 256 + c8 * 8); } }
    __syncthreads();
    const int l15 = F.lane & 15, lq = F.lane >> 4;
    for (int u = F.bid; u < 256; u += F.G) {
        const int b = u >> 6, k1 = u & 63;
        f32x4 acc[2][8];
#pragma unroll
        for (int m = 0; m < 2; ++m)
#pragma unroll
            for (int n = 0; n < 8; ++n) acc[m][n] = (f32x4){0.f, 0.f, 0.f, 0.f};
        const bf16_t* ar = AT + ((size_t)u * 256 + 32 * F.wave + l15) * 256 + 8 * lq;
#pragma unroll
        for (int ks = 0; ks < 8; ++ks) { const bf16x8 a0 = *(const bf16x8*)(ar + 32 * ks), a1 = *(const bf16x8*)(ar + 16 * 256 + 32 * ks);
#pragma unroll
            for (int n = 0; n < 8; ++n) { const bf16x8 bfr = *(const LAS bf16x8*)(Hs + (16 * n + l15) * 264 + 32 * ks + 8 * lq);
                acc[0][n] = __builtin_amdgcn_mfma_f32_16x16x32_bf16(a0, bfr, acc[0][n], 0, 0, 0); acc[1][n] = __builtin_amdgcn_mfma_f32_16x16x32_bf16(a1, bfr, acc[1][n], 0, 0, 0); }
            if (ks & 1) __builtin_amdgcn_sched_barrier(0); }
#pragma unroll
        for (int m = 0; m < 2; ++m)
#pragma unroll
            for (int n = 0; n < 8; ++n) { const int k2 = 16 * n + l15, chn = 32 * F.wave + 16 * m + 4 * lq;
                const f32x4 y = acc[m][n] * MIX_SCALE;
                *(unsigned*)(mix + (size_t)(b * S + k1 + 64 * k2) * D + chn) = pg8::pk4_fp8(y[0], y[1], y[2], y[3]); }
    }
    __syncthreads();
}

__device__ __forceinline__ int build_tiles(const Frame& F, unsigned* cnt, LAS int* tst, LAS unsigned char* tile_e) {
    if (F.wave == 0) { const int cv = F.lane < NE ? (int)__hip_atomic_load(cnt + (F.lane & (NE - 1)), __ATOMIC_RELAXED, __HIP_MEMORY_SCOPE_AGENT) : 0; const int ntl = (cv + 255) >> 8;
        int inc = ntl;
#pragma unroll
        for (int o = 1; o < NE; o <<= 1) { const int t = __shfl_up(inc, o); if (F.lane >= o) inc += t; }
        if (F.lane < NE) { tst[F.lane] = inc - ntl; ((LAS int*)(F.lds + MISC_OFF + 1280))[F.lane] = cv; }
        if (F.lane == NE - 1) tst[NE] = inc; }
    __syncthreads();
    const int ntot = tst[NE];
    for (int mt = F.tid; mt < ntot; mt += NTHR) { int e = 0; for (int q = 1; q < NE; ++q) if (mt >= tst[q]) e = q; tile_e[mt] = (unsigned char)e; }
    __syncthreads();
    return ntot;
}

__device__ __forceinline__ f32x4 unpack4(u32x2 w) { return (f32x4){__builtin_bit_cast(float, w.x << 16), __builtin_bit_cast(float, w.x & 0xffff0000u), __builtin_bit_cast(float, w.y << 16), __builtin_bit_cast(float, w.y & 0xffff0000u)}; }

__device__ __forceinline__ void phaseF(const Frame& F0, const Args& a, int l) {
    Frame F = F0; asm volatile("" : "+v"(F.tid), "+v"(F.lane)); asm volatile("" : "+s"(F.wave));
    unsigned char* ws = KA(ws);
    const bf16_t* pre = (const bf16_t*)(ws + WS_PRE); float* x1st = (float*)(ws + WS_X1B); unsigned char* x1q = (unsigned char*)(ws + WS_XS);
    int* tke = (int*)(ws + WS_TKE); float* tkg = (float*)(ws + WS_TKG); int* tks = (int*)(ws + WS_TKS); int* list = (int*)(ws + WS_LIST);
    unsigned* cnt = F.ctl + CW_CNT + l * 64;
    constexpr int XST = 1032;
    LAS bf16_t* Xh = (LAS bf16_t*)F.lds;
    LAS bf16_t* Xl = Xh + 16 * XST;
    LAS float* red = (LAS float*)(Xl + 16 * XST);
    LAS int* lcnt = (LAS int*)(F.lds + MISC_OFF + 2048);
    LAS int* lbase = lcnt + 32;
    LAS int* le = lbase + 32;
    LAS int* ls = le + 512;
    const int w = F.wave, l15 = F.lane & 15, lq = F.lane >> 4;
    bf16x8 Bh[2][4], Bl[2][4];
    { const float* wrt = (const float*)(ws + WS_BIN + WRT_OFF) + (size_t)l * NE * D;
#pragma unroll
      for (int n = 0; n < 2; ++n)
#pragma unroll
          for (int ks = 0; ks < 4; ++ks) { const float* p = wrt + (size_t)(16 * n + l15) * D + 128 * w + 32 * ks + 8 * lq; const f32x4 x0 = *(const f32x4*)p, x1 = *(const f32x4*)(p + 4);
              unsigned hw[4], lw[4];
#pragma unroll
              for (int i = 0; i < 4; ++i) { const float a0 = i < 2 ? x0[2 * i] : x1[2 * i - 4], a1 = i < 2 ? x0[2 * i + 1] : x1[2 * i - 3];
                  const unsigned h0 = f2bf(a0), h1 = f2bf(a1); hw[i] = h0 | (h1 << 16);
                  lw[i] = pk2(a0 - __builtin_bit_cast(float, h0 << 16), a1 - __builtin_bit_cast(float, h1 << 16)); }
              Bh[n][ks] = __builtin_bit_cast(bf16x8, (u32x4){hw[0], hw[1], hw[2], hw[3]}); Bl[n][ks] = __builtin_bit_cast(bf16x8, (u32x4){lw[0], lw[1], lw[2], lw[3]}); } }
    if (F.tid < 32) lcnt[F.tid] = 0;
    const float* g1 = KA(ln1_g) + (size_t)l * D; const float* b1 = KA(ln1_b) + (size_t)l * D; const float* br = KA(b_router) + (size_t)l * NE;
    f32x4 gg[4], bb[4];
#pragma unroll
    for (int j = 0; j < 4; ++j) { gg[j] = *(const f32x4*)(g1 + 4 * F.lane + 256 * j); bb[j] = *(const f32x4*)(b1 + 4 * F.lane + 256 * j); }
    const float brv = br[F.tid & 31];
    __syncthreads();
    for (int chunk = F.bid; chunk < T / 128; chunk += F.G) {
        u32x2 nx[2][4];
#pragma unroll
        for (int q = 0; q < 2; ++q)
#pragma unroll
            for (int j = 0; j < 4; ++j) nx[q][j] = *(const u32x2*)(pre + (size_t)(chunk * 128 + 2 * w + q) * D + 4 * F.lane + 256 * j);
#pragma unroll 1
        for (int g = 0; g < 8; ++g) {
            u32x2 cx[2][4];
#pragma unroll
            for (int q = 0; q < 2; ++q)
#pragma unroll
                for (int j = 0; j < 4; ++j) cx[q][j] = nx[q][j];
            if (g < 7) {
#pragma unroll
                for (int q = 0; q < 2; ++q)
#pragma unroll
                    for (int j = 0; j < 4; ++j) nx[q][j] = *(const u32x2*)(pre + (size_t)(chunk * 128 + (g + 1) * 16 + 2 * w + q) * D + 4 * F.lane + 256 * j); }
#pragma unroll
            for (int q = 0; q < 2; ++q) { const int tl = 2 * w + q, t = chunk * 128 + g * 16 + tl;
                f32x4 v[4]; float s = 0.f;
#pragma unroll
                for (int j = 0; j < 4; ++j) { v[j] = unpack4(cx[q][j]); s += (v[j].x + v[j].y) + (v[j].z + v[j].w); }
                const float mean = wave_sum(s) * (1.f / D); float s2 = 0.f;
#pragma unroll
                for (int j = 0; j < 4; ++j) { v[j] = v[j] - mean; s2 += (v[j].x * v[j].x + v[j].y * v[j].y) + (v[j].z * v[j].z + v[j].w * v[j].w); }
                const float rstd = 1.f / sqrtf(wave_sum(s2) * (1.f / D) + LN_EPS);
                if (F.lane == 0) *(f32x2*)(x1st + 2 * (size_t)t) = (f32x2){mean, rstd};
#pragma unroll
                for (int j = 0; j < 4; ++j) { const f32x4 o = v[j] * rstd * gg[j] + bb[j];
                    const unsigned h0 = f2bf(o.x), h1 = f2bf(o.y), h2 = f2bf(o.z), h3 = f2bf(o.w);
                    u32x2 hw; hw.x = h0 | (h1 << 16); hw.y = h2 | (h3 << 16);
                    u32x2 lw; lw.x = pk2(o.x - __builtin_bit_cast(float, h0 << 16), o.y - __builtin_bit_cast(float, h1 << 16)); lw.y = pk2(o.z - __builtin_bit_cast(float, h2 << 16), o.w - __builtin_bit_cast(float, h3 << 16));
                    *(unsigned*)(x1q + (size_t)t * D + 4 * F.lane + 256 * j) = pg8::pk4_fp8(o.x, o.y, o.z, o.w);
                    *(LAS u32x2*)(Xh + tl * XST + 4 * F.lane + 256 * j) = hw; *(LAS u32x2*)(Xl + tl * XST + 4 * F.lane + 256 * j) = lw; } }
            __syncthreads();
            f32x4 acc[2] = {(f32x4){0.f, 0.f, 0.f, 0.f}, (f32x4){0.f, 0.f, 0.f, 0.f}};
#pragma unroll
            for (int ks = 0; ks < 4; ++ks) { const bf16x8 ah = *(const LAS bf16x8*)(Xh + l15 * XST + 128 * w + 32 * ks + 8 * lq), al = *(const LAS bf16x8*)(Xl + l15 * XST + 128 * w + 32 * ks + 8 * lq);
#pragma unroll
                for (int n = 0; n < 2; ++n) { acc[n] = __builtin_amdgcn_mfma_f32_16x16x32_bf16(ah, Bh[n][ks], acc[n], 0, 0, 0); acc[n] = __builtin_amdgcn_mfma_f32_16x16x32_bf16(al, Bh[n][ks], acc[n], 0, 0, 0);
                    acc[n] = __builtin_amdgcn_mfma_f32_16x16x32_bf16(ah, Bl[n][ks], acc[n], 0, 0, 0); } }
#pragma unroll
            for (int n = 0; n < 2; ++n)
#pragma unroll
                for (int r = 0; r < 4; ++r) red[(w * 16 + 4 * lq + r) * 32 + 16 * n + l15] = acc[n][r];
            __syncthreads();
            { const int tl = F.tid >> 5, e = F.tid & 31, t = chunk * 128 + g * 16 + tl;
              float lg = brv;
#pragma unroll
              for (int ww = 0; ww < 8; ++ww) lg += red[(ww * 16 + tl) * 32 + e];
              float tv[4]; int ti[4];
#pragma unroll
              for (int k = 0; k < 4; ++k) { float bv = lg; int bi = e;
#pragma unroll
                  for (int o = 1; o < 32; o <<= 1) { const float ov = __shfl_xor(bv, o); const int oi = __shfl_xor(bi, o); if (ov > bv || (ov == bv && oi < bi)) { bv = ov; bi = oi; } }
                  tv[k] = bv; ti[k] = bi; if (e == bi) lg = -INFINITY; }
              const float w1 = __expf(tv[1] - tv[0]), w2 = __expf(tv[2] - tv[0]), w3 = __expf(tv[3] - tv[0]); const float inv = 1.0f / (1.0f + w1 + w2 + w3);
              if (e < 4) { const int ek = e == 0 ? ti[0] : e == 1 ? ti[1] : e == 2 ? ti[2] : ti[3]; const float gk = (e == 0 ? 1.0f : e == 1 ? w1 : e == 2 ? w2 : w3) * inv;
                  tke[t * 4 + e] = ek; tkg[t * 4 + e] = gk;
                  const int sl = __hip_atomic_fetch_add(lcnt + ek, 1, __ATOMIC_RELAXED, __HIP_MEMORY_SCOPE_WORKGROUP);
                  le[(g * 16 + tl) * 4 + e] = ek; ls[(g * 16 + tl) * 4 + e] = sl; } }
        }
        __syncthreads();
        if (F.tid < 32) lbase[F.tid] = (int)__hip_atomic_fetch_add(cnt + F.tid, (unsigned)lcnt[F.tid], __ATOMIC_RELAXED, __HIP_MEMORY_SCOPE_AGENT);
        __syncthreads();
        { const int tl = F.tid >> 2, k = F.tid & 3, t = chunk * 128 + tl, e = le[F.tid], slot = lbase[e] + ls[F.tid];
          list[(size_t)e * T + slot] = t; tks[t * 4 + k] = slot; }
        __syncthreads();
        if (F.tid < 32) lcnt[F.tid] = 0;
        __syncthreads();
    }
}

struct IRows { u32x2 x[4]; unsigned y[4][4]; f32x4 g; f32x2 ms; };
__device__ __forceinline__ f32x4 unpack4_fp8(unsigned w) { const f32x2 lo = __builtin_amdgcn_cvt_pk_f32_fp8((int)w, false), hi = __builtin_amdgcn_cvt_pk_f32_fp8((int)w, true); return (f32x4){lo.x, lo.y, hi.x, hi.y}; }
struct IIdx { u32x4 e, s; f32x4 g; };
__device__ __forceinline__ void phaseI(const Frame& F0, const Args& a, int l) {
    Frame F = F0; asm volatile("" : "+v"(F.tid), "+v"(F.lane)); asm volatile("" : "+s"(F.wave));
    unsigned char* ws = KA(ws);
    unsigned* cnt = F.ctl + CW_CNT + l * 64;
    LAS int* tst = (LAS int*)(F.lds + MISC_OFF + 256); LAS unsigned char* tile_e = (LAS unsigned char*)(F.lds + MISC_OFF + 512);
    (void)build_tiles(F, cnt, tst, tile_e);
    const bf16_t* pre = (const bf16_t*)(ws + WS_PRE); const float* x1st = (const float*)(ws + WS_X1B); const unsigned char* Y = (const unsigned char*)(ws + WS_Y);
    f32x4 ga[4], ba[4];
    { const float* g1 = KA(ln1_g) + (size_t)l * D; const float* b1 = KA(ln1_b) + (size_t)l * D;
#pragma unroll
      for (int j = 0; j < 4; ++j) { ga[j] = *(const f32x4*)(g1 + 4 * F.lane + 256 * j) * DN_ALPHA; ba[j] = *(const f32x4*)(b1 + 4 * F.lane + 256 * j) * DN_ALPHA; } }
    const int* tke = (const int*)(ws + WS_TKE); const float* tkg = (const float*)(ws + WS_TKG); const int* tks = (const int*)(ws + WS_TKS);
    bf16_t* xb = (bf16_t*)(ws + WS_XB);
    const float* g2 = KA(ln2_g) + (size_t)l * D; const float* b2 = KA(ln2_b) + (size_t)l * D;
    const int gw = F.bid * NWAVES + F.wave, NGW = F.G * NWAVES; float* outp = KA(out);
#define I_LOAD_IDX(ix, t_) do { const int tq_ = min((t_), T - 1); (ix).e = *(const u32x4*)(tke + tq_ * 4); (ix).s = *(const u32x4*)(tks + tq_ * 4); (ix).g = *(const f32x4*)(tkg + tq_ * 4); } while (0)
#define I_LOAD_ROWS(rw, ix, t_) do { const int tq_ = min((t_), T - 1); (rw).g = (ix).g * (1.0f / Y_SCALE); \
        _Pragma("unroll") for (int k = 0; k < 4; ++k) { const size_t row = (size_t)tst[(ix).e[k]] * 256 + (ix).s[k]; \
            _Pragma("unroll") for (int j = 0; j < 4; ++j) (rw).y[k][j] = *(const unsigned*)(Y + row * D + 4 * F.lane + 256 * j); } \
        (rw).ms = *(const f32x2*)(x1st + 2 * (size_t)tq_); \
        _Pragma("unroll") for (int j = 0; j < 4; ++j) (rw).x[j] = *(const u32x2*)(pre + (size_t)tq_ * D + 4 * F.lane + 256 * j); } while (0)
#define I_FINISH(rw, t_) do { const int tq_ = (t_); if (tq_ < T) { f32x4 v[4]; \
        _Pragma("unroll") for (int j = 0; j < 4; ++j) v[j] = (unpack4((rw).x[j]) - (rw).ms.x) * (rw).ms.y * ga[j] + ba[j]; \
        _Pragma("unroll") for (int k = 0; k < 4; ++k) _Pragma("unroll") for (int j = 0; j < 4; ++j) v[j] += unpack4_fp8((rw).y[k][j]) * (rw).g[k]; \
        ln_row(v, g2, b2, nullptr, xb + (size_t)tq_ * D, l == NL - 1 ? outp + (size_t)tq_ * D : nullptr, F.lane, (unsigned char*)(ws + WS_XQ) + (size_t)tq_ * D); } } while (0)
    IIdx ix; IRows r0, r1, r2;
    int t = gw;
    I_LOAD_IDX(ix, t); I_LOAD_ROWS(r0, ix, t); I_LOAD_IDX(ix, t + NGW); I_LOAD_ROWS(r1, ix, t + NGW); I_LOAD_IDX(ix, t + 2 * NGW);
#pragma unroll 1
    for (; t < T; t += 3 * NGW) {
        I_LOAD_ROWS(r2, ix, t + 2 * NGW); I_LOAD_IDX(ix, t + 3 * NGW); I_FINISH(r0, t);
        I_LOAD_ROWS(r0, ix, t + 3 * NGW); I_LOAD_IDX(ix, t + 4 * NGW); I_FINISH(r1, t + NGW);
        I_LOAD_ROWS(r1, ix, t + 4 * NGW); I_LOAD_IDX(ix, t + 5 * NGW); I_FINISH(r2, t + 2 * NGW);
    }
#undef I_LOAD_IDX
#undef I_LOAD_ROWS
#undef I_FINISH
    __syncthreads();
}

template <int PHMASK_T> __global__ void __launch_bounds__(NTHR, 2) hybrid_fwd(Args a) {
    extern __shared__ __attribute__((aligned(16))) unsigned char lds_raw[];
    Frame F;
    F.lds = (LAS unsigned char*)lds_raw;
    F.tid = threadIdx.x; F.lane = F.tid & 63; F.wave = __builtin_amdgcn_readfirstlane(F.tid >> 6);
    F.G = gridDim.x; F.bid = blockIdx.x;
    F.ctl = (unsigned*)(KA(ws) + WS_CTL);
    unsigned char* ws = KA(ws);
    volatile LAS unsigned* MISC = (volatile LAS unsigned*)(F.lds + MISC_OFF);
    if (F.tid < 64) MISC[F.tid] = 0u;
    __syncthreads();
#if MK_MULTI
#define GRID_BAR() do { } while (0)
#else
    XcdBarrier bar = xcd_barrier_post(F.ctl + CW_BAR, MISC);
#define GRID_BAR() do { GAS unsigned* _bp = (GAS unsigned*)bar.bar; unsigned _bx = bar.x; unsigned _bs = (unsigned)(uintptr_t)bar.st; asm volatile("" : "+s"(_bp), "+s"(_bx), "+s"(_bs)); \
        XcdBarrier _b; _b.bar = (unsigned*)_bp; _b.x = _bx; _b.st = (volatile LAS unsigned*)(uintptr_t)_bs; xcd_barrier(_b); } while (0)
#endif
    const int lo = KA(ph_lo), hi = KA(ph_hi);
#if PROBE_MASK
    unsigned long long pt0 = 0;
#define PROBE_BEGIN() do { pt0 = __builtin_amdgcn_s_memrealtime(); } while (0)
#define PROBE_END(j) do { if ((PROBE_MASK >> (j)) & 1) { const unsigned long long d_ = __builtin_amdgcn_s_memrealtime() - pt0; while (__builtin_amdgcn_s_memrealtime() - pt0 < 2 * d_) __builtin_amdgcn_s_sleep(8); } } while (0)
#else
#define PROBE_BEGIN() do { } while (0)
#define PROBE_END(j) do { } while (0)
#endif
#define PH_ON(j) (((PHMASK_T) >> (j)) & 1)
#define IN(k) (lo <= (k) && (k) < hi)
#if PROBE_MASK & 0xC00
#define SEAM(k) do { if (IN(k) && IN((k) + 1)) { const unsigned long long b0_ = __builtin_amdgcn_s_memrealtime(); GRID_BAR(); if (PROBE_MASK & 0x400) GRID_BAR(); \
        if (PROBE_MASK & 0x800) { const unsigned long long d_ = __builtin_amdgcn_s_memrealtime() - b0_; while (__builtin_amdgcn_s_memrealtime() - b0_ < 2 * d_) __builtin_amdgcn_s_sleep(8); } } } while (0)
#else
#define SEAM(k) do { if (IN(k) && IN((k) + 1)) GRID_BAR(); } while (0)
#endif
    PROBE_BEGIN();
    if (PH_ON(9) && IN(0)) { p0_prologue(F, a); }
    PROBE_END(9);
    SEAM(0);
#define LAUNDER() do { unsigned _lp = (unsigned)(uintptr_t)F.lds; GAS unsigned* _cp = (GAS unsigned*)F.ctl; GAS unsigned char* _wp = (GAS unsigned char*)ws;     \
        F.tid = threadIdx.x; asm volatile("" : "+v"(F.tid)); F.lane = F.tid & 63; F.wave = __builtin_amdgcn_readfirstlane(F.tid >> 6); F.bid = blockIdx.x; F.G = gridDim.x; \
        asm volatile("" : "+s"(F.bid), "+s"(F.G), "+s"(_lp), "+s"(_cp), "+s"(_wp)); \
        F.lds = (LAS unsigned char*)(uintptr_t)_lp; F.ctl = (unsigned*)_cp; ws = (unsigned char*)_wp; } while (0)
    for (int l = 0; l < NL; ++l) {
        const int pb = 1 + l * NPH_LAYER;
        LAUNDER(); PROBE_BEGIN();
        if (PH_ON(0) && IN(pb + 0)) {
            pg8::PlainOrderBf So; So.init(ws + WS_XB, (bf16_t*)(ws + WS_WIN) + (size_t)l * PWP * D, T, 4 * 256, D, F.G, F.bid);
            pg8::EpiBf16Bias E{(bf16_t*)(ws + WS_P), PWP, (const float*)(ws + WS_BIN) + (size_t)l * PWP, 1.0f};
            pg8::gemm_phase<pg8::EpiBf16Bias, pg8::PlainOrderBf, true, true>(F.lds, D, So, E, F.tid);
            pg8::PlainOrderF8 Sq; Sq.init(ws + WS_XQ, (unsigned char*)(ws + WS_WINQ) + (size_t)l * PWP * D, T, 6 * 256, D, F.G, F.bid);
            pg8::EpiBf16Bias Eq{(bf16_t*)(ws + WS_P), PWP, (const float*)(ws + WS_BIN) + (size_t)l * PWP, 1.0f / (XQ_SCALE * WINQ_SCALE)};
            pg8::gemm_phase_f8<pg8::EpiBf16Bias, pg8::PlainOrderF8, true, true>(F.lds, D, Sq, Eq, F.tid);
            pg8::FourierOrder8 Sf{(const char*)(ws + WS_WFQ) + (size_t)l * 512 * D, (const char*)(ws + WS_XQ), D, F.G, F.bid};
            pg8::EpiFourierT Ef{(bf16_t*)(ws + WS_UT), (const float*)(ws + WS_FG + FG_BF_OFF) + l * 512, 1.0f / (XQ_SCALE * WFQ_SCALE)};
            pg8::gemm_phase_f8<pg8::EpiFourierT, pg8::FourierOrder8, true, true>(F.lds, D, Sf, Ef, F.tid);
        }
        PROBE_END(0);
        SEAM(pb + 0);
        LAUNDER(); PROBE_BEGIN();
        if (PH_ON(1) && IN(pb + 1)) {
            for (int u = F.bid; u < 2048; u += F.G) phaseB_mfma(F, a, l, u);
            fourier_stage1(F, ws);
        }
        PROBE_END(1);
        SEAM(pb + 1);
        LAUNDER(); PROBE_BEGIN();
        if (PH_ON(2) && IN(pb + 2)) { for (int u = F.bid; u < 256; u += F.G) phaseC_unit(F, a, u); fourier_stage2(F, ws); }
        PROBE_END(2);
        SEAM(pb + 2);
        LAUNDER(); PROBE_BEGIN();
        if (PH_ON(3) && IN(pb + 3)) {
            for (int rep_ = 0; rep_ < ((PROBE_MASK & 0x40000) ? 2 : 1); ++rep_)
            for (int u = F.bid; u < 2048; u += F.G) phaseD_mfma(F, a, l, u);
        }
        PROBE_END(3);
        SEAM(pb + 3);
        LAUNDER(); PROBE_BEGIN();
        if (PH_ON(4) && IN(pb + 4)) {
            pg8::PlainOrder8 So; So.init(ws + WS_MIX, (unsigned char*)(ws + WS_WOUT) + (size_t)l * D * D, T, D, D, F.G, F.bid);
            pg8::EpiResBf16 E{(bf16_t*)(ws + WS_PRE), (const bf16_t*)(ws + WS_XB), D, DN_ALPHA, 1.0f / (MIX_SCALE * WOUT_SCALE)};
            pg8::gemm_phase_f8<pg8::EpiResBf16, pg8::PlainOrder8, true, true>(F.lds, D, So, E, F.tid);
        }
        PROBE_END(4);
        SEAM(pb + 4);
        LAUNDER(); PROBE_BEGIN();
        if (PH_ON(5) && IN(pb + 5)) phaseF(F, a, l);
        PROBE_END(5);
        SEAM(pb + 5);
        LAUNDER(); PROBE_BEGIN();
        if (PH_ON(6) && IN(pb + 6)) {
            LAS int* tst = (LAS int*)(F.lds + MISC_OFF + 256); LAS unsigned char* tile_e = (LAS unsigned char*)(F.lds + MISC_OFF + 512); LAS unsigned* gtab = (LAS unsigned*)(F.lds + GTAB_OFF);
            unsigned* cnt = F.ctl + CW_CNT + l * 64;
            const int ntot = build_tiles(F, cnt, tst, tile_e);
            { const int* list = (const int*)(ws + WS_LIST); int nun = 0; { int pm_, pn_; while (nun < 18 && pg8::moe_unit(nun, F.bid, F.G, 8, ntot, pm_, pn_)) ++nun; }
              for (int idx = F.tid; idx < nun * 256; idx += NTHR) { const int i = idx >> 8, r = idx & 255; int mt, pn_; (void)pg8::moe_unit(i, F.bid, F.G, 8, ntot, mt, pn_); const int e = tile_e[mt], within = (mt - tst[e]) * 256 + r;
                  const int ce = ((const LAS int*)(F.lds + MISC_OFF + 1280))[e];
                  const int tok = within < ce ? list[(size_t)e * T + within] : 0; gtab[idx] = (unsigned)tok * (unsigned)D; }
              __syncthreads(); }
            pg8::GatherOrder So{(const char*)(ws + WS_XS), (const char*)(ws + WS_W1) + (size_t)l * NE * 2048 * D, D, 8, ntot, F.G, F.bid, (size_t)2048 * D, tile_e, gtab};
            pg8::EpiSwiglu8 E{(unsigned char*)(ws + WS_H), KA(b1) + (size_t)l * NE * 2048, 1.0f / W1_SCALE};
            for (int rep_ = 0; rep_ < ((PROBE_MASK & 0x80000) ? 2 : 1); ++rep_)
            pg8::gemm_phase_f8<pg8::EpiSwiglu8, pg8::GatherOrder, true, true>(F.lds, D, So, E, F.tid);
        }
        PROBE_END(6);
        SEAM(pb + 6);
        LAUNDER(); PROBE_BEGIN();
        if (PH_ON(7) && IN(pb + 7)) {
            LAS int* tst = (LAS int*)(F.lds + MISC_OFF + 256); LAS unsigned char* tile_e = (LAS unsigned char*)(F.lds + MISC_OFF + 512);
            const int ntot = build_tiles(F, F.ctl + CW_CNT + l * 64, tst, tile_e);
            pg8::GroupOrder So{(const char*)(ws + WS_H), (const char*)(ws + WS_W2) + (size_t)l * NE * D * FF, FF, 4, ntot, F.G, F.bid, (size_t)D * FF, tile_e};
            pg8::EpiExpertOut E{(unsigned char*)(ws + WS_Y), KA(b2) + (size_t)l * NE * D, 1.0f / W2_SCALE};
            pg8::gemm_phase_f8<pg8::EpiExpertOut, pg8::GroupOrder, true, true>(F.lds, FF, So, E, F.tid);
        }
        PROBE_END(7);
        SEAM(pb + 7);
        LAUNDER(); PROBE_BEGIN();
        if (PH_ON(8) && IN(pb + 8)) phaseI(F, a, l);
        PROBE_END(8);
        SEAM(pb + 8);
    }
#undef IN
#undef SEAM
}

template <int MASK> static void launch_one(int grid, hipStream_t stream, const Args& a) {
    static bool attr = false;
    if (!attr) { (void)hipFuncSetAttribute((const void*)hybrid_fwd<MASK>, hipFuncAttributeMaxDynamicSharedMemorySize, LDS_BYTES); attr = true; }
    hipLaunchKernelGGL(hybrid_fwd<MASK>, dim3(grid), dim3(NTHR), LDS_BYTES, stream, a);
}
extern "C" void kernel_launch(void* const* d_in, const int* in_sizes, int n_in, void* d_out, int out_size, void* d_ws, size_t ws_size, hipStream_t stream) {
    static int grid = 0;
    if (grid == 0) {
        if (n_in != 19 || out_size != T * D || ws_size < WS_END) { fprintf(stderr, "kernel_launch: unexpected shapes (n_in %d out %d ws %zu need %zu)\n", n_in, out_size, ws_size, (size_t)WS_END); grid = -1; return; }
        int dev = 0, cus = 0;
        if (hipGetDevice(&dev) != hipSuccess || hipDeviceGetAttribute(&cus, hipDeviceAttributeMultiprocessorCount, dev) != hipSuccess) { grid = -1; return; }
        grid = cus;
    }
    if (grid < 0) return;
    (void)hipMemsetAsync((char*)d_ws + WS_CTL, 0, CTL_BYTES, stream);
    Args a{};
    a.x = (const float*)d_in[0]; a.emb_g = (const float*)d_in[1]; a.emb_b = (const float*)d_in[2]; a.w_in = (const float*)d_in[3]; a.b_in = (const float*)d_in[4];
    a.conv_w = (const float*)d_in[5]; a.ml_nw = (const float*)d_in[6]; a.ret_nw = (const float*)d_in[7]; a.w_out = (const float*)d_in[8];
    a.ln1_g = (const float*)d_in[9]; a.ln1_b = (const float*)d_in[10]; a.w_router = (const float*)d_in[11]; a.b_router = (const float*)d_in[12];
    a.w1 = (const float*)d_in[13]; a.b1 = (const float*)d_in[14]; a.w2 = (const float*)d_in[15]; a.b2 = (const float*)d_in[16]; a.ln2_g = (const float*)d_in[17]; a.ln2_b = (const float*)d_in[18];
    a.out = (float*)d_out; a.ws = (unsigned char*)d_ws;
#if MK_MULTI
    a.ph_lo = 0; a.ph_hi = 1; launch_one<0x200>(grid, stream, a);
#define LAUNDER() do { unsigned _lp = (unsigned)(uintptr_t)F.lds; GAS unsigned* _cp = (GAS unsigned*)F.ctl; GAS unsigned char* _wp = (GAS unsigned char*)ws;     \
        F.tid = threadIdx.x; asm volatile("" : "+v"(F.tid)); F.lane = F.tid & 63; F.wave = __builtin_amdgcn_readfirstlane(F.tid >> 6); F.bid = blockIdx.x; F.G = gridDim.x; \
        asm volatile("" : "+s"(F.bid), "+s"(F.G), "+s"(_lp), "+s"(_cp), "+s"(_wp)); \
        F.lds = (LAS unsigned char*)(uintptr_t)_lp; F.ctl = (unsigned*)_cp; ws = (unsigned char*)_wp; } while (0)
    for (int l = 0; l < NL; ++l) {
        const int pb = 1 + l * NPH_LAYER;
#define LP(j) a.ph_lo = pb + (j); a.ph_hi = pb + (j) + 1; launch_one<(1 << (j))>(grid, stream, a);
        LP(0) LP(1) LP(2) LP(3) LP(4) LP(5) LP(6) LP(7) LP(8)
#undef LP
    }
#else
    a.ph_lo = 0; a.ph_hi = NPH; launch_one<0x3ff>(grid, stream, a);
#endif
}
```

```cpp
#include <hip/hip_runtime.h>
#include <cstdio>
#include <cstdint>

#ifndef MK_MULTI
#define MK_MULTI 0
#endif

#ifndef PROBE_MASK
#define PROBE_MASK 0
#endif
#define LAS __attribute__((address_space(3)))
#define GAS __attribute__((address_space(1)))
typedef unsigned short bf16_t;
typedef short bf16x8 __attribute__((ext_vector_type(8)));
typedef float f32x4 __attribute__((ext_vector_type(4)));
typedef float f32x2 __attribute__((ext_vector_type(2)));
typedef unsigned u32x4 __attribute__((ext_vector_type(4)));
typedef unsigned u32x2 __attribute__((ext_vector_type(2)));
typedef int v4i __attribute__((ext_vector_type(4)));
typedef int v8i __attribute__((ext_vector_type(8)));
typedef int v8i_a16 __attribute__((ext_vector_type(8), aligned(16)));

constexpr int D = 1024, NB = 4, S = 8192, T = NB * S, NL = 4;
constexpr int CH = 128, NCH = S / CH;
constexpr int PW = 2576, PWF = 256, PW2 = PW - PWF, PWP = 2560;
constexpr int COL_MQK = 0, COL_MV = 384, COL_MO = 768, COL_MG = 1152, COL_RQ = 1168, COL_RK = 1360, COL_RV = 1552, COL_RG = 1936;
constexpr int NH = 4, DK = 48, DV = 96;
constexpr int NE = 32, TOPK = 4, FF = 1024;
constexpr int ROWS_PAD = T * TOPK + NE * 256;
constexpr int MT_MAX = ROWS_PAD / 256;
constexpr float LN_EPS = 1e-5f;
constexpr float DN_ALPHA = 1.6817928305074290f;
constexpr float SW_ALPHA = 1.702f, SW_LIMIT = 7.0f;
constexpr float LOG2E = 1.4426950408889634f;
constexpr float XQ_SCALE = 4.0f, WINQ_SCALE = 32.0f, WFQ_SCALE = 8.0f;
constexpr float WOUT_SCALE = 64.0f, MIX_SCALE = 4.0f;
constexpr float W1_SCALE = 32.0f, W2_SCALE = 64.0f, Y_SCALE = 16.0f;

constexpr size_t MiB = 1u << 20;
constexpr size_t WS_CTL = 0, CTL_BYTES = 1 * MiB;
constexpr size_t WS_WIN = 1 * MiB;
constexpr size_t WS_WOUT = WS_WIN + 22 * MiB;
constexpr size_t WS_W1 = WS_WOUT + 8 * MiB;
constexpr size_t WS_W2 = WS_W1 + 512 * MiB;
constexpr size_t WS_BIN = WS_W2 + 256 * MiB;
constexpr size_t WS_ROT = WS_BIN + 1 * MiB;
constexpr size_t WS_XF = WS_ROT + 2 * MiB;
constexpr size_t WS_XB = WS_XF + 128 * MiB;
constexpr size_t WS_P = WS_XB + 64 * MiB;
constexpr size_t WS_MIX = WS_P + 176 * MiB;
constexpr size_t WS_PRE = WS_MIX + 64 * MiB;
constexpr size_t WS_X1F = WS_PRE + 128 * MiB;
constexpr size_t WS_X1B = WS_X1F + 128 * MiB;
constexpr size_t WS_XS = WS_X1B + 64 * MiB;
constexpr size_t WS_CBM = WS_XS + 64 * MiB, WS_CBR = WS_XS + 96 * MiB;
constexpr size_t WS_H = WS_XS + 272 * MiB;
constexpr size_t WS_Y = WS_H + 272 * MiB;
constexpr size_t WS_TKE = WS_Y + 272 * MiB;
constexpr size_t WS_TKG = WS_TKE + 1 * MiB;
constexpr size_t WS_TKS = WS_TKG + 1 * MiB;
constexpr size_t WS_LIST = WS_TKS + 1 * MiB;
constexpr size_t WS_MC = WS_LIST + 4 * MiB;
constexpr size_t WS_RS = WS_MC + 36 * MiB;
constexpr size_t WS_MN = WS_RS + 36 * MiB;
constexpr size_t WS_MSC = WS_MN + 1 * MiB;
constexpr size_t WS_UT = WS_MSC + 1 * MiB;
constexpr size_t WS_AT = WS_UT + 32 * MiB;
constexpr size_t WS_WF = WS_AT + 32 * MiB;
constexpr size_t WS_FG = WS_WF + 4 * MiB;
constexpr size_t WS_END = WS_FG + 1 * MiB;
constexpr size_t WS_XQ = WS_XF;
constexpr size_t WS_WINQ = WS_X1F, WS_WFQ = WS_X1F + 16 * MiB;
constexpr size_t FG_H_OFF = 32768, FG_BF_OFF = 131072, WRT_OFF = 262144;

constexpr int CW_TMO = 0;
constexpr int CW_BAR = 4096;
constexpr int CW_CNT = 16384;

constexpr int RING_BYTES = 131072;
constexpr int MISC_OFF = RING_BYTES;
constexpr int GTAB_OFF = MISC_OFF + 8192;
constexpr int LDS_BYTES = 163840;

typedef __bf16 bf16x2_t __attribute__((ext_vector_type(2)));
__device__ __forceinline__ unsigned pk2(float lo, float hi) { const f32x2 v = {lo, hi}; return __builtin_bit_cast(unsigned, __builtin_convertvector(v, bf16x2_t)); }
__device__ __forceinline__ unsigned f2bf(float f) { return pk2(f, 0.f) & 0xffffu; }
__device__ __forceinline__ float bf2f(bf16_t b) { return __builtin_bit_cast(float, (unsigned)b << 16); }
__device__ __forceinline__ float wave_sum(float v) {
#pragma unroll
    for (int o = 1; o < 64; o <<= 1) v += __shfl_xor(v, o);
    return v;
}
__device__ __forceinline__ float wave_max(float v) {
#pragma unroll
    for (int o = 1; o < 64; o <<= 1) v = fmaxf(v, __shfl_xor(v, o));
    return v;
}
__device__ __forceinline__ float sigmoidf_(float x) { return __builtin_amdgcn_rcpf(1.0f + __builtin_amdgcn_exp2f(x * -1.4426950408889634f)); }
__device__ __forceinline__ float siluf_(float x) { return x * __builtin_amdgcn_rcpf(1.0f + __builtin_amdgcn_exp2f(x * -1.4426950408889634f)); }
__device__ __forceinline__ float logsigmoidf_(float x) { return fminf(x, 0.f) - __logf(1.0f + __expf(-fabsf(x))); }

namespace pg8 {
constexpr int BM = 256, BK = 64, HALF = 128, HTB = HALF * BK * 2, STAGE_BYTES = 8 * HTB;
__host__ __device__ __forceinline__ int lds_byte(int r, int c) { const int st = (r >> 4) * 2 + (c >> 5), rr = r & 15, cc = c & 31, ob = rr * 64 + cc * 2; return st * 1024 + (ob ^ (((ob >> 9) & 1) << 5)); }
__host__ __device__ __forceinline__ void stage_rc(int b, int& R, int& C) { const int st = b / 1024, sb = b % 1024, swz = sb ^ (((sb >> 9) & 1) << 5); R = (st >> 1) * 16 + swz / 64; C = (st & 1) * 32 + (swz % 64) / 2; }
__host__ __device__ __forceinline__ int perm32(int rho) { const int n = rho >> 4, i = rho & 15; return 8 * (i >> 2) + 4 * n + (i & 3); }
__host__ __device__ __forceinline__ int lds_byte8(int r, int byte) { const int st = (r >> 4) * 2 + (byte >> 6), rr = r & 15, c = (byte & 63) >> 4; return st * 1024 + rr * 64 + ((c ^ (rr >> 3)) << 4); }
__host__ __device__ __forceinline__ void stage_rc8(int b, int& R, int& C) { const int st = b / 1024, sb = b % 1024, rr = sb >> 6, c = ((sb & 63) >> 4) ^ (rr >> 3); R = (st >> 1) * 16 + rr; C = (st & 1) * 32 + c * 8; }
struct Unit { int pm, pn, e; };
__device__ __forceinline__ unsigned cvt_pk_bf16(float lo, float hi) { return ::pk2(lo, hi); }

template <class Epi, class Sched, bool ALIGN_EPI = false, bool SP2 = true>
__device__ __forceinline__ void gemm_phase(LAS unsigned char* lds, const int K, const Sched& S, const Epi& E, const int tid) {
    static_assert(SP2, "only the two-MFMA-blocks-per-barrier loop is kept");
    const int wid = __builtin_amdgcn_readfirstlane(tid >> 6), lane = tid & 63, wr = wid >> 2, wc = wid & 3, fr = lane & 15, fq = lane >> 4;
    const int nt = K / BK;
    unsigned vA0[2], vA1[2], voffB[2];
#pragma unroll
    for (int i = 0; i < 2; ++i) { int R, C; stage_rc(tid * 16 + i * 8192, R, C); const int Rb = Epi::PERM ? ((R & ~31) + perm32(R & 31)) : R;
        voffB[i] = S.b_off(Rb, C); if constexpr (!Sched::GATHER) { vA0[i] = S.a_off(R, C); vA1[i] = vA0[i]; } }
    Unit cur, nxt; int ui = 0;
    if (!S.next(0, cur)) return;
    typename Epi::Bias bia; E.load_bias(cur, wr, wc, fr, fq, bia);
    if constexpr (Sched::GATHER) { S.a_offs(0, tid, vA0, vA1); }
    const size_t kstep = (size_t)(BK * 2);
    const size_t hstepA = S.hstep_a(), hstepB = S.hstep_b();
    const unsigned ldsw = (unsigned)wid * 1024u;
    const int aoff = lds_byte(wr * 64 + fr, fq * 8), boff = lds_byte(wc * 32 + fr, fq * 8);
#define PG8_SA(b, h) (((b) * 2 + (h)) * HTB)
#define PG8_SB(b, h) ((4 + (b) * 2 + (h)) * HTB)
#define PG8_STAGE(bufoff, gbase, voff) do { _Pragma("unroll") for (int _i = 0; _i < 2; ++_i) { unsigned _o = (voff)[_i]; asm volatile("" : "+v"(_o)); \
        __builtin_amdgcn_global_load_lds((const unsigned*)((const char*)(gbase) + _o), (LAS unsigned*)(lds + (bufoff) + ldsw + _i * 8192), 16, 0, 0); } } while (0)
#define PG8_LDA(dst, b, h) do { _Pragma("unroll") for (int m = 0; m < 4; ++m) _Pragma("unroll") for (int k = 0; k < 2; ++k) dst[m][k] = *(const LAS bf16x8*)(lds + PG8_SA(b, h) + aoff + m * 2048 + k * 1024); } while (0)
#define PG8_LDB(dst, b, h) do { _Pragma("unroll") for (int n = 0; n < 2; ++n) _Pragma("unroll") for (int k = 0; k < 2; ++k) dst[n][k] = *(const LAS bf16x8*)(lds + PG8_SB(b, h) + boff + n * 2048 + k * 1024); } while (0)
#define PG8_MMA(ai, bj, At, Bt) do { __builtin_amdgcn_s_setprio(1); _Pragma("unroll") for (int m = 0; m < 4; ++m) _Pragma("unroll") for (int n = 0; n < 2; ++n) _Pragma("unroll") for (int k = 0; k < 2; ++k) \
        acc[ai][bj][m][n] = __builtin_amdgcn_mfma_f32_16x16x32_bf16(Bt[n][k], At[m][k], acc[ai][bj][m][n], 0, 0, 0); __builtin_amdgcn_s_setprio(0); } while (0)
#define PG8_WAIT_V(n) asm volatile("s_waitcnt vmcnt(" #n ")" ::: "memory")
#define PG8_WAIT_L(n) asm volatile("s_waitcnt lgkmcnt(" #n ")" ::: "memory")
#define PG8_BAR __builtin_amdgcn_s_barrier()
#define PG8_SCHED __builtin_amdgcn_sched_barrier(0)
    float zf_ = 0.f; asm volatile("" : "+v"(zf_)); const f32x4 zero4 = (f32x4){zf_, zf_, zf_, zf_};
    f32x4 acc[2][2][4][2];
#pragma unroll
    for (int a = 0; a < 2; ++a)
#pragma unroll
        for (int b = 0; b < 2; ++b)
#pragma unroll
            for (int m = 0; m < 4; ++m)
#pragma unroll
                for (int n = 0; n < 2; ++n) acc[a][b][m][n] = zero4;
    bf16x8 At[4][2], B0[2][2], B1[2][2];
    const char* cA = S.a_base(cur); const char* cB = S.b_base(cur);
    PG8_STAGE(PG8_SB(0, 0), cB, voffB); PG8_STAGE(PG8_SB(0, 1), cB + hstepB, voffB); PG8_STAGE(PG8_SA(0, 0), cA, vA0); PG8_STAGE(PG8_SA(0, 1), cA + hstepA, vA1);
    if (wr == 1) PG8_BAR;
    PG8_WAIT_V(2); PG8_BAR;
    PG8_STAGE(PG8_SB(1, 0), cB + kstep, voffB); PG8_STAGE(PG8_SA(1, 0), cA + kstep, vA0); PG8_STAGE(PG8_SB(1, 1), cB + hstepB + kstep, voffB);
    PG8_WAIT_V(6); PG8_BAR;
    for (;;) {
        const bool has_next = S.next(ui + 1, nxt);
        const char* nA = has_next ? S.a_base(nxt) : cA; const char* nB = has_next ? S.b_base(nxt) : cB;
#pragma unroll 1
        for (int t = 0; t < nt; t += 2) {
            const bool last = (t == nt - 2);
            const char* a1 = cA + (size_t)(t + 1) * kstep;
            const char* a2 = last ? nA : cA + (size_t)(t + 2) * kstep; const char* b2 = last ? nB : cB + (size_t)(t + 2) * kstep;
            const char* a3 = a2 + kstep; const char* b3 = b2 + kstep;
            PG8_LDB(B0, 0, 0); PG8_LDB(B1, 0, 1); PG8_SCHED; PG8_LDA(At, 0, 0); PG8_STAGE(PG8_SA(1, 1), a1 + hstepA, vA1);
            if constexpr (Sched::GATHER) { if (last && has_next) S.a_offs(ui + 1, tid, vA0, vA1); }
            PG8_WAIT_V(8); PG8_WAIT_L(0); PG8_BAR; PG8_MMA(0, 0, At, B0); PG8_MMA(0, 1, At, B1); PG8_BAR; PG8_SCHED;
            PG8_LDA(At, 0, 1); PG8_STAGE(PG8_SB(0, 0), b2, voffB); PG8_STAGE(PG8_SB(0, 1), b2 + hstepB, voffB); PG8_STAGE(PG8_SA(0, 0), a2, vA0);
            PG8_WAIT_V(8); PG8_WAIT_L(0); PG8_BAR; PG8_MMA(1, 0, At, B0); PG8_MMA(1, 1, At, B1); PG8_BAR; PG8_SCHED;
            PG8_LDB(B0, 1, 0); PG8_LDB(B1, 1, 1); PG8_SCHED; PG8_LDA(At, 1, 0); PG8_STAGE(PG8_SA(0, 1), a2 + hstepA, vA1);
            PG8_WAIT_V(8); PG8_WAIT_L(0); PG8_BAR; PG8_MMA(0, 0, At, B0); PG8_MMA(0, 1, At, B1); PG8_BAR; PG8_SCHED;
            PG8_LDA(At, 1, 1); PG8_STAGE(PG8_SB(1, 0), b3, voffB); PG8_STAGE(PG8_SB(1, 1), b3 + hstepB, voffB); PG8_STAGE(PG8_SA(1, 0), a3, vA0);
            PG8_WAIT_V(8); PG8_WAIT_L(0); PG8_BAR; PG8_MMA(1, 0, At, B0); PG8_MMA(1, 1, At, B1); PG8_BAR; PG8_SCHED;
        }
        if constexpr (ALIGN_EPI) { if (wr == 0) PG8_BAR; }
        { int te = tid; asm volatile("" : "+v"(te)); const int le_ = te & 63, we_ = __builtin_amdgcn_readfirstlane(te >> 6); E(acc, cur, we_ >> 2, we_ & 3, le_ & 15, le_ >> 4, bia); }
        if (!has_next) break;
#pragma unroll
        for (int a = 0; a < 2; ++a)
#pragma unroll
            for (int b = 0; b < 2; ++b)
#pragma unroll
                for (int m = 0; m < 4; ++m)
#pragma unroll
                    for (int n = 0; n < 2; ++n) acc[a][b][m][n] = zero4;
        cur = nxt; cA = nA; cB = nB; ++ui;
        E.load_bias(cur, wr, wc, fr, fq, bia);
        if constexpr (ALIGN_EPI) { if (wr == 1) PG8_BAR; }
    }
    PG8_WAIT_V(0);
    if constexpr (!ALIGN_EPI) { if (wr == 0) PG8_BAR; }
    PG8_BAR;
#undef PG8_SA
#undef PG8_SB
#undef PG8_STAGE
#undef PG8_LDA
#undef PG8_LDB
#undef PG8_MMA
#undef PG8_WAIT_V
#undef PG8_WAIT_L
#undef PG8_BAR
#undef PG8_SCHED
}

template <class Epi, class Sched, bool ALIGN_EPI = false, bool SP2 = true>
__device__ __forceinline__ void gemm_phase_f8(LAS unsigned char* lds, const int K, const Sched& S, const Epi& E, const int tid) {
    static_assert(SP2, "only the two-MFMA-blocks-per-barrier loop is kept");
    const int wid = __builtin_amdgcn_readfirstlane(tid >> 6), lane = tid & 63, wr = wid >> 2, wc = wid & 3, fr = lane & 15, fq = lane >> 4;
    const int nt = K / 128;
    unsigned vA0[2], vA1[2], voffB[2];
#pragma unroll
    for (int i = 0; i < 2; ++i) { int R, C; stage_rc8(tid * 16 + i * 8192, R, C); const int Rb = Epi::PERM ? ((R & ~31) + perm32(R & 31)) : R;
        voffB[i] = S.b_off(Rb, C); if constexpr (!Sched::GATHER) { vA0[i] = S.a_off(R, C); vA1[i] = vA0[i]; } }
    Unit cur, nxt; int ui = 0;
    if (!S.next(0, cur)) return;
    typename Epi::Bias bia; E.load_bias(cur, wr, wc, fr, fq, bia);
    if constexpr (Sched::GATHER) { S.a_offs(0, tid, vA0, vA1); }
    const size_t kstep = (size_t)(BK * 2);
    const size_t hstepA = S.hstep_a(), hstepB = S.hstep_b();
    const unsigned ldsw = (unsigned)wid * 1024u;
    const int aoff = lds_byte8(wr * 64 + fr, fq * 32), boff = lds_byte8(wc * 32 + fr, fq * 32);
    const int poff = (fr >> 3) ? -16 : 16;
#define PG8_SA(b, h) (((b) * 2 + (h)) * HTB)
#define PG8_SB(b, h) ((4 + (b) * 2 + (h)) * HTB)
#define PG8_STAGE(bufoff, gbase, voff) do { _Pragma("unroll") for (int _i = 0; _i < 2; ++_i) { unsigned _o = (voff)[_i]; asm volatile("" : "+v"(_o)); \
        __builtin_amdgcn_global_load_lds((const unsigned*)((const char*)(gbase) + _o), (LAS unsigned*)(lds + (bufoff) + ldsw + _i * 8192), 16, 0, 0); } } while (0)
#define PG8_LD32(p) __builtin_shufflevector(__builtin_bit_cast(v4i, *(const LAS bf16x8*)(p)), __builtin_bit_cast(v4i, *(const LAS bf16x8*)((p) + poff)), 0, 1, 2, 3, 4, 5, 6, 7)
#define PG8_LDA(dst, b, h) do { _Pragma("unroll") for (int m = 0; m < 4; ++m) dst[m] = PG8_LD32(lds + PG8_SA(b, h) + aoff + m * 2048); } while (0)
#define PG8_LDB(dst, b, h) do { _Pragma("unroll") for (int n = 0; n < 2; ++n) dst[n] = PG8_LD32(lds + PG8_SB(b, h) + boff + n * 2048); } while (0)
#define PG8_F8(x) (x)
#define PG8_MMA(ai, bj, At, Bt) do { __builtin_amdgcn_s_setprio(1); _Pragma("unroll") for (int m = 0; m < 4; ++m) _Pragma("unroll") for (int n = 0; n < 2; ++n) \
        asm volatile("v_mfma_scale_f32_16x16x128_f8f6f4 %0, %1, %2, %0, %3, %3 op_sel_hi:[0,0,0]" : "+v"(acc[ai][bj][m][n]) : "v"(Bt[n]), "v"(At[m]), "v"(sc127)); __builtin_amdgcn_s_setprio(0); } while (0)
#define PG8_WAIT_V(n) asm volatile("s_waitcnt vmcnt(" #n ")" ::: "memory")
#define PG8_WAIT_L(n) asm volatile("s_waitcnt lgkmcnt(" #n ")" ::: "memory")
#define PG8_BAR __builtin_amdgcn_s_barrier()
#define PG8_SCHED __builtin_amdgcn_sched_barrier(0)
    float zf_ = 0.f; asm volatile("" : "+v"(zf_)); const f32x4 zero4 = (f32x4){zf_, zf_, zf_, zf_};
    f32x4 acc[2][2][4][2];
#pragma unroll
    for (int a = 0; a < 2; ++a)
#pragma unroll
        for (int b = 0; b < 2; ++b)
#pragma unroll
            for (int m = 0; m < 4; ++m)
#pragma unroll
                for (int n = 0; n < 2; ++n) acc[a][b][m][n] = zero4;
    v8i At[4], B0[2], B1[2];
    const int sc127 = 0x7F7F7F7F;
    const char* cA = S.a_base(cur); const char* cB = S.b_base(cur);
    PG8_STAGE(PG8_SB(0, 0), cB, voffB); PG8_STAGE(PG8_SB(0, 1), cB + hstepB, voffB); PG8_STAGE(PG8_SA(0, 0), cA, vA0); PG8_STAGE(PG8_SA(0, 1), cA + hstepA, vA1);
    if (wr == 1) PG8_BAR;
    PG8_WAIT_V(2); PG8_BAR;
    PG8_STAGE(PG8_SB(1, 0), cB + kstep, voffB); PG8_STAGE(PG8_SA(1, 0), cA + kstep, vA0); PG8_STAGE(PG8_SB(1, 1), cB + hstepB + kstep, voffB);
    PG8_WAIT_V(6); PG8_BAR;
#if PROBE_MASK & 0x30000
    unsigned long long gts_ = __builtin_amdgcn_s_memrealtime();
#define GSEC(bit) do { if (PROBE_MASK & (bit)) { const unsigned long long d_ = __builtin_amdgcn_s_memrealtime() - gts_; while (__builtin_amdgcn_s_memrealtime() - gts_ < 2 * d_) __builtin_amdgcn_s_sleep(2); } gts_ = __builtin_amdgcn_s_memrealtime(); } while (0)
#else
#define GSEC(bit) do { } while (0)
#endif
    for (;;) {
        const bool has_next = S.next(ui + 1, nxt);
        const char* nA = has_next ? S.a_base(nxt) : cA; const char* nB = has_next ? S.b_base(nxt) : cB;
#pragma unroll 1
        for (int t = 0; t < nt; t += 2) {
            const bool last = (t == nt - 2);
            const char* a1 = cA + (size_t)(t + 1) * kstep;
            const char* a2 = last ? nA : cA + (size_t)(t + 2) * kstep; const char* b2 = last ? nB : cB + (size_t)(t + 2) * kstep;
            const char* a3 = a2 + kstep; const char* b3 = b2 + kstep;
            PG8_LDB(B0, 0, 0); PG8_LDB(B1, 0, 1); PG8_SCHED; PG8_LDA(At, 0, 0); PG8_STAGE(PG8_SA(1, 1), a1 + hstepA, vA1);
            if constexpr (Sched::GATHER) { if (last && has_next) S.a_offs(ui + 1, tid, vA0, vA1); }
            PG8_WAIT_V(8); PG8_WAIT_L(0); PG8_BAR; PG8_MMA(0, 0, At, B0); PG8_MMA(0, 1, At, B1); PG8_BAR; PG8_SCHED;
            PG8_LDA(At, 0, 1); PG8_STAGE(PG8_SB(0, 0), b2, voffB); PG8_STAGE(PG8_SB(0, 1), b2 + hstepB, voffB); PG8_STAGE(PG8_SA(0, 0), a2, vA0);
            PG8_WAIT_V(8); PG8_WAIT_L(0); PG8_BAR; PG8_MMA(1, 0, At, B0); PG8_MMA(1, 1, At, B1); PG8_BAR; PG8_SCHED;
            PG8_LDB(B0, 1, 0); PG8_LDB(B1, 1, 1); PG8_SCHED; PG8_LDA(At, 1, 0); PG8_STAGE(PG8_SA(0, 1), a2 + hstepA, vA1);
            PG8_WAIT_V(8); PG8_WAIT_L(0); PG8_BAR; PG8_MMA(0, 0, At, B0); PG8_MMA(0, 1, At, B1); PG8_BAR; PG8_SCHED;
            PG8_LDA(At, 1, 1); PG8_STAGE(PG8_SB(1, 0), b3, voffB); PG8_STAGE(PG8_SB(1, 1), b3 + hstepB, voffB); PG8_STAGE(PG8_SA(1, 0), a3, vA0);
            PG8_WAIT_V(8); PG8_WAIT_L(0); PG8_BAR; PG8_MMA(1, 0, At, B0); PG8_MMA(1, 1, At, B1); PG8_BAR; PG8_SCHED;
        }
        GSEC(0x10000);
        if constexpr (ALIGN_EPI) { if (wr == 0) PG8_BAR; }
        asm volatile("s_nop 15\n\ts_nop 15" ::: "memory");
        { int te = tid; asm volatile("" : "+v"(te)); const int le_ = te & 63, we_ = __builtin_amdgcn_readfirstlane(te >> 6); E(acc, cur, we_ >> 2, we_ & 3, le_ & 15, le_ >> 4, bia); }
        if (!has_next) break;
#pragma unroll
        for (int a = 0; a < 2; ++a)
#pragma unroll
            for (int b = 0; b < 2; ++b)
#pragma unroll
                for (int m = 0; m < 4; ++m)
#pragma unroll
                    for (int n = 0; n < 2; ++n) acc[a][b][m][n] = zero4;
        cur = nxt; cA = nA; cB = nB; ++ui;
        E.load_bias(cur, wr, wc, fr, fq, bia);
        GSEC(0x20000);
        if constexpr (ALIGN_EPI) { if (wr == 1) PG8_BAR; }
    }
    PG8_WAIT_V(0);
    if constexpr (!ALIGN_EPI) { if (wr == 0) PG8_BAR; }
    PG8_BAR;
#undef PG8_SA
#undef PG8_SB
#undef PG8_STAGE
#undef PG8_LDA
#undef PG8_LDB
#undef PG8_MMA
#undef PG8_F8
#undef GSEC
#undef PG8_LD32
#undef PG8_WAIT_V
#undef PG8_WAIT_L
#undef PG8_BAR
#undef PG8_SCHED
}

struct PlainOrder {
    static constexpr bool GATHER = false;
    const char* A; const char* Bt; int K; int nM, nN, nwg, G, c;
    __device__ __forceinline__ void init(const void* A_, const void* Bt_, int M, int N, int K_, int G_, int c_) { A = (const char*)A_; Bt = (const char*)Bt_; K = K_; nM = M / BM; nN = N / BM; nwg = nM * nN; G = G_; c = c_; }
    __device__ __forceinline__ bool next(int i, Unit& u) const {
        const long Lq = (long)i * G + c; if (Lq >= nwg) return false;
        int wgid = (int)Lq; { const int q = nwg / 8, r = nwg % 8, xcd = wgid % 8, off = wgid / 8; wgid = (xcd < r ? xcd * (q + 1) : r * (q + 1) + (xcd - r) * q) + off; }
        const int nig = 8 * nN, gid = wgid / nig, fm = gid * 8, gsz = (nM - fm) < 8 ? (nM - fm) : 8;
        u.pm = fm + ((wgid % nig) % gsz); u.pn = (wgid % nig) / gsz; u.e = 0; return true;
    }
    __device__ __forceinline__ const char* a_base(const Unit& u) const { return A + (size_t)u.pm * 256 * K * 2; }
    __device__ __forceinline__ const char* b_base(const Unit& u) const { return Bt + (size_t)u.pn * 256 * K * 2; }
    __device__ __forceinline__ unsigned a_off(int R, int C) const { return (unsigned)(R * K + C) * 2u; }
    __device__ __forceinline__ unsigned b_off(int R, int C) const { return (unsigned)(R * K + C) * 2u; }
    __device__ __forceinline__ size_t hstep_a() const { return (size_t)HALF * K * 2; }
    __device__ __forceinline__ size_t hstep_b() const { return (size_t)HALF * K * 2; }
};
struct PlainOrder8 : PlainOrder {
    __device__ __forceinline__ const char* a_base(const Unit& u) const { return A + (size_t)u.pm * 256 * K; }
    __device__ __forceinline__ const char* b_base(const Unit& u) const { return Bt + (size_t)u.pn * 256 * K; }
    __device__ __forceinline__ unsigned a_off(int R, int C) const { return (unsigned)(R * K + C * 2); }
    __device__ __forceinline__ unsigned b_off(int R, int C) const { return (unsigned)(R * K + C * 2); }
    __device__ __forceinline__ size_t hstep_a() const { return (size_t)HALF * K; }
    __device__ __forceinline__ size_t hstep_b() const { return (size_t)HALF * K; }
};
struct PlainOrderBf : PlainOrder {
    __device__ __forceinline__ bool next(int i, Unit& u) const { if (!PlainOrder::next(i, u)) return false; u.pn = u.pn < 2 ? u.pn : u.pn + 2; return true; }
};
struct PlainOrderF8 : PlainOrder8 {
    __device__ __forceinline__ bool next(int i, Unit& u) const { if (!PlainOrder::next(i, u)) return false; u.pn = u.pn < 2 ? u.pn + 2 : u.pn + 4; return true; }
};
struct FourierOrder {
    static constexpr bool GATHER = false;
    const char* A; const char* X; int K, G, c;
    __device__ __forceinline__ bool next(int i, Unit& u) const { const int Lq = i * G + c; if (Lq >= 256) return false; u.pm = Lq & 1; u.pn = Lq >> 1; u.e = 0; return true; }
    __device__ __forceinline__ const char* a_base(const Unit& u) const { return A + (size_t)u.pm * 256 * K * 2; }
    __device__ __forceinline__ const char* b_base(const Unit& u) const { return X + (size_t)((u.pn >> 5) * 8192 + (u.pn & 31) * 4) * K * 2; }
    __device__ __forceinline__ unsigned a_off(int R, int C) const { return (unsigned)(R * K + C) * 2u; }
    __device__ __forceinline__ unsigned b_off(int R, int C) const { return (unsigned)((((R & 63) * 128 + (R >> 6)) * K + C) * 2); }
    __device__ __forceinline__ size_t hstep_a() const { return (size_t)HALF * K * 2; }
    __device__ __forceinline__ size_t hstep_b() const { return (size_t)2 * K * 2; }
};
struct FourierOrder8 {
    static constexpr bool GATHER = false;
    const char* A; const char* X; int K, G, c;
    __device__ __forceinline__ bool next(int i, Unit& u) const { const int Lq = i * G + c; if (Lq >= 256) return false; u.pm = Lq & 1; u.pn = Lq >> 1; u.e = 0; return true; }
    __device__ __forceinline__ const char* a_base(const Unit& u) const { return A + (size_t)u.pm * 256 * K; }
    __device__ __forceinline__ const char* b_base(const Unit& u) const { return X + (size_t)((u.pn >> 5) * 8192 + (u.pn & 31) * 4) * K; }
    __device__ __forceinline__ unsigned a_off(int R, int C) const { return (unsigned)(R * K + C * 2); }
    __device__ __forceinline__ unsigned b_off(int R, int C) const { return (unsigned)(((R & 63) * 128 + (R >> 6)) * K + C * 2); }
    __device__ __forceinline__ size_t hstep_a() const { return (size_t)HALF * K; }
    __device__ __forceinline__ size_t hstep_b() const { return (size_t)2 * K; }
};
__device__ __forceinline__ bool moe_unit(int i, int c, int G, int nN, int ntot, int& pm, int& pn) {
    if (G == 256) { const int x = c & 7, j = c >> 3;
        if (nN == 8) { pm = i * 32 + x * 4 + (j >> 3); pn = j & 7; } else { pm = i * 64 + x * 8 + (j >> 2); pn = j & 3; }
        return pm < ntot; }
    const long Lq = (long)i * G + c; pm = (int)(Lq / nN); pn = (int)(Lq % nN); return pm < ntot;
}
struct GroupOrder {
    static constexpr bool GATHER = false;
    const char* A; const char* Bt; int K  ; int nN, ntot, G, c; size_t bstride; const LAS unsigned char* tile_e;
    __device__ __forceinline__ bool next(int i, Unit& u) const {
        if (!moe_unit(i, c, G, nN, ntot, u.pm, u.pn)) return false;
        u.e = __builtin_amdgcn_readfirstlane((int)tile_e[u.pm]); return true;
    }
    __device__ __forceinline__ const char* a_base(const Unit& u) const { return A + (size_t)u.pm * 256 * K; }
    __device__ __forceinline__ const char* b_base(const Unit& u) const { return Bt + (size_t)u.e * bstride + (size_t)u.pn * 256 * K; }
    __device__ __forceinline__ unsigned a_off(int R, int C) const { return (unsigned)(R * K + C * 2); }
    __device__ __forceinline__ unsigned b_off(int R, int C) const { return (unsigned)(R * K + C * 2); }
    __device__ __forceinline__ size_t hstep_a() const { return (size_t)HALF * K; }
    __device__ __forceinline__ size_t hstep_b() const { return (size_t)HALF * K; }
};

struct GatherOrder {
    static constexpr bool GATHER = true;
    const char* X; const char* Bt; int K  ; int nN, ntot, G, c; size_t bstride; const LAS unsigned char* tile_e; const LAS unsigned* gtab;
    __device__ __forceinline__ bool next(int i, Unit& u) const {
        if (!moe_unit(i, c, G, nN, ntot, u.pm, u.pn)) return false;
        u.e = __builtin_amdgcn_readfirstlane((int)tile_e[u.pm]); return true;
    }
    __device__ __forceinline__ const char* a_base(const Unit&) const { return X; }
    __device__ __forceinline__ const char* b_base(const Unit& u) const { return Bt + (size_t)u.e * bstride + (size_t)u.pn * 256 * K; }
    __device__ __forceinline__ unsigned a_off(int, int) const { return 0u; }
    __device__ __forceinline__ void a_offs(int ui, int tid, unsigned (&v0)[2], unsigned (&v1)[2]) const {
#pragma unroll
        for (int i = 0; i < 2; ++i) { int R, C; stage_rc8(tid * 16 + i * 8192, R, C); v0[i] = gtab[ui * 256 + R] + (unsigned)C * 2u; v1[i] = gtab[ui * 256 + 128 + R] + (unsigned)C * 2u; } }
    __device__ __forceinline__ unsigned b_off(int R, int C) const { return (unsigned)(R * K + C * 2); }
    __device__ __forceinline__ size_t hstep_a() const { return 0; }
    __device__ __forceinline__ size_t hstep_b() const { return (size_t)HALF * K; }
};

struct EpiBf16Bias {
    static constexpr bool PERM = true;
    bf16_t* O; int ldc; const float* bias; float ascale;
    struct Bias { f32x4 v[2][2]; };
    __device__ __forceinline__ void load_bias(const Unit& u, int wr, int wc, int fr, int fq, Bias& B) const {
        const int col0 = u.pn * BM + wc * 32 + 8 * fq;
#pragma unroll
        for (int bj = 0; bj < 2; ++bj)
#pragma unroll
            for (int n = 0; n < 2; ++n) B.v[bj][n] = *(const f32x4*)(bias + col0 + bj * HALF + 4 * n);
    }
    __device__ __forceinline__ void operator()(const f32x4 (&acc)[2][2][4][2], const Unit& u, int wr, int wc, int fr, int fq, const Bias& B) const {
        const int row0 = u.pm * BM + wr * 64 + fr, col0 = u.pn * BM + wc * 32 + 8 * fq;
        const f32x4 (&bv)[2][2] = B.v;
#pragma unroll
        for (int ai = 0; ai < 2; ++ai)
#pragma unroll
            for (int m = 0; m < 4; ++m) { bf16_t* rowp = O + (size_t)(row0 + ai * HALF + m * 16) * ldc + col0;
#pragma unroll
                for (int bj = 0; bj < 2; ++bj) { const f32x4 v0 = acc[ai][bj][m][0] * ascale + bv[bj][0], v1 = acc[ai][bj][m][1] * ascale + bv[bj][1];
                    u32x4 w; w.x = cvt_pk_bf16(v0[0], v0[1]); w.y = cvt_pk_bf16(v0[2], v0[3]); w.z = cvt_pk_bf16(v1[0], v1[1]); w.w = cvt_pk_bf16(v1[2], v1[3]);
                    *(u32x4*)(rowp + bj * HALF) = w; } }
    }
};
struct EpiFourierT {
    static constexpr bool PERM = true;
    bf16_t* UT; const float* bF; float ascale;
    struct Bias { float v[2][4]; };
    __device__ __forceinline__ void load_bias(const Unit& u, int wr, int wc, int fr, int fq, Bias& B) const {
#pragma unroll
        for (int ai = 0; ai < 2; ++ai)
#pragma unroll
            for (int m = 0; m < 4; ++m) B.v[ai][m] = bF[u.pm * 256 + ai * HALF + wr * 64 + m * 16 + fr];
    }
    __device__ __forceinline__ void operator()(const f32x4 (&acc)[2][2][4][2], const Unit& u, int wr, int wc, int fr, int fq, const Bias& B) const {
        const int b = u.pn >> 5, q = u.pn & 31, cs = u.pm;
#pragma unroll
        for (int ai = 0; ai < 2; ++ai)
#pragma unroll
            for (int m = 0; m < 4; ++m) { const int ch = ai * HALF + wr * 64 + m * 16 + fr; const float bv = B.v[ai][m];
#pragma unroll
                for (int bj = 0; bj < 2; ++bj) { const int s2 = 4 * q + 2 * bj + (wc >> 1), s1 = 32 * (wc & 1) + 8 * fq;
                    const f32x4 v0 = acc[ai][bj][m][0] * ascale + bv, v1 = acc[ai][bj][m][1] * ascale + bv;
                    u32x4 w; w.x = cvt_pk_bf16(v0[0], v0[1]); w.y = cvt_pk_bf16(v0[2], v0[3]); w.z = cvt_pk_bf16(v1[0], v1[1]); w.w = cvt_pk_bf16(v1[2], v1[3]);
                    *(u32x4*)(UT + ((size_t)((b * 256 + ch) * 128 + s2) * 2 + cs) * 64 + s1) = w; } }
    }
};
struct EpiResBf16 {
    static constexpr bool PERM = true;
    bf16_t* O; const bf16_t* R; int ldc; float alpha, ascale;
    struct Bias { };
    __device__ __forceinline__ void load_bias(const Unit&, int, int, int, int, Bias&) const { }
    __device__ __forceinline__ void operator()(const f32x4 (&acc)[2][2][4][2], const Unit& u, int wr, int wc, int fr, int fq, const Bias&) const {
        const int row0 = u.pm * BM + wr * 64 + fr, col0 = u.pn * BM + wc * 32 + 8 * fq;
        u32x4 rall[2][4][2];
#pragma unroll
        for (int ai = 0; ai < 2; ++ai)
#pragma unroll
            for (int m = 0; m < 4; ++m)
#pragma unroll
                for (int bj = 0; bj < 2; ++bj) rall[ai][m][bj] = *(const u32x4*)(R + (size_t)(row0 + ai * HALF + m * 16) * ldc + col0 + bj * HALF);
#pragma unroll
        for (int ai = 0; ai < 2; ++ai)
#pragma unroll
            for (int m = 0; m < 4; ++m) { const size_t off = (size_t)(row0 + ai * HALF + m * 16) * ldc + col0;
#pragma unroll
                for (int bj = 0; bj < 2; ++bj) { const u32x4 rv = rall[ai][m][bj]; const f32x4 a0 = acc[ai][bj][m][0] * ascale, a1 = acc[ai][bj][m][1] * ascale;
                    u32x4 w;
                    w.x = cvt_pk_bf16(a0[0] + alpha * __builtin_bit_cast(float, rv.x << 16), a0[1] + alpha * __builtin_bit_cast(float, rv.x & 0xffff0000u));
                    w.y = cvt_pk_bf16(a0[2] + alpha * __builtin_bit_cast(float, rv.y << 16), a0[3] + alpha * __builtin_bit_cast(float, rv.y & 0xffff0000u));
                    w.z = cvt_pk_bf16(a1[0] + alpha * __builtin_bit_cast(float, rv.z << 16), a1[1] + alpha * __builtin_bit_cast(float, rv.z & 0xffff0000u));
                    w.w = cvt_pk_bf16(a1[2] + alpha * __builtin_bit_cast(float, rv.w << 16), a1[3] + alpha * __builtin_bit_cast(float, rv.w & 0xffff0000u));
                    *(u32x4*)(O + off + bj * HALF) = w; } }
    }
};
__device__ __forceinline__ unsigned pk4_fp8(float a, float b, float c, float d) { int w = 0; w = __builtin_amdgcn_cvt_pk_fp8_f32(a, b, w, false); w = __builtin_amdgcn_cvt_pk_fp8_f32(c, d, w, true); return (unsigned)w; }
struct EpiSwiglu8 {
    static constexpr bool PERM = true;
    unsigned char* H; const float* b1; float ascale;
    struct Bias { f32x4 v[4]; };
    __device__ __forceinline__ void load_bias(const Unit& u, int wr, int wc, int fr, int fq, Bias& B) const {
        const float* bg = b1 + (size_t)u.e * 2048 + u.pn * HALF + wc * 32 + 8 * fq; const float* bu = bg + 1024;
        B.v[0] = *(const f32x4*)(bg); B.v[1] = *(const f32x4*)(bg + 4); B.v[2] = *(const f32x4*)(bu); B.v[3] = *(const f32x4*)(bu + 4);
    }
    __device__ __forceinline__ void operator()(const f32x4 (&acc)[2][2][4][2], const Unit& u, int wr, int wc, int fr, int fq, const Bias& B) const {
        const int row0 = u.pm * BM + wr * 64 + fr, col0 = u.pn * HALF + wc * 32 + 8 * fq;
        const f32x4 g0 = B.v[0], g1 = B.v[1], u0 = B.v[2], u1 = B.v[3];
#pragma unroll
        for (int ai = 0; ai < 2; ++ai)
#pragma unroll
            for (int m = 0; m < 4; ++m) { unsigned char* rowp = H + (size_t)(row0 + ai * HALF + m * 16) * FF + col0;
                u32x2 w;
#pragma unroll
                for (int n = 0; n < 2; ++n) { f32x4 g = acc[ai][0][m][n] * ascale + (n ? g1 : g0), up = acc[ai][1][m][n] * ascale + (n ? u1 : u0);
#pragma unroll
                    for (int j = 0; j < 4; ++j) { g[j] = fminf(g[j], SW_LIMIT); up[j] = fminf(fmaxf(up[j], -SW_LIMIT), SW_LIMIT); }
                    const f32x4 z = g * (-SW_ALPHA * LOG2E); f32x4 e;
#pragma unroll
                    for (int j = 0; j < 4; ++j) e[j] = __builtin_amdgcn_exp2f(z[j]);
                    const f32x4 d = e + 1.0f; f32x4 r;
#pragma unroll
                    for (int j = 0; j < 4; ++j) r[j] = __builtin_amdgcn_rcpf(d[j]);
                    const f32x4 o = (up + 1.0f) * (g * r);
                    if (n == 0) w.x = pk4_fp8(o[0], o[1], o[2], o[3]); else w.y = pk4_fp8(o[0], o[1], o[2], o[3]); }
                *(u32x2*)rowp = w; }
    }
};
struct EpiExpertOut {
    static constexpr bool PERM = true;
    unsigned char* Y; const float* b2; float ascale;
    struct Bias { f32x4 v[2][2]; };
    __device__ __forceinline__ void load_bias(const Unit& u, int wr, int wc, int fr, int fq, Bias& B) const {
        const float* bb = b2 + (size_t)u.e * D + u.pn * BM + wc * 32 + 8 * fq;
#pragma unroll
        for (int bj = 0; bj < 2; ++bj)
#pragma unroll
            for (int n = 0; n < 2; ++n) B.v[bj][n] = *(const f32x4*)(bb + bj * HALF + 4 * n) * Y_SCALE;
    }
    __device__ __forceinline__ void operator()(const f32x4 (&acc)[2][2][4][2], const Unit& u, int wr, int wc, int fr, int fq, const Bias& B) const {
        const int row0 = u.pm * BM + wr * 64 + fr, col0 = u.pn * BM + wc * 32 + 8 * fq;
        const f32x4 (&bv)[2][2] = B.v; const float sc = ascale * Y_SCALE;
#pragma unroll
        for (int ai = 0; ai < 2; ++ai)
#pragma unroll
            for (int m = 0; m < 4; ++m) { unsigned char* rowp = Y + (size_t)(row0 + ai * HALF + m * 16) * D + col0;
#pragma unroll
                for (int bj = 0; bj < 2; ++bj) { const f32x4 v0 = acc[ai][bj][m][0] * sc + bv[bj][0], v1 = acc[ai][bj][m][1] * sc + bv[bj][1];
                    u32x2 w; w.x = pk4_fp8(v0[0], v0[1], v0[2], v0[3]); w.y = pk4_fp8(v1[0], v1[1], v1[2], v1[3]);
                    *(u32x2*)(rowp + bj * HALF) = w; } }
    }
};
}

#define XB_TMO      128
#define XB_XCNT(j)  (256  + 64 * (j))
#define XB_XSUB(j)  (1280 + 64 * (j))
#define XB_XGEN(j)  (2304 + 64 * (j))
#define XB_TOP      3328
#define XB_TOPGEN   3392
#define XCD_BAR_WORDS 3456
#define XB_SPIN_CAP (1u << 22)
__device__ __forceinline__ unsigned xb_ld(unsigned* p)              { return __hip_atomic_load(p, __ATOMIC_RELAXED, __HIP_MEMORY_SCOPE_AGENT); }
__device__ __forceinline__ unsigned xb_add(unsigned* p, unsigned v) { return __hip_atomic_fetch_add(p, v, __ATOMIC_RELAXED, __HIP_MEMORY_SCOPE_AGENT); }
__device__ __forceinline__ unsigned xb_xcc_id() { return (unsigned)__builtin_amdgcn_s_getreg((3 << 11) | 20) & 0xFu; }
#define XB_SPIN(cond, bar) do { unsigned _sp = 0; while (cond) { __builtin_amdgcn_s_sleep(1); \
    if ((++_sp & 255u) == 0u) { if (xb_ld(&(bar)[XB_TMO])) break; if (_sp > XB_SPIN_CAP) { atomicAdd(&(bar)[XB_TMO], 1u); break; } } } } while (0)
struct XcdBarrier { unsigned* bar; unsigned x; volatile LAS unsigned* st; };
__device__ __forceinline__ XcdBarrier xcd_barrier_post(unsigned* bar, volatile LAS unsigned* st) {
    XcdBarrier b; b.bar = bar; b.x = xb_xcc_id(); b.st = st;
    if (threadIdx.x == 0) (void)xb_add(&bar[XB_XCNT(b.x)], 1u);
    return b;
}
__device__ __forceinline__ void xcd_barrier_complete(unsigned* bar, unsigned x, unsigned& nloc, unsigned& nx) {
    const unsigned G = gridDim.x * gridDim.y * gridDim.z;
    unsigned sum, cnt, mine, sp = 0u;
    for (;;) {
        sum = 0u; cnt = 0u; mine = 0u;
#pragma unroll
        for (unsigned j = 0; j < 16; ++j) { const unsigned c = xb_ld(&bar[XB_XCNT(j)]); sum += c; cnt += (c > 0u) ? 1u : 0u; mine = (j == x) ? c : mine; }
        if (sum == G) break;
        __builtin_amdgcn_s_sleep(1);
        if ((++sp & 255u) == 0u) { if (xb_ld(&bar[XB_TMO])) break; if (sp > XB_SPIN_CAP) { atomicAdd(&bar[XB_TMO], 1u); break; } }
    }
    nloc = mine > 0u ? mine : 1u; nx = cnt > 0u ? cnt : 1u;
}
__device__ __forceinline__ void xcd_barrier(const XcdBarrier& b) {
    asm volatile("s_waitcnt vmcnt(0)" ::: "memory");
    __syncthreads();
    if (threadIdx.x == 0) {
        unsigned* bar = b.bar;
        __builtin_amdgcn_s_waitcnt(0);
        unsigned nloc = b.st[0], nx = b.st[1];
        if (nloc == 0u) { xcd_barrier_complete(bar, b.x, nloc, nx); b.st[0] = nloc; b.st[1] = nx; }
        const unsigned old = xb_add(&bar[XB_XSUB(b.x)], 1u);
        const unsigned gen = old / nloc;
        if (old + 1u == (gen + 1u) * nloc) {
            __builtin_amdgcn_fence(__ATOMIC_RELEASE, "agent");
            asm volatile("s_waitcnt vmcnt(0)" ::: "memory");
            const unsigned og = xb_add(&bar[XB_TOP], 1u);
            const unsigned tg = og / nx;
            if (og + 1u == (tg + 1u) * nx) xb_add(&bar[XB_TOPGEN], 1u);
            else XB_SPIN(xb_ld(&bar[XB_TOPGEN]) == tg, bar);
            __builtin_amdgcn_fence(__ATOMIC_ACQUIRE, "agent");
            xb_add(&bar[XB_XGEN(b.x)], 1u);
            asm volatile("s_waitcnt vmcnt(0)" ::: "memory");
        } else {
            XB_SPIN(xb_ld(&bar[XB_XGEN(b.x)]) == gen, bar);
            __builtin_amdgcn_fence(__ATOMIC_ACQUIRE, "agent");
            asm volatile("s_waitcnt vmcnt(0)" ::: "memory");
        }
    }
    __syncthreads();
}

struct Args {
    const float* x; const float* emb_g; const float* emb_b; const float* w_in; const float* b_in; const float* conv_w; const float* ml_nw; const float* ret_nw;
    const float* w_out; const float* ln1_g; const float* ln1_b; const float* w_router; const float* b_router; const float* w1; const float* b1; const float* w2; const float* b2;
    const float* ln2_g; const float* ln2_b;
    float* out; unsigned char* ws; int ph_lo, ph_hi;
};
template <class Tp> __device__ __forceinline__ Tp* as_global(Tp* p) { return (Tp*)(__attribute__((address_space(1))) Tp*)p; }
__device__ __forceinline__ int as_global(int v) { return v; }
#define KA(f) as_global(((const volatile __attribute__((address_space(4))) Args*)__builtin_amdgcn_kernarg_segment_ptr())->f)
constexpr int NWAVES = 8, NTHR = 512;
constexpr int NPH_LAYER = 9;
constexpr int NPH = 1 + NL * NPH_LAYER;

struct Frame {
    LAS unsigned char* lds;
    unsigned* ctl;
    int tid, lane, wave, G, bid;
};

__device__ __forceinline__ int sidx(int b, int h, int dir, int c) { return ((b * NH + h) * 2 + dir) * NCH + c; }

template <class RowMap>
__device__ __forceinline__ void transpose_item(const float* W, int K, int Nsrc, bf16_t* WT, LAS float* scr, int kb, int nb, int lane, const RowMap& rm, int coff = 0) {
    const int k0 = 64 * kb, n0 = 32 * nb;
    const int nn = n0 + (lane & 31) + coff;
    float tv[32];
#pragma unroll
    for (int i = 0; i < 32; ++i) { const int kk = 2 * i + (lane >> 5); tv[i] = nn < Nsrc ? __builtin_nontemporal_load(W + (size_t)(k0 + kk) * Nsrc + nn) : 0.f; }
#pragma unroll
    for (int i = 0; i < 32; ++i) { const int kk = 2 * i + (lane >> 5); scr[kk * 33 + (lane & 31)] = tv[i]; }
    asm volatile("s_waitcnt lgkmcnt(0)" ::: "memory");
    const int c = lane & 7;
#pragma unroll
    for (int j = 0; j < 4; ++j) { const int n = (lane >> 3) + 8 * j; const LAS float* s = scr + (8 * c) * 33 + n;
        u32x4 o; o.x = pk2(s[0 * 33], s[1 * 33]); o.y = pk2(s[2 * 33], s[3 * 33]); o.z = pk2(s[4 * 33], s[5 * 33]); o.w = pk2(s[6 * 33], s[7 * 33]);
        *(u32x4*)(WT + (size_t)rm(n0 + n) * K + k0 + 8 * c) = o; }
    asm volatile("s_waitcnt lgkmcnt(0)" ::: "memory");
}
template <class RowMap>
__device__ __forceinline__ void transpose_item_f8(const float* W, int K, int Nsrc, unsigned char* WT, LAS float* scr, int kb, int nb, int lane, const RowMap& rm, float scale) {
    const int k0 = 64 * kb, n0 = 32 * nb;
    const int nn = n0 + (lane & 31);
    float tv[32];
#pragma unroll
    for (int i = 0; i < 32; ++i) { const int kk = 2 * i + (lane >> 5); tv[i] = __builtin_nontemporal_load(W + (size_t)(k0 + kk) * Nsrc + nn); }
#pragma unroll
    for (int i = 0; i < 32; ++i) { const int kk = 2 * i + (lane >> 5); scr[kk * 33 + (lane & 31)] = tv[i] * scale; }
    asm volatile("s_waitcnt lgkmcnt(0)" ::: "memory");
    const int c = lane & 7;
#pragma unroll
    for (int j = 0; j < 4; ++j) { const int n = (lane >> 3) + 8 * j; const LAS float* sp = scr + (8 * c) * 33 + n;
        u32x2 o; o.x = pg8::pk4_fp8(sp[0 * 33], sp[1 * 33], sp[2 * 33], sp[3 * 33]); o.y = pg8::pk4_fp8(sp[4 * 33], sp[5 * 33], sp[6 * 33], sp[7 * 33]);
        *(u32x2*)(WT + (size_t)rm(n0 + n) * K + k0 + 8 * c) = o; }
    asm volatile("s_waitcnt lgkmcnt(0)" ::: "memory");
}
template <class RowMap>
__device__ __forceinline__ void transpose_item128_f8(const float* W, int K, int Nsrc, unsigned char* WT, LAS unsigned* scr, int kb, int nb, int lane, const RowMap& rm, float scale, int coff = 0) {
    const int k0 = 128 * kb, n0 = 32 * nb, n4 = lane & 7, kq = lane >> 3; const bool inb = n0 + 4 * n4 + coff < Nsrc;
    f32x4 x[4][4];
#pragma unroll
    for (int it = 0; it < 4; ++it)
#pragma unroll
        for (int r = 0; r < 4; ++r) x[it][r] = inb ? __builtin_nontemporal_load((const f32x4*)(W + (size_t)(k0 + 32 * it + 4 * kq + r) * Nsrc + n0 + 4 * n4 + coff)) : (f32x4){0.f, 0.f, 0.f, 0.f};
#pragma unroll
    for (int it = 0; it < 4; ++it)
#pragma unroll
        for (int j = 0; j < 4; ++j) scr[(4 * n4 + j) * 33 + 8 * it + kq] = pg8::pk4_fp8(x[it][0][j] * scale, x[it][1][j] * scale, x[it][2][j] * scale, x[it][3][j] * scale);
    asm volatile("s_waitcnt lgkmcnt(0)" ::: "memory");
#pragma unroll
    for (int q = 0; q < 4; ++q) { const int n = 8 * q + (lane >> 3), c = lane & 7; const LAS unsigned* sp = scr + n * 33 + 4 * c;
        u32x4 o; o.x = sp[0]; o.y = sp[1]; o.z = sp[2]; o.w = sp[3];
        *(u32x4*)(WT + (size_t)rm(n0 + n) * K + k0 + 16 * c) = o; }
    asm volatile("s_waitcnt lgkmcnt(0)" ::: "memory");
}
struct RowId { __device__ __forceinline__ int operator()(int n) const { return n; } };
struct RowW1 { __device__ __forceinline__ int operator()(int n) const { const int up = n >> 10, j = n & 1023; return (j >> 7) * 256 + up * 128 + (j & 127); } };

__device__ __forceinline__ void ln_row(const f32x4 (&vin)[4], const float* g, const float* b, float* of, bf16_t* ob, float* of2, int lane, unsigned char* oq = nullptr) {
    f32x4 v[4]; float s = 0.f;
#pragma unroll
    for (int j = 0; j < 4; ++j) { v[j] = vin[j]; s += (v[j].x + v[j].y) + (v[j].z + v[j].w); }
    const float mean = wave_sum(s) * (1.f / D); float s2 = 0.f;
#pragma unroll
    for (int j = 0; j < 4; ++j) { v[j] = v[j] - mean; s2 += (v[j].x * v[j].x + v[j].y * v[j].y) + (v[j].z * v[j].z + v[j].w * v[j].w); }
    const float rstd = 1.f / sqrtf(wave_sum(s2) * (1.f / D) + LN_EPS);
#pragma unroll
    for (int j = 0; j < 4; ++j) { const f32x4 gg = *(const f32x4*)(g + 4 * lane + 256 * j), bb = *(const f32x4*)(b + 4 * lane + 256 * j);
        const f32x4 o = v[j] * rstd * gg + bb;
        if (of) *(f32x4*)(of + 4 * lane + 256 * j) = o;
        if (of2) *(f32x4*)(of2 + 4 * lane + 256 * j) = o;
        if (ob) { u32x2 w; w.x = pk2(o.x, o.y); w.y = pk2(o.z, o.w); *(u32x2*)(ob + 4 * lane + 256 * j) = w; }
        if (oq) { const f32x4 q = o * XQ_SCALE; *(unsigned*)(oq + 4 * lane + 256 * j) = pg8::pk4_fp8(q.x, q.y, q.z, q.w); } }
}

__device__ __forceinline__ void p0_prologue(const Frame& F, const Args& a) {
    unsigned char* ws = KA(ws);
    LAS float* scr = (LAS float*)(F.lds + F.wave * 16384);
    const int gw = F.bid * NWAVES + F.wave, NGW = F.G * NWAVES;
    const float* w_in_ = KA(w_in); const float* w_out_ = KA(w_out); const float* w1_ = KA(w1); const float* w2_ = KA(w2);
    constexpr int I_INQ = NL * 8 * 80; constexpr int I_IN = NL * 16 * 80, I_OUT = NL * 8 * 32, I_W1 = NL * NE * 8 * 64, I_W2 = NL * NE * 8 * 32;
    for (int it = gw; it < I_INQ + I_IN + I_OUT + I_W1 + I_W2; it += NGW) {
        int r = it;
        if (r < I_INQ) { const int l = r / (8 * 80), q = r % (8 * 80); const int tl_ = (q % 80) >> 3; if (tl_ < 2 || tl_ == 4 || tl_ == 5) continue;
            transpose_item128_f8(w_in_ + (size_t)l * D * PW, D, PW, (unsigned char*)(ws + WS_WINQ) + (size_t)l * PWP * D, (LAS unsigned*)scr, q / 80, q % 80, F.lane, RowId(), WINQ_SCALE, PWF); continue; } r -= I_INQ;
        if (r < I_IN) { const int l = r / (16 * 80), q = r % (16 * 80); const int tl_ = (q % 80) >> 3; if (!(tl_ < 2 || tl_ == 4 || tl_ == 5)) continue;
            transpose_item(w_in_ + (size_t)l * D * PW, D, PW, (bf16_t*)(ws + WS_WIN) + (size_t)l * PWP * D, scr, q / 80, q % 80, F.lane, RowId(), PWF); continue; } r -= I_IN;
        if (r < I_OUT) { const int l = r / (8 * 32), q = r % (8 * 32); transpose_item128_f8(w_out_ + (size_t)l * D * D, D, D, (unsigned char*)(ws + WS_WOUT) + (size_t)l * D * D, (LAS unsigned*)scr, q / 32, q % 32, F.lane, RowId(), WOUT_SCALE); continue; } r -= I_OUT;
        if (r < I_W1) { const int le = r / (8 * 64), q = r % (8 * 64); transpose_item128_f8(w1_ + (size_t)le * D * 2048, D, 2048, (unsigned char*)(ws + WS_W1) + (size_t)le * 2048 * D, (LAS unsigned*)scr, q / 64, q % 64, F.lane, RowW1(), W1_SCALE); continue; } r -= I_W1;
        { const int le = r / (8 * 32), q = r % (8 * 32); transpose_item128_f8(w2_ + (size_t)le * FF * D, FF, D, (unsigned char*)(ws + WS_W2) + (size_t)le * D * FF, (LAS unsigned*)scr, q / 32, q % 32, F.lane, RowId(), W2_SCALE); }
    }
    const int gt = F.bid * NTHR + F.tid, NGT = F.G * NTHR;
    float* binp = (float*)(ws + WS_BIN); const float* bin_ = KA(b_in);
    for (int i = gt; i < NL * PWP; i += NGT) { const int l = i / PWP, c = i % PWP; binp[i] = c < PW2 ? bin_[l * PW + PWF + c] : 0.f; }
    { bf16_t* WF = (bf16_t*)(ws + WS_WF); float* bF = (float*)(ws + WS_FG + FG_BF_OFF);
      {
        LAS float* wr8 = scr;
        LAS float* tab = scr + 2048;
        tab[F.lane] = __builtin_amdgcn_cosf((float)F.lane * (1.0f / 64.0f)); tab[64 + F.lane] = __builtin_amdgcn_sinf((float)F.lane * (1.0f / 64.0f));
        for (int rg = gw; rg < NL * D / 8; rg += NGW) { const int l = rg / (D / 8), k0 = (rg % (D / 8)) * 8;
#pragma unroll
            for (int kr = 0; kr < 8; ++kr) *(LAS f32x4*)(wr8 + kr * 256 + 4 * F.lane) = *(const f32x4*)(w_in_ + ((size_t)l * D + k0 + kr) * PW + 4 * F.lane);
            asm volatile("s_waitcnt lgkmcnt(0)" ::: "memory");
#pragma unroll 1
            for (int q = 0; q < 8; ++q) { const int cs = q >> 2, g = q & 3; float acc[8];
#pragma unroll
                for (int kr = 0; kr < 8; ++kr) acc[kr] = 0.f;
#pragma unroll 4
                for (int c = 0; c < 64; ++c) { const float tv = tab[cs * 64 + ((c * F.lane) & 63)];
#pragma unroll
                    for (int kr = 0; kr < 8; ++kr) acc[kr] += wr8[kr * 256 + g * 64 + c] * tv; }
                u32x4 o; o.x = pk2(acc[0], acc[1]); o.y = pk2(acc[2], acc[3]); o.z = pk2(acc[4], acc[5]); o.w = pk2(acc[6], acc[7]);
                *(u32x4*)(WF + ((size_t)l * 512 + cs * 256 + g * 64 + F.lane) * D + k0) = o;
                u32x2 oq; oq.x = pg8::pk4_fp8(acc[0] * WFQ_SCALE, acc[1] * WFQ_SCALE, acc[2] * WFQ_SCALE, acc[3] * WFQ_SCALE); oq.y = pg8::pk4_fp8(acc[4] * WFQ_SCALE, acc[5] * WFQ_SCALE, acc[6] * WFQ_SCALE, acc[7] * WFQ_SCALE);
                *(u32x2*)((unsigned char*)(ws + WS_WFQ) + ((size_t)l * 512 + cs * 256 + g * 64 + F.lane) * D + k0) = oq; }
            asm volatile("s_waitcnt lgkmcnt(0)" ::: "memory"); } }
      for (int i = gt; i < NL * 512; i += NGT) { const int l = i / 512, r = i % 512, cs = r >> 8, g = (r >> 6) & 3, cp = r & 63; float acc = 0.f;
          for (int c = 0; c < 64; ++c) { const float rev = (float)((c * cp) & 63) * (1.0f / 64.0f); acc += bin_[l * PW + g * 64 + c] * (cs ? __builtin_amdgcn_sinf(rev) : __builtin_amdgcn_cosf(rev)); }
          bF[i] = acc; }
      bf16_t* Gm = (bf16_t*)(ws + WS_FG);
      for (int i = gt; i < 128 * 128; i += NGT) { const int ro = i >> 13, k1 = (i >> 7) & 63, ri = (i >> 6) & 1, s1 = i & 63; const float rev = (float)((k1 * s1) & 63) * (1.0f / 64.0f);
          const float c = __builtin_amdgcn_cosf(rev), sn = __builtin_amdgcn_sinf(rev); Gm[i] = (bf16_t)f2bf(ro == 0 ? (ri == 0 ? c : -sn) : (ri == 0 ? -sn : -c)); }
      bf16_t* Hm = (bf16_t*)(ws + WS_FG + FG_H_OFF);
      for (int i = gt; i < 128 * 256; i += NGT) { const int k2 = i >> 8, ri = (i >> 7) & 1, s2 = i & 127; const float rev = (float)((k2 * s2) & 127) * (1.0f / 128.0f);
          Hm[i] = (bf16_t)f2bf(0.0013810679320049757f * (ri ? __builtin_amdgcn_sinf(rev) : __builtin_amdgcn_cosf(rev))); } }
    float* rot = (float*)(ws + WS_ROT);
    for (int i = gt; i < S * 24; i += NGT) { const int pos = i / 24, j = i % 24; const float inv = 1.0f / powf(10000.0f, (float)(2 * j) / 48.0f); const float ang = (float)pos * inv;
        float sn, cs; sincosf(ang, &sn, &cs); rot[2 * i] = cs; rot[2 * i + 1] = sn; }
    float* xf = (float*)(ws + WS_XF); bf16_t* xb = (bf16_t*)(ws + WS_XB); const float* xin = KA(x); const float* eg = KA(emb_g); const float* eb = KA(emb_b);
    for (int m = gw; m < T; m += NGW) { f32x4 v[4];
#pragma unroll
        for (int j = 0; j < 4; ++j) v[j] = *(const f32x4*)(xin + (size_t)m * D + 4 * F.lane + 256 * j);
        ln_row(v, eg, eb, nullptr, xb + (size_t)m * D, nullptr, F.lane, (unsigned char*)(ws + WS_XQ) + (size_t)m * D); }
    { float* wrt = (float*)(ws + WS_BIN + WRT_OFF); const float* wrs = KA(w_router);
      for (int i = gt; i < NL * NE * D; i += NGT) { const int l = i / (NE * D), e = (i / D) % NE, k = i % D; wrt[i] = wrs[((size_t)l * D + k) * NE + e]; } }
}

template <bool REV, bool MAXOP> __device__ __forceinline__ void scan2(float& x0, float& x1, int lane) {
    float s = MAXOP ? fmaxf(x0, x1) : x0 + x1;
#pragma unroll
    for (int o = 1; o < 64; o <<= 1) { const float t = REV ? __shfl_down(s, o) : __shfl_up(s, o); const bool ok = REV ? (lane + o < 64) : (lane >= o); if (ok) s = MAXOP ? fmaxf(s, t) : s + t; }
    float ex = REV ? __shfl_down(s, 1) : __shfl_up(s, 1); if (REV ? lane == 63 : lane == 0) ex = MAXOP ? -INFINITY : 0.f;
    if (!REV) { x0 = MAXOP ? fmaxf(ex, x0) : ex + x0; x1 = MAXOP ? fmaxf(x0, x1) : x0 + x1; }
    else      { x1 = MAXOP ? fmaxf(ex, x1) : ex + x1; x0 = MAXOP ? fmaxf(x1, x0) : x1 + x0; }
}
__device__ __forceinline__ float ret_lg(int h, float off) {
    return off == 0.f ? (h == 0 ? -0.0317486983145803f : h == 1 ? -0.015748356968139168f : h == 2 ? -0.007843177461025893f : -0.003913899321136329f)
                      : (h == 0 ? -0.02234488474624582f : h == 1 ? -0.01111003193719751f : h == 2 ? -0.005539586946744796f : -0.002765957600334473f);
}

typedef short s16x4 __attribute__((ext_vector_type(4)));
__device__ __forceinline__ bf16x8 tr_frag(const LAS bf16_t* tile, int stride, int row0, int col0, int lane) {
    const LAS bf16_t* a0 = tile + (row0 + 8 * (lane >> 4) + ((lane & 15) >> 2)) * stride + col0 + 4 * (lane & 3);
    const s16x4 lo = __builtin_amdgcn_ds_read_tr16_b64_v4i16((LAS s16x4*)a0);
    const s16x4 hi = __builtin_amdgcn_ds_read_tr16_b64_v4i16((LAS s16x4*)(a0 + 4 * stride));
    return (bf16x8){lo[0], lo[1], lo[2], lo[3], hi[0], hi[1], hi[2], hi[3]};
}
constexpr int QKS = 72, VSS = 104, WSS = 136, KPS = 56;

__device__ __forceinline__ void qk_chunk8(const bf16_t* P, const float* convw, const float* rot, int type, int b, int s, int h, int isk, int cc, float (&o)[8]) {
    if (type == 0) {
        const int ch0 = isk * 192 + h * DK + 8 * cc;
        const bf16_t* p0 = P + (size_t)(b * S + s) * PWP + COL_MQK + ch0;
        const u32x4 z = (u32x4){0u, 0u, 0u, 0u};
        const u32x4 xm = s > 0 ? *(const u32x4*)(p0 - PWP) : z, x0 = *(const u32x4*)p0, xp = s < S - 1 ? *(const u32x4*)(p0 + PWP) : z;
        const float* w = convw + ch0;
        const f32x4 w0a = *(const f32x4*)w, w0b = *(const f32x4*)(w + 4), w1a = *(const f32x4*)(w + 384), w1b = *(const f32x4*)(w + 388), w2a = *(const f32x4*)(w + 768), w2b = *(const f32x4*)(w + 772);
#pragma unroll
        for (int i = 0; i < 4; ++i) { const unsigned am = xm[i], a0 = x0[i], ap = xp[i];
            const float wl0 = i < 2 ? w0a[2 * i] : w0b[2 * i - 4], wh0 = i < 2 ? w0a[2 * i + 1] : w0b[2 * i - 3];
            const float wl1 = i < 2 ? w1a[2 * i] : w1b[2 * i - 4], wh1 = i < 2 ? w1a[2 * i + 1] : w1b[2 * i - 3];
            const float wl2 = i < 2 ? w2a[2 * i] : w2b[2 * i - 4], wh2 = i < 2 ? w2a[2 * i + 1] : w2b[2 * i - 3];
            const float lo = __builtin_bit_cast(float, am << 16) * wl0 + __builtin_bit_cast(float, a0 << 16) * wl1 + __builtin_bit_cast(float, ap << 16) * wl2;
            const float hi = __builtin_bit_cast(float, am & 0xffff0000u) * wh0 + __builtin_bit_cast(float, a0 & 0xffff0000u) * wh1 + __builtin_bit_cast(float, ap & 0xffff0000u) * wh2;
            o[2 * i] = siluf_(lo); o[2 * i + 1] = siluf_(hi); }
    } else {
        const u32x4 x0 = *(const u32x4*)(P + (size_t)(b * S + s) * PWP + (isk ? COL_RK : COL_RQ) + h * DK + 8 * cc);
        const float* rp = rot + (size_t)(s * 24 + 4 * cc) * 2;
        const f32x4 ra = *(const f32x4*)rp, rb = *(const f32x4*)(rp + 4);
#pragma unroll
        for (int i = 0; i < 4; ++i) { const float t1 = __builtin_bit_cast(float, x0[i] << 16), t2 = __builtin_bit_cast(float, x0[i] & 0xffff0000u);
            const float cs = i < 2 ? ra[2 * i] : rb[2 * i - 4], sn = i < 2 ? ra[2 * i + 1] : rb[2 * i - 3];
            o[2 * i] = t1 * cs - t2 * sn; o[2 * i + 1] = t1 * sn + t2 * cs; }
    }
}
__device__ __forceinline__ void load_qk(const Frame& F, const bf16_t* P, const float* convw, const float* rot, int type, int b, int c, int h, float kscale, LAS bf16_t* Qs, LAS bf16_t* Ks) {
#pragma unroll
    for (int it = 0; it < 3; ++it) { const int item = F.tid + NTHR * it, j = item / 12, ck = item % 12, isk = ck >= 6, cc = isk ? ck - 6 : ck;
        float o[8]; qk_chunk8(P, convw, rot, type, b, c * CH + j, h, isk, cc, o);
        const float sc = isk ? kscale : 1.0f;
        u32x4 w; w.x = pk2(o[0] * sc, o[1] * sc); w.y = pk2(o[2] * sc, o[3] * sc); w.z = pk2(o[4] * sc, o[5] * sc); w.w = pk2(o[6] * sc, o[7] * sc);
        *(LAS u32x4*)((isk ? Ks : Qs) + j * QKS + 8 * cc) = w; }
}
__device__ __forceinline__ void load_v(const Frame& F, const bf16_t* P, int type, int t0, int h, LAS bf16_t* Vs) {
    u32x4 vv[3];
#pragma unroll
    for (int it = 0; it < 3; ++it) { const int idx = F.tid + NTHR * it, j = idx / 12, vc = idx % 12; vv[it] = *(const u32x4*)(P + (size_t)(t0 + j) * PWP + (type ? COL_RV : COL_MV) + h * DV + 8 * vc); }
#pragma unroll
    for (int it = 0; it < 3; ++it) { const int idx = F.tid + NTHR * it, j = idx / 12, vc = idx % 12; *(LAS u32x4*)(Vs + j * VSS + 8 * vc) = vv[it]; }
}

__device__ __forceinline__ void phaseB_mfma(const Frame& F0, const Args& a, int l, int u) {
    Frame F = F0; asm volatile("" : "+v"(F.tid), "+v"(F.lane)); asm volatile("" : "+s"(F.wave));
    unsigned char* ws = KA(ws);
    const bf16_t* P = (const bf16_t*)(ws + WS_P);
    const int type = u >> 10, r_ = u & 1023, b = r_ >> 8, c = (r_ >> 2) & 63, h = r_ & 3;
    LAS bf16_t* Kf = (LAS bf16_t*)F.lds;
    LAS bf16_t* Kb = Kf + 128 * KPS;
    LAS bf16_t* Vs = Kb + 128 * KPS;
    LAS float* ga = (LAS float*)(Vs + 128 * VSS);
    LAS float* lff = ga, *lfb = ga + 128, *iff = ga + 256, *ibb = ga + 384, *pf = ga + 512, *pb = ga + 640, *scal = ga + 768;
    const int t0 = b * S + c * CH;
    const float kscale = 0.14433756729740643f;
    const float* rot = (const float*)(ws + WS_ROT);
    const float* convw = KA(conv_w) + (size_t)l * 3 * 384;
    float* msc = (float*)(ws + WS_MSC);
    load_v(F, P, type, t0, h, Vs);
    { float pf0, pf1, pb0, pb1;
      if (type == 0) {
        const bf16_t* g0 = P + (size_t)(t0 + 2 * F.lane) * PWP + COL_MG; const bf16_t* g1 = g0 + PWP;
        const float if0 = bf2f(g0[h]), if1 = bf2f(g1[h]), ib0 = bf2f(g0[8 + h]), ib1 = bf2f(g1[8 + h]);
        float af0 = logsigmoidf_(bf2f(g0[4 + h])), af1 = logsigmoidf_(bf2f(g1[4 + h])), ab0 = logsigmoidf_(bf2f(g0[12 + h])), ab1 = logsigmoidf_(bf2f(g1[12 + h]));
        scan2<false, false>(af0, af1, F.lane); scan2<true, false>(ab0, ab1, F.lane);
        const float aend_f = __shfl(af1, 63), aend_b = __shfl(ab0, 0);
        pf0 = aend_f - af0 + if0; pf1 = aend_f - af1 + if1; pb0 = aend_b - ab0 + ib0; pb1 = aend_b - ab1 + ib1;
        const float mf = wave_max(fmaxf(pf0, pf1)), mb = wave_max(fmaxf(pb0, pb1));
        pf0 = __expf(pf0 - mf); pf1 = __expf(pf1 - mf); pb0 = __expf(pb0 - mb); pb1 = __expf(pb1 - mb);
        if (F.tid == 0) { msc[sidx(b, h, 0, c)] = mf; msc[sidx(b, h, 1, c)] = mb; msc[2048 + sidx(b, h, 0, c)] = aend_f; msc[2048 + sidx(b, h, 1, c)] = aend_b; }
      } else {
        const float lgf = ret_lg(h, 0.f), lgb = ret_lg(h, 0.5f);
        pf0 = __expf(lgf * (float)(127 - 2 * F.lane)); pf1 = __expf(lgf * (float)(126 - 2 * F.lane)); pb0 = __expf(lgb * (float)(2 * F.lane)); pb1 = __expf(lgb * (float)(2 * F.lane + 1));
      }
      *(LAS f32x2*)(pf + 2 * F.lane) = (f32x2){pf0, pf1}; *(LAS f32x2*)(pb + 2 * F.lane) = (f32x2){pb0, pb1}; }
#pragma unroll
    for (int it = 0; it < 2; ++it) { const int item = F.tid + NTHR * it;
        if (item < 128 * 6) { const int j = item / 6, cc = item % 6; float o[8]; qk_chunk8(P, convw, rot, type, b, c * CH + j, h, 1, cc, o);
            const float sf = kscale * pf[j], sb = kscale * pb[j];
            u32x4 w; w.x = pk2(o[0] * sf, o[1] * sf); w.y = pk2(o[2] * sf, o[3] * sf); w.z = pk2(o[4] * sf, o[5] * sf); w.w = pk2(o[6] * sf, o[7] * sf);
            *(LAS u32x4*)(Kf + j * KPS + 8 * cc) = w;
            w.x = pk2(o[0] * sb, o[1] * sb); w.y = pk2(o[2] * sb, o[3] * sb); w.z = pk2(o[4] * sb, o[5] * sb); w.w = pk2(o[6] * sb, o[7] * sb);
            *(LAS u32x4*)(Kb + j * KPS + 8 * cc) = w; } }
    __syncthreads();
    float* X = (float*)(ws + (type ? WS_RS : WS_MC));
    const int l15 = F.lane & 15, lq = F.lane >> 4;
    for (int tt = F.wave; tt < 36; tt += NWAVES) { const int dir = tt / 18, mt = (tt % 18) / 6, nt = tt % 6; const LAS bf16_t* Ksrc = dir ? Kb : Kf;
        f32x4 acc = (f32x4){0.f, 0.f, 0.f, 0.f};
#pragma unroll
        for (int ks = 0; ks < 4; ++ks) { const bf16x8 af = tr_frag(Ksrc, KPS, 32 * ks, 16 * mt, F.lane), bfv = tr_frag(Vs, VSS, 32 * ks, 16 * nt, F.lane);
            acc = __builtin_amdgcn_mfma_f32_16x16x32_bf16(af, bfv, acc, 0, 0, 0); }
        *(f32x4*)(X + (size_t)sidx(b, h, dir, c) * (DV * DK) + (16 * nt + l15) * DK + 16 * mt + 4 * lq) = acc; }
    if (type == 0 && F.tid < 2 * DK) { const int dir = F.tid / DK, kk = F.tid % DK; const LAS bf16_t* Ksrc = dir ? Kb : Kf; float sN = 0.f;
        for (int j = 0; j < 128; ++j) sN += bf2f(Ksrc[j * KPS + kk]);
        ((float*)(ws + WS_MN))[(size_t)sidx(b, h, dir, c) * DK + kk] = sN; }
    __syncthreads();
}

__device__ __forceinline__ void phaseD_mfma(const Frame& F0, const Args& a, int l, int u) {
    Frame F = F0; asm volatile("" : "+v"(F.tid), "+v"(F.lane)); asm volatile("" : "+s"(F.wave));
    unsigned char* ws = KA(ws);
    const bf16_t* P = (const bf16_t*)(ws + WS_P); unsigned char* mix = (unsigned char*)(ws + WS_MIX);
    const int type = u >> 10, r_ = u & 1023, b = r_ >> 8, c = (r_ >> 2) & 63, h = r_ & 3;
    LAS bf16_t* Qs = (LAS bf16_t*)F.lds;
    LAS bf16_t* Ks = Qs + 128 * QKS;
    LAS bf16_t* Vs = Ks + 128 * QKS;
    LAS bf16_t* Wm = Vs + 128 * VSS;
    LAS bf16_t* Cf = Wm + 128 * WSS;
    LAS bf16_t* Cb = Cf + 96 * QKS;
    LAS float* ar = (LAS float*)(Cb + 96 * QKS);
    LAS float* af = ar, *ab = ar + 128, *iff = ar + 256, *ibb = ar + 384, *gxf = ar + 512, *gxb = ar + 640, *mtf = ar + 768, *mtb = ar + 896;
    static_assert((128 * QKS * 2 + 128 * VSS + 128 * WSS + 2 * 96 * QKS) * 2 + 8 * 128 * 4 <= RING_BYTES, "phase D LDS");
    const int t0 = b * S + c * CH;
    const float kscale = 0.14433756729740643f;
    const float* rot = (const float*)(ws + WS_ROT);
    const float* convw = KA(conv_w) + (size_t)l * 3 * 384;
#if PROBE_MASK & 0xF000
    unsigned long long dts_ = __builtin_amdgcn_s_memrealtime();
#define DSEC(bit) do { if (PROBE_MASK & (bit)) { const unsigned long long d_ = __builtin_amdgcn_s_memrealtime() - dts_; while (__builtin_amdgcn_s_memrealtime() - dts_ < 2 * d_) __builtin_amdgcn_s_sleep(2); } dts_ = __builtin_amdgcn_s_memrealtime(); } while (0)
#else
#define DSEC(bit) do { } while (0)
#endif
    const int w = F.wave, l15 = F.lane & 15, lq = F.lane >> 4, j = 16 * w + l15;
    float npfv[12], npbv[12];
    if (type == 0) { const float* npf = (const float*)(ws + WS_MN) + (size_t)sidx(b, h, 0, c) * DK + 12 * lq; const float* npb = (const float*)(ws + WS_MN) + (size_t)sidx(b, h, 1, c) * DK + 12 * lq;
#pragma unroll
        for (int q4 = 0; q4 < 3; ++q4) { const f32x4 x = *(const f32x4*)(npf + 4 * q4), y = *(const f32x4*)(npb + 4 * q4);
#pragma unroll
            for (int e = 0; e < 4; ++e) { npfv[4 * q4 + e] = x[e]; npbv[4 * q4 + e] = y[e]; } } }
    u32x2 gtw[6]; f32x4 nwv[6];
    { const bf16_t* prow = P + (size_t)(t0 + j) * PWP + (type ? COL_RG : COL_MO) + h * DV + 4 * lq;
      const float* nwp = (type ? KA(ret_nw) : KA(ml_nw)); const float* nw = nwp + (size_t)l * 384 + h * DV + 4 * lq;
#pragma unroll
      for (int n = 0; n < 6; ++n) { gtw[n] = *(const u32x2*)(prow + 16 * n); nwv[n] = *(const f32x4*)(nw + 16 * n); } }
    load_qk(F, P, convw, rot, type, b, c, h, kscale, Qs, Ks);
    load_v(F, P, type, t0, h, Vs);
    {
      for (int idx = F.tid; idx < 448 * 2; idx += NTHR) { const int rr = idx >> 1, hh = idx & 1; LAS bf16_t* base = rr < 128 ? Qs + rr * QKS : rr < 256 ? Ks + (rr - 128) * QKS : rr < 352 ? Cf + (rr - 256) * QKS : Cb + (rr - 352) * QKS;
          *(LAS u32x4*)(base + 48 + 8 * hh) = (u32x4){0u, 0u, 0u, 0u}; }
      const bf16_t* Cg = (const bf16_t*)(ws + (type ? WS_CBR : WS_CBM));
#pragma unroll
      for (int it = 0; it < 3; ++it) { const int idx = F.tid + NTHR * it; if (idx < 2 * 96 * 6) { const int dir = idx / (96 * 6), rem = idx % (96 * 6), v = rem / 6, ch = rem % 6;
          *(LAS u32x4*)((dir ? Cb : Cf) + v * QKS + 8 * ch) = *(const u32x4*)(Cg + (size_t)sidx(b, h, dir, c) * (DV * DK) + v * DK + 8 * ch); } } }
#if PROBE_MASK & 0xF000
    asm volatile("s_waitcnt vmcnt(0) lgkmcnt(0)" ::: "memory"); DSEC(0x1000);
#endif
    float mpf = 0.f, mpb = 0.f;
    if (type == 0) {
        const float* msc = (const float*)(ws + WS_MSC);
        mpf = msc[4096 + sidx(b, h, 0, c)]; mpb = msc[4096 + sidx(b, h, 1, c)];
        const bf16_t* g0 = P + (size_t)(t0 + 2 * F.lane) * PWP + COL_MG; const bf16_t* g1 = g0 + PWP;
        const float if0 = bf2f(g0[h]), if1 = bf2f(g1[h]), ib0 = bf2f(g0[8 + h]), ib1 = bf2f(g1[8 + h]);
        float af0 = logsigmoidf_(bf2f(g0[4 + h])), af1 = logsigmoidf_(bf2f(g1[4 + h])), ab0 = logsigmoidf_(bf2f(g0[12 + h])), ab1 = logsigmoidf_(bf2f(g1[12 + h]));
        scan2<false, false>(af0, af1, F.lane); scan2<true, false>(ab0, ab1, F.lane);
        float gf0 = if0 - af0, gf1 = if1 - af1, gb0 = ib0 - ab0, gb1 = ib1 - ab1;
        scan2<false, true>(gf0, gf1, F.lane); scan2<true, true>(gb0, gb1, F.lane);
        *(LAS f32x2*)(af + 2 * F.lane) = (f32x2){af0, af1}; *(LAS f32x2*)(ab + 2 * F.lane) = (f32x2){ab0, ab1};
        *(LAS f32x2*)(gxf + 2 * F.lane) = (f32x2){(if0 - af0) * LOG2E, (if1 - af1) * LOG2E}; *(LAS f32x2*)(gxb + 2 * F.lane) = (f32x2){(ib0 - ab0) * LOG2E, (ib1 - ab1) * LOG2E};
        *(LAS f32x2*)(mtf + 2 * F.lane) = (f32x2){fmaxf(af0 + mpf, af0 + gf0), fmaxf(af1 + mpf, af1 + gf1)};
        *(LAS f32x2*)(mtb + 2 * F.lane) = (f32x2){fmaxf(ab0 + mpb, ab0 + gb0), fmaxf(ab1 + mpb, ab1 + gb1)};
    }
    __syncthreads();
    DSEC(0x2000);
    bf16x8 qf[2];
#pragma unroll
    for (int ks = 0; ks < 2; ++ks) qf[ks] = *(const LAS bf16x8*)(Qs + j * QKS + 32 * ks + 8 * lq);
    f32x4 If[6], Ib[6];
#pragma unroll
    for (int n = 0; n < 6; ++n) { If[n] = (f32x4){0.f, 0.f, 0.f, 0.f}; Ib[n] = (f32x4){0.f, 0.f, 0.f, 0.f};
#pragma unroll
        for (int ks = 0; ks < 2; ++ks) { const bf16x8 cf = *(const LAS bf16x8*)(Cf + (16 * n + l15) * QKS + 32 * ks + 8 * lq), cb = *(const LAS bf16x8*)(Cb + (16 * n + l15) * QKS + 32 * ks + 8 * lq);
            If[n] = __builtin_amdgcn_mfma_f32_16x16x32_bf16(cf, qf[ks], If[n], 0, 0, 0); Ib[n] = __builtin_amdgcn_mfma_f32_16x16x32_bf16(cb, qf[ks], Ib[n], 0, 0, 0); } }
    f32x4 St[8];
#pragma unroll
    for (int m = 0; m < 8; ++m) { St[m] = (f32x4){0.f, 0.f, 0.f, 0.f};
#pragma unroll
        for (int ks = 0; ks < 2; ++ks) { const bf16x8 kf = *(const LAS bf16x8*)(Ks + (16 * m + l15) * QKS + 32 * ks + 8 * lq); St[m] = __builtin_amdgcn_mfma_f32_16x16x32_bf16(kf, qf[ks], St[m], 0, 0, 0); } }
    float cfj, cbj;
    if (type == 0) {
        const float afj = af[j], abj = ab[j], mtfj = mtf[j], mtbj = mtb[j];
        const float cjf = (afj - mtfj) * LOG2E, cjb = (abj - mtbj) * LOG2E;
        float denf = 0.f, denb = 0.f; f32x4 sd = (f32x4){0.f, 0.f, 0.f, 0.f};
#pragma unroll
        for (int m = 0; m < 8; ++m) { const f32x4 g4 = *(const LAS f32x4*)((m <= w ? gxf : gxb) + 16 * m + 4 * lq);
            if (m < w) {
#pragma unroll
                for (int r = 0; r < 4; ++r) { St[m][r] *= __builtin_amdgcn_exp2f(cjf + g4[r]); denf += St[m][r]; }
            } else if (m > w) {
#pragma unroll
                for (int r = 0; r < 4; ++r) { St[m][r] *= __builtin_amdgcn_exp2f(cjb + g4[r]); denb += St[m][r]; }
            } else {
                const f32x4 g4b = *(const LAS f32x4*)(gxb + 16 * m + 4 * lq);
#pragma unroll
                for (int r = 0; r < 4; ++r) { const int s = 16 * m + 4 * lq + r; const float raw = St[m][r];
                    const float ef = s <= j ? __builtin_amdgcn_exp2f(cjf + g4[r]) : 0.f, eb = s >= j ? __builtin_amdgcn_exp2f(cjb + g4b[r]) : 0.f;
                    St[m][r] = raw * ef; sd[r] = raw * eb; denf += St[m][r]; denb += sd[r]; }
            } }
        float nqf = 0.f, nqb = 0.f;
#pragma unroll
        for (int kk = 0; kk < 12; ++kk) { const float qv = bf2f(Qs[j * QKS + 12 * lq + kk]); nqf += npfv[kk] * qv; nqb += npbv[kk] * qv; }
        denf += __shfl_xor(denf, 16); denf += __shfl_xor(denf, 32); denb += __shfl_xor(denb, 16); denb += __shfl_xor(denb, 32);
        nqf += __shfl_xor(nqf, 16); nqf += __shfl_xor(nqf, 32); nqb += __shfl_xor(nqb, 16); nqb += __shfl_xor(nqb, 32);
        const float sif = __expf(afj + mpf - mtfj), sib = __expf(abj + mpb - mtbj);
        const float rdf = 1.0f / fmaxf(fabsf(denf + sif * nqf), __expf(-mtfj)), rdb = 1.0f / fmaxf(fabsf(denb + sib * nqb), __expf(-mtbj));
        cfj = sif * rdf; cbj = sib * rdb;
#pragma unroll
        for (int m = 0; m < 8; ++m) { const float sc = m <= w ? rdf : rdb; f32x4 wv = St[m] * sc; if (m == w) wv += sd * rdb;
            u32x2 pk; pk.x = pk2(wv[0], wv[1]); pk.y = pk2(wv[2], wv[3]); *(LAS u32x2*)(Wm + j * WSS + 16 * m + 4 * lq) = pk; }
    } else {
        const float l2f = ret_lg(h, 0.f) * LOG2E, l2b = ret_lg(h, 0.5f) * LOG2E;
        const float dj = (float)(j - 4 * lq);
#pragma unroll
        for (int m = 0; m < 8; ++m) { f32x4 wv;
#pragma unroll
            for (int r = 0; r < 4; ++r) { const float d = dj - (float)(16 * m + r); wv[r] = St[m][r] * __builtin_amdgcn_exp2f(d >= 0.f ? l2f * d : -l2b * d); }
            u32x2 pk; pk.x = pk2(wv[0], wv[1]); pk.y = pk2(wv[2], wv[3]); *(LAS u32x2*)(Wm + j * WSS + 16 * m + 4 * lq) = pk; }
        cfj = __builtin_amdgcn_exp2f(l2f * (float)(j + 1)); cbj = __builtin_amdgcn_exp2f(l2b * (float)(128 - j));
    }
    DSEC(0x4000);
    f32x4 O[6];
#pragma unroll
    for (int n = 0; n < 6; ++n) O[n] = If[n] * cfj + Ib[n] * cbj;
#pragma unroll
    for (int ks = 0; ks < 4; ++ks) { const bf16x8 wf = *(const LAS bf16x8*)(Wm + j * WSS + 32 * ks + 8 * lq);
#pragma unroll
        for (int n = 0; n < 6; ++n) { const bf16x8 vf = tr_frag(Vs, VSS, 32 * ks, 16 * n, F.lane); O[n] = __builtin_amdgcn_mfma_f32_16x16x32_bf16(vf, wf, O[n], 0, 0, 0); } }
    float s1 = 0.f;
    f32x4 gt[6];
#pragma unroll
    for (int n = 0; n < 6; ++n) { const u32x2 gw = gtw[n];
        gt[n] = (f32x4){__builtin_bit_cast(float, gw.x << 16), __builtin_bit_cast(float, gw.x & 0xffff0000u), __builtin_bit_cast(float, gw.y << 16), __builtin_bit_cast(float, gw.y & 0xffff0000u)};
        if (type == 0) {
#pragma unroll
            for (int r = 0; r < 4; ++r) O[n][r] *= sigmoidf_(gt[n][r]); }
        s1 += (O[n][0] + O[n][1]) + (O[n][2] + O[n][3]); }
    s1 += __shfl_xor(s1, 16); s1 += __shfl_xor(s1, 32);
    const float mean = s1 * (1.0f / 96.0f); float s2 = 0.f;
#pragma unroll
    for (int n = 0; n < 6; ++n) { O[n] = O[n] - mean; s2 += (O[n][0] * O[n][0] + O[n][1] * O[n][1]) + (O[n][2] * O[n][2] + O[n][3] * O[n][3]); }
    s2 += __shfl_xor(s2, 16); s2 += __shfl_xor(s2, 32);
    const float rstd = 1.0f / sqrtf(s2 * (1.0f / 96.0f) + LN_EPS);
    unsigned char* o = mix + (size_t)(t0 + j) * D + (type ? 640 : 256) + h * DV + 4 * lq;
#pragma unroll
    for (int n = 0; n < 6; ++n) { const f32x4 wv = nwv[n]; f32x4 y = O[n] * rstd * wv;
        if (type == 1) {
#pragma unroll
            for (int r = 0; r < 4; ++r) y[r] *= siluf_(gt[n][r]); }
        y = y * MIX_SCALE; *(unsigned*)(o + 16 * n) = pg8::pk4_fp8(y[0], y[1], y[2], y[3]); }
    DSEC(0x8000);
#undef DSEC
    __syncthreads();
}

__device__ __forceinline__ void phaseC_unit(const Frame& F, const Args& a, int u) {
    unsigned char* ws = KA(ws);
    const int type = u >> 7, seq = (u & 127) >> 2, part = u & 3, dir = seq & 1;
    LAS float* sp = (LAS float*)F.lds; LAS float* sc = sp + 64;
    float* msc = (float*)(ws + WS_MSC);
    if (type == 0) {
        if (F.wave == 0) { const int cn = dir ? NCH - 1 - F.lane : F.lane, sin_ = seq * NCH + cn; const float mcl = msc[sin_], ael = msc[2048 + sin_];
            float m = 0.f, my_sp = 0.f, my_sc = 0.f, my_mp = 0.f;
#pragma unroll 1
            for (int n = 0; n < NCH; ++n) { const float mc = __shfl(mcl, n), ae = __shfl(ael, n);
                const float mn = fmaxf(ae + m, mc); const float spn = __expf(ae + m - mn), scn = __expf(mc - mn);
                if (F.lane == n) { my_sp = spn; my_sc = scn; my_mp = m; }
                m = mn; }
            sp[F.lane] = my_sp; sc[F.lane] = my_sc; if (part == 0) msc[4096 + sin_] = my_mp; }
    } else {
        if (F.tid < 64) { const int h = (seq >> 1) & 3; const float lg = ret_lg(h, dir ? 0.5f : 0.f); sp[F.tid] = __expf(lg * 128.0f); sc[F.tid] = 1.0f; }
    }
    __syncthreads();
    const float* X = (const float*)(ws + (type ? WS_RS : WS_MC)); bf16_t* Xo = (bf16_t*)(ws + (type ? WS_CBR : WS_CBM));
    { const size_t o0 = (size_t)seq * NCH * (DV * DK) + part * 1152 + F.tid; const bool has3 = F.tid < 1152 - 2 * NTHR;
      float st0 = 0.f, st1 = 0.f, st2 = 0.f;
#pragma unroll 1
      for (int n0 = 0; n0 < NCH; n0 += 8) { float v0[8], v1[8], v2[8];
#pragma unroll
          for (int i = 0; i < 8; ++i) { const int c = dir ? NCH - 1 - (n0 + i) : n0 + i; const size_t o = o0 + (size_t)c * (DV * DK); v0[i] = X[o]; v1[i] = X[o + NTHR]; v2[i] = has3 ? X[o + 2 * NTHR] : 0.f; }
#pragma unroll
          for (int i = 0; i < 8; ++i) { const int c = dir ? NCH - 1 - (n0 + i) : n0 + i; const size_t o = o0 + (size_t)c * (DV * DK); const float a_ = sp[n0 + i], b_ = sc[n0 + i];
              Xo[o] = (bf16_t)f2bf(st0); Xo[o + NTHR] = (bf16_t)f2bf(st1); if (has3) Xo[o + 2 * NTHR] = (bf16_t)f2bf(st2);
              st0 = a_ * st0 + b_ * v0[i]; st1 = a_ * st1 + b_ * v1[i]; st2 = a_ * st2 + b_ * v2[i]; } } }
    if (type == 0 && part == 0 && F.tid < DK) { float st = 0.f; float* p = (float*)(ws + WS_MN) + (size_t)seq * NCH * DK + F.tid;
#pragma unroll 1
        for (int n0 = 0; n0 < NCH; n0 += 16) { float v[16];
#pragma unroll
            for (int i = 0; i < 16; ++i) { const int c = dir ? NCH - 1 - (n0 + i) : n0 + i; v[i] = p[(size_t)c * DK]; }
#pragma unroll
            for (int i = 0; i < 16; ++i) { const int c = dir ? NCH - 1 - (n0 + i) : n0 + i; p[(size_t)c * DK] = st; st = sp[n0 + i] * st + sc[n0 + i] * v[i]; } } }
    __syncthreads();
}

__device__ __forceinline__ void fourier_stage1(const Frame& F, unsigned char* ws) {
    const bf16_t* UT = (const bf16_t*)(ws + WS_UT); bf16_t* AT = (bf16_t*)(ws + WS_AT);
    LAS bf16_t* Gs = (LAS bf16_t*)F.lds;
    { const bf16_t* Gg = (const bf16_t*)(ws + WS_FG);
      for (int i = F.tid; i < 128 * 16; i += NTHR) { const int r = i >> 4, c8 = i & 15; *(LAS u32x4*)(Gs + r * 136 + c8 * 8) = *(const u32x4*)(Gg + r * 128 + c8 * 8); } }
    __syncthreads();
    const int l15 = F.lane & 15, lq = F.lane >> 4;
    for (int u = F.bid; u < 1024; u += F.G) {
        const int b = u >> 8, ch = u & 255;
        const bf16_t* xr = UT + ((size_t)u * 128 + 16 * F.wave + l15) * 128 + 8 * lq;
        bf16x8 af[4];
#pragma unroll
        for (int ks = 0; ks < 4; ++ks) af[ks] = *(const bf16x8*)(xr + 32 * ks);
        f32x4 acc[8];
#pragma unroll
        for (int n = 0; n < 8; ++n) { acc[n] = (f32x4){0.f, 0.f, 0.f, 0.f};
#pragma unroll
            for (int ks = 0; ks < 4; ++ks) { const bf16x8 bfr = *(const LAS bf16x8*)(Gs + (16 * n + l15) * 136 + 32 * ks + 8 * lq);
                acc[n] = __builtin_amdgcn_mfma_f32_16x16x32_bf16(af[ks], bfr, acc[n], 0, 0, 0); }
            if (n & 1) __builtin_amdgcn_sched_barrier(0); }
#pragma unroll
        for (int n = 0; n < 4; ++n) { const int k1 = 16 * n + l15; u32x2 wre, wim; float ore[4], oim[4];
#pragma unroll
            for (int r = 0; r < 4; ++r) { const int s2 = 16 * F.wave + 4 * lq + r; const float rev = (float)(k1 * s2) * (1.0f / 8192.0f);
                const float cs = __builtin_amdgcn_cosf(rev), sn = __builtin_amdgcn_sinf(rev); const float re = acc[n][r], im = acc[n + 4][r];
                ore[r] = re * cs + im * sn; oim[r] = im * cs - re * sn; }
            wre.x = pk2(ore[0], ore[1]); wre.y = pk2(ore[2], ore[3]); wim.x = pk2(oim[0], oim[1]); wim.y = pk2(oim[2], oim[3]);
            bf16_t* o = AT + ((size_t)((b * 64 + k1) * 256 + ch)) * 256 + 16 * F.wave + 4 * lq;
            *(u32x2*)o = wre; *(u32x2*)(o + 128) = wim; }
    }
    __syncthreads();
}
__device__ __forceinline__ void fourier_stage2(const Frame& F, unsigned char* ws) {
    const bf16_t* AT = (const bf16_t*)(ws + WS_AT); unsigned char* mix = (unsigned char*)(ws + WS_MIX);
    LAS bf16_t* Hs = (LAS bf16_t*)F.lds;
    { const bf16_t* Hg = (const bf16_t*)(ws + WS_FG + FG_H_OFF);
      for (int i = F.tid; i < 128 * 32; i += NTHR) { const int r = i >> 5, c8 = i & 31; *(LAS u32x4*)(Hs + r * 264 + c8 * 8) = *(const u32x4*)(Hg + r * 256 + c8 * 8); } }
    __syncthreads();
    const int l15 = F.lane & 15, lq = F.lane >> 4;
    for (int u = F.bid; u < 256; u += F.G) {
        const int b = u >> 6, k1 = u & 63;
        f32x4 acc[2][8];
#pragma unroll
        for (int m = 0; m < 2; ++m)
#pragma unroll
            for (int n = 0; n < 8; ++n) acc[m][n] = (f32x4){0.f, 0.f, 0.f, 0.f};
        const bf16_t* ar = AT + ((size_t)u * 256 + 32 * F.wave + l15) * 256 + 8 * lq;
#pragma unroll
        for (int ks = 0; ks < 8; ++ks) { const bf16x8 a0 = *(const bf16x8*)(ar + 32 * ks), a1 = *(const bf16x8*)(ar + 16 * 256 + 32 * ks);
#pragma unroll
            for (int n = 0; n < 8; ++n) { const bf16x8 bfr = *(const LAS bf16x8*)(Hs + (16 * n + l15) * 264 + 32 * ks + 8 * lq);
                acc[0][n] = __builtin_amdgcn_mfma_f32_16x16x32_bf16(a0, bfr, acc[0][n], 0, 0, 0); acc[1][n] = __builtin_amdgcn_mfma_f32_16x16x32_bf16(a1, bfr, acc[1][n], 0, 0, 0); }
            if (ks & 1) __builtin_amdgcn_sched_barrier(0); }
#pragma unroll
        for (int m = 0; m < 2; ++m)
#pragma unroll
            for (int n = 0; n < 8; ++n) { const int k2 = 16 * n + l15, chn = 32 * F.wave + 16 * m + 4 * lq;
                const f32x4 y = acc[m][n] * MIX_SCALE;
                *(unsigned*)(mix + (size_t)(b * S + k1 + 64 * k2) * D + chn) = pg8::pk4_fp8(y[0], y[1], y[2], y[3]); }
    }
    __syncthreads();
}

__device__ __forceinline__ int build_tiles(const Frame& F, unsigned* cnt, LAS int* tst, LAS unsigned char* tile_e) {
    if (F.wave == 0) { const int cv = F.lane < NE ? (int)__hip_atomic_load(cnt + (F.lane & (NE - 1)), __ATOMIC_RELAXED, __HIP_MEMORY_SCOPE_AGENT) : 0; const int ntl = (cv + 255) >> 8;
        int inc = ntl;
#pragma unroll
        for (int o = 1; o < NE; o <<= 1) { const int t = __shfl_up(inc, o); if (F.lane >= o) inc += t; }
        if (F.lane < NE) { tst[F.lane] = inc - ntl; ((LAS int*)(F.lds + MISC_OFF + 1280))[F.lane] = cv; }
        if (F.lane == NE - 1) tst[NE] = inc; }
    __syncthreads();
    const int ntot = tst[NE];
    for (int mt = F.tid; mt < ntot; mt += NTHR) { int e = 0; for (int q = 1; q < NE; ++q) if (mt >= tst[q]) e = q; tile_e[mt] = (unsigned char)e; }
    __syncthreads();
    return ntot;
}

__device__ __forceinline__ f32x4 unpack4(u32x2 w) { return (f32x4){__builtin_bit_cast(float, w.x << 16), __builtin_bit_cast(float, w.x & 0xffff0000u), __builtin_bit_cast(float, w.y << 16), __builtin_bit_cast(float, w.y & 0xffff0000u)}; }

__device__ __forceinline__ void phaseF(const Frame& F0, const Args& a, int l) {
    Frame F = F0; asm volatile("" : "+v"(F.tid), "+v"(F.lane)); asm volatile("" : "+s"(F.wave));
    unsigned char* ws = KA(ws);
    const bf16_t* pre = (const bf16_t*)(ws + WS_PRE); float* x1st = (float*)(ws + WS_X1B); unsigned char* x1q = (unsigned char*)(ws + WS_XS);
    int* tke = (int*)(ws + WS_TKE); float* tkg = (float*)(ws + WS_TKG); int* tks = (int*)(ws + WS_TKS); int* list = (int*)(ws + WS_LIST);
    unsigned* cnt = F.ctl + CW_CNT + l * 64;
    constexpr int XST = 1032;
    LAS bf16_t* Xh = (LAS bf16_t*)F.lds;
    LAS bf16_t* Xl = Xh + 16 * XST;
    LAS float* red = (LAS float*)(Xl + 16 * XST);
    LAS int* lcnt = (LAS int*)(F.lds + MISC_OFF + 2048);
    LAS int* lbase = lcnt + 32;
    LAS int* le = lbase + 32;
    LAS int* ls = le + 512;
    const int w = F.wave, l15 = F.lane & 15, lq = F.lane >> 4;
    bf16x8 Bh[2][4], Bl[2][4];
    { const float* wrt = (const float*)(ws + WS_BIN + WRT_OFF) + (size_t)l * NE * D;
#pragma unroll
      for (int n = 0; n < 2; ++n)
#pragma unroll
          for (int ks = 0; ks < 4; ++ks) { const float* p = wrt + (size_t)(16 * n + l15) * D + 128 * w + 32 * ks + 8 * lq; const f32x4 x0 = *(const f32x4*)p, x1 = *(const f32x4*)(p + 4);
              unsigned hw[4], lw[4];
#pragma unroll
              for (int i = 0; i < 4; ++i) { const float a0 = i < 2 ? x0[2 * i] : x1[2 * i - 4], a1 = i < 2 ? x0[2 * i + 1] : x1[2 * i - 3];
                  const unsigned h0 = f2bf(a0), h1 = f2bf(a1); hw[i] = h0 | (h1 << 16);
                  lw[i] = pk2(a0 - __builtin_bit_cast(float, h0 << 16), a1 - __builtin_bit_cast(float, h1 << 16)); }
              Bh[n][ks] = __builtin_bit_cast(bf16x8, (u32x4){hw[0], hw[1], hw[2], hw[3]}); Bl[n][ks] = __builtin_bit_cast(bf16x8, (u32x4){lw[0], lw[1], lw[2], lw[3]}); } }
    if (F.tid < 32) lcnt[F.tid] = 0;
    const float* g1 = KA(ln1_g) + (size_t)l * D; const float* b1 = KA(ln1_b) + (size_t)l * D; const float* br = KA(b_router) + (size_t)l * NE;
    f32x4 gg[4], bb[4];
#pragma unroll
    for (int j = 0; j < 4; ++j) { gg[j] = *(const f32x4*)(g1 + 4 * F.lane + 256 * j); bb[j] = *(const f32x4*)(b1 + 4 * F.lane + 256 * j); }
    const float brv = br[F.tid & 31];
    __syncthreads();
    for (int chunk = F.bid; chunk < T / 128; chunk += F.G) {
        u32x2 nx[2][4];
#pragma unroll
        for (int q = 0; q < 2; ++q)
#pragma unroll
            for (int j = 0; j < 4; ++j) nx[q][j] = *(const u32x2*)(pre + (size_t)(chunk * 128 + 2 * w + q) * D + 4 * F.lane + 256 * j);
#pragma unroll 1
        for (int g = 0; g < 8; ++g) {
            u32x2 cx[2][4];
#pragma unroll
            for (int q = 0; q < 2; ++q)
#pragma unroll
                for (int j = 0; j < 4; ++j) cx[q][j] = nx[q][j];
            if (g < 7) {
#pragma unroll
                for (int q = 0; q < 2; ++q)
#pragma unroll
                    for (int j = 0; j < 4; ++j) nx[q][j] = *(const u32x2*)(pre + (size_t)(chunk * 128 + (g + 1) * 16 + 2 * w + q) * D + 4 * F.lane + 256 * j); }
#pragma unroll
            for (int q = 0; q < 2; ++q) { const int tl = 2 * w + q, t = chunk * 128 + g * 16 + tl;
                f32x4 v[4]; float s = 0.f;
#pragma unroll
                for (int j = 0; j < 4; ++j) { v[j] = unpack4(cx[q][j]); s += (v[j].x + v[j].y) + (v[j].z + v[j].w); }
                const float mean = wave_sum(s) * (1.f / D); float s2 = 0.f;
#pragma unroll
                for (int j = 0; j < 4; ++j) { v[j] = v[j] - mean; s2 += (v[j].x * v[j].x + v[j].y * v[j].y) + (v[j].z * v[j].z + v[j].w * v[j].w); }
                const float rstd = 1.f / sqrtf(wave_sum(s2) * (1.f / D) + LN_EPS);
                if (F.lane == 0) *(f32x2*)(x1st + 2 * (size_t)t) = (f32x2){mean, rstd};
#pragma unroll
                for (int j = 0; j < 4; ++j) { const f32x4 o = v[j] * rstd * gg[j] + bb[j];
                    const unsigned h0 = f2bf(o.x), h1 = f2bf(o.y), h2 = f2bf(o.z), h3 = f2bf(o.w);
                    u32x2 hw; hw.x = h0 | (h1 << 16); hw.y = h2 | (h3 << 16);
                    u32x2 lw; lw.x = pk2(o.x - __builtin_bit_cast(float, h0 << 16), o.y - __builtin_bit_cast(float, h1 << 16)); lw.y = pk2(o.z - __builtin_bit_cast(float, h2 << 16), o.w - __builtin_bit_cast(float, h3 << 16));
                    *(unsigned*)(x1q + (size_t)t * D + 4 * F.lane + 256 * j) = pg8::pk4_fp8(o.x, o.y, o.z, o.w);
                    *(LAS u32x2*)(Xh + tl * XST + 4 * F.lane + 256 * j) = hw; *(LAS u32x2*)(Xl + tl * XST + 4 * F.lane + 256 * j) = lw; } }
            __syncthreads();
            f32x4 acc[2] = {(f32x4){0.f, 0.f, 0.f, 0.f}, (f32x4){0.f, 0.f, 0.f, 0.f}};
#pragma unroll
            for (int ks = 0; ks < 4; ++ks) { const bf16x8 ah = *(const LAS bf16x8*)(Xh + l15 * XST + 128 * w + 32 * ks + 8 * lq), al = *(const LAS bf16x8*)(Xl + l15 * XST + 128 * w + 32 * ks + 8 * lq);
#pragma unroll
                for (int n = 0; n < 2; ++n) { acc[n] = __builtin_amdgcn_mfma_f32_16x16x32_bf16(ah, Bh[n][ks], acc[n], 0, 0, 0); acc[n] = __builtin_amdgcn_mfma_f32_16x16x32_bf16(al, Bh[n][ks], acc[n], 0, 0, 0);
                    acc[n] = __builtin_amdgcn_mfma_f32_16x16x32_bf16(ah, Bl[n][ks], acc[n], 0, 0, 0); } }
#pragma unroll
            for (int n = 0; n < 2; ++n)
#pragma unroll
                for (int r = 0; r < 4; ++r) red[(w * 16 + 4 * lq + r) * 32 + 16 * n + l15] = acc[n][r];
            __syncthreads();
            { const int tl = F.tid >> 5, e = F.tid & 31, t = chunk * 128 + g * 16 + tl;
              float lg = brv;
#pragma unroll
              for (int ww = 0; ww < 8; ++ww) lg += red[(ww * 16 + tl) * 32 + e];
              float tv[4]; int ti[4];
#pragma unroll
              for (int k = 0; k < 4; ++k) { float bv = lg; int bi = e;
#pragma unroll
                  for (int o = 1; o < 32; o <<= 1) { const float ov = __shfl_xor(bv, o); const int oi = __shfl_xor(bi, o); if (ov > bv || (ov == bv && oi < bi)) { bv = ov; bi = oi; } }
                  tv[k] = bv; ti[k] = bi; if (e == bi) lg = -INFINITY; }
              const float w1 = __expf(tv[1] - tv[0]), w2 = __expf(tv[2] - tv[0]), w3 = __expf(tv[3] - tv[0]); const float inv = 1.0f / (1.0f + w1 + w2 + w3);
              if (e < 4) { const int ek = e == 0 ? ti[0] : e == 1 ? ti[1] : e == 2 ? ti[2] : ti[3]; const float gk = (e == 0 ? 1.0f : e == 1 ? w1 : e == 2 ? w2 : w3) * inv;
                  tke[t * 4 + e] = ek; tkg[t * 4 + e] = gk;
                  const int sl = __hip_atomic_fetch_add(lcnt + ek, 1, __ATOMIC_RELAXED, __HIP_MEMORY_SCOPE_WORKGROUP);
                  le[(g * 16 + tl) * 4 + e] = ek; ls[(g * 16 + tl) * 4 + e] = sl; } }
        }
        __syncthreads();
        if (F.tid < 32) lbase[F.tid] = (int)__hip_atomic_fetch_add(cnt + F.tid, (unsigned)lcnt[F.tid], __ATOMIC_RELAXED, __HIP_MEMORY_SCOPE_AGENT);
        __syncthreads();
        { const int tl = F.tid >> 2, k = F.tid & 3, t = chunk * 128 + tl, e = le[F.tid], slot = lbase[e] + ls[F.tid];
          list[(size_t)e * T + slot] = t; tks[t * 4 + k] = slot; }
        __syncthreads();
        if (F.tid < 32) lcnt[F.tid] = 0;
        __syncthreads();
    }
}

struct IRows { u32x2 x[4]; unsigned y[4][4]; f32x4 g; f32x2 ms; };
__device__ __forceinline__ f32x4 unpack4_fp8(unsigned w) { const f32x2 lo = __builtin_amdgcn_cvt_pk_f32_fp8((int)w, false), hi = __builtin_amdgcn_cvt_pk_f32_fp8((int)w, true); return (f32x4){lo.x, lo.y, hi.x, hi.y}; }
struct IIdx { u32x4 e, s; f32x4 g; };
__device__ __forceinline__ void phaseI(const Frame& F0, const Args& a, int l) {
    Frame F = F0; asm volatile("" : "+v"(F.tid), "+v"(F.lane)); asm volatile("" : "+s"(F.wave));
    unsigned char* ws = KA(ws);
    unsigned* cnt = F.ctl + CW_CNT + l * 64;
    LAS int* tst = (LAS int*)(F.lds + MISC_OFF + 256); LAS unsigned char* tile_e = (LAS unsigned char*)(F.lds + MISC_OFF + 512);
    (void)build_tiles(F, cnt, tst, tile_e);
    const bf16_t* pre = (const bf16_t*)(ws + WS_PRE); const float* x1st = (const float*)(ws + WS_X1B); const unsigned char* Y = (const unsigned char*)(ws + WS_Y);
    f32x4 ga[4], ba[4];
    { const float* g1 = KA(ln1_g) + (size_t)l * D; const float* b1 = KA(ln1_b) + (size_t)l * D;
#pragma unroll
      for (int j = 0; j < 4; ++j) { ga[j] = *(const f32x4*)(g1 + 4 * F.lane + 256 * j) * DN_ALPHA; ba[j] = *(const f32x4*)(b1 + 4 * F.lane + 256 * j) * DN_ALPHA; } }
    const int* tke = (const int*)(ws + WS_TKE); const float* tkg = (const float*)(ws + WS_TKG); const int* tks = (const int*)(ws + WS_TKS);
    bf16_t* xb = (bf16_t*)(ws + WS_XB);
    const float* g2 = KA(ln2_g) + (size_t)l * D; const float* b2 = KA(ln2_b) + (size_t)l * D;
    const int gw = F.bid * NWAVES + F.wave, NGW = F.G * NWAVES; float* outp = KA(out);
#define I_LOAD_IDX(ix, t_) do { const int tq_ = min((t_), T - 1); (ix).e = *(const u32x4*)(tke + tq_ * 4); (ix).s = *(const u32x4*)(tks + tq_ * 4); (ix).g = *(const f32x4*)(tkg + tq_ * 4); } while (0)
#define I_LOAD_ROWS(rw, ix, t_) do { const int tq_ = min((t_), T - 1); (rw).g = (ix).g * (1.0f / Y_SCALE); \
        _Pragma("unroll") for (int k = 0; k < 4; ++k) { const size_t row = (size_t)tst[(ix).e[k]] * 256 + (ix).s[k]; \
            _Pragma("unroll") for (int j = 0; j < 4; ++j) (rw).y[k][j] = *(const unsigned*)(Y + row * D + 4 * F.lane + 256 * j); } \
        (rw).ms = *(const f32x2*)(x1st + 2 * (size_t)tq_); \
        _Pragma("unroll") for (int j = 0; j < 4; ++j) (rw).x[j] = *(const u32x2*)(pre + (size_t)tq_ * D + 4 * F.lane + 256 * j); } while (0)
#define I_FINISH(rw, t_) do { const int tq_ = (t_); if (tq_ < T) { f32x4 v[4]; \
        _Pragma("unroll") for (int j = 0; j < 4; ++j) v[j] = (unpack4((rw).x[j]) - (rw).ms.x) * (rw).ms.y * ga[j] + ba[j]; \
        _Pragma("unroll") for (int k = 0; k < 4; ++k) _Pragma("unroll") for (int j = 0; j < 4; ++j) v[j] += unpack4_fp8((rw).y[k][j]) * (rw).g[k]; \
        ln_row(v, g2, b2, nullptr, l == NL - 1 ? (bf16_t*)nullptr : xb + (size_t)tq_ * D, l == NL - 1 ? outp + (size_t)tq_ * D : nullptr, F.lane, l == NL - 1 ? (unsigned char*)nullptr : (unsigned char*)(ws + WS_XQ) + (size_t)tq_ * D); } } while (0)
    IIdx ix; IRows r0, r1, r2;
    int t = gw;
    I_LOAD_IDX(ix, t); I_LOAD_ROWS(r0, ix, t); I_LOAD_IDX(ix, t + NGW); I_LOAD_ROWS(r1, ix, t + NGW); I_LOAD_IDX(ix, t + 2 * NGW);
#pragma unroll 1
    for (; t < T; t += 3 * NGW) {
        I_LOAD_ROWS(r2, ix, t + 2 * NGW); I_LOAD_IDX(ix, t + 3 * NGW); I_FINISH(r0, t);
        I_LOAD_ROWS(r0, ix, t + 3 * NGW); I_LOAD_IDX(ix, t + 4 * NGW); I_FINISH(r1, t + NGW);
        I_LOAD_ROWS(r1, ix, t + 4 * NGW); I_LOAD_IDX(ix, t + 5 * NGW); I_FINISH(r2, t + 2 * NGW);
    }
#undef I_LOAD_IDX
#undef I_LOAD_ROWS
#undef I_FINISH
    __syncthreads();
}

template <int PHMASK_T> __global__ void __launch_bounds__(NTHR, 2) hybrid_fwd(Args a) {
    extern __shared__ __attribute__((aligned(16))) unsigned char lds_raw[];
    Frame F;
    F.lds = (LAS unsigned char*)lds_raw;
    F.tid = threadIdx.x; F.lane = F.tid & 63; F.wave = __builtin_amdgcn_readfirstlane(F.tid >> 6);
    F.G = gridDim.x; F.bid = blockIdx.x;
    F.ctl = (unsigned*)(KA(ws) + WS_CTL);
    unsigned char* ws = KA(ws);
    volatile LAS unsigned* MISC = (volatile LAS unsigned*)(F.lds + MISC_OFF);
    if (F.tid < 64) MISC[F.tid] = 0u;
    __syncthreads();
#if MK_MULTI
#define GRID_BAR() do { } while (0)
#else
    XcdBarrier bar = xcd_barrier_post(F.ctl + CW_BAR, MISC);
#define GRID_BAR() do { GAS unsigned* _bp = (GAS unsigned*)bar.bar; unsigned _bx = bar.x; unsigned _bs = (unsigned)(uintptr_t)bar.st; asm volatile("" : "+s"(_bp), "+s"(_bx), "+s"(_bs)); \
        XcdBarrier _b; _b.bar = (unsigned*)_bp; _b.x = _bx; _b.st = (volatile LAS unsigned*)(uintptr_t)_bs; xcd_barrier(_b); } while (0)
#endif
    const int lo = KA(ph_lo), hi = KA(ph_hi);
#if PROBE_MASK
    unsigned long long pt0 = 0;
#define PROBE_BEGIN() do { pt0 = __builtin_amdgcn_s_memrealtime(); } while (0)
#define PROBE_END(j) do { if ((PROBE_MASK >> (j)) & 1) { const unsigned long long d_ = __builtin_amdgcn_s_memrealtime() - pt0; while (__builtin_amdgcn_s_memrealtime() - pt0 < 2 * d_) __builtin_amdgcn_s_sleep(8); } } while (0)
#else
#define PROBE_BEGIN() do { } while (0)
#define PROBE_END(j) do { } while (0)
#endif
#define PH_ON(j) (((PHMASK_T) >> (j)) & 1)
#define IN(k) (lo <= (k) && (k) < hi)
#if PROBE_MASK & 0xC00
#define SEAM(k) do { if (IN(k) && IN((k) + 1)) { const unsigned long long b0_ = __builtin_amdgcn_s_memrealtime(); GRID_BAR(); if (PROBE_MASK & 0x400) GRID_BAR(); \
        if (PROBE_MASK & 0x800) { const unsigned long long d_ = __builtin_amdgcn_s_memrealtime() - b0_; while (__builtin_amdgcn_s_memrealtime() - b0_ < 2 * d_) __builtin_amdgcn_s_sleep(8); } } } while (0)
#else
#define SEAM(k) do { if (IN(k) && IN((k) + 1)) GRID_BAR(); } while (0)
#endif
    PROBE_BEGIN();
    if (PH_ON(9) && IN(0)) { p0_prologue(F, a); }
    PROBE_END(9);
    SEAM(0);
#define LAUNDER() do { unsigned _lp = (unsigned)(uintptr_t)F.lds; GAS unsigned* _cp = (GAS unsigned*)F.ctl; GAS unsigned char* _wp = (GAS unsigned char*)ws;     \
        F.tid = threadIdx.x; asm volatile("" : "+v"(F.tid)); F.lane = F.tid & 63; F.wave = __builtin_amdgcn_readfirstlane(F.tid >> 6); F.bid = blockIdx.x; F.G = gridDim.x; \
        asm volatile("" : "+s"(F.bid), "+s"(F.G), "+s"(_lp), "+s"(_cp), "+s"(_wp)); \
        F.lds = (LAS unsigned char*)(uintptr_t)_lp; F.ctl = (unsigned*)_cp; ws = (unsigned char*)_wp; } while (0)
    for (int l = 0; l < NL; ++l) {
        const int pb = 1 + l * NPH_LAYER;
        LAUNDER(); PROBE_BEGIN();
        if (PH_ON(0) && IN(pb + 0)) {
            pg8::PlainOrderBf So; So.init(ws + WS_XB, (bf16_t*)(ws + WS_WIN) + (size_t)l * PWP * D, T, 4 * 256, D, F.G, F.bid);
            pg8::EpiBf16Bias E{(bf16_t*)(ws + WS_P), PWP, (const float*)(ws + WS_BIN) + (size_t)l * PWP, 1.0f};
            pg8::gemm_phase<pg8::EpiBf16Bias, pg8::PlainOrderBf, true, true>(F.lds, D, So, E, F.tid);
            pg8::PlainOrderF8 Sq; Sq.init(ws + WS_XQ, (unsigned char*)(ws + WS_WINQ) + (size_t)l * PWP * D, T, 6 * 256, D, F.G, F.bid);
            pg8::EpiBf16Bias Eq{(bf16_t*)(ws + WS_P), PWP, (const float*)(ws + WS_BIN) + (size_t)l * PWP, 1.0f / (XQ_SCALE * WINQ_SCALE)};
            pg8::gemm_phase_f8<pg8::EpiBf16Bias, pg8::PlainOrderF8, true, true>(F.lds, D, Sq, Eq, F.tid);
            pg8::FourierOrder8 Sf{(const char*)(ws + WS_WFQ) + (size_t)l * 512 * D, (const char*)(ws + WS_XQ), D, F.G, F.bid};
            pg8::EpiFourierT Ef{(bf16_t*)(ws + WS_UT), (const float*)(ws + WS_FG + FG_BF_OFF) + l * 512, 1.0f / (XQ_SCALE * WFQ_SCALE)};
            pg8::gemm_phase_f8<pg8::EpiFourierT, pg8::FourierOrder8, true, true>(F.lds, D, Sf, Ef, F.tid);
        }
        PROBE_END(0);
        SEAM(pb + 0);
        LAUNDER(); PROBE_BEGIN();
        if (PH_ON(1) && IN(pb + 1)) {
            for (int u = F.bid; u < 2048; u += F.G) phaseB_mfma(F, a, l, u);
            fourier_stage1(F, ws);
        }
        PROBE_END(1);
        SEAM(pb + 1);
        LAUNDER(); PROBE_BEGIN();
        if (PH_ON(2) && IN(pb + 2)) { for (int u = F.bid; u < 256; u += F.G) phaseC_unit(F, a, u); fourier_stage2(F, ws); }
        PROBE_END(2);
        SEAM(pb + 2);
        LAUNDER(); PROBE_BEGIN();
        if (PH_ON(3) && IN(pb + 3)) {
            for (int rep_ = 0; rep_ < ((PROBE_MASK & 0x40000) ? 2 : 1); ++rep_)
            for (int u = F.bid; u < 2048; u += F.G) phaseD_mfma(F, a, l, u);
        }
        PROBE_END(3);
        SEAM(pb + 3);
        LAUNDER(); PROBE_BEGIN();
        if (PH_ON(4) && IN(pb + 4)) {
            pg8::PlainOrder8 So; So.init(ws + WS_MIX, (unsigned char*)(ws + WS_WOUT) + (size_t)l * D * D, T, D, D, F.G, F.bid);
            pg8::EpiResBf16 E{(bf16_t*)(ws + WS_PRE), (const bf16_t*)(ws + WS_XB), D, DN_ALPHA, 1.0f / (MIX_SCALE * WOUT_SCALE)};
            pg8::gemm_phase_f8<pg8::EpiResBf16, pg8::PlainOrder8, true, true>(F.lds, D, So, E, F.tid);
        }
        PROBE_END(4);
        SEAM(pb + 4);
        LAUNDER(); PROBE_BEGIN();
        if (PH_ON(5) && IN(pb + 5)) phaseF(F, a, l);
        PROBE_END(5);
        SEAM(pb + 5);
        LAUNDER(); PROBE_BEGIN();
        if (PH_ON(6) && IN(pb + 6)) {
            LAS int* tst = (LAS int*)(F.lds + MISC_OFF + 256); LAS unsigned char* tile_e = (LAS unsigned char*)(F.lds + MISC_OFF + 512); LAS unsigned* gtab = (LAS unsigned*)(F.lds + GTAB_OFF);
            unsigned* cnt = F.ctl + CW_CNT + l * 64;
            const int ntot = build_tiles(F, cnt, tst, tile_e);
            { const int* list = (const int*)(ws + WS_LIST); int nun = 0; { int pm_, pn_; while (nun < 18 && pg8::moe_unit(nun, F.bid, F.G, 8, ntot, pm_, pn_)) ++nun; }
              for (int idx = F.tid; idx < nun * 256; idx += NTHR) { const int i = idx >> 8, r = idx & 255; int mt, pn_; (void)pg8::moe_unit(i, F.bid, F.G, 8, ntot, mt, pn_); const int e = tile_e[mt], within = (mt - tst[e]) * 256 + r;
                  const int ce = ((const LAS int*)(F.lds + MISC_OFF + 1280))[e];
                  const int tok = within < ce ? list[(size_t)e * T + within] : 0; gtab[idx] = (unsigned)tok * (unsigned)D; }
              __syncthreads(); }
            pg8::GatherOrder So{(const char*)(ws + WS_XS), (const char*)(ws + WS_W1) + (size_t)l * NE * 2048 * D, D, 8, ntot, F.G, F.bid, (size_t)2048 * D, tile_e, gtab};
            pg8::EpiSwiglu8 E{(unsigned char*)(ws + WS_H), KA(b1) + (size_t)l * NE * 2048, 1.0f / W1_SCALE};
            for (int rep_ = 0; rep_ < ((PROBE_MASK & 0x80000) ? 2 : 1); ++rep_)
            pg8::gemm_phase_f8<pg8::EpiSwiglu8, pg8::GatherOrder, true, true>(F.lds, D, So, E, F.tid);
        }
        PROBE_END(6);
        SEAM(pb + 6);
        LAUNDER(); PROBE_BEGIN();
        if (PH_ON(7) && IN(pb + 7)) {
            LAS int* tst = (LAS int*)(F.lds + MISC_OFF + 256); LAS unsigned char* tile_e = (LAS unsigned char*)(F.lds + MISC_OFF + 512);
            const int ntot = build_tiles(F, F.ctl + CW_CNT + l * 64, tst, tile_e);
            pg8::GroupOrder So{(const char*)(ws + WS_H), (const char*)(ws + WS_W2) + (size_t)l * NE * D * FF, FF, 4, ntot, F.G, F.bid, (size_t)D * FF, tile_e};
            pg8::EpiExpertOut E{(unsigned char*)(ws + WS_Y), KA(b2) + (size_t)l * NE * D, 1.0f / W2_SCALE};
            pg8::gemm_phase_f8<pg8::EpiExpertOut, pg8::GroupOrder, true, true>(F.lds, FF, So, E, F.tid);
        }
        PROBE_END(7);
        SEAM(pb + 7);
        LAUNDER(); PROBE_BEGIN();
        if (PH_ON(8) && IN(pb + 8)) phaseI(F, a, l);
        PROBE_END(8);
        SEAM(pb + 8);
    }
#undef IN
#undef SEAM
}

template <int MASK> static void launch_one(int grid, hipStream_t stream, const Args& a) {
    static bool attr = false;
    if (!attr) { (void)hipFuncSetAttribute((const void*)hybrid_fwd<MASK>, hipFuncAttributeMaxDynamicSharedMemorySize, LDS_BYTES); attr = true; }
    hipLaunchKernelGGL(hybrid_fwd<MASK>, dim3(grid), dim3(NTHR), LDS_BYTES, stream, a);
}
extern "C" void kernel_launch(void* const* d_in, const int* in_sizes, int n_in, void* d_out, int out_size, void* d_ws, size_t ws_size, hipStream_t stream) {
    static int grid = 0;
    if (grid == 0) {
        if (n_in != 19 || out_size != T * D || ws_size < WS_END) { fprintf(stderr, "kernel_launch: unexpected shapes (n_in %d out %d ws %zu need %zu)\n", n_in, out_size, ws_size, (size_t)WS_END); grid = -1; return; }
        int dev = 0, cus = 0;
        if (hipGetDevice(&dev) != hipSuccess || hipDeviceGetAttribute(&cus, hipDeviceAttributeMultiprocessorCount, dev) != hipSuccess) { grid = -1; return; }
        grid = cus;
    }
    if (grid < 0) return;
    (void)hipMemsetAsync((char*)d_ws + WS_CTL, 0, CTL_BYTES, stream);
    Args a{};
    a.x = (const float*)d_in[0]; a.emb_g = (const float*)d_in[1]; a.emb_b = (const float*)d_in[2]; a.w_in = (const float*)d_in[3]; a.b_in = (const float*)d_in[4];
    a.conv_w = (const float*)d_in[5]; a.ml_nw = (const float*)d_in[6]; a.ret_nw = (const float*)d_in[7]; a.w_out = (const float*)d_in[8];
    a.ln1_g = (const float*)d_in[9]; a.ln1_b = (const float*)d_in[10]; a.w_router = (const float*)d_in[11]; a.b_router = (const float*)d_in[12];
    a.w1 = (const float*)d_in[13]; a.b1 = (const float*)d_in[14]; a.w2 = (const float*)d_in[15]; a.b2 = (const float*)d_in[16]; a.ln2_g = (const float*)d_in[17]; a.ln2_b = (const float*)d_in[18];
    a.out = (float*)d_out; a.ws = (unsigned char*)d_ws;
#if MK_MULTI
    a.ph_lo = 0; a.ph_hi = 1; launch_one<0x200>(grid, stream, a);
#define LAUNDER() do { unsigned _lp = (unsigned)(uintptr_t)F.lds; GAS unsigned* _cp = (GAS unsigned*)F.ctl; GAS unsigned char* _wp = (GAS unsigned char*)ws;     \
        F.tid = threadIdx.x; asm volatile("" : "+v"(F.tid)); F.lane = F.tid & 63; F.wave = __builtin_amdgcn_readfirstlane(F.tid >> 6); F.bid = blockIdx.x; F.G = gridDim.x; \
        asm volatile("" : "+s"(F.bid), "+s"(F.G), "+s"(_lp), "+s"(_cp), "+s"(_wp)); \
        F.lds = (LAS unsigned char*)(uintptr_t)_lp; F.ctl = (unsigned*)_cp; ws = (unsigned char*)_wp; } while (0)
    for (int l = 0; l < NL; ++l) {
        const int pb = 1 + l * NPH_LAYER;
#define LP(j) a.ph_lo = pb + (j); a.ph_hi = pb + (j) + 1; launch_one<(1 << (j))>(grid, stream, a);
        LP(0) LP(1) LP(2) LP(3) LP(4) LP(5) LP(6) LP(7) LP(8)
#undef LP
    }
#else
    a.ph_lo = 0; a.ph_hi = NPH; launch_one<0x3ff>(grid, stream, a);
#endif
}
```
